# Optimizing an MI355X kernel written in HIP

```python
import jax, jax.numpy as jnp
from jax import lax
import numpy as np

D_MODEL = 1024
BATCH = 32
SEQ = 2048
DEPTH = 1
DEC_BATCH = 16
DEC_SEQ = 16
PAST_LEN = 4096

CHUNK = 64
Q_BLOCK = 128
RET_HEADS = 4
RET_KEY_DIM = 128
RET_VAL_DIM = 256
FOX_HEADS = 8
FOX_HEAD_DIM = 64
D_FF = 2816
PLE_DIM = 256
N_BRANCH = 2
ROPE_BASE = 10000.0
EPS = 1e-6
RET_QK_W = RET_HEADS * RET_KEY_DIM
RET_V_W = RET_HEADS * RET_VAL_DIM
FOX_W = FOX_HEADS * FOX_HEAD_DIM
IN_SIZES = (RET_QK_W, RET_QK_W, RET_V_W, RET_V_W, FOX_W, FOX_W, FOX_W, FOX_HEADS, N_BRANCH * D_MODEL)
IN_COLS = RET_QK_W * 2 + RET_V_W * 2 + FOX_W * 3 + FOX_HEADS + N_BRANCH * D_MODEL

kernel_name = "hybrid_retention_fox_streaming_step"


def rms_norm(x, g=None):
    xf = x.astype(jnp.float32)
    y = xf * lax.rsqrt(jnp.mean(xf * xf, axis=-1, keepdims=True) + EPS)
    if g is not None:
        y = y * g.astype(jnp.float32)
    return y.astype(x.dtype)


def swiglu(x, w_in, w_out):
    gu = x @ w_in
    g, u = gu[..., :D_FF], gu[..., D_FF:]
    return (jax.nn.silu(g) * u) @ w_out


def rotary(x, pos):
    d = x.shape[-1]
    half = d // 2
    freqs = ROPE_BASE ** (-jnp.arange(half, dtype=jnp.float32) / half)
    ang = pos[:, None] * freqs[None, :]
    c = jnp.cos(ang)[None, :, None, :]
    s = jnp.sin(ang)[None, :, None, :]
    xf = x.astype(jnp.float32)
    x1, x2 = xf[..., :half], xf[..., half:]
    return jnp.concatenate([x1 * c - x2 * s, x1 * s + x2 * c], axis=-1).astype(x.dtype)


def retention(q, k, v, s0, chunk_len):
    B, S, H, dk = q.shape
    dv = v.shape[-1]
    nc = S // chunk_len
    log_gamma = jnp.log(1.0 - 2.0 ** (-5.0 - jnp.arange(H, dtype=jnp.float32)))
    idx = jnp.arange(chunk_len, dtype=jnp.float32)
    intra_decay = jnp.exp(log_gamma[:, None, None] * jnp.abs(idx[:, None] - idx[None, :]))
    inter_decay = jnp.exp(log_gamma[None, :] * (idx[:, None] + 1.0))[None, :, :, None]
    kv_decay = jnp.exp(log_gamma[None, :] * (chunk_len - 1.0 - idx[:, None]))[None, :, :, None]
    chunk_decay = jnp.exp(log_gamma * chunk_len)[None, :, None, None]

    def to_chunks(a):
        return a.reshape(B, nc, chunk_len, H, a.shape[-1]).transpose(1, 0, 2, 3, 4)

    def step(state, qkv):
        qc, kc, vc = (a.astype(jnp.float32) for a in qkv)
        inter = jnp.einsum('bchk,bhkv->bchv', qc, state) * inter_decay
        att = jnp.einsum('bihk,bjhk->bhij', qc, kc) * intra_decay[None]
        intra = jnp.einsum('bhij,bjhv->bihv', att, vc)
        new_state = state * chunk_decay + jnp.einsum('bjhk,bjhv->bhkv', kc * kv_decay, vc)
        return new_state, (inter + intra).astype(v.dtype)

    s_final, o = lax.scan(step, s0.astype(jnp.float32), (to_chunks(q), to_chunks(k), to_chunks(v)))
    o = o.transpose(1, 0, 2, 3, 4).reshape(B, S, H, dv)
    return o, s_final.astype(s0.dtype)


def fox_prompt(q, k, v, logf):
    B, S, H, d = q.shape
    scale = d ** -0.5
    c = jnp.cumsum(logf, axis=1).transpose(0, 2, 1)
    outs = []
    for i0 in range(0, S, Q_BLOCK):
        i1 = i0 + Q_BLOCK
        s = jnp.einsum('bqhd,bkhd->bhqk', q[:, i0:i1], k[:, :i1], preferred_element_type=jnp.float32) * scale
        bias = c[:, :, i0:i1, None] - c[:, :, None, :i1]
        mask = (i0 + jnp.arange(Q_BLOCK))[:, None] >= jnp.arange(i1)[None, :]
        w = jax.nn.softmax(jnp.where(mask, s + bias, -jnp.inf), axis=-1)
        outs.append(jnp.einsum('bhqk,bkhd->bqhd', w.astype(v.dtype), v[:, :i1]))
    return jnp.concatenate(outs, axis=1)


def fox_sample(q, k, v, logf, ck, cv, clogf):
    L = q.shape[1]
    P = ck.shape[1]
    scale = q.shape[-1] ** -0.5
    cn = jnp.cumsum(logf, axis=1).transpose(0, 2, 1)
    clf = clogf.astype(jnp.float32)
    suf = (lax.cumsum(clf, axis=1, reverse=True) - clf).transpose(0, 2, 1)
    s_past = jnp.einsum('bqhd,bkhd->bhqk', q, ck.astype(q.dtype), preferred_element_type=jnp.float32) * scale
    s_past = s_past + cn[..., :, None] + suf[..., None, :]
    s_new = jnp.einsum('bqhd,bkhd->bhqk', q, k, preferred_element_type=jnp.float32) * scale
    s_new = s_new + cn[..., :, None] - cn[..., None, :]
    mask = jnp.arange(L)[:, None] >= jnp.arange(L)[None, :]
    s_new = jnp.where(mask, s_new, -jnp.inf)
    w = jax.nn.softmax(jnp.concatenate([s_past, s_new], axis=-1), axis=-1).astype(v.dtype)
    return (jnp.einsum('bhqk,bkhd->bqhd', w[..., :P], cv.astype(v.dtype))
            + jnp.einsum('bhqk,bkhd->bqhd', w[..., P:], v))


def token_mixer(x, pos, ret_s0, fox_cache, prm, ret_chunk):
    B, S, _ = x.shape
    h = rms_norm(x, prm['norm_mix_g'])
    z = h @ prm['w_in_mix']
    parts = []
    off = 0
    for n in IN_SIZES:
        parts.append(z[..., off:off + n])
        off += n
    rq, rk, rv, rg, fq, fk, fv, ff, zg = parts
    q = rotary(rq.reshape(B, S, RET_HEADS, RET_KEY_DIM), pos)
    k = rotary(rk.reshape(B, S, RET_HEADS, RET_KEY_DIM), pos) * (RET_KEY_DIM ** -0.5)
    v = rv.reshape(B, S, RET_HEADS, RET_VAL_DIM)
    o_ret, ret_state = retention(q, k, v, ret_s0, ret_chunk)
    o_ret = rms_norm(o_ret).reshape(B, S, RET_V_W) * jax.nn.silu(rg)
    br_ret = o_ret @ prm['w_br_ret']
    fq = rms_norm(fq.reshape(B, S, FOX_HEADS, FOX_HEAD_DIM), prm['q_norm_g'])
    fk = rms_norm(fk.reshape(B, S, FOX_HEADS, FOX_HEAD_DIM), prm['k_norm_g'])
    fv = fv.reshape(B, S, FOX_HEADS, FOX_HEAD_DIM)
    logf = jax.nn.log_sigmoid(ff.astype(jnp.float32) + prm['b_forget'].astype(jnp.float32))
    if fox_cache is None:
        o_fox = fox_prompt(fq, fk, fv, logf)
    else:
        o_fox = fox_sample(fq, fk, fv, logf, *fox_cache)
    br_fox = o_fox.reshape(B, S, FOX_W) @ prm['w_br_fox']
    g = jax.nn.sigmoid(zg).reshape(B, S, N_BRANCH, D_MODEL)
    y = (g[..., 0, :] * br_ret + g[..., 1, :] * br_fox) @ prm['w_out']
    return y, ret_state, fk, fv, logf


def layer(x, p, pos, ret_s0, fox_cache, prm, ret_chunk):
    x = x + 0.5 * swiglu(rms_norm(x, prm['norm_ffn1_g']), prm['ffn1_w_in'], prm['ffn1_w_out'])
    y, ret_state, fk, fv, logf = token_mixer(x, pos, ret_s0, fox_cache, prm, ret_chunk)
    x = x + y
    x = x + 0.5 * swiglu(rms_norm(x, prm['norm_ffn2_g']), prm['ffn2_w_in'], prm['ffn2_w_out'])
    gate = jax.nn.sigmoid(rms_norm(x, prm['norm_ple_g']) @ prm['w_ple_gate'])
    x = x + (p @ prm['w_ple']) * gate
    return x, ret_state, fk, fv, logf


def setup_inputs(seed: int = 0) -> dict:
    key = jax.random.key(seed)
    ks = jax.random.split(key, 32)
    f32 = jnp.float32

    def nrm(k, shape, scale):
        return jax.random.normal(k, shape, f32) * scale

    def gain(k, shape):
        return 1.0 + 0.05 * jax.random.normal(k, shape, f32)

    return {
        'x_prompt': nrm(ks[0], (BATCH, SEQ, D_MODEL), 1.0),
        'x_sample': nrm(ks[1], (DEC_BATCH, DEC_SEQ, D_MODEL), 1.0),
        'p_prompt': nrm(ks[2], (DEPTH, BATCH, SEQ, PLE_DIM), 1.0),
        'p_sample': nrm(ks[3], (DEPTH, DEC_BATCH, DEC_SEQ, PLE_DIM), 1.0),
        'state_ret': nrm(ks[4], (DEPTH, DEC_BATCH, RET_HEADS, RET_KEY_DIM, RET_VAL_DIM), 0.1),
        'cache_fox_k': nrm(ks[5], (DEPTH, DEC_BATCH, PAST_LEN, FOX_HEADS, FOX_HEAD_DIM), 1.0),
        'cache_fox_v': nrm(ks[6], (DEPTH, DEC_BATCH, PAST_LEN, FOX_HEADS, FOX_HEAD_DIM), 1.0),
        'cache_fox_logf': jax.nn.log_sigmoid(2.0 + jax.random.normal(ks[7], (DEPTH, DEC_BATCH, PAST_LEN, FOX_HEADS), f32)),
        'norm_ffn1_g': gain(ks[8], (DEPTH, D_MODEL)),
        'ffn1_w_in': nrm(ks[9], (DEPTH, D_MODEL, 2 * D_FF), D_MODEL ** -0.5),
        'ffn1_w_out': nrm(ks[10], (DEPTH, D_FF, D_MODEL), D_FF ** -0.5),
        'norm_mix_g': gain(ks[11], (DEPTH, D_MODEL)),
        'w_in_mix': nrm(ks[12], (DEPTH, D_MODEL, IN_COLS), D_MODEL ** -0.5),
        'b_forget': 1.0 + 0.1 * jax.random.normal(ks[13], (DEPTH, FOX_HEADS), f32),
        'q_norm_g': gain(ks[14], (DEPTH, FOX_HEAD_DIM)),
        'k_norm_g': gain(ks[15], (DEPTH, FOX_HEAD_DIM)),
        'w_br_ret': nrm(ks[16], (DEPTH, RET_V_W, D_MODEL), RET_V_W ** -0.5),
        'w_br_fox': nrm(ks[17], (DEPTH, FOX_W, D_MODEL), FOX_W ** -0.5),
        'w_out': nrm(ks[18], (DEPTH, D_MODEL, D_MODEL), D_MODEL ** -0.5),
        'norm_ffn2_g': gain(ks[19], (DEPTH, D_MODEL)),
        'ffn2_w_in': nrm(ks[20], (DEPTH, D_MODEL, 2 * D_FF), D_MODEL ** -0.5),
        'ffn2_w_out': nrm(ks[21], (DEPTH, D_FF, D_MODEL), D_FF ** -0.5),
        'norm_ple_g': gain(ks[22], (DEPTH, D_MODEL)),
        'w_ple': nrm(ks[23], (DEPTH, PLE_DIM, D_MODEL), PLE_DIM ** -0.5),
        'w_ple_gate': nrm(ks[24], (DEPTH, D_MODEL, D_MODEL), D_MODEL ** -0.5),
    }


def reference(x_prompt, x_sample, p_prompt, p_sample, state_ret, cache_fox_k, cache_fox_v, cache_fox_logf,
              norm_ffn1_g, ffn1_w_in, ffn1_w_out, norm_mix_g, w_in_mix, b_forget, q_norm_g, k_norm_g,
              w_br_ret, w_br_fox, w_out, norm_ffn2_g, ffn2_w_in, ffn2_w_out, norm_ple_g, w_ple, w_ple_gate):
    B, S, _ = x_prompt.shape
    DB, L, _ = x_sample.shape
    pos_prompt = jnp.arange(S, dtype=jnp.float32)
    pos_sample = PAST_LEN + jnp.arange(L, dtype=jnp.float32)
    xp, xs = x_prompt, x_sample
    rp_l, kp_l, vp_l, lp_l = [], [], [], []
    rs_l, ks_l, vs_l, ls_l = [], [], [], []
    for i in range(DEPTH):
        prm = {
            'norm_ffn1_g': norm_ffn1_g[i], 'ffn1_w_in': ffn1_w_in[i], 'ffn1_w_out': ffn1_w_out[i],
            'norm_mix_g': norm_mix_g[i], 'w_in_mix': w_in_mix[i], 'b_forget': b_forget[i],
            'q_norm_g': q_norm_g[i], 'k_norm_g': k_norm_g[i], 'w_br_ret': w_br_ret[i],
            'w_br_fox': w_br_fox[i], 'w_out': w_out[i], 'norm_ffn2_g': norm_ffn2_g[i],
            'ffn2_w_in': ffn2_w_in[i], 'ffn2_w_out': ffn2_w_out[i], 'norm_ple_g': norm_ple_g[i],
            'w_ple': w_ple[i], 'w_ple_gate': w_ple_gate[i],
        }
        s0_prompt = jnp.zeros((B, RET_HEADS, RET_KEY_DIM, RET_VAL_DIM), state_ret.dtype)
        xp, rp, kp, vp, lp = layer(xp, p_prompt[i], pos_prompt, s0_prompt, None, prm, CHUNK)
        xs, rs, ks_, vs, ls = layer(xs, p_sample[i], pos_sample, state_ret[i],
                                    (cache_fox_k[i], cache_fox_v[i], cache_fox_logf[i]), prm, L)
        rp_l.append(rp); kp_l.append(kp); vp_l.append(vp); lp_l.append(lp)
        rs_l.append(rs); ks_l.append(ks_); vs_l.append(vs); ls_l.append(ls)
    new_state_ret_prompt = jnp.stack(rp_l)
    new_fox_k_prompt = jnp.stack(kp_l)
    new_fox_v_prompt = jnp.stack(vp_l)
    new_fox_logf_prompt = jnp.stack(lp_l)
    new_state_ret_sample = jnp.stack(rs_l)
    new_fox_k_sample = jnp.stack(ks_l)
    new_fox_v_sample = jnp.stack(vs_l)
    new_fox_logf_sample = jnp.stack(ls_l)
    return (xp, xs, new_state_ret_prompt, new_fox_k_prompt, new_fox_v_prompt, new_fox_logf_prompt,
            new_state_ret_sample, new_fox_k_sample, new_fox_v_sample, new_fox_logf_sample)
```

```cpp
#include <hip/hip_runtime.h>
#include <hip/hip_cooperative_groups.h>
#include <cstdio>
#include <cstdint>
#include <hip/hip_bf16.h>
#include <cmath>
namespace cg = cooperative_groups;
namespace pg8 {
#define PG8_LAS __attribute__((address_space(3)))
typedef unsigned short bf16_t;
typedef short bf16x8 __attribute__((ext_vector_type(8)));
typedef float f32x4 __attribute__((ext_vector_type(4)));
typedef unsigned u32x4 __attribute__((ext_vector_type(4)));
constexpr int BM = 256, BK = 64, HALF = 128, HTB = HALF * BK * 2  , STAGE_BYTES = 8 * HTB, NXCD = 8, WGM = 8;

__host__ __device__ __forceinline__ int lds_byte(int r, int c) { const int st = (r >> 4) * 2 + (c >> 5), rr = r & 15, cc = c & 31, ob = rr * 64 + cc * 2; return st * 1024 + (ob ^ (((ob >> 9) & 1) << 5)); }
__host__ __device__ __forceinline__ void stage_rc(int b, int& R, int& C) { const int st = b / 1024, sb = b % 1024, swz = sb ^ (((sb >> 9) & 1) << 5); R = (st >> 1) * 16 + swz / 64; C = (st & 1) * 32 + (swz % 64) / 2; }
__host__ __device__ __forceinline__ int perm32(int rho) { const int n = rho >> 4, i = rho & 15; return 8 * (i >> 2) + 4 * n + (i & 3); }

struct Unit { int pm, pn; };
struct Gemm { const bf16_t* A; const bf16_t* Bt; int M, N, K; };

struct StaticOrder {
    int nM, nN, nwg, G, c;
    __host__ __device__ void init(int M, int N, int G_, int c_) { nM = M / BM; nN = N / BM; nwg = nM * nN; G = G_; c = c_; }
    __host__ __device__ bool next(int i, Unit& u) const {
        const long L = (long)i * G + c; if (L >= nwg) return false;
        int wgid = (int)L; { const int q = nwg / NXCD, r = nwg % NXCD, xcd = wgid % NXCD, off = wgid / NXCD; wgid = (xcd < r ? xcd * (q + 1) : r * (q + 1) + (xcd - r) * q) + off; }
        const int nig = WGM * nN, gid = wgid / nig, fm = gid * WGM, gsz = (nM - fm) < WGM ? (nM - fm) : WGM;
        u.pm = fm + ((wgid % nig) % gsz); u.pn = (wgid % nig) / gsz; return true;
    }
    __device__ __forceinline__ void a_ready(const Unit&) const {}
    __device__ __forceinline__ void done(const Unit&) const {}
};

typedef float f32x2c __attribute__((ext_vector_type(2))); typedef __bf16 bf16x2c __attribute__((ext_vector_type(2)));
__device__ __forceinline__ unsigned cvt_pk_bf16(float lo, float hi) { f32x2c v = {lo, hi}; bf16x2c b = __builtin_convertvector(v, bf16x2c); return __builtin_bit_cast(unsigned, b); }
typedef float f32x2 __attribute__((ext_vector_type(2)));
template <class Epi, class Sched, bool ALIGN_EPI = false, bool SP2 = false>
__device__ __forceinline__ void gemm_phase(PG8_LAS unsigned char* lds, const Gemm g, const Sched& S, const Epi& E) {
    int tid = threadIdx.x; asm volatile("" : "+v"(tid)); const int wid = __builtin_amdgcn_readfirstlane(tid >> 6), lane = tid & 63, wr = wid >> 2, wc = wid & 3, fr = lane & 15, fq = lane >> 4;
    const int K = g.K, nt = K / BK;
    unsigned voffA[2], voffB[2];
#pragma unroll
    for (int i = 0; i < 2; ++i) { int R, C; stage_rc(tid * 16 + i * 8192, R, C); const int Rb = Epi::PERM ? ((R & ~31) + perm32(R & 31)) : R;
        voffA[i] = (unsigned)(R * K + C) * 2u; voffB[i] = (unsigned)(Rb * K + C) * 2u; }
    const size_t kstep = (size_t)(BK * 2);
    const size_t hstep = (size_t)HALF * K * 2;
    const size_t tstep = 2 * hstep;
    const unsigned ldsw = (unsigned)wid * 1024u;
    const int aoff = lds_byte(wr * 64 + fr, fq * 8), boff = lds_byte(wc * 32 + fr, fq * 8);
#define PG8_SA(b, h) (((b) * 2 + (h)) * HTB)
#define PG8_SB(b, h) ((4 + (b) * 2 + (h)) * HTB)
#define PG8_STAGE(bufoff, gbase, voff) do { _Pragma("unroll") for (int _i = 0; _i < 2; ++_i) \
        __builtin_amdgcn_global_load_lds((const unsigned*)((const char*)(gbase) + (voff)[_i]), (PG8_LAS unsigned*)(lds + (bufoff) + ldsw + _i * 8192), 16, 0, 0); } while (0)
#define PG8_LDA(dst, b, h) do { _Pragma("unroll") for (int m = 0; m < 4; ++m) _Pragma("unroll") for (int k = 0; k < 2; ++k) dst[m][k] = *(const PG8_LAS bf16x8*)(lds + PG8_SA(b, h) + aoff + m * 2048 + k * 1024); } while (0)
#define PG8_LDB(dst, b, h) do { _Pragma("unroll") for (int n = 0; n < 2; ++n) _Pragma("unroll") for (int k = 0; k < 2; ++k) dst[n][k] = *(const PG8_LAS bf16x8*)(lds + PG8_SB(b, h) + boff + n * 2048 + k * 1024); } while (0)
#define PG8_MMA(ai, bj, At, Bt) do { __builtin_amdgcn_s_setprio(1); _Pragma("unroll") for (int m = 0; m < 4; ++m) _Pragma("unroll") for (int n = 0; n < 2; ++n) _Pragma("unroll") for (int k = 0; k < 2; ++k) \
        acc[ai][bj][m][n] = __builtin_amdgcn_mfma_f32_16x16x32_bf16(Bt[n][k], At[m][k], acc[ai][bj][m][n], 0, 0, 0); __builtin_amdgcn_s_setprio(0); } while (0)
#define PG8_WAIT_V(n) asm volatile("s_waitcnt vmcnt(" #n ")" ::: "memory")
#define PG8_WAIT_L(n) asm volatile("s_waitcnt lgkmcnt(" #n ")" ::: "memory")
#define PG8_BAR __builtin_amdgcn_s_barrier()
#define PG8_SCHED __builtin_amdgcn_sched_barrier(0)
    Unit cur, nxt; int ui = 0;
    if (!S.next(0, cur)) return;
    f32x4 acc[2][2][4][2];
#pragma unroll
    for (int a = 0; a < 2; ++a)
#pragma unroll
        for (int b = 0; b < 2; ++b)
#pragma unroll
            for (int m = 0; m < 4; ++m)
#pragma unroll
                for (int n = 0; n < 2; ++n) acc[a][b][m][n] = (f32x4){0.f, 0.f, 0.f, 0.f};
    bf16x8 At[4][2], B0[2][2], B1[2][2];
    const char* cA = (const char*)g.A + (size_t)cur.pm * tstep; const char* cB = (const char*)g.Bt + (size_t)cur.pn * tstep;
    S.a_ready(cur);
    if constexpr (SP2) {
        PG8_STAGE(PG8_SB(0, 0), cB, voffB); PG8_STAGE(PG8_SB(0, 1), cB + hstep, voffB); PG8_STAGE(PG8_SA(0, 0), cA, voffA); PG8_STAGE(PG8_SA(0, 1), cA + hstep, voffA);
        if (wr == 1) PG8_BAR;
        PG8_WAIT_V(2); PG8_BAR;
        PG8_STAGE(PG8_SB(1, 0), cB + kstep, voffB); PG8_STAGE(PG8_SA(1, 0), cA + kstep, voffA); PG8_STAGE(PG8_SB(1, 1), cB + hstep + kstep, voffB);
        PG8_WAIT_V(6); PG8_BAR;
    } else {
        PG8_STAGE(PG8_SB(0, 0), cB, voffB); PG8_STAGE(PG8_SA(0, 0), cA, voffA); PG8_STAGE(PG8_SB(0, 1), cB + hstep, voffB); PG8_STAGE(PG8_SA(0, 1), cA + hstep, voffA);
        if (wr == 1) PG8_BAR;
        PG8_WAIT_V(4); PG8_BAR;
        PG8_STAGE(PG8_SB(1, 0), cB + kstep, voffB); PG8_STAGE(PG8_SA(1, 0), cA + kstep, voffA); PG8_STAGE(PG8_SB(1, 1), cB + hstep + kstep, voffB);
        PG8_WAIT_V(6); PG8_BAR;
    }
    for (;;) {
        const bool has_next = S.next(ui + 1, nxt);
        const char* nA = has_next ? (const char*)g.A + (size_t)nxt.pm * tstep : cA; const char* nB = has_next ? (const char*)g.Bt + (size_t)nxt.pn * tstep : cB;
        for (int t = 0; t < nt; t += 2) {
            const bool last = (t == nt - 2);
            const char* a1 = cA + (size_t)(t + 1) * kstep;
            const char* a2 = last ? nA : cA + (size_t)(t + 2) * kstep; const char* b2 = last ? nB : cB + (size_t)(t + 2) * kstep;
            const char* a3 = a2 + kstep; const char* b3 = b2 + kstep;
            if (last && has_next) S.a_ready(nxt);
            if constexpr (SP2) {
            PG8_LDB(B0, 0, 0); PG8_LDB(B1, 0, 1); PG8_SCHED; PG8_LDA(At, 0, 0); PG8_STAGE(PG8_SA(1, 1), a1 + hstep, voffA);
            PG8_WAIT_V(8); PG8_WAIT_L(0); PG8_BAR; PG8_MMA(0, 0, At, B0); PG8_MMA(0, 1, At, B1); PG8_BAR; PG8_SCHED;
            PG8_LDA(At, 0, 1); PG8_STAGE(PG8_SB(0, 0), b2, voffB); PG8_STAGE(PG8_SB(0, 1), b2 + hstep, voffB); PG8_STAGE(PG8_SA(0, 0), a2, voffA);
            PG8_WAIT_V(8); PG8_WAIT_L(0); PG8_BAR; PG8_MMA(1, 0, At, B0); PG8_MMA(1, 1, At, B1); PG8_BAR; PG8_SCHED;
            PG8_LDB(B0, 1, 0); PG8_LDB(B1, 1, 1); PG8_SCHED; PG8_LDA(At, 1, 0); PG8_STAGE(PG8_SA(0, 1), a2 + hstep, voffA);
            PG8_WAIT_V(8); PG8_WAIT_L(0); PG8_BAR; PG8_MMA(0, 0, At, B0); PG8_MMA(0, 1, At, B1); PG8_BAR; PG8_SCHED;
            PG8_LDA(At, 1, 1); PG8_STAGE(PG8_SB(1, 0), b3, voffB); PG8_STAGE(PG8_SB(1, 1), b3 + hstep, voffB); PG8_STAGE(PG8_SA(1, 0), a3, voffA);
            PG8_WAIT_V(8); PG8_WAIT_L(0); PG8_BAR; PG8_MMA(1, 0, At, B0); PG8_MMA(1, 1, At, B1); PG8_BAR; PG8_SCHED;
            } else {
            PG8_LDB(B0, 0, 0); PG8_SCHED; PG8_LDA(At, 0, 0); PG8_STAGE(PG8_SA(1, 1), a1 + hstep, voffA);
            PG8_WAIT_L(8); PG8_BAR; PG8_WAIT_L(0); PG8_MMA(0, 0, At, B0); PG8_BAR; PG8_SCHED;
            PG8_LDB(B1, 0, 1); PG8_STAGE(PG8_SB(0, 0), b2, voffB);
            PG8_BAR; PG8_WAIT_L(0); PG8_MMA(0, 1, At, B1); PG8_BAR;
            PG8_LDA(At, 0, 1); PG8_STAGE(PG8_SA(0, 0), a2, voffA);
            PG8_BAR; PG8_WAIT_L(0); PG8_MMA(1, 0, At, B0); PG8_BAR; PG8_SCHED;
            PG8_STAGE(PG8_SB(0, 1), b2 + hstep, voffB);
            PG8_WAIT_V(6); PG8_BAR; PG8_MMA(1, 1, At, B1); PG8_BAR;
            PG8_LDB(B0, 1, 0); PG8_SCHED; PG8_LDA(At, 1, 0); PG8_STAGE(PG8_SA(0, 1), a2 + hstep, voffA);
            PG8_WAIT_L(8); PG8_BAR; PG8_WAIT_L(0); PG8_MMA(0, 0, At, B0); PG8_BAR; PG8_SCHED;
            PG8_LDB(B1, 1, 1); PG8_STAGE(PG8_SB(1, 0), b3, voffB);
            PG8_BAR; PG8_WAIT_L(0); PG8_MMA(0, 1, At, B1); PG8_BAR;
            PG8_LDA(At, 1, 1); PG8_STAGE(PG8_SA(1, 0), a3, voffA);
            PG8_BAR; PG8_WAIT_L(0); PG8_MMA(1, 0, At, B0); PG8_BAR; PG8_SCHED;
            PG8_STAGE(PG8_SB(1, 1), b3 + hstep, voffB);
            PG8_WAIT_V(6); PG8_BAR; PG8_MMA(1, 1, At, B1); PG8_BAR;
            }
        }
        if constexpr (ALIGN_EPI) { if (wr == 0) PG8_BAR; }
        if constexpr (!Epi::AFTER_DRAIN) { E(acc, cur, wr, wc, fr, fq); S.done(cur); }
        if (!has_next) break;
#pragma unroll
        for (int a = 0; a < 2; ++a)
#pragma unroll
            for (int b = 0; b < 2; ++b)
#pragma unroll
                for (int m = 0; m < 4; ++m)
#pragma unroll
                    for (int n = 0; n < 2; ++n) acc[a][b][m][n] = (f32x4){0.f, 0.f, 0.f, 0.f};
        cur = nxt; cA = nA; cB = nB; ++ui;
        if constexpr (ALIGN_EPI) { if (wr == 1) PG8_BAR; }
    }
    PG8_WAIT_V(0);
    if constexpr (!ALIGN_EPI) { if (wr == 0) PG8_BAR; }
    PG8_BAR;
    if constexpr (Epi::AFTER_DRAIN) { E.fused(acc, cur, wr, wc, fr, fq, lds, wid, lane); S.done(cur); }
#undef PG8_SA
#undef PG8_SB
#undef PG8_STAGE
#undef PG8_LDA
#undef PG8_LDB
#undef PG8_MMA
#undef PG8_WAIT_V
#undef PG8_WAIT_L
#undef PG8_BAR
#undef PG8_SCHED
}
}
namespace attn_body {
using bf16=__hip_bfloat16;
using bf16x8=__attribute__((ext_vector_type(8)))short;
using s16x4=__attribute__((ext_vector_type(4)))short;
using f32x16=__attribute__((ext_vector_type(16)))float;
using u32x4=__attribute__((ext_vector_type(4)))unsigned;
using f32x4v=__attribute__((ext_vector_type(4)))float;
constexpr int BATCH=32,NHEAD=8,SEQ=2048,D=64,DM=NHEAD*D;
constexpr int NW=8,QBLK=32,QB=QBLK*NW,KVBLK=64,NQB=SEQ/QB;
constexpr int ATTN_PITCH=DM, ATTN_UNIT_ROWS=QB;
__device__ __forceinline__ int crow(int r,int hi){return (r&3)+8*(r>>2)+4*hi;}
#define SBAR() __builtin_amdgcn_sched_barrier(0)
__device__ __forceinline__ void cmask(f32x16&p0,f32x16&p1,int jb,int qrel,int hi){
  const float NEG=-INFINITY; int kb=64*jb+4*hi;
  #pragma unroll
  for(int r=0;r<16;++r){int kv=kb+(r&3)+8*(r>>2); if(kv>qrel)p0[r]=NEG; if(kv+32>qrel)p1[r]=NEG;}
}

constexpr int NSLOT=3, SLOTB=8192;
constexpr int LDS_K=0, LDS_V=NSLOT*SLOTB, LDS_WS=2*NSLOT*SLOTB, LDS_OST=LDS_WS+NW*64*4, LDS_CB=LDS_OST+NW*4096, LDS_CBX=LDS_CB+2048*4, LDS_BYTES=LDS_CBX+64;
constexpr float C2=0.125f*1.4426950408889634f;
__device__ __forceinline__ void glds16(const void*gsrc,unsigned lds_dst){unsigned keep;
  asm volatile("s_mov_b32 %0, m0\n\ts_mov_b32 m0, %2\n\ts_nop 0\n\tglobal_load_lds_dwordx4 %1, off\n\ts_mov_b32 m0, %0":"=&s"(keep):"v"(gsrc),"s"(lds_dst):"memory");}
__device__ __forceinline__ float max3f(float a,float b,float c){float r;asm("v_max3_f32 %0, %1, %2, %3":"=v"(r):"v"(a),"v"(b),"v"(c));return r;}
__device__ __forceinline__ float max2f(float a,float b){float r;asm("v_max_f32_e32 %0, %1, %2":"=v"(r):"v"(a),"v"(b));return r;}
__device__ __forceinline__ float fadd_s(float a,float b){float r;asm("v_add_f32_e32 %0, %1, %2":"=v"(r):"v"(a),"v"(b));return r;}
__device__ __forceinline__ float fsub_s(float a,float b){float r;asm("v_sub_f32_e32 %0, %1, %2":"=v"(r):"v"(a),"v"(b));return r;}
typedef float f32x2_t __attribute__((ext_vector_type(2))); typedef __bf16 bf16x2_t __attribute__((ext_vector_type(2)));
__device__ __forceinline__ unsigned cvtpk_s(float lo,float hi){f32x2_t v={lo,hi};bf16x2_t b=__builtin_convertvector(v,bf16x2_t);return __builtin_bit_cast(unsigned,b);}
#define WAIT_BAR(N) asm volatile("s_waitcnt vmcnt(" #N ") lgkmcnt(0)\n\ts_barrier":::"memory")

__device__ __forceinline__ void qkt(f32x16&p0,f32x16&p1,const char*Kslot,const bf16x8*qr,const f32x16&negm,int r32,int hi){
  const char*kb=Kslot+hi*1024+r32*16;
  #pragma unroll
  for(int d0=0;d0<4;++d0){
    const bf16x8 b0=*reinterpret_cast<const bf16x8*>(kb+d0*2048);
    const bf16x8 b1=*reinterpret_cast<const bf16x8*>(kb+d0*2048+512);
    if(d0==0){p0=__builtin_amdgcn_mfma_f32_32x32x16_bf16(b0,qr[0],negm,0,0,0);p1=__builtin_amdgcn_mfma_f32_32x32x16_bf16(b1,qr[0],negm,0,0,0);}
    else{p0=__builtin_amdgcn_mfma_f32_32x32x16_bf16(b0,qr[d0],p0,0,0,0);p1=__builtin_amdgcn_mfma_f32_32x32x16_bf16(b1,qr[d0],p1,0,0,0);}}
}
typedef __attribute__((address_space(3))) const char* lds_cptr;
typedef short v4i16_t __attribute__((ext_vector_type(4)));
__device__ __forceinline__ void kload8(bf16x8*kf,lds_cptr kp){
  kf[0]=*(const __attribute__((address_space(3))) bf16x8*)(kp);      kf[1]=*(const __attribute__((address_space(3))) bf16x8*)(kp+512);
  kf[2]=*(const __attribute__((address_space(3))) bf16x8*)(kp+2048); kf[3]=*(const __attribute__((address_space(3))) bf16x8*)(kp+2560);
  kf[4]=*(const __attribute__((address_space(3))) bf16x8*)(kp+4096); kf[5]=*(const __attribute__((address_space(3))) bf16x8*)(kp+4608);
  kf[6]=*(const __attribute__((address_space(3))) bf16x8*)(kp+6144); kf[7]=*(const __attribute__((address_space(3))) bf16x8*)(kp+6656);
}
__device__ __forceinline__ void kload2(bf16x8*kf,lds_cptr kp,int j){ kf[2*j]=*(const __attribute__((address_space(3))) bf16x8*)(kp+j*2048); kf[2*j+1]=*(const __attribute__((address_space(3))) bf16x8*)(kp+j*2048+512); }
__device__ __forceinline__ s16x4 vtr(lds_cptr p){ return __builtin_bit_cast(s16x4,__builtin_amdgcn_ds_read_tr16_b64_v4i16((__attribute__((address_space(3))) v4i16_t*)p)); }
__device__ __forceinline__ float rowmax(const f32x16&p0,const f32x16&p1){
  float a=max3f(p0[0],p0[1],p1[0]),b=max3f(p0[2],p0[3],p1[1]);a=max3f(a,p1[2],p1[3]);
  #pragma unroll
  for(int r=4;r<16;r+=4){a=max3f(a,p0[r],p0[r+1]);b=max3f(b,p0[r+2],p0[r+3]);a=max3f(a,p1[r],p1[r+1]);b=max3f(b,p1[r+2],p1[r+3]);}
  const float m=max2f(a,b);
  auto rr=__builtin_amdgcn_permlane32_swap(__float_as_uint(m),__float_as_uint(m),false,false);
  return max2f(__uint_as_float(rr[0]),__uint_as_float(rr[1]));
}
__device__ __forceinline__ void pv(f32x16*o,int vb,bf16x8 pa0,bf16x8 pa1,bf16x8 pa2,bf16x8 pa3){
  #pragma unroll
  for(int d0=0;d0<2;++d0){s16x4 lo[4],hi[4];
    #pragma unroll
    for(int ks=0;ks<4;++ks){
      asm volatile("ds_read_b64_tr_b16 %0,%1 offset:%c2":"=&v"(lo[ks]):"v"(vb),"i"(d0*4096+ks*1024):"memory");
      asm volatile("ds_read_b64_tr_b16 %0,%1 offset:%c2":"=&v"(hi[ks]):"v"(vb),"i"(d0*4096+ks*1024+512):"memory");}
    asm volatile("s_waitcnt lgkmcnt(0)":::"memory");SBAR();
    #define PK(k) (bf16x8){lo[k][0],lo[k][1],lo[k][2],lo[k][3],hi[k][0],hi[k][1],hi[k][2],hi[k][3]}
    o[d0]=__builtin_amdgcn_mfma_f32_32x32x16_bf16(pa0,PK(0),o[d0],0,0,0);
    o[d0]=__builtin_amdgcn_mfma_f32_32x32x16_bf16(pa1,PK(1),o[d0],0,0,0);
    o[d0]=__builtin_amdgcn_mfma_f32_32x32x16_bf16(pa2,PK(2),o[d0],0,0,0);
    o[d0]=__builtin_amdgcn_mfma_f32_32x32x16_bf16(pa3,PK(3),o[d0],0,0,0);
    #undef PK
  }
}

#ifndef ATTN_STORE16
#define ATTN_STORE16(p,v) (*(u32x4*)(p)=(v))
#endif
template<int THRL> __device__ __forceinline__ void attn_unit(int b,int h,int qb,const bf16*Q,const bf16*__restrict__ K,const bf16*__restrict__ V,bf16*O,const float*__restrict__ LF,char*shm){
  int tid=threadIdx.x; asm volatile("":"+v"(tid)); const int lane=tid&63,r32=lane&31,hi=lane>>5; const int wid=__builtin_amdgcn_readfirstlane(tid>>6);
  const long rowbase=(long)b*SEQ; const int q0=qb*QB;
  const bf16*Qw=Q+(rowbase+q0+wid*QBLK)*DM+h*D;
  const bf16*Kh=K+rowbase*DM+h*D,*Vh=V+rowbase*DM+h*D;
  const unsigned lds0=(unsigned)(uintptr_t)shm;
  float*wsf=(float*)(shm+LDS_WS)+wid*64;
  const bf16*ksrc=Kh+(long)lane*DM+wid*8;
  const bf16*vsrc=Vh+(long)(16*(wid&3)+(lane>>2))*DM+(wid>>2)*32+(lane&3)*8;
  const unsigned kdst=lds0+LDS_K+wid*1024, vdst=lds0+LDS_V+wid*1024;
  #define DMA_K(t,slot) glds16(ksrc+(long)(t)*KVBLK*DM,(unsigned)__builtin_amdgcn_readfirstlane(kdst+(slot)))
  #define DMA_V(t,slot) glds16(vsrc+(long)(t)*KVBLK*DM,(unsigned)__builtin_amdgcn_readfirstlane(vdst+(slot)))
  const int vb0=(int)(lds0+LDS_V)+((lane>>4)&1)*32+(lane&3)*8+(4*hi+((lane&15)>>2))*64;
  const char*Kbase=shm+LDS_K; bf16x8 kf[8];
  const lds_cptr shm3=(lds_cptr)shm; const lds_cptr kp0=shm3+LDS_K+hi*1024+r32*16; const lds_cptr vp0=shm3+LDS_V+((lane>>4)&1)*32+(lane&3)*8+(4*hi+((lane&15)>>2))*64;
  const int NT=(q0+QB)/KVBLK;
  typedef __attribute__((address_space(3))) const f32x4v* lds_f4p;
  typedef __attribute__((address_space(3))) float* lds_fp;
  {
    lds_fp cbw=(lds_fp)(shm3+LDS_CB); lds_fp cbx=(lds_fp)(shm3+LDS_CBX);
    const int nk=q0+QB; float v0=0.f,v1=0.f,v2=0.f,v3=0.f;
    if(4*tid<nk){ const float*lp=LF+((long)(rowbase+4*tid))*NHEAD+h; v0=lp[0]; v1=lp[NHEAD]; v2=lp[2*NHEAD]; v3=lp[3*NHEAD]; }
    v1+=v0; v2+=v1; v3+=v2; float tot=v3;
    #pragma unroll
    for(int o_=1;o_<64;o_<<=1){ float u_=__shfl_up(tot,o_); if(lane>=o_)tot+=u_; }
    if(lane==63)cbx[wid]=tot;
    asm volatile("s_waitcnt vmcnt(0) lgkmcnt(0)\n\ts_barrier":::"memory");
    float base=tot-v3;
    #pragma unroll
    for(int w_=0;w_<NW;++w_){ float x_=cbx[w_]; if(w_<wid)base+=x_; }
    v0+=base;v1+=base;v2+=base;v3+=base;
    if(4*tid==q0)cbx[8]=v0;
    asm volatile("s_waitcnt vmcnt(0) lgkmcnt(0)\n\ts_barrier":::"memory");
    const float cref=cbx[8]; const float L2E=1.4426950408889634f;
    if(4*tid<nk){ cbw[4*tid]=(cref-v0)*L2E; cbw[4*tid+1]=(cref-v1)*L2E; cbw[4*tid+2]=(cref-v2)*L2E; cbw[4*tid+3]=(cref-v3)*L2E; }
    asm volatile("s_waitcnt vmcnt(0) lgkmcnt(0)\n\ts_barrier":::"memory");
  }
  const lds_f4p cbp=(lds_f4p)(shm3+LDS_CB)+hi;
  #define CBIAS(P0,P1,t) do{ const lds_f4p bp_=cbp+16*(t); _Pragma("unroll") for(int a_=0;a_<4;++a_){ const f32x4v b0_=bp_[2*a_], b1_=bp_[8+2*a_]; \
      P0[4*a_]+=b0_[0];P0[4*a_+1]+=b0_[1];P0[4*a_+2]+=b0_[2];P0[4*a_+3]+=b0_[3]; P1[4*a_]+=b1_[0];P1[4*a_+1]+=b1_[1];P1[4*a_+2]+=b1_[2];P1[4*a_+3]+=b1_[3]; } }while(0)
  DMA_K(0,0);DMA_V(0,0);DMA_K(1,SLOTB);
  bf16x8 qr[4];
  #pragma unroll
  for(int d0=0;d0<4;++d0)qr[d0]=*reinterpret_cast<const bf16x8*>(&Qw[(long)r32*DM+d0*16+hi*8]);
  float mhat=0.f,l_reg=0.f;f32x16 o[2];o[0]=f32x16{};o[1]=f32x16{};f32x16 negm=f32x16{};asm volatile("":"+v"(negm));
  const int qrel=wid*QBLK+r32;
  #define CMASK(P0,P1,t) do{int jb_=(t)-(NT-4); if(jb_>=0)cmask(P0,P1,jb_,qrel,hi);}while(0)
  bool resc=false;
  #define START(P0,P1) do{ const float rm=rowmax(P0,P1); resc=false; \
    { const float dl=rm; mhat=fadd_s(mhat,dl); \
      _Pragma("unroll") for(int r=0;r<16;++r){P0[r]=fsub_s(P0[r],dl);P1[r]=fsub_s(P1[r],dl);} \
      _Pragma("unroll") for(int r=0;r<16;++r)negm[r]=-mhat; asm volatile("":"+v"(negm)); } \
    _Pragma("unroll") for(int r=0;r<16;++r)P0[r]=__builtin_amdgcn_exp2f(P0[r]); }while(0)
  #define RESC() do{ if(resc){ asm volatile("s_waitcnt lgkmcnt(0)":::"memory"); \
      _Pragma("unroll") for(int d_=0;d_<2;++d_) _Pragma("unroll") for(int r=0;r<16;++r)o[d_][r]*=wsf[crow(r,hi)]; } }while(0)
  f32x16 pA0,pA1,pB0,pB1;
  int sl_prev=0,sl_cur=0,sl_next=SLOTB;
  #define ROT() do{sl_prev=sl_cur;sl_cur=sl_next;sl_next=(sl_next==(NSLOT-1)*SLOTB)?0:sl_next+SLOTB;}while(0)
  DMA_K(2,2*SLOTB);
  WAIT_BAR(3);
  qkt(pA0,pA1,Kbase,qr,negm,r32,hi);asm volatile("s_nop 15\n\ts_nop 7":"+v"(pA0),"+v"(pA1));CMASK(pA0,pA1,0);CBIAS(pA0,pA1,0);
  START(pA0,pA1);
  _Pragma("unroll") for(int r=0;r<16;++r)pA1[r]=__builtin_amdgcn_exp2f(pA1[r]);
  WAIT_BAR(0);
  DMA_K(3,0);DMA_V(1,SLOTB);
  ROT();
  kload8(kf,kp0+sl_cur);
  WAIT_BAR(2);
  s16x4 vlo[8],vhi[8]; u32x4 pw0,pw1,pw2,pw3;
  #define PKW(P,B) cvtpk_s(P[B],P[B+1])
  #define PAF(k) __builtin_bit_cast(bf16x8,pw##k)
  #define VFR(i) (bf16x8){vlo[i][0],vlo[i][1],vlo[i][2],vlo[i][3],vhi[i][0],vhi[i][1],vhi[i][2],vhi[i][3]}
  #define PIN(x) asm volatile("":"+v"(x))
  #define MX3(a,b,c) __builtin_fmaxf(__builtin_fmaxf((a),(b)),(c))
  #define GAPA(MF,A0,A1,A2,A3,W0,W1,PW) do{ MF; sacc+=A0; sacc+=A1; sacc+=A2; sacc+=A3; PIN(sacc); W0; W1; PIN(PW); SBAR(); }while(0)
  #define EX(v) __builtin_amdgcn_exp2f(v)
  #define GAPB(MF,X,B) do{ MF; X[B]=EX(X[B]); X[B+1]=EX(X[B+1]); X[B+2]=EX(X[B+2]); X[B+3]=EX(X[B+3]); PIN(X); SBAR(); }while(0)
  #define VRD(i) do{ vlo[i]=vtr(vp_+(((i)>>2)*4096+((i)&3)*1024)); vhi[i]=vtr(vp_+(((i)>>2)*4096+((i)&3)*1024+512)); }while(0)
  #define KRD(G,j) do{ if(G){ kload2(kf,kp0+sl_next,j); SBAR(); } }while(0)
  #define STEP(C0,C1,P0,P1,t,GK,GV,GL) do{ SBAR(); \
    const lds_cptr vp_=vp0+sl_prev; \
    VRD(0); SBAR(); float sacc=(P0[0]+P0[1]); \
    GAPA(C0=__builtin_amdgcn_mfma_f32_32x32x16_bf16(kf[0],qr[0],negm,0,0,0), P0[2],P0[3],P0[4],P0[5],     pw0[0]=PKW(P0,0), pw0[1]=PKW(P0,2), pw0); \
    VRD(4); SBAR(); GAPA(C1=__builtin_amdgcn_mfma_f32_32x32x16_bf16(kf[1],qr[0],negm,0,0,0), P0[6],P0[7],P0[8],P0[9],     pw0[2]=PKW(P0,4), pw0[3]=PKW(P0,6), pw0); \
    VRD(1); SBAR(); GAPA(C0=__builtin_amdgcn_mfma_f32_32x32x16_bf16(kf[2],qr[1],C0,0,0,0),   P0[10],P0[11],P0[12],P0[13], pw1[0]=PKW(P0,8), pw1[1]=PKW(P0,10), pw1); \
    VRD(5); SBAR(); GAPA(C1=__builtin_amdgcn_mfma_f32_32x32x16_bf16(kf[3],qr[1],C1,0,0,0),   P0[14],P0[15],P1[0],P1[1],   pw1[2]=PKW(P0,12),pw1[3]=PKW(P0,14), pw1); \
    VRD(2); SBAR(); GAPA(C0=__builtin_amdgcn_mfma_f32_32x32x16_bf16(kf[4],qr[2],C0,0,0,0),   P1[2],P1[3],P1[4],P1[5],     pw2[0]=PKW(P1,0), pw2[1]=PKW(P1,2), pw2); \
    VRD(6); SBAR(); GAPA(C1=__builtin_amdgcn_mfma_f32_32x32x16_bf16(kf[5],qr[2],C1,0,0,0),   P1[6],P1[7],P1[8],P1[9],     pw2[2]=PKW(P1,4), pw2[3]=PKW(P1,6), pw2); \
    VRD(3); SBAR(); GAPA(C0=__builtin_amdgcn_mfma_f32_32x32x16_bf16(kf[6],qr[3],C0,0,0,0),   P1[10],P1[11],P1[12],P1[13], pw3[0]=PKW(P1,8), pw3[1]=PKW(P1,10), pw3); \
    VRD(7); SBAR(); GAPA(C1=__builtin_amdgcn_mfma_f32_32x32x16_bf16(kf[7],qr[3],C1,0,0,0),   P1[14],P1[15],0.f,0.f,       pw3[2]=PKW(P1,12),pw3[3]=PKW(P1,14), pw3); \
    l_reg+=sacc; \
    if(GK){DMA_K((t)+3,sl_cur);} if(GV){DMA_V((t)+1,sl_next);} \
    CMASK(C0,C1,t); CBIAS(C0,C1,t); \
    { float a=MX3(C0[0],C0[1],C1[0]),b=MX3(C0[2],C0[3],C1[1]); a=MX3(a,C1[2],C1[3]); \
      _Pragma("unroll") for(int r=4;r<16;r+=4){a=MX3(a,C0[r],C0[r+1]);b=MX3(b,C0[r+2],C0[r+3]);a=MX3(a,C1[r],C1[r+1]);b=MX3(b,C1[r+2],C1[r+3]);} \
      float rm=__builtin_fmaxf(a,b); { auto rr=__builtin_amdgcn_permlane32_swap(__float_as_uint(rm),__float_as_uint(rm),false,false); rm=__builtin_fmaxf(__uint_as_float(rr[0]),__uint_as_float(rr[1])); } \
      resc=false; \
      if(__builtin_expect(__any(rm>(float)THRL),0)){ const float dl=__builtin_fmaxf(rm,0.f); mhat+=dl; \
        _Pragma("unroll") for(int r=0;r<16;++r){C0[r]-=dl;C1[r]-=dl;} \
        _Pragma("unroll") for(int r=0;r<16;++r)negm[r]=-mhat; asm volatile("":"+v"(negm)); \
        const float f=__builtin_amdgcn_exp2f(-dl); l_reg*=f; if(hi==0)wsf[r32]=f; resc=true; } } \
    SBAR(); \
    GAPB(o[0]=__builtin_amdgcn_mfma_f32_32x32x16_bf16(PAF(0),VFR(0),o[0],0,0,0), C0,0); \
    GAPB(o[1]=__builtin_amdgcn_mfma_f32_32x32x16_bf16(PAF(0),VFR(4),o[1],0,0,0), C0,4); \
    KRD(GL,0); GAPB(o[0]=__builtin_amdgcn_mfma_f32_32x32x16_bf16(PAF(1),VFR(1),o[0],0,0,0), C0,8); \
    KRD(GL,1); GAPB(o[1]=__builtin_amdgcn_mfma_f32_32x32x16_bf16(PAF(1),VFR(5),o[1],0,0,0), C0,12); \
    KRD(GL,2); GAPB(o[0]=__builtin_amdgcn_mfma_f32_32x32x16_bf16(PAF(2),VFR(2),o[0],0,0,0), C1,0); \
    KRD(GL,3); GAPB(o[1]=__builtin_amdgcn_mfma_f32_32x32x16_bf16(PAF(2),VFR(6),o[1],0,0,0), C1,4); \
    GAPB(o[0]=__builtin_amdgcn_mfma_f32_32x32x16_bf16(PAF(3),VFR(3),o[0],0,0,0), C1,8); \
    GAPB(o[1]=__builtin_amdgcn_mfma_f32_32x32x16_bf16(PAF(3),VFR(7),o[1],0,0,0), C1,12); \
    }while(0)
  int t=1;
  #undef CMASK
  #define CMASK(P0,P1,t) do{}while(0)
  for(;t+5<NT;t+=2){
    STEP(pB0,pB1,pA0,pA1,t,true,true,true);     WAIT_BAR(2); RESC(); ROT();
    STEP(pA0,pA1,pB0,pB1,t+1,true,true,true);   WAIT_BAR(2); RESC(); ROT();
  }
  #undef CMASK
  #define CMASK(P0,P1,t) do{int jb_=(t)-(NT-4); if(jb_>=0)cmask(P0,P1,jb_,qrel,hi);}while(0)
  #define ENDW(tt) do{ if((tt)+3<NT){WAIT_BAR(2);} else if((tt)+2<NT){WAIT_BAR(1);} else {WAIT_BAR(0);} }while(0)
  for(;t+1<NT;t+=2){
    STEP(pB0,pB1,pA0,pA1,t,(t+3<NT),(t+1<NT),(t+1<NT));       ENDW(t);   RESC(); ROT();
    STEP(pA0,pA1,pB0,pB1,t+1,(t+4<NT),(t+2<NT),(t+2<NT));     ENDW(t+1); RESC(); ROT();
  }
  STEP(pB0,pB1,pA0,pA1,NT-1,false,false,false); RESC();
  { float sacc=pB0[0]+pB0[1]; _Pragma("unroll") for(int r=2;r<16;++r)sacc+=pB0[r]; _Pragma("unroll") for(int r=0;r<16;++r)sacc+=pB1[r]; l_reg+=sacc;
    pw0=(u32x4){PKW(pB0,0),PKW(pB0,2),PKW(pB0,4),PKW(pB0,6)};pw1=(u32x4){PKW(pB0,8),PKW(pB0,10),PKW(pB0,12),PKW(pB0,14)};pw2=(u32x4){PKW(pB1,0),PKW(pB1,2),PKW(pB1,4),PKW(pB1,6)};pw3=(u32x4){PKW(pB1,8),PKW(pB1,10),PKW(pB1,12),PKW(pB1,14)};
    SBAR(); pv(o,vb0+sl_cur,PAF(0),PAF(1),PAF(2),PAF(3)); }
  #undef PKW
  #undef PAF
  #undef VFR
  #undef PIN
  #undef MX3
  #undef GAPA
  #undef GAPB
  #undef EX
  #undef VRD
  #undef KRD
  #undef STEP
  #undef ENDW
  {auto rr=__builtin_amdgcn_permlane32_swap(__float_as_uint(l_reg),__float_as_uint(l_reg),false,false);l_reg=__uint_as_float(rr[0])+__uint_as_float(rr[1]);}
  if(hi==0)wsf[32+r32]=l_reg;asm volatile("s_waitcnt lgkmcnt(0)":::"memory");
  float rli[16];
  #pragma unroll
  for(int r=0;r<16;++r)rli[r]=__builtin_amdgcn_rcpf(wsf[32+crow(r,hi)]);
  bf16*Ow=O+(rowbase+q0+wid*QBLK)*DM+h*D;
  { bf16*stg=(bf16*)(shm+LDS_OST)+wid*2048;
    #pragma unroll
    for(int r=0;r<16;++r){const int orow=crow(r,hi);
      #pragma unroll
      for(int d0=0;d0<2;++d0)stg[orow*64+d0*32+r32]=__float2bfloat16(o[d0][r]*rli[r]);}
    asm volatile("s_waitcnt lgkmcnt(0)":::"memory");
    #pragma unroll
    for(int i=0;i<4;++i){const int row=i*8+(lane>>3),ch=lane&7; const u32x4 v=*(const u32x4*)(stg+row*64+ch*8); ATTN_STORE16(Ow+(long)row*DM+ch*8,v);} }
  asm volatile("s_waitcnt lgkmcnt(0)\n\ts_barrier":::"memory");
  #undef DMA_K
  #undef DMA_V
  #undef CMASK
  #undef CBIAS
  #undef START
  #undef RESC
  #undef ROT
}
constexpr int ATTN_LDS_BYTES=LDS_BYTES;
#undef SBAR
#undef WAIT_BAR
}
namespace xb {
#define XLAS __attribute__((address_space(3)))
#define XB_TMO      128
#define XB_XCNT(j)  (256  + 64 * (j))
#define XB_XSUB(j)  (1280 + 64 * (j))
#define XB_XGEN(j)  (2304 + 64 * (j))
#define XB_TOP      3328
#define XB_TOPGEN   3392
#define XCD_BAR_WORDS 3456
#define XB_SPIN_CAP (1u << 18)

__device__ __forceinline__ unsigned xb_ld(unsigned* p)              { return __hip_atomic_load(p, __ATOMIC_RELAXED, __HIP_MEMORY_SCOPE_AGENT); }
__device__ __forceinline__ unsigned xb_add(unsigned* p, unsigned v) { return __hip_atomic_fetch_add(p, v, __ATOMIC_RELAXED, __HIP_MEMORY_SCOPE_AGENT); }
__device__ __forceinline__ unsigned xb_xcc_id() { return (unsigned)__builtin_amdgcn_s_getreg((3 << 11) | 20) & 0xFu; }
#define XB_SPIN(cond, bar) do { unsigned _sp = 0; while (cond) { __builtin_amdgcn_s_sleep(1); \
    if ((++_sp & 255u) == 0u) { if (xb_ld(&(bar)[XB_TMO])) break; if (_sp > XB_SPIN_CAP) { atomicAdd(&(bar)[XB_TMO], 1u); break; } } } } while (0)

struct XcdBarrier {
    unsigned* bar; unsigned x;
    volatile XLAS unsigned* st;
};

__device__ __forceinline__ XcdBarrier xcd_barrier_post(unsigned* bar, volatile XLAS unsigned* st) {
    XcdBarrier b; b.bar = bar; b.x = xb_xcc_id(); b.st = st;
    if (threadIdx.x == 0) (void)xb_add(&bar[XB_XCNT(b.x)], 1u);
    return b;
}
__device__ __forceinline__ void xcd_barrier_complete(unsigned* bar, unsigned x, unsigned& nloc, unsigned& nx) {
    const unsigned G = gridDim.x * gridDim.y * gridDim.z;
    unsigned sum, cnt, mine, sp = 0u;
    for (;;) {
        sum = 0u; cnt = 0u; mine = 0u;
#pragma unroll
        for (unsigned j = 0; j < 16; ++j) { const unsigned c = xb_ld(&bar[XB_XCNT(j)]); sum += c; cnt += (c > 0u) ? 1u : 0u; mine = (j == x) ? c : mine; }
        if (sum == G) break;
        __builtin_amdgcn_s_sleep(1);
        if ((++sp & 255u) == 0u) { if (xb_ld(&bar[XB_TMO])) break; if (sp > XB_SPIN_CAP) { atomicAdd(&bar[XB_TMO], 1u); break; } }
    }
    nloc = mine > 0u ? mine : 1u; nx = cnt > 0u ? cnt : 1u;
}

__device__ __forceinline__ void xcd_barrier(const XcdBarrier& b) {
    asm volatile("s_waitcnt vmcnt(0)" ::: "memory");
    __syncthreads();
    if (threadIdx.x == 0) {
        unsigned* bar = b.bar;
        __builtin_amdgcn_s_waitcnt(0);
        unsigned nloc = b.st[0], nx = b.st[1];
        if (nloc == 0u) { xcd_barrier_complete(bar, b.x, nloc, nx); b.st[0] = nloc; b.st[1] = nx; }
        const unsigned old = xb_add(&bar[XB_XSUB(b.x)], 1u);
        const unsigned gen = old / nloc;
        if (old + 1u == (gen + 1u) * nloc) {
            __builtin_amdgcn_fence(__ATOMIC_RELEASE, "agent");
            asm volatile("s_waitcnt vmcnt(0)" ::: "memory");
            const unsigned og = xb_add(&bar[XB_TOP], 1u);
            const unsigned tg = og / nx;
            if (og + 1u == (tg + 1u) * nx) xb_add(&bar[XB_TOPGEN], 1u);
            else XB_SPIN(xb_ld(&bar[XB_TOPGEN]) == tg, bar);
            __builtin_amdgcn_fence(__ATOMIC_ACQUIRE, "agent");
            xb_add(&bar[XB_XGEN(b.x)], 1u);
            asm volatile("s_waitcnt vmcnt(0)" ::: "memory");
        } else {
            XB_SPIN(xb_ld(&bar[XB_XGEN(b.x)]) == gen, bar);
            __builtin_amdgcn_fence(__ATOMIC_ACQUIRE, "agent");
            asm volatile("s_waitcnt vmcnt(0)" ::: "memory");
        }
    }
    __syncthreads();
}
}
namespace mk {
#define LAS __attribute__((address_space(3)))
typedef unsigned short u16;
typedef pg8::f32x4 f32x4;
typedef pg8::u32x4 u32x4;
typedef pg8::bf16x8 bf16x8;
typedef unsigned u32x2 __attribute__((ext_vector_type(2)));
using pg8::cvt_pk_bf16;

constexpr int DMODEL = 1024, SEQ = 2048, MP = 65536, MS = 256, MT = MP + MS, DFF = 2816, NMIX = 6912, PAST = 4096, NPOS = 2048 + 16;
constexpr float L2E = 1.4426950408889634f;
constexpr float QC2 = 0.125f * L2E;

constexpr size_t SZ1024 = (size_t)MT * 1024 * 2, SZ512 = (size_t)MT * 512 * 2;
constexpr size_t O_CTL = 0;
constexpr size_t O_SS = 65536;
constexpr size_t O_TABC = O_SS + (size_t)MT * 64;
constexpr size_t O_TABS = O_TABC + (size_t)NPOS * 256;
constexpr size_t O_W1IN = O_TABS + (size_t)NPOS * 256;
constexpr size_t O_W1OUT = O_W1IN + (size_t)5632 * 1024 * 2;
constexpr size_t O_WMIX = O_W1OUT + (size_t)1024 * 2816 * 2;
constexpr size_t O_WBR = O_WMIX + (size_t)NMIX * 1024 * 2;
constexpr size_t O_WBF = O_WBR + (size_t)1024 * 1024 * 2;
constexpr size_t O_WOUT = O_WBF + (size_t)1024 * 512 * 2;
constexpr size_t O_W2IN = O_WOUT + (size_t)1024 * 1024 * 2;
constexpr size_t O_W2OUT = O_W2IN + (size_t)5632 * 1024 * 2;
constexpr size_t O_WPLE = O_W2OUT + (size_t)1024 * 2816 * 2;
constexpr size_t O_WPG = O_WPLE + (size_t)1024 * 256 * 2;
constexpr size_t O_XB = O_WPG + (size_t)1024 * 1024 * 2;
constexpr size_t O_RQK = O_XB + SZ1024;
constexpr size_t O_RV = O_RQK + SZ1024;
constexpr size_t O_RG = O_RV + SZ1024;
constexpr size_t O_FQ = O_RG + SZ1024;
constexpr size_t O_FK = O_FQ + SZ512;
constexpr size_t O_FV = O_FK + SZ512;
constexpr size_t O_ZG = O_FV + SZ512;
constexpr size_t WS_NEED = O_ZG + (size_t)MT * 2048 * 2;
constexpr size_t O_ACT1 = O_RQK;
constexpr size_t O_ACT2 = O_RV;
static_assert(O_ACT1 + (size_t)MT * DFF * 2 <= O_FQ, "act1 overlay");
static_assert(O_ACT2 + (size_t)MT * DFF * 2 <= O_FV, "act2 overlay");
static_assert(WS_NEED <= 1073741824ull, "ws");
constexpr size_t OUT_YP = 0, OUT_YS = OUT_YP + (size_t)MP * 1024, OUT_RSP = OUT_YS + (size_t)MS * 1024, OUT_KP = OUT_RSP + (size_t)32 * 4 * 128 * 256,
                 OUT_VP = OUT_KP + (size_t)MP * 512, OUT_LP = OUT_VP + (size_t)MP * 512, OUT_RSS = OUT_LP + (size_t)MP * 8, OUT_KS = OUT_RSS + (size_t)16 * 4 * 128 * 256,
                 OUT_VS = OUT_KS + (size_t)MS * 512, OUT_LS = OUT_VS + (size_t)MS * 512, OUT_END = OUT_LS + (size_t)MS * 8;

constexpr int LDS_BYTES = 147456;

__device__ __forceinline__ float bf2f(unsigned h) { return __uint_as_float(h << 16); }
__device__ __forceinline__ float bflo(unsigned w) { return __uint_as_float(w << 16); }
__device__ __forceinline__ float bfhi(unsigned w) { return __uint_as_float(w & 0xffff0000u); }
__device__ __forceinline__ float fast_sigmoid(float x) { return __builtin_amdgcn_rcpf(1.f + __builtin_amdgcn_exp2f(-x * L2E)); }
__device__ __forceinline__ float wave_sum(float v) {
#pragma unroll
    for (int o = 1; o < 64; o <<= 1) v += __shfl_xor(v, o);
    return v;
}
__device__ __forceinline__ float wave_max(float v) {
#pragma unroll
    for (int o = 1; o < 64; o <<= 1) v = fmaxf(v, __shfl_xor(v, o));
    return v;
}
__device__ __forceinline__ float rstd_of(const float* ss, int row) {
    const f32x4* p = (const f32x4*)(ss + (size_t)row * 16); const f32x4 a = p[0], b = p[1], c = p[2], d = p[3];
    const float s = (((a[0] + a[1]) + (a[2] + a[3])) + ((b[0] + b[1]) + (b[2] + b[3]))) + (((c[0] + c[1]) + (c[2] + c[3])) + ((d[0] + d[1]) + (d[2] + d[3])));
    return rsqrtf(s * (1.f / 1024.f) + 1e-6f);
}
__device__ __forceinline__ int gcol(int q) { return (q & 128) + (q & 96) + ((q >> 2) & 3) * 8 + ((q >> 4) & 1) * 4 + (q & 3); }

struct EpiSwiglu {
    static constexpr bool PERM = false, AFTER_DRAIN = false;
    u16* O; const float* ss;
    __device__ __forceinline__ void operator()(const f32x4 (&acc)[2][2][4][2], const pg8::Unit& u, int wr, int wc, int fr, int fq) const {
        const int col = u.pn * 128 + wc * 32 + fq * 8;
#pragma unroll
        for (int ai = 0; ai < 2; ++ai)
#pragma unroll
            for (int m = 0; m < 4; ++m) {
                const int row = u.pm * 256 + ai * 128 + wr * 64 + m * 16 + fr; const float rs = rstd_of(ss, row);
                float a[8];
#pragma unroll
                for (int n = 0; n < 2; ++n)
#pragma unroll
                    for (int e = 0; e < 4; ++e) { const float g = acc[ai][0][m][n][e] * rs, uu = acc[ai][1][m][n][e] * rs; a[n * 4 + e] = g * uu * fast_sigmoid(g); }
                u32x4 w; w.x = cvt_pk_bf16(a[0], a[1]); w.y = cvt_pk_bf16(a[2], a[3]); w.z = cvt_pk_bf16(a[4], a[5]); w.w = cvt_pk_bf16(a[6], a[7]);
                *(u32x4*)(O + (size_t)row * DFF + col) = w;
            }
    }
};
struct EpiResid {
    static constexpr bool PERM = false, AFTER_DRAIN = false;
    const float* srcP; const float* srcS; float* dstP; float* dstS; u16* XB; float* ss; float alpha;
    __device__ __forceinline__ void operator()(const f32x4 (&acc)[2][2][4][2], const pg8::Unit& u, int wr, int wc, int fr, int fq) const {
#pragma unroll
        for (int ai = 0; ai < 2; ++ai)
#pragma unroll
            for (int m = 0; m < 4; ++m) {
                const int row = u.pm * 256 + ai * 128 + wr * 64 + m * 16 + fr;
                const float* src = row < MP ? srcP + (size_t)row * 1024 : srcS + (size_t)(row - MP) * 1024;
                float* dst = row < MP ? dstP + (size_t)row * 1024 : dstS + (size_t)(row - MP) * 1024;
                float q = 0.f;
#pragma unroll
                for (int bj = 0; bj < 2; ++bj) {
                    const int col = u.pn * 256 + bj * 128 + wc * 32 + fq * 8;
                    const f32x4 x0 = *(const f32x4*)(src + col), x1 = *(const f32x4*)(src + col + 4);
                    const f32x4 v0 = x0 + acc[ai][bj][m][0] * alpha, v1 = x1 + acc[ai][bj][m][1] * alpha;
                    *(f32x4*)(dst + col) = v0; *(f32x4*)(dst + col + 4) = v1;
                    u32x4 w; w.x = cvt_pk_bf16(v0[0], v0[1]); w.y = cvt_pk_bf16(v0[2], v0[3]); w.z = cvt_pk_bf16(v1[0], v1[1]); w.w = cvt_pk_bf16(v1[2], v1[3]);
                    *(u32x4*)(XB + (size_t)row * 1024 + col) = w;
                    q += (v0[0] * v0[0] + v0[1] * v0[1]) + (v0[2] * v0[2] + v0[3] * v0[3]) + (v1[0] * v1[0] + v1[1] * v1[1]) + (v1[2] * v1[2] + v1[3] * v1[3]);
                }
                q += __shfl_xor(q, 16); q += __shfl_xor(q, 32);
                if (fq == 0) ss[(size_t)row * 16 + u.pn * 4 + wc] = q;
            }
    }
};
struct EpiMix {
    static constexpr bool PERM = false, AFTER_DRAIN = false;
    const float* ss; const float* tabc; const float* tabs; const float* qg; const float* kg; const float* bfg;
    u16 *RQK, *RV, *RG, *FQ, *FK, *FV, *ZG; float* out;
    template <int MODE> static __device__ __forceinline__ void store8(const f32x4 (&acc)[2][2][4][2], u16* base, int ld, int t, int row, float rs, int ai, int m, int wc, int fq) {
#pragma unroll
        for (int bj = 0; bj < 2; ++bj) {
            float a[8];
#pragma unroll
            for (int n = 0; n < 2; ++n)
#pragma unroll
                for (int e = 0; e < 4; ++e) { const float v = acc[ai][bj][m][n][e] * rs; a[n * 4 + e] = MODE == 0 ? v : (MODE == 1 ? v * fast_sigmoid(v) : fast_sigmoid(v)); }
            u32x4 w; w.x = cvt_pk_bf16(a[0], a[1]); w.y = cvt_pk_bf16(a[2], a[3]); w.z = cvt_pk_bf16(a[4], a[5]); w.w = cvt_pk_bf16(a[6], a[7]);
            *(u32x4*)(base + (size_t)row * ld + t * 256 + bj * 128 + wc * 32 + fq * 8) = w;
        }
    }
    template <bool ISK> static __device__ __forceinline__ void headnorm(const f32x4 (&acc)[2][2][4][2], u16* dst, const float* gn, float* o, int row, float rs, int ai, int m, int head, int fq) {
        float q = 0.f;
#pragma unroll
        for (int bj = 0; bj < 2; ++bj)
#pragma unroll
            for (int n = 0; n < 2; ++n) { const f32x4 v = acc[ai][bj][m][n] * rs; q += (v[0] * v[0] + v[1] * v[1]) + (v[2] * v[2] + v[3] * v[3]); }
        q += __shfl_xor(q, 16); q += __shfl_xor(q, 32);
        const float hr = rsqrtf(q * (1.f / 64.f) + 1e-6f) * rs * (ISK ? 1.f : QC2);
#pragma unroll
        for (int bj = 0; bj < 2; ++bj)
#pragma unroll
            for (int n = 0; n < 2; ++n) {
                const int d = 32 * bj + 16 * n + 4 * fq; const f32x4 g4 = *(const f32x4*)(gn + d); const f32x4 v = acc[ai][bj][m][n] * hr * g4;
                u32x2 w; w.x = cvt_pk_bf16(v[0], v[1]); w.y = cvt_pk_bf16(v[2], v[3]);
                *(u32x2*)(dst + (size_t)row * 512 + head * 64 + d) = w;
                if (ISK) *(f32x4*)(o + head * 64 + d) = v;
            }
    }
    __device__ __forceinline__ void operator()(const f32x4 (&acc)[2][2][4][2], const pg8::Unit& u, int wr, int wc, int fr, int fq) const {
        const int pn = u.pn;
#pragma unroll
        for (int ai = 0; ai < 2; ++ai)
#pragma unroll
            for (int m = 0; m < 4; ++m) {
                const int row = u.pm * 256 + ai * 128 + wr * 64 + m * 16 + fr; const float rs = rstd_of(ss, row);
                if (pn < 4) {
                    const int pidx = row < MP ? (row & (SEQ - 1)) : SEQ + ((row - MP) & 15);
                    const int d = 16 * wc + 4 * fq;
                    const f32x4 c = *(const f32x4*)(tabc + pidx * 64 + d), s = *(const f32x4*)(tabs + pidx * 64 + d);
                    const float sc = rs * (pn >= 2 ? 0.08838834764831845f : 1.f);
#pragma unroll
                    for (int bj = 0; bj < 2; ++bj) {
                        const f32x4 x1 = acc[ai][bj][m][0] * sc, x2 = acc[ai][bj][m][1] * sc;
                        const f32x4 o1 = x1 * c - x2 * s, o2 = x1 * s + x2 * c;
                        u16* p = RQK + (size_t)row * 1024 + (pn >> 1) * 512 + (2 * (pn & 1) + bj) * 128 + d;
                        u32x2 w1, w2; w1.x = cvt_pk_bf16(o1[0], o1[1]); w1.y = cvt_pk_bf16(o1[2], o1[3]); w2.x = cvt_pk_bf16(o2[0], o2[1]); w2.y = cvt_pk_bf16(o2[2], o2[3]);
                        *(u32x2*)p = w1; *(u32x2*)(p + 64) = w2;
                    }
                } else if (pn < 8) { store8<0>(acc, RV, 1024, pn - 4, row, rs, ai, m, wc, fq);
                } else if (pn < 12) { store8<1>(acc, RG, 1024, pn - 8, row, rs, ai, m, wc, fq);
                } else if (pn >= 19) { store8<2>(acc, ZG, 2048, pn - 19, row, rs, ai, m, wc, fq);
                } else if (pn < 14) { headnorm<false>(acc, FQ, qg, nullptr, row, rs, ai, m, 4 * (pn & 1) + wc, fq);
                } else if (pn < 16) { headnorm<true>(acc, FK, kg, row < MP ? out + OUT_KP + (size_t)row * 512 : out + OUT_KS + (size_t)(row - MP) * 512, row, rs, ai, m, 4 * (pn & 1) + wc, fq);
                } else if (pn < 18) {
                    float* o = row < MP ? out + OUT_VP + (size_t)row * 512 : out + OUT_VS + (size_t)(row - MP) * 512;
#pragma unroll
                    for (int bj = 0; bj < 2; ++bj) {
                        const int col = (pn - 16) * 256 + bj * 128 + wc * 32 + fq * 8;
                        const f32x4 v0 = acc[ai][bj][m][0] * rs, v1 = acc[ai][bj][m][1] * rs;
                        u32x4 w; w.x = cvt_pk_bf16(v0[0], v0[1]); w.y = cvt_pk_bf16(v0[2], v0[3]); w.z = cvt_pk_bf16(v1[0], v1[1]); w.w = cvt_pk_bf16(v1[2], v1[3]);
                        *(u32x4*)(FV + (size_t)row * 512 + col) = w; *(f32x4*)(o + col) = v0; *(f32x4*)(o + col + 4) = v1;
                    }
                } else {
                    if (wc == 0 && fq == 0) {
                        float* o = row < MP ? out + OUT_LP + (size_t)row * 8 : out + OUT_LS + (size_t)(row - MP) * 8;
#pragma unroll
                        for (int n = 0; n < 2; ++n) { f32x4 r;
#pragma unroll
                            for (int e = 0; e < 4; ++e) { const float x = acc[ai][0][m][n][e] * rs + bfg[n * 4 + e]; r[e] = fminf(x, 0.f) - __logf(1.f + __expf(-fabsf(x))); }
                            *(f32x4*)(o + n * 4) = r; }
                    }
                }
            }
    }
};
template <bool SECOND> struct EpiGate {
    static constexpr bool PERM = false, AFTER_DRAIN = false;
    u16* T; const u16* ZG;
    __device__ __forceinline__ void operator()(const f32x4 (&acc)[2][2][4][2], const pg8::Unit& u, int wr, int wc, int fr, int fq) const {
#pragma unroll
        for (int ai = 0; ai < 2; ++ai)
#pragma unroll
            for (int m = 0; m < 4; ++m) {
                const int row = u.pm * 256 + ai * 128 + wr * 64 + m * 16 + fr;
#pragma unroll
                for (int bj = 0; bj < 2; ++bj) {
                    const int col = u.pn * 256 + bj * 128 + wc * 32 + fq * 8;
                    const u32x4 g = *(const u32x4*)(ZG + (size_t)row * 2048 + (SECOND ? 1024 : 0) + col);
                    const f32x4 a0 = acc[ai][bj][m][0], a1 = acc[ai][bj][m][1];
                    float v[8] = {bflo(g.x) * a0[0], bfhi(g.x) * a0[1], bflo(g.y) * a0[2], bfhi(g.y) * a0[3], bflo(g.z) * a1[0], bfhi(g.z) * a1[1], bflo(g.w) * a1[2], bfhi(g.w) * a1[3]};
                    u16* tp = T + (size_t)row * 1024 + col;
                    if (SECOND) { const u32x4 p = *(const u32x4*)tp; v[0] += bflo(p.x); v[1] += bfhi(p.x); v[2] += bflo(p.y); v[3] += bfhi(p.y); v[4] += bflo(p.z); v[5] += bfhi(p.z); v[6] += bflo(p.w); v[7] += bfhi(p.w); }
                    u32x4 w; w.x = cvt_pk_bf16(v[0], v[1]); w.y = cvt_pk_bf16(v[2], v[3]); w.z = cvt_pk_bf16(v[4], v[5]); w.w = cvt_pk_bf16(v[6], v[7]);
                    *(u32x4*)tp = w;
                }
            }
    }
};
struct EpiPlain {
    static constexpr bool PERM = false, AFTER_DRAIN = false;
    u16* O;
    __device__ __forceinline__ void operator()(const f32x4 (&acc)[2][2][4][2], const pg8::Unit& u, int wr, int wc, int fr, int fq) const {
#pragma unroll
        for (int ai = 0; ai < 2; ++ai)
#pragma unroll
            for (int m = 0; m < 4; ++m) {
                const int row = u.pm * 256 + ai * 128 + wr * 64 + m * 16 + fr;
#pragma unroll
                for (int bj = 0; bj < 2; ++bj) {
                    const int col = u.pn * 256 + bj * 128 + wc * 32 + fq * 8; const f32x4 a0 = acc[ai][bj][m][0], a1 = acc[ai][bj][m][1];
                    u32x4 w; w.x = cvt_pk_bf16(a0[0], a0[1]); w.y = cvt_pk_bf16(a0[2], a0[3]); w.z = cvt_pk_bf16(a1[0], a1[1]); w.w = cvt_pk_bf16(a1[2], a1[3]);
                    *(u32x4*)(O + (size_t)row * 1024 + col) = w;
                }
            }
    }
};
struct EpiFinal {
    static constexpr bool PERM = false, AFTER_DRAIN = false;
    float* yP; float* yS; const u16* PLE; const float* ss;
    __device__ __forceinline__ void operator()(const f32x4 (&acc)[2][2][4][2], const pg8::Unit& u, int wr, int wc, int fr, int fq) const {
#pragma unroll
        for (int ai = 0; ai < 2; ++ai)
#pragma unroll
            for (int m = 0; m < 4; ++m) {
                const int row = u.pm * 256 + ai * 128 + wr * 64 + m * 16 + fr; const float rs = rstd_of(ss, row);
                float* y = row < MP ? yP + (size_t)row * 1024 : yS + (size_t)(row - MP) * 1024;
#pragma unroll
                for (int bj = 0; bj < 2; ++bj) {
                    const int col = u.pn * 256 + bj * 128 + wc * 32 + fq * 8;
                    const u32x4 p = *(const u32x4*)(PLE + (size_t)row * 1024 + col);
                    f32x4 y0 = *(const f32x4*)(y + col), y1 = *(const f32x4*)(y + col + 4);
                    const f32x4 a0 = acc[ai][bj][m][0] * rs, a1 = acc[ai][bj][m][1] * rs;
                    y0[0] += bflo(p.x) * fast_sigmoid(a0[0]); y0[1] += bfhi(p.x) * fast_sigmoid(a0[1]); y0[2] += bflo(p.y) * fast_sigmoid(a0[2]); y0[3] += bfhi(p.y) * fast_sigmoid(a0[3]);
                    y1[0] += bflo(p.z) * fast_sigmoid(a1[0]); y1[1] += bfhi(p.z) * fast_sigmoid(a1[1]); y1[2] += bflo(p.w) * fast_sigmoid(a1[2]); y1[3] += bfhi(p.w) * fast_sigmoid(a1[3]);
                    *(f32x4*)(y + col) = y0; *(f32x4*)(y + col + 4) = y1;
                }
            }
    }
};
__device__ __forceinline__ int logical_col(int kind, int pr) {
    const int t = pr >> 8, q = pr & 255, g = gcol(q);
    if (kind == 0) return t * 256 + g;
    if (kind == 1) { const int bj = q >> 7; return bj * DFF + t * 128 + (g & 127); }
    const int bj = q >> 7, wc = (q >> 5) & 3, n = (q >> 4) & 1, fq = (q >> 2) & 3, e = q & 3;
    if (t < 4) return (t >> 1) * 512 + (2 * (t & 1) + bj) * 128 + 16 * wc + 4 * fq + e + 64 * n;
    if (t < 8) return 1024 + (t - 4) * 256 + g;
    if (t < 12) return 2048 + (t - 8) * 256 + g;
    if (t < 16) return (t < 14 ? 3072 : 3584) + (4 * (t & 1) + wc) * 64 + 32 * bj + 16 * n + 4 * fq + e;
    if (t < 18) return 4096 + (t - 16) * 256 + g;
    if (t == 18) return g < 8 ? 4608 + g : -1;
    return 4616 + (t - 19) * 256 + g;
}
__device__ __forceinline__ void transpose_item(const float* W, const float* gain, int K, int Nlog, int kind, u16* WT, int nblk, LAS float* scr, int item, int lane) {
    const int kb = item / nblk, nb = item % nblk, k0 = 64 * kb, n0 = 32 * nb;
    const int lc = logical_col(kind, n0 + (lane & 31));
#pragma unroll 8
    for (int i = 0; i < 32; ++i) { const int kk = 2 * i + (lane >> 5); float v = 0.f; if (lc >= 0) { v = W[(size_t)(k0 + kk) * Nlog + lc]; if (gain) v *= gain[k0 + kk]; } scr[kk * 33 + (lane & 31)] = v; }
    asm volatile("s_waitcnt lgkmcnt(0)" ::: "memory");
    const int c = lane & 7;
#pragma unroll
    for (int j = 0; j < 4; ++j) { const int n = (lane >> 3) + 8 * j; const LAS float* s = scr + (8 * c) * 33 + n;
        u32x4 o; o.x = cvt_pk_bf16(s[0 * 33], s[1 * 33]); o.y = cvt_pk_bf16(s[2 * 33], s[3 * 33]); o.z = cvt_pk_bf16(s[4 * 33], s[5 * 33]); o.w = cvt_pk_bf16(s[6 * 33], s[7 * 33]);
        *(u32x4*)(WT + (size_t)(n0 + n) * K + k0 + 8 * c) = o; }
    asm volatile("s_waitcnt lgkmcnt(0)" ::: "memory");
}

constexpr int R_QS = 0, R_KS = 17408, R_KDT = 34816, R_VT = 53248, R_AS = 90112, R_RED = 99328, R_RSTD = 101376, R_END = 101632;
template <int CH>
__device__ __forceinline__ void ret_item(LAS unsigned char* lds, const u16* RQK, u16* RV, const u16* RG, const float* s0, float* sout, size_t rowbase, int nchunks, int h) {
    constexpr int TT = CH / 16, KSN = (CH + 31) / 32;
    int tid = threadIdx.x; asm volatile("" : "+v"(tid)); const int lane = tid & 63, w = __builtin_amdgcn_readfirstlane(tid >> 6), g = lane >> 4, c16 = lane & 15;
    LAS u16* Qs = (LAS u16*)(lds + R_QS); LAS u16* Ks = (LAS u16*)(lds + R_KS); LAS u16* KdT = (LAS u16*)(lds + R_KDT); LAS u16* VT = (LAS u16*)(lds + R_VT); LAS u16* As = (LAS u16*)(lds + R_AS);
    LAS float* red = (LAS float*)(lds + R_RED); LAS float* rstdv = (LAS float*)(lds + R_RSTD);
    const float lg2 = __log2f(1.f - __builtin_amdgcn_exp2f(-5.f - (float)h));
    f32x4 S[8][2];
#pragma unroll
    for (int kt = 0; kt < 8; ++kt)
#pragma unroll
        for (int nt = 0; nt < 2; ++nt)
#pragma unroll
            for (int i = 0; i < 4; ++i) S[kt][nt][i] = s0 ? s0[(size_t)(16 * kt + 4 * g + i) * 256 + 32 * w + 16 * nt + c16] : 0.f;
    __syncthreads();
    if (CH < 32) {
        for (int i = tid; i < (R_RED - R_KDT) / 4; i += 512) ((LAS unsigned*)(lds + R_KDT))[i] = 0u;
        __syncthreads();
    }
    for (int c = 0; c < nchunks; ++c) {
        const size_t row0 = rowbase + (size_t)c * CH;
        __syncthreads();
        for (int p = tid; p < CH * 16; p += 512) {
            const int r = p >> 4, cc = p & 15;
            const u32x4 q = *(const u32x4*)(RQK + (row0 + r) * 1024 + h * 128 + cc * 8);
            const u32x4 k = *(const u32x4*)(RQK + (row0 + r) * 1024 + 512 + h * 128 + cc * 8);
            *(LAS u32x4*)(Qs + r * 136 + cc * 8) = q; *(LAS u32x4*)(Ks + r * 136 + cc * 8) = k;
            const float dec = __builtin_amdgcn_exp2f(lg2 * (float)(CH - 1 - r));
            const unsigned kw[4] = {k.x, k.y, k.z, k.w};
#pragma unroll
            for (int j = 0; j < 4; ++j) { const unsigned pk = cvt_pk_bf16(bflo(kw[j]) * dec, bfhi(kw[j]) * dec); KdT[(cc * 8 + 2 * j) * 72 + r] = (u16)(pk & 0xffffu); KdT[(cc * 8 + 2 * j + 1) * 72 + r] = (u16)(pk >> 16); }
        }
        for (int p = tid; p < CH * 32; p += 512) {
            const int r = p >> 5, cc = p & 31;
            const u32x4 v = *(const u32x4*)(RV + (row0 + r) * 1024 + h * 256 + cc * 8);
            const unsigned vw[4] = {v.x, v.y, v.z, v.w};
#pragma unroll
            for (int j = 0; j < 4; ++j) { VT[(cc * 8 + 2 * j) * 72 + r] = (u16)(vw[j] & 0xffffu); VT[(cc * 8 + 2 * j + 1) * 72 + r] = (u16)(vw[j] >> 16); }
        }
        __syncthreads();
        for (int tile = w; tile < TT * TT; tile += 8) {
            const int ti = tile / TT, tj = tile % TT; f32x4 a4 = {0.f, 0.f, 0.f, 0.f};
#pragma unroll
            for (int kk = 0; kk < 4; ++kk) {
                const bf16x8 a = *(const LAS bf16x8*)(Qs + (16 * ti + c16) * 136 + 32 * kk + 8 * g), b = *(const LAS bf16x8*)(Ks + (16 * tj + c16) * 136 + 32 * kk + 8 * g);
                a4 = __builtin_amdgcn_mfma_f32_16x16x32_bf16(a, b, a4, 0, 0, 0);
            }
#pragma unroll
            for (int i = 0; i < 4; ++i) { const int ri = 16 * ti + 4 * g + i, cj = 16 * tj + c16; const int dd = ri > cj ? ri - cj : cj - ri;
                const unsigned pk = cvt_pk_bf16(a4[i] * __builtin_amdgcn_exp2f(lg2 * (float)dd), 0.f); As[ri * 72 + cj] = (u16)(pk & 0xffffu); }
        }
        bf16x8 sb[4][2];
#pragma unroll
        for (int kk = 0; kk < 4; ++kk)
#pragma unroll
            for (int nt = 0; nt < 2; ++nt) { u32x4 t; t.x = cvt_pk_bf16(S[2 * kk][nt][0], S[2 * kk][nt][1]); t.y = cvt_pk_bf16(S[2 * kk][nt][2], S[2 * kk][nt][3]);
                t.z = cvt_pk_bf16(S[2 * kk + 1][nt][0], S[2 * kk + 1][nt][1]); t.w = cvt_pk_bf16(S[2 * kk + 1][nt][2], S[2 * kk + 1][nt][3]); sb[kk][nt] = __builtin_bit_cast(bf16x8, t); }
        f32x4 O[TT][2];
#pragma unroll
        for (int tt = 0; tt < TT; ++tt) {
            f32x4 o0 = {0.f, 0.f, 0.f, 0.f}, o1 = {0.f, 0.f, 0.f, 0.f};
#pragma unroll
            for (int kk = 0; kk < 4; ++kk) {
                const u32x2 lo = *(const LAS u32x2*)(Qs + (16 * tt + c16) * 136 + 32 * kk + 4 * g), hi = *(const LAS u32x2*)(Qs + (16 * tt + c16) * 136 + 32 * kk + 16 + 4 * g);
                u32x4 t; t.x = lo.x; t.y = lo.y; t.z = hi.x; t.w = hi.y; const bf16x8 a = __builtin_bit_cast(bf16x8, t);
                o0 = __builtin_amdgcn_mfma_f32_16x16x32_bf16(a, sb[kk][0], o0, 0, 0, 0); o1 = __builtin_amdgcn_mfma_f32_16x16x32_bf16(a, sb[kk][1], o1, 0, 0, 0);
            }
#pragma unroll
            for (int i = 0; i < 4; ++i) { const float dsc = __builtin_amdgcn_exp2f(lg2 * (float)(16 * tt + 4 * g + i + 1)); o0[i] *= dsc; o1[i] *= dsc; }
            O[tt][0] = o0; O[tt][1] = o1;
        }
        __syncthreads();
#pragma unroll
        for (int tt = 0; tt < TT; ++tt)
#pragma unroll
            for (int ks = 0; ks < KSN; ++ks) {
                const bf16x8 a = *(const LAS bf16x8*)(As + (16 * tt + c16) * 72 + 32 * ks + 8 * g);
#pragma unroll
                for (int nt = 0; nt < 2; ++nt) { const bf16x8 b = *(const LAS bf16x8*)(VT + (32 * w + 16 * nt + c16) * 72 + 32 * ks + 8 * g); O[tt][nt] = __builtin_amdgcn_mfma_f32_16x16x32_bf16(a, b, O[tt][nt], 0, 0, 0); }
            }
#pragma unroll
        for (int tt = 0; tt < TT; ++tt)
#pragma unroll
            for (int i = 0; i < 4; ++i) { float q = O[tt][0][i] * O[tt][0][i] + O[tt][1][i] * O[tt][1][i]; q += __shfl_xor(q, 1); q += __shfl_xor(q, 2); q += __shfl_xor(q, 4); q += __shfl_xor(q, 8);
                if (c16 == 0) red[w * 64 + 16 * tt + 4 * g + i] = q; }
        __syncthreads();
        if (tid < CH) { float s = 0.f;
#pragma unroll
            for (int ww = 0; ww < 8; ++ww) s += red[ww * 64 + tid];
            rstdv[tid] = rsqrtf(s * (1.f / 256.f) + 1e-6f); }
        __syncthreads();
#pragma unroll
        for (int tt = 0; tt < TT; ++tt)
#pragma unroll
            for (int i = 0; i < 4; ++i) { const int tok = 16 * tt + 4 * g + i; const float rsd = rstdv[tok];
#pragma unroll
                for (int nt = 0; nt < 2; ++nt) { const size_t off = (row0 + tok) * 1024 + h * 256 + 32 * w + 16 * nt + c16; const float gt = bf2f(RG[off]);
                    const unsigned pk = cvt_pk_bf16(O[tt][nt][i] * rsd * gt, 0.f); RV[off] = (u16)(pk & 0xffffu); } }
        const float cd = __builtin_amdgcn_exp2f(lg2 * (float)CH);
#pragma unroll
        for (int kt = 0; kt < 8; ++kt)
#pragma unroll
            for (int nt = 0; nt < 2; ++nt) S[kt][nt] = S[kt][nt] * cd;
#pragma unroll
        for (int ks = 0; ks < KSN; ++ks) {
            const bf16x8 b0 = *(const LAS bf16x8*)(VT + (32 * w + c16) * 72 + 32 * ks + 8 * g), b1 = *(const LAS bf16x8*)(VT + (32 * w + 16 + c16) * 72 + 32 * ks + 8 * g);
#pragma unroll
            for (int kt = 0; kt < 8; ++kt) { const bf16x8 a = *(const LAS bf16x8*)(KdT + (16 * kt + c16) * 72 + 32 * ks + 8 * g);
                S[kt][0] = __builtin_amdgcn_mfma_f32_16x16x32_bf16(a, b0, S[kt][0], 0, 0, 0); S[kt][1] = __builtin_amdgcn_mfma_f32_16x16x32_bf16(a, b1, S[kt][1], 0, 0, 0); }
        }
    }
#pragma unroll
    for (int kt = 0; kt < 8; ++kt)
#pragma unroll
        for (int nt = 0; nt < 2; ++nt)
#pragma unroll
            for (int i = 0; i < 4; ++i) sout[(size_t)(16 * kt + 4 * g + i) * 256 + 32 * w + 16 * nt + c16] = S[kt][nt][i];
    __syncthreads();
}
constexpr int F_Q = 0, F_BIAS = 4096, F_WS = 20736, F_P = 24576, F_M = 57344, F_L = 57856, F_ACC = 58368, F_END = 91136;
__device__ __forceinline__ void fox_sample_item(LAS unsigned char* lds, int b, int h, u16* FQ, const u16* FK, const u16* FV, const float* ck, const float* cv, const float* clf, const float* lfnew) {
    int tid = threadIdx.x; asm volatile("" : "+v"(tid)); const int lane = tid & 63, w = __builtin_amdgcn_readfirstlane(tid >> 6);
    LAS float* QF = (LAS float*)(lds + F_Q); LAS float* BIAS = (LAS float*)(lds + F_BIAS); LAS float* WS = (LAS float*)(lds + F_WS);
    LAS float* Pw = (LAS float*)(lds + F_P) + w * 1024; LAS float* Mx = (LAS float*)(lds + F_M); LAS float* Lx = (LAS float*)(lds + F_L); LAS float* ACC = (LAS float*)(lds + F_ACC);
    const size_t srow = (size_t)MP + (size_t)b * 16;
    __syncthreads();
    for (int e = tid; e < 1024; e += 512) QF[e] = bf2f(FQ[(srow + (e >> 6)) * 512 + h * 64 + (e & 63)]);
    {
        float v[8]; float run = 0.f;
#pragma unroll
        for (int j = 0; j < 8; ++j) { run += clf[((size_t)b * PAST + 8 * tid + j) * 8 + h]; v[j] = run; }
        float tot = run;
#pragma unroll
        for (int o = 1; o < 64; o <<= 1) { const float u = __shfl_up(tot, o); if (lane >= o) tot += u; }
        if (lane == 63) WS[w] = tot;
        __syncthreads();
        float base = tot - run, all = 0.f;
#pragma unroll
        for (int ww = 0; ww < 8; ++ww) { const float x = WS[ww]; all += x; if (ww < w) base += x; }
#pragma unroll
        for (int j = 0; j < 8; ++j) BIAS[8 * tid + j] = (all - (base + v[j])) * L2E;
        if (tid == 0) { float cn = 0.f; for (int t = 0; t < 16; ++t) { cn += lfnew[((size_t)b * 16 + t) * 8 + h]; BIAS[PAST + t] = -cn * L2E; } }
    }
    __syncthreads();
    float mrun[16], lrun[16], acc[16];
#pragma unroll
    for (int t = 0; t < 16; ++t) { mrun[t] = -INFINITY; lrun[t] = 0.f; acc[t] = 0.f; }
    const int ntile = (w == 0) ? 9 : 8;
    for (int tile = 0; tile < ntile; ++tile) {
        const bool isnew = tile == 8;
        const int key0 = isnew ? 0 : 512 * w + 64 * tile;
        float s[16];
        {
            f32x4 k[16];
            if (!isnew) { const f32x4* kp = (const f32x4*)(ck + (((size_t)b * PAST + key0 + lane) * 8 + h) * 64);
#pragma unroll
                for (int i = 0; i < 16; ++i) k[i] = kp[i];
            } else { const u32x4* kp = (const u32x4*)(FK + (srow + (lane & 15)) * 512 + h * 64);
#pragma unroll
                for (int i = 0; i < 8; ++i) { const u32x4 x = kp[i]; k[2 * i] = (f32x4){bflo(x.x), bfhi(x.x), bflo(x.y), bfhi(x.y)}; k[2 * i + 1] = (f32x4){bflo(x.z), bfhi(x.z), bflo(x.w), bfhi(x.w)}; } }
            const float bias = isnew ? BIAS[PAST + (lane & 15)] : BIAS[key0 + lane];
#pragma unroll
            for (int t = 0; t < 16; ++t) { float a = 0.f;
#pragma unroll
                for (int i = 0; i < 16; ++i) { const f32x4 q = *(const LAS f32x4*)(QF + t * 64 + 4 * i); a += (q[0] * k[i][0] + q[1] * k[i][1]) + (q[2] * k[i][2] + q[3] * k[i][3]); }
                a += bias; if (isnew && (lane > t || lane >= 16)) a = -INFINITY; s[t] = a; }
        }
#pragma unroll
        for (int t = 0; t < 16; ++t) {
            const float tm = wave_max(s[t]), mn = fmaxf(mrun[t], tm), al = __builtin_amdgcn_exp2f(mrun[t] - mn), p = __builtin_amdgcn_exp2f(s[t] - mn);
            Pw[lane * 16 + t] = p; acc[t] *= al; lrun[t] = lrun[t] * al + wave_sum(p); mrun[t] = mn;
        }
        asm volatile("s_waitcnt lgkmcnt(0)" ::: "memory"); __builtin_amdgcn_wave_barrier();
        const int nk = isnew ? 16 : 64;
        for (int kk = 0; kk < nk; ++kk) {
            const float v = isnew ? bf2f(FV[(srow + kk) * 512 + h * 64 + lane]) : cv[(((size_t)b * PAST + key0 + kk) * 8 + h) * 64 + lane];
#pragma unroll
            for (int i = 0; i < 4; ++i) { const f32x4 p = *(const LAS f32x4*)(Pw + kk * 16 + 4 * i); acc[4 * i] += p[0] * v; acc[4 * i + 1] += p[1] * v; acc[4 * i + 2] += p[2] * v; acc[4 * i + 3] += p[3] * v; }
        }
        asm volatile("s_waitcnt lgkmcnt(0)" ::: "memory"); __builtin_amdgcn_wave_barrier();
    }
#pragma unroll
    for (int t = 0; t < 16; ++t) { ACC[(w * 16 + t) * 64 + lane] = acc[t]; if (lane == 0) { Mx[w * 16 + t] = mrun[t]; Lx[w * 16 + t] = lrun[t]; } }
    __syncthreads();
    for (int e = tid; e < 1024; e += 512) {
        const int t = e >> 6, d = e & 63; float mm = -INFINITY;
#pragma unroll
        for (int ww = 0; ww < 8; ++ww) mm = fmaxf(mm, Mx[ww * 16 + t]);
        float num = 0.f, den = 0.f;
#pragma unroll
        for (int ww = 0; ww < 8; ++ww) { const float f = __builtin_amdgcn_exp2f(Mx[ww * 16 + t] - mm); num += ACC[(ww * 16 + t) * 64 + d] * f; den += Lx[ww * 16 + t] * f; }
        const unsigned pk = cvt_pk_bf16(num / den, 0.f); FQ[(srow + t) * 512 + h * 64 + d] = (u16)(pk & 0xffffu);
    }
    __syncthreads();
}

struct Args { const float* in[25]; float* out; unsigned char* ws; };
constexpr int P4_RET = 128, P4_FS = 128, P4_FP = 2048, P4_RS = 64, P4_ITEMS = P4_RET + P4_FS + P4_FP + P4_RS;

__device__ __forceinline__ unsigned char* kern_ptr(int k) {
    const __attribute__((address_space(4))) char* p = (const __attribute__((address_space(4))) char*)__builtin_amdgcn_kernarg_segment_ptr();
    asm volatile("" : "+s"(p));
    return *(unsigned char* const __attribute__((address_space(4)))*)(p + 8 * k);
}
__global__ void __launch_bounds__(512, 2) fwd(Args a) {
    extern __shared__ __attribute__((aligned(16))) unsigned char lds_raw[];
    LAS unsigned char* lds = (LAS unsigned char*)lds_raw;
    cg::grid_group grid = cg::this_grid();
    const int tid = threadIdx.x, lane = tid & 63, wave = __builtin_amdgcn_readfirstlane(tid >> 6);
    const int G = gridDim.x, bx = blockIdx.x;
#define WSB() kern_ptr(26)
#define OUTB() ((float*)kern_ptr(25))
#define INP(k) ((const float*)kern_ptr(k))
#define P16(off) ((u16*)(WSB() + (off)))
#define PF32(off) ((float*)(WSB() + (off)))
    unsigned* ctl = (unsigned*)(WSB() + O_CTL);
    LAS unsigned* misc = (LAS unsigned*)(lds + LDS_BYTES - 128);
    if (tid < 32) misc[tid] = 0u;
    __syncthreads();
    const xb::XcdBarrier bar = xb::xcd_barrier_post(ctl + 4096, (volatile XLAS unsigned*)(misc + 8));
#define GSYNC() xb::xcd_barrier(bar)

#ifndef PHM
#define PHM 0xffff
#endif
#define PH(k) if constexpr (((PHM)>>(k))&1)
    PH(0) {
        LAS float* scr = (LAS float*)(lds + wave * 16384);
        const int gw = bx * 8 + wave, NGW = G * 8;
        constexpr int I0 = 16 * 176, I1 = 44 * 32, I2 = 16 * 216, I3 = 16 * 32, I4 = 8 * 32, I5 = 16 * 32, I8 = 4 * 32;
        constexpr int NIT = I0 + I1 + I2 + I3 + I4 + I5 + I0 + I1 + I8 + I3;
        for (int it = gw; it < NIT; it += NGW) {
            int r = it;
            if (r < I0) { transpose_item(INP(9), INP(8), 1024, 5632, 1, P16(O_W1IN), 176, scr, r, lane); continue; } r -= I0;
            if (r < I1) { transpose_item(INP(10), nullptr, 2816, 1024, 0, P16(O_W1OUT), 32, scr, r, lane); continue; } r -= I1;
            if (r < I2) { transpose_item(INP(12), INP(11), 1024, 6664, 2, P16(O_WMIX), 216, scr, r, lane); continue; } r -= I2;
            if (r < I3) { transpose_item(INP(16), nullptr, 1024, 1024, 0, P16(O_WBR), 32, scr, r, lane); continue; } r -= I3;
            if (r < I4) { transpose_item(INP(17), nullptr, 512, 1024, 0, P16(O_WBF), 32, scr, r, lane); continue; } r -= I4;
            if (r < I5) { transpose_item(INP(18), nullptr, 1024, 1024, 0, P16(O_WOUT), 32, scr, r, lane); continue; } r -= I5;
            if (r < I0) { transpose_item(INP(20), INP(19), 1024, 5632, 1, P16(O_W2IN), 176, scr, r, lane); continue; } r -= I0;
            if (r < I1) { transpose_item(INP(21), nullptr, 2816, 1024, 0, P16(O_W2OUT), 32, scr, r, lane); continue; } r -= I1;
            if (r < I8) { transpose_item(INP(23), nullptr, 256, 1024, 0, P16(O_WPLE), 32, scr, r, lane); continue; } r -= I8;
            transpose_item(INP(24), INP(22), 1024, 1024, 0, P16(O_WPG), 32, scr, r, lane);
        }
        for (int row = gw; row < MT; row += NGW) {
            const f32x4* xr = (const f32x4*)(row < MP ? INP(0) + (size_t)row * 1024 : INP(1) + (size_t)(row - MP) * 1024) + lane;
            f32x4 v[4]; float s = 0.f;
#pragma unroll
            for (int j = 0; j < 4; ++j) { v[j] = xr[64 * j]; s += (v[j][0] * v[j][0] + v[j][1] * v[j][1]) + (v[j][2] * v[j][2] + v[j][3] * v[j][3]); }
            s = wave_sum(s);
            u32x2* o = (u32x2*)(P16(O_XB) + (size_t)row * 1024) + lane;
#pragma unroll
            for (int j = 0; j < 4; ++j) { u32x2 w; w.x = cvt_pk_bf16(v[j][0], v[j][1]); w.y = cvt_pk_bf16(v[j][2], v[j][3]); o[64 * j] = w; }
            if (lane < 16) PF32(O_SS)[(size_t)row * 16 + lane] = lane == 0 ? s : 0.f;
        }
        for (int i = bx * 512 + tid; i < NPOS * 64; i += G * 512) {
            const int pi = i >> 6, f = i & 63; const float pos = pi < SEQ ? (float)pi : (float)(PAST + pi - SEQ);
            const float freq = __builtin_amdgcn_exp2f(-(float)f * (13.287712379549449f / 64.f)); const float ang = pos * freq;
            double rev = (double)ang * 0.15915494309189535; rev -= floor(rev); const float rf = (float)rev;
            PF32(O_TABC)[i] = __builtin_amdgcn_cosf(rf); PF32(O_TABS)[i] = __builtin_amdgcn_sinf(rf);
        }
    }
    grid.sync(); GSYNC();
    PH(1) { pg8::Gemm g{P16(O_XB), P16(O_W1IN), MT, 5632, 1024}; pg8::StaticOrder S; S.init(MT, 5632, G, bx); EpiSwiglu E{P16(O_ACT1), PF32(O_SS)};
      pg8::gemm_phase<EpiSwiglu, pg8::StaticOrder, true, true>(lds, g, S, E); }
    GSYNC();
    PH(2) { pg8::Gemm g{P16(O_ACT1), P16(O_W1OUT), MT, 1024, DFF}; pg8::StaticOrder S; S.init(MT, 1024, G, bx); EpiResid E{INP(0), INP(1), OUTB() + OUT_YP, OUTB() + OUT_YS, P16(O_XB), PF32(O_SS), 0.5f};
      pg8::gemm_phase<EpiResid, pg8::StaticOrder, true, true>(lds, g, S, E); }
    GSYNC();
    PH(3) { pg8::Gemm g{P16(O_XB), P16(O_WMIX), MT, NMIX, 1024}; pg8::StaticOrder S; S.init(MT, NMIX, G, bx);
      EpiMix E{PF32(O_SS), PF32(O_TABC), PF32(O_TABS), INP(14), INP(15), INP(13), P16(O_RQK), P16(O_RV), P16(O_RG), P16(O_FQ), P16(O_FK), P16(O_FV), P16(O_ZG), OUTB()};
      pg8::gemm_phase<EpiMix, pg8::StaticOrder, true, true>(lds, g, S, E); }
    GSYNC();
    {
        LAS unsigned* slot = misc;
        for (;;) {
            __syncthreads();
            if (tid == 0) slot[0] = atomicAdd(ctl, 1u);
            __syncthreads();
            const int it = (int)slot[0];
            if (it >= P4_ITEMS) break;
            if (it < P4_RET) { const int b = it >> 2, h = it & 3;
                PH(10) ret_item<64>(lds, P16(O_RQK), P16(O_RV), P16(O_RG), nullptr, OUTB() + OUT_RSP + (size_t)(b * 4 + h) * 32768, (size_t)b * SEQ, 32, h);
            } else if (it < P4_RET + P4_FS) { const int j = it - P4_RET, b = j >> 3, h = j & 7;
                PH(11) fox_sample_item(lds, b, h, P16(O_FQ), P16(O_FK), P16(O_FV), INP(5), INP(6), INP(7), OUTB() + OUT_LS);
            } else if (it < P4_RET + P4_FS + P4_FP) { const int j = it - P4_RET - P4_FS, qb = 7 - (j >> 8), bh = j & 255;
                PH(12) attn_body::attn_unit<8>(bh >> 3, bh & 7, qb, (const attn_body::bf16*)P16(O_FQ), (const attn_body::bf16*)P16(O_FK), (const attn_body::bf16*)P16(O_FV), (attn_body::bf16*)P16(O_FQ), OUTB() + OUT_LP, (char*)lds_raw);
            } else { const int j = it - P4_RET - P4_FS - P4_FP, b = j >> 2, h = j & 3;
                PH(13) ret_item<16>(lds, P16(O_RQK), P16(O_RV), P16(O_RG), INP(4) + (size_t)(b * 4 + h) * 32768, OUTB() + OUT_RSS + (size_t)(b * 4 + h) * 32768, (size_t)MP + (size_t)b * 16, 1, h);
            }
        }
    }
    GSYNC();
    {
        for (size_t i = (size_t)bx * 512 + tid; i < (size_t)MT * 32; i += (size_t)G * 512) {
            const size_t e8 = i * 8; const float* src = e8 < (size_t)MP * 256 ? INP(2) + e8 : INP(3) + (e8 - (size_t)MP * 256);
            const f32x4 v0 = *(const f32x4*)src, v1 = *(const f32x4*)(src + 4);
            u32x4 w; w.x = cvt_pk_bf16(v0[0], v0[1]); w.y = cvt_pk_bf16(v0[2], v0[3]); w.z = cvt_pk_bf16(v1[0], v1[1]); w.w = cvt_pk_bf16(v1[2], v1[3]);
            *(u32x4*)(P16(O_FV) + e8) = w;
        }
        PH(5) { pg8::Gemm g{P16(O_RV), P16(O_WBR), MT, 1024, 1024}; pg8::StaticOrder S; S.init(MT, 1024, G, bx); EpiGate<false> E{P16(O_XB), P16(O_ZG)};
          pg8::gemm_phase<EpiGate<false>, pg8::StaticOrder, true, true>(lds, g, S, E); }
        PH(5) { pg8::Gemm g{P16(O_FQ), P16(O_WBF), MT, 1024, 512}; pg8::StaticOrder S; S.init(MT, 1024, G, bx); EpiGate<true> E{P16(O_XB), P16(O_ZG)};
          pg8::gemm_phase<EpiGate<true>, pg8::StaticOrder, true, true>(lds, g, S, E); }
    }
    GSYNC();
    PH(6) { pg8::Gemm g{P16(O_XB), P16(O_WOUT), MT, 1024, 1024}; pg8::StaticOrder S; S.init(MT, 1024, G, bx); EpiResid E{OUTB() + OUT_YP, OUTB() + OUT_YS, OUTB() + OUT_YP, OUTB() + OUT_YS, P16(O_RQK), PF32(O_SS), 1.0f};
      pg8::gemm_phase<EpiResid, pg8::StaticOrder, true, true>(lds, g, S, E); }
    GSYNC();
    PH(7) { pg8::Gemm g{P16(O_RQK), P16(O_W2IN), MT, 5632, 1024}; pg8::StaticOrder S; S.init(MT, 5632, G, bx); EpiSwiglu E{P16(O_ACT2), PF32(O_SS)};
      pg8::gemm_phase<EpiSwiglu, pg8::StaticOrder, true, true>(lds, g, S, E); }
    GSYNC();
    PH(8) { pg8::Gemm g{P16(O_ACT2), P16(O_W2OUT), MT, 1024, DFF}; pg8::StaticOrder S; S.init(MT, 1024, G, bx); EpiResid E{OUTB() + OUT_YP, OUTB() + OUT_YS, OUTB() + OUT_YP, OUTB() + OUT_YS, P16(O_XB), PF32(O_SS), 0.5f};
      pg8::gemm_phase<EpiResid, pg8::StaticOrder, true, true>(lds, g, S, E); }
    PH(8) { pg8::Gemm g{P16(O_FV), P16(O_WPLE), MT, 1024, 256}; pg8::StaticOrder S; S.init(MT, 1024, G, bx); EpiPlain E{P16(O_RQK)};
      pg8::gemm_phase<EpiPlain, pg8::StaticOrder, true, true>(lds, g, S, E); }
    GSYNC();
    PH(9) { pg8::Gemm g{P16(O_XB), P16(O_WPG), MT, 1024, 1024}; pg8::StaticOrder S; S.init(MT, 1024, G, bx); EpiFinal E{OUTB() + OUT_YP, OUTB() + OUT_YS, P16(O_RQK), PF32(O_SS)};
      pg8::gemm_phase<EpiFinal, pg8::StaticOrder, true, true>(lds, g, S, E); }
}
}

extern "C" void kernel_launch(void* const* d_in, const int* in_sizes, int n_in, void* d_out, int out_size, void* d_ws, size_t ws_size, hipStream_t stream) {
    static int grid = 0;
    if (grid == 0) {
        if (n_in != 25 || (size_t)out_size != mk::OUT_END || ws_size < mk::WS_NEED) { fprintf(stderr, "kernel_launch: unexpected shapes (n_in %d out %d ws %zu need %zu)\n", n_in, out_size, ws_size, (size_t)mk::WS_NEED); grid = -1; return; }
        int dev = 0, cus = 0, per_cu = 0;
        hipGetDevice(&dev); hipDeviceGetAttribute(&cus, hipDeviceAttributeMultiprocessorCount, dev);
        if (hipFuncSetAttribute((const void*)mk::fwd, hipFuncAttributeMaxDynamicSharedMemorySize, mk::LDS_BYTES) != hipSuccess) { fprintf(stderr, "kernel_launch: hipFuncSetAttribute failed\n"); grid = -1; return; }
        hipOccupancyMaxActiveBlocksPerMultiprocessor(&per_cu, (const void*)mk::fwd, 512, mk::LDS_BYTES);
        if (per_cu < 1) { fprintf(stderr, "kernel_launch: occupancy query says %d blocks per CU\n", per_cu); per_cu = 1; }
        grid = cus;
    }
    if (grid < 0) return;
    if (hipMemsetAsync((char*)d_ws + mk::O_CTL, 0, 65536, stream) != hipSuccess) { fprintf(stderr, "kernel_launch: memset failed\n"); return; }
    mk::Args a{};
    for (int i = 0; i < 25; ++i) a.in[i] = (const float*)d_in[i];
    a.out = (float*)d_out; a.ws = (unsigned char*)d_ws;
    void* args[] = {&a};
    hipError_t e = hipLaunchCooperativeKernel((const void*)mk::fwd, dim3(grid), dim3(512), args, mk::LDS_BYTES, stream);
    if (e != hipSuccess) fprintf(stderr, "cooperative launch failed: %s (grid %d)\n", hipGetErrorString(e), grid);
}
```

```cpp
#include <hip/hip_runtime.h>
#include <hip/hip_cooperative_groups.h>
#include <cstdio>
#include <cstdint>
#include <hip/hip_bf16.h>
#include <cmath>
namespace cg = cooperative_groups;
namespace pg8 {
#define PG8_LAS __attribute__((address_space(3)))
typedef unsigned short bf16_t;
typedef short bf16x8 __attribute__((ext_vector_type(8)));
typedef float f32x4 __attribute__((ext_vector_type(4)));
typedef unsigned u32x4 __attribute__((ext_vector_type(4)));
constexpr int BM = 256, BK = 64, HALF = 128, HTB = HALF * BK * 2  , STAGE_BYTES = 8 * HTB, NXCD = 8, WGM = 8;

__host__ __device__ __forceinline__ int lds_byte(int r, int c) { const int st = (r >> 4) * 2 + (c >> 5), rr = r & 15, cc = c & 31, ob = rr * 64 + cc * 2; return st * 1024 + (ob ^ (((ob >> 9) & 1) << 5)); }
__host__ __device__ __forceinline__ void stage_rc(int b, int& R, int& C) { const int st = b / 1024, sb = b % 1024, swz = sb ^ (((sb >> 9) & 1) << 5); R = (st >> 1) * 16 + swz / 64; C = (st & 1) * 32 + (swz % 64) / 2; }
__host__ __device__ __forceinline__ int perm32(int rho) { const int n = rho >> 4, i = rho & 15; return 8 * (i >> 2) + 4 * n + (i & 3); }

struct Unit { int pm, pn; };
struct Gemm { const bf16_t* A; const bf16_t* Bt; int M, N, K; };

struct StaticOrder {
    int nM, nN, nwg, G, c;
    __host__ __device__ void init(int M, int N, int G_, int c_) { nM = M / BM; nN = N / BM; nwg = nM * nN; G = G_; c = c_; }
    __host__ __device__ bool next(int i, Unit& u) const {
        const long L = (long)i * G + c; if (L >= nwg) return false;
        int wgid = (int)L; { const int q = nwg / NXCD, r = nwg % NXCD, xcd = wgid % NXCD, off = wgid / NXCD; wgid = (xcd < r ? xcd * (q + 1) : r * (q + 1) + (xcd - r) * q) + off; }
        const int nig = WGM * nN, gid = wgid / nig, fm = gid * WGM, gsz = (nM - fm) < WGM ? (nM - fm) : WGM;
        u.pm = fm + ((wgid % nig) % gsz); u.pn = (wgid % nig) / gsz; return true;
    }
    __device__ __forceinline__ void a_ready(const Unit&) const {}
    __device__ __forceinline__ void done(const Unit&) const {}
};

typedef float f32x2c __attribute__((ext_vector_type(2))); typedef __bf16 bf16x2c __attribute__((ext_vector_type(2)));
__device__ __forceinline__ unsigned cvt_pk_bf16(float lo, float hi) { f32x2c v = {lo, hi}; bf16x2c b = __builtin_convertvector(v, bf16x2c); return __builtin_bit_cast(unsigned, b); }
typedef float f32x2 __attribute__((ext_vector_type(2)));
template <class Epi, class Sched, bool ALIGN_EPI = false, bool SP2 = false>
__device__ __forceinline__ void gemm_phase(PG8_LAS unsigned char* lds, const Gemm g, const Sched& S, const Epi& E) {
    int tid = threadIdx.x; asm volatile("" : "+v"(tid)); const int wid = __builtin_amdgcn_readfirstlane(tid >> 6), lane = tid & 63, wr = wid >> 2, wc = wid & 3, fr = lane & 15, fq = lane >> 4;
    const int K = g.K, nt = K / BK;
    unsigned voffA[2], voffB[2];
#pragma unroll
    for (int i = 0; i < 2; ++i) { int R, C; stage_rc(tid * 16 + i * 8192, R, C); const int Rb = Epi::PERM ? ((R & ~31) + perm32(R & 31)) : R;
        voffA[i] = (unsigned)(R * K + C) * 2u; voffB[i] = (unsigned)(Rb * K + C) * 2u; }
    const size_t kstep = (size_t)(BK * 2);
    const size_t hstep = (size_t)HALF * K * 2;
    const size_t tstep = 2 * hstep;
    const unsigned ldsw = (unsigned)wid * 1024u;
    const int aoff = lds_byte(wr * 64 + fr, fq * 8), boff = lds_byte(wc * 32 + fr, fq * 8);
#define PG8_SA(b, h) (((b) * 2 + (h)) * HTB)
#define PG8_SB(b, h) ((4 + (b) * 2 + (h)) * HTB)
#define PG8_STAGE(bufoff, gbase, voff) do { _Pragma("unroll") for (int _i = 0; _i < 2; ++_i) \
        __builtin_amdgcn_global_load_lds((const unsigned*)((const char*)(gbase) + (voff)[_i]), (PG8_LAS unsigned*)(lds + (bufoff) + ldsw + _i * 8192), 16, 0, 0); } while (0)
#define PG8_LDA(dst, b, h) do { _Pragma("unroll") for (int m = 0; m < 4; ++m) _Pragma("unroll") for (int k = 0; k < 2; ++k) dst[m][k] = *(const PG8_LAS bf16x8*)(lds + PG8_SA(b, h) + aoff + m * 2048 + k * 1024); } while (0)
#define PG8_LDB(dst, b, h) do { _Pragma("unroll") for (int n = 0; n < 2; ++n) _Pragma("unroll") for (int k = 0; k < 2; ++k) dst[n][k] = *(const PG8_LAS bf16x8*)(lds + PG8_SB(b, h) + boff + n * 2048 + k * 1024); } while (0)
#define PG8_MMA(ai, bj, At, Bt) do { __builtin_amdgcn_s_setprio(1); _Pragma("unroll") for (int m = 0; m < 4; ++m) _Pragma("unroll") for (int n = 0; n < 2; ++n) _Pragma("unroll") for (int k = 0; k < 2; ++k) \
        acc[ai][bj][m][n] = __builtin_amdgcn_mfma_f32_16x16x32_bf16(Bt[n][k], At[m][k], acc[ai][bj][m][n], 0, 0, 0); __builtin_amdgcn_s_setprio(0); } while (0)
#define PG8_WAIT_V(n) asm volatile("s_waitcnt vmcnt(" #n ")" ::: "memory")
#define PG8_WAIT_L(n) asm volatile("s_waitcnt lgkmcnt(" #n ")" ::: "memory")
#define PG8_BAR __builtin_amdgcn_s_barrier()
#define PG8_SCHED __builtin_amdgcn_sched_barrier(0)
    Unit cur, nxt; int ui = 0;
    if (!S.next(0, cur)) return;
    f32x4 acc[2][2][4][2];
#pragma unroll
    for (int a = 0; a < 2; ++a)
#pragma unroll
        for (int b = 0; b < 2; ++b)
#pragma unroll
            for (int m = 0; m < 4; ++m)
#pragma unroll
                for (int n = 0; n < 2; ++n) acc[a][b][m][n] = (f32x4){0.f, 0.f, 0.f, 0.f};
    bf16x8 At[4][2], B0[2][2], B1[2][2];
    const char* cA = (const char*)g.A + (size_t)cur.pm * tstep; const char* cB = (const char*)g.Bt + (size_t)cur.pn * tstep;
    S.a_ready(cur);
    if constexpr (SP2) {
        PG8_STAGE(PG8_SB(0, 0), cB, voffB); PG8_STAGE(PG8_SB(0, 1), cB + hstep, voffB); PG8_STAGE(PG8_SA(0, 0), cA, voffA); PG8_STAGE(PG8_SA(0, 1), cA + hstep, voffA);
        if (wr == 1) PG8_BAR;
        PG8_WAIT_V(2); PG8_BAR;
        PG8_STAGE(PG8_SB(1, 0), cB + kstep, voffB); PG8_STAGE(PG8_SA(1, 0), cA + kstep, voffA); PG8_STAGE(PG8_SB(1, 1), cB + hstep + kstep, voffB);
        PG8_WAIT_V(6); PG8_BAR;
    } else {
        PG8_STAGE(PG8_SB(0, 0), cB, voffB); PG8_STAGE(PG8_SA(0, 0), cA, voffA); PG8_STAGE(PG8_SB(0, 1), cB + hstep, voffB); PG8_STAGE(PG8_SA(0, 1), cA + hstep, voffA);
        if (wr == 1) PG8_BAR;
        PG8_WAIT_V(4); PG8_BAR;
        PG8_STAGE(PG8_SB(1, 0), cB + kstep, voffB); PG8_STAGE(PG8_SA(1, 0), cA + kstep, voffA); PG8_STAGE(PG8_SB(1, 1), cB + hstep + kstep, voffB);
        PG8_WAIT_V(6); PG8_BAR;
    }
    for (;;) {
        const bool has_next = S.next(ui + 1, nxt);
        const char* nA = has_next ? (const char*)g.A + (size_t)nxt.pm * tstep : cA; const char* nB = has_next ? (const char*)g.Bt + (size_t)nxt.pn * tstep : cB;
        for (int t = 0; t < nt; t += 2) {
            const bool last = (t == nt - 2);
            const char* a1 = cA + (size_t)(t + 1) * kstep;
            const char* a2 = last ? nA : cA + (size_t)(t + 2) * kstep; const char* b2 = last ? nB : cB + (size_t)(t + 2) * kstep;
            const char* a3 = a2 + kstep; const char* b3 = b2 + kstep;
            if (last && has_next) S.a_ready(nxt);
            if constexpr (SP2) {
            PG8_LDB(B0, 0, 0); PG8_LDB(B1, 0, 1); PG8_SCHED; PG8_LDA(At, 0, 0); PG8_STAGE(PG8_SA(1, 1), a1 + hstep, voffA);
            PG8_WAIT_V(8); PG8_WAIT_L(0); PG8_BAR; PG8_MMA(0, 0, At, B0); PG8_MMA(0, 1, At, B1); PG8_BAR; PG8_SCHED;
            PG8_LDA(At, 0, 1); PG8_STAGE(PG8_SB(0, 0), b2, voffB); PG8_STAGE(PG8_SB(0, 1), b2 + hstep, voffB); PG8_STAGE(PG8_SA(0, 0), a2, voffA);
            PG8_WAIT_V(8); PG8_WAIT_L(0); PG8_BAR; PG8_MMA(1, 0, At, B0); PG8_MMA(1, 1, At, B1); PG8_BAR; PG8_SCHED;
            PG8_LDB(B0, 1, 0); PG8_LDB(B1, 1, 1); PG8_SCHED; PG8_LDA(At, 1, 0); PG8_STAGE(PG8_SA(0, 1), a2 + hstep, voffA);
            PG8_WAIT_V(8); PG8_WAIT_L(0); PG8_BAR; PG8_MMA(0, 0, At, B0); PG8_MMA(0, 1, At, B1); PG8_BAR; PG8_SCHED;
            PG8_LDA(At, 1, 1); PG8_STAGE(PG8_SB(1, 0), b3, voffB); PG8_STAGE(PG8_SB(1, 1), b3 + hstep, voffB); PG8_STAGE(PG8_SA(1, 0), a3, voffA);
            PG8_WAIT_V(8); PG8_WAIT_L(0); PG8_BAR; PG8_MMA(1, 0, At, B0); PG8_MMA(1, 1, At, B1); PG8_BAR; PG8_SCHED;
            } else {
            PG8_LDB(B0, 0, 0); PG8_SCHED; PG8_LDA(At, 0, 0); PG8_STAGE(PG8_SA(1, 1), a1 + hstep, voffA);
            PG8_WAIT_L(8); PG8_BAR; PG8_WAIT_L(0); PG8_MMA(0, 0, At, B0); PG8_BAR; PG8_SCHED;
            PG8_LDB(B1, 0, 1); PG8_STAGE(PG8_SB(0, 0), b2, voffB);
            PG8_BAR; PG8_WAIT_L(0); PG8_MMA(0, 1, At, B1); PG8_BAR;
            PG8_LDA(At, 0, 1); PG8_STAGE(PG8_SA(0, 0), a2, voffA);
            PG8_BAR; PG8_WAIT_L(0); PG8_MMA(1, 0, At, B0); PG8_BAR; PG8_SCHED;
            PG8_STAGE(PG8_SB(0, 1), b2 + hstep, voffB);
            PG8_WAIT_V(6); PG8_BAR; PG8_MMA(1, 1, At, B1); PG8_BAR;
            PG8_LDB(B0, 1, 0); PG8_SCHED; PG8_LDA(At, 1, 0); PG8_STAGE(PG8_SA(0, 1), a2 + hstep, voffA);
            PG8_WAIT_L(8); PG8_BAR; PG8_WAIT_L(0); PG8_MMA(0, 0, At, B0); PG8_BAR; PG8_SCHED;
            PG8_LDB(B1, 1, 1); PG8_STAGE(PG8_SB(1, 0), b3, voffB);
            PG8_BAR; PG8_WAIT_L(0); PG8_MMA(0, 1, At, B1); PG8_BAR;
            PG8_LDA(At, 1, 1); PG8_STAGE(PG8_SA(1, 0), a3, voffA);
            PG8_BAR; PG8_WAIT_L(0); PG8_MMA(1, 0, At, B0); PG8_BAR; PG8_SCHED;
            PG8_STAGE(PG8_SB(1, 1), b3 + hstep, voffB);
            PG8_WAIT_V(6); PG8_BAR; PG8_MMA(1, 1, At, B1); PG8_BAR;
            }
        }
        if constexpr (ALIGN_EPI) { if (wr == 0) PG8_BAR; }
        if constexpr (!Epi::AFTER_DRAIN) { E(acc, cur, wr, wc, fr, fq); S.done(cur); }
        if (!has_next) break;
#pragma unroll
        for (int a = 0; a < 2; ++a)
#pragma unroll
            for (int b = 0; b < 2; ++b)
#pragma unroll
                for (int m = 0; m < 4; ++m)
#pragma unroll
                    for (int n = 0; n < 2; ++n) acc[a][b][m][n] = (f32x4){0.f, 0.f, 0.f, 0.f};
        cur = nxt; cA = nA; cB = nB; ++ui;
        if constexpr (ALIGN_EPI) { if (wr == 1) PG8_BAR; }
    }
    PG8_WAIT_V(0);
    if constexpr (!ALIGN_EPI) { if (wr == 0) PG8_BAR; }
    PG8_BAR;
    if constexpr (Epi::AFTER_DRAIN) { E.fused(acc, cur, wr, wc, fr, fq, lds, wid, lane); S.done(cur); }
#undef PG8_SA
#undef PG8_SB
#undef PG8_STAGE
#undef PG8_LDA
#undef PG8_LDB
#undef PG8_MMA
#undef PG8_WAIT_V
#undef PG8_WAIT_L
#undef PG8_BAR
#undef PG8_SCHED
}
}
namespace attn_body {
using bf16=__hip_bfloat16;
using bf16x8=__attribute__((ext_vector_type(8)))short;
using s16x4=__attribute__((ext_vector_type(4)))short;
using f32x16=__attribute__((ext_vector_type(16)))float;
using u32x4=__attribute__((ext_vector_type(4)))unsigned;
using f32x4v=__attribute__((ext_vector_type(4)))float;
constexpr int BATCH=32,NHEAD=8,SEQ=2048,D=64,DM=NHEAD*D;
constexpr int NW=8,QBLK=32,QB=QBLK*NW,KVBLK=64,NQB=SEQ/QB;
constexpr int ATTN_PITCH=DM, ATTN_UNIT_ROWS=QB;
__device__ __forceinline__ int crow(int r,int hi){return (r&3)+8*(r>>2)+4*hi;}
#define SBAR() __builtin_amdgcn_sched_barrier(0)
__device__ __forceinline__ void cmask(f32x16&p0,f32x16&p1,int jb,int qrel,int hi){
  const float NEG=-INFINITY; int kb=64*jb+4*hi;
  #pragma unroll
  for(int r=0;r<16;++r){int kv=kb+(r&3)+8*(r>>2); if(kv>qrel)p0[r]=NEG; if(kv+32>qrel)p1[r]=NEG;}
}

constexpr int NSLOT=3, SLOTB=8192;
constexpr int LDS_K=0, LDS_V=NSLOT*SLOTB, LDS_WS=2*NSLOT*SLOTB, LDS_OST=LDS_WS+NW*64*4, LDS_CB=LDS_OST+NW*4096, LDS_CBX=LDS_CB+2048*4, LDS_AL=LDS_CBX+256, LDS_BYTES=LDS_AL+256;
constexpr float C2=0.125f*1.4426950408889634f;
__device__ __forceinline__ void glds16(const void*gsrc,unsigned lds_dst){unsigned keep;
  asm volatile("s_mov_b32 %0, m0\n\ts_mov_b32 m0, %2\n\ts_nop 0\n\tglobal_load_lds_dwordx4 %1, off\n\ts_mov_b32 m0, %0":"=&s"(keep):"v"(gsrc),"s"(lds_dst):"memory");}
__device__ __forceinline__ float max3f(float a,float b,float c){float r;asm("v_max3_f32 %0, %1, %2, %3":"=v"(r):"v"(a),"v"(b),"v"(c));return r;}
__device__ __forceinline__ float max2f(float a,float b){float r;asm("v_max_f32_e32 %0, %1, %2":"=v"(r):"v"(a),"v"(b));return r;}
__device__ __forceinline__ float fadd_s(float a,float b){float r;asm("v_add_f32_e32 %0, %1, %2":"=v"(r):"v"(a),"v"(b));return r;}
__device__ __forceinline__ float fsub_s(float a,float b){float r;asm("v_sub_f32_e32 %0, %1, %2":"=v"(r):"v"(a),"v"(b));return r;}
typedef float f32x2_t __attribute__((ext_vector_type(2))); typedef __bf16 bf16x2_t __attribute__((ext_vector_type(2)));
__device__ __forceinline__ unsigned cvtpk_s(float lo,float hi){f32x2_t v={lo,hi};bf16x2_t b=__builtin_convertvector(v,bf16x2_t);return __builtin_bit_cast(unsigned,b);}
#define WAIT_BAR(N) asm volatile("s_waitcnt vmcnt(" #N ") lgkmcnt(0)\n\ts_barrier":::"memory")

__device__ __forceinline__ void qkt(f32x16&p0,f32x16&p1,const char*Kslot,const bf16x8*qr,int r32,int hi){ const f32x16 negm=f32x16{};
  const char*kb=Kslot+hi*1024+r32*16;
  #pragma unroll
  for(int d0=0;d0<4;++d0){
    const bf16x8 b0=*reinterpret_cast<const bf16x8*>(kb+d0*2048);
    const bf16x8 b1=*reinterpret_cast<const bf16x8*>(kb+d0*2048+512);
    if(d0==0){p0=__builtin_amdgcn_mfma_f32_32x32x16_bf16(b0,qr[0],negm,0,0,0);p1=__builtin_amdgcn_mfma_f32_32x32x16_bf16(b1,qr[0],negm,0,0,0);}
    else{p0=__builtin_amdgcn_mfma_f32_32x32x16_bf16(b0,qr[d0],p0,0,0,0);p1=__builtin_amdgcn_mfma_f32_32x32x16_bf16(b1,qr[d0],p1,0,0,0);}}
}
typedef __attribute__((address_space(3))) const char* lds_cptr;
typedef short v4i16_t __attribute__((ext_vector_type(4)));
__device__ __forceinline__ void kload8(bf16x8*kf,lds_cptr kp){
  kf[0]=*(const __attribute__((address_space(3))) bf16x8*)(kp);      kf[1]=*(const __attribute__((address_space(3))) bf16x8*)(kp+512);
  kf[2]=*(const __attribute__((address_space(3))) bf16x8*)(kp+2048); kf[3]=*(const __attribute__((address_space(3))) bf16x8*)(kp+2560);
  kf[4]=*(const __attribute__((address_space(3))) bf16x8*)(kp+4096); kf[5]=*(const __attribute__((address_space(3))) bf16x8*)(kp+4608);
  kf[6]=*(const __attribute__((address_space(3))) bf16x8*)(kp+6144); kf[7]=*(const __attribute__((address_space(3))) bf16x8*)(kp+6656);
}
__device__ __forceinline__ void kload2(bf16x8*kf,lds_cptr kp,int j){ kf[2*j]=*(const __attribute__((address_space(3))) bf16x8*)(kp+j*2048); kf[2*j+1]=*(const __attribute__((address_space(3))) bf16x8*)(kp+j*2048+512); }
__device__ __forceinline__ s16x4 vtr(lds_cptr p){ return __builtin_bit_cast(s16x4,__builtin_amdgcn_ds_read_tr16_b64_v4i16((__attribute__((address_space(3))) v4i16_t*)p)); }
__device__ __forceinline__ float rowmax(const f32x16&p0,const f32x16&p1){
  float a=max3f(p0[0],p0[1],p1[0]),b=max3f(p0[2],p0[3],p1[1]);a=max3f(a,p1[2],p1[3]);
  #pragma unroll
  for(int r=4;r<16;r+=4){a=max3f(a,p0[r],p0[r+1]);b=max3f(b,p0[r+2],p0[r+3]);a=max3f(a,p1[r],p1[r+1]);b=max3f(b,p1[r+2],p1[r+3]);}
  const float m=max2f(a,b);
  auto rr=__builtin_amdgcn_permlane32_swap(__float_as_uint(m),__float_as_uint(m),false,false);
  return max2f(__uint_as_float(rr[0]),__uint_as_float(rr[1]));
}
__device__ __forceinline__ void pv(f32x16*o,int vb,bf16x8 pa0,bf16x8 pa1,bf16x8 pa2,bf16x8 pa3){
  #pragma unroll
  for(int d0=0;d0<2;++d0){s16x4 lo[4],hi[4];
    #pragma unroll
    for(int ks=0;ks<4;++ks){
      asm volatile("ds_read_b64_tr_b16 %0,%1 offset:%c2":"=&v"(lo[ks]):"v"(vb),"i"(d0*4096+ks*1024):"memory");
      asm volatile("ds_read_b64_tr_b16 %0,%1 offset:%c2":"=&v"(hi[ks]):"v"(vb),"i"(d0*4096+ks*1024+512):"memory");}
    asm volatile("s_waitcnt lgkmcnt(0)":::"memory");SBAR();
    #define PK(k) (bf16x8){lo[k][0],lo[k][1],lo[k][2],lo[k][3],hi[k][0],hi[k][1],hi[k][2],hi[k][3]}
    o[d0]=__builtin_amdgcn_mfma_f32_32x32x16_bf16(pa0,PK(0),o[d0],0,0,0);
    o[d0]=__builtin_amdgcn_mfma_f32_32x32x16_bf16(pa1,PK(1),o[d0],0,0,0);
    o[d0]=__builtin_amdgcn_mfma_f32_32x32x16_bf16(pa2,PK(2),o[d0],0,0,0);
    o[d0]=__builtin_amdgcn_mfma_f32_32x32x16_bf16(pa3,PK(3),o[d0],0,0,0);
    #undef PK
  }
}

#ifndef ATTN_STORE16
#define ATTN_STORE16(p,v) (*(u32x4*)(p)=(v))
#endif
template<int THRL> __device__ __forceinline__ void attn_unit(int b,int h,int qb,const bf16*Q,const bf16*__restrict__ K,const bf16*__restrict__ V,bf16*O,const float*__restrict__ LFT,const float Dd,char*shm){
  int tid=threadIdx.x; asm volatile("":"+v"(tid)); const int lane=tid&63,r32=lane&31,hi=lane>>5; const int wid=__builtin_amdgcn_readfirstlane(tid>>6);
  const long rowbase=(long)b*SEQ; const int q0=qb*QB;
  const bf16*Qw=Q+(rowbase+q0+wid*QBLK)*DM+h*D;
  const bf16*Kh=K+rowbase*DM+h*D,*Vh=V+rowbase*DM+h*D;
  const unsigned lds0=(unsigned)(uintptr_t)shm;
  float*wsf=(float*)(shm+LDS_WS)+wid*64;
  const bf16*ksrc=Kh+(long)lane*DM+wid*8;
  const bf16*vsrc=Vh+(long)(16*(wid&3)+(lane>>2))*DM+(wid>>2)*32+(lane&3)*8;
  const unsigned kdst=lds0+LDS_K+wid*1024, vdst=lds0+LDS_V+wid*1024;
  #define DMA_K(t,slot) glds16(ksrc+(long)(t)*KVBLK*DM,(unsigned)__builtin_amdgcn_readfirstlane(kdst+(slot)))
  #define DMA_V(t,slot) glds16(vsrc+(long)(t)*KVBLK*DM,(unsigned)__builtin_amdgcn_readfirstlane(vdst+(slot)))
  const int vb0=(int)(lds0+LDS_V)+((lane>>4)&1)*32+(lane&3)*8+(4*hi+((lane&15)>>2))*64;
  const char*Kbase=shm+LDS_K; bf16x8 kf[8];
  const lds_cptr shm3=(lds_cptr)shm; const lds_cptr kp0=shm3+LDS_K+hi*1024+r32*16; const lds_cptr vp0=shm3+LDS_V+((lane>>4)&1)*32+(lane&3)*8+(4*hi+((lane&15)>>2))*64;
  int NT=(q0+QB)/KVBLK;
  typedef __attribute__((address_space(3))) const f32x4v* lds_f4p;
  typedef __attribute__((address_space(3))) float* lds_fp;
  bool stat; int t0;
  {
    lds_fp cbw=(lds_fp)(shm3+LDS_CB); lds_fp cbx=(lds_fp)(shm3+LDS_CBX); lds_fp alw=(lds_fp)(shm3+LDS_AL);
    const float L2E=1.4426950408889634f;
    const int nk=q0+QB; float v0=0.f,v1=0.f,v2=0.f,v3=0.f;
    if(4*tid<nk){ const f32x4v l4=*(const f32x4v*)(LFT+((long)(b*NHEAD+h))*SEQ+4*tid); v0=l4[0]; v1=l4[1]; v2=l4[2]; v3=l4[3]; }
    v1+=v0; v2+=v1; v3+=v2; float tot=v3;
    #pragma unroll
    for(int o_=1;o_<64;o_<<=1){ float u_=__shfl_up(tot,o_); if(lane>=o_)tot+=u_; }
    if(lane==63)cbx[wid]=tot;
    if(tid==0){cbx[48]=0.f;}
    asm volatile("s_waitcnt vmcnt(0) lgkmcnt(0)\n\ts_barrier":::"memory");
    float base=tot-v3;
    #pragma unroll
    for(int w_=0;w_<NW;++w_){ float x_=cbx[w_]; if(w_<wid)base+=x_; }
    v0+=base;v1+=base;v2+=base;v3+=base;
    if(4*tid<nk && ((4*tid+3)&63)==63)cbx[16+((4*tid+3)>>6)]=v3;
    if(4*tid==q0)cbx[8]=v0;
    asm volatile("s_waitcnt vmcnt(0) lgkmcnt(0)\n\ts_barrier":::"memory");
    const float cq0=cbx[8];
    if(4*tid<nk){ const float ce=cbx[16+(tid>>4)]; cbw[4*tid]=(ce-v0)*L2E-Dd; cbw[4*tid+1]=(ce-v1)*L2E-Dd; cbw[4*tid+2]=(ce-v2)*L2E-Dd; cbw[4*tid+3]=(ce-v3)*L2E-Dd; }
    bool skip_=false;
    if(tid<NT){ const float ce=cbx[16+tid], cp=(tid>0)?cbx[16+tid-1]:0.f; const float dl_=(cp-ce)*L2E;
      alw[tid]=__builtin_amdgcn_exp2f(-dl_); alw[32+tid]=dl_; if(dl_+2.f*Dd>110.f)cbx[48]=1.f;
      skip_=(tid<NT-4)&&((ce-cq0)*L2E>2.f*Dd+160.f); }
    const unsigned long long bal_=__ballot(skip_);
    if(tid==0)cbx[49]=(float)(__popcll(bal_)&~1);
    asm volatile("s_waitcnt vmcnt(0) lgkmcnt(0)\n\ts_barrier":::"memory");
    stat=(cbx[48]==0.f); t0=(int)cbx[49];
    stat=__builtin_amdgcn_readfirstlane((int)stat)!=0; t0=__builtin_amdgcn_readfirstlane(t0);
#ifdef FORCE_EXACT
    stat=false;
#endif
  }
  NT-=t0; ksrc+=(long)t0*KVBLK*DM; vsrc+=(long)t0*KVBLK*DM;
  typedef __attribute__((address_space(3))) const float* lds_cfp;
  const lds_cfp alp=(lds_cfp)(shm3+LDS_AL)+t0;
  const int tdw=NT-4+(wid>>1);
  #define ALF(t) (((t)>tdw)?1.f:alp[t])
  const lds_f4p cbp=(lds_f4p)(shm3+LDS_CB)+hi+16*t0;
  #define CBIAS(P0,P1,t) do{ const lds_f4p bp_=cbp+16*(t); _Pragma("unroll") for(int a_=0;a_<4;++a_){ const f32x4v b0_=bp_[2*a_], b1_=bp_[8+2*a_]; \
      P0[4*a_]+=b0_[0];P0[4*a_+1]+=b0_[1];P0[4*a_+2]+=b0_[2];P0[4*a_+3]+=b0_[3]; P1[4*a_]+=b1_[0];P1[4*a_+1]+=b1_[1];P1[4*a_+2]+=b1_[2];P1[4*a_+3]+=b1_[3]; } }while(0)
  DMA_K(0,0);DMA_V(0,0);DMA_K(1,SLOTB);
  bf16x8 qr[4];
  #pragma unroll
  for(int d0=0;d0<4;++d0)qr[d0]=*reinterpret_cast<const bf16x8*>(&Qw[(long)r32*DM+d0*16+hi*8]);
  float mhat=0.f,l_reg=0.f;f32x16 o[2];o[0]=f32x16{};o[1]=f32x16{};
  const int qrel=wid*QBLK+r32;
  #define CMASK(P0,P1,t) do{int jb_=(t)-(NT-4); if(jb_>=0)cmask(P0,P1,jb_,qrel,hi);}while(0)
  bool resc=false;
  #define START(P0,P1) do{ resc=false; \
    if(!stat){ const float rm=rowmax(P0,P1); const float dl=rm; mhat=fadd_s(mhat,dl); \
      _Pragma("unroll") for(int r=0;r<16;++r){P0[r]=fsub_s(P0[r],dl);P1[r]=fsub_s(P1[r],dl);} \
      } \
    _Pragma("unroll") for(int r=0;r<16;++r)P0[r]=__builtin_amdgcn_exp2f(P0[r]); }while(0)
  #define RESC(t) do{ if(stat){ const float al_=ALF(t); _Pragma("unroll") for(int d_=0;d_<2;++d_) _Pragma("unroll") for(int r=0;r<16;++r)o[d_][r]*=al_; } \
    else if(resc){ asm volatile("s_waitcnt lgkmcnt(0)":::"memory"); \
      _Pragma("unroll") for(int d_=0;d_<2;++d_) _Pragma("unroll") for(int r=0;r<16;++r)o[d_][r]*=wsf[crow(r,hi)]; } }while(0)
  f32x16 pA0,pA1,pB0,pB1;
  int sl_prev=0,sl_cur=0,sl_next=SLOTB;
  #define ROT() do{sl_prev=sl_cur;sl_cur=sl_next;sl_next=(sl_next==(NSLOT-1)*SLOTB)?0:sl_next+SLOTB;}while(0)
  DMA_K(2,2*SLOTB);
  WAIT_BAR(3);
  qkt(pA0,pA1,Kbase,qr,r32,hi);asm volatile("s_nop 15\n\ts_nop 7":"+v"(pA0),"+v"(pA1));CMASK(pA0,pA1,0);CBIAS(pA0,pA1,0);
  START(pA0,pA1);
  _Pragma("unroll") for(int r=0;r<16;++r)pA1[r]=__builtin_amdgcn_exp2f(pA1[r]);
  WAIT_BAR(0);
  DMA_K(3,0);DMA_V(1,SLOTB);
  ROT();
  kload8(kf,kp0+sl_cur);
  WAIT_BAR(2);
  s16x4 vlo[8],vhi[8]; u32x4 pw0,pw1,pw2,pw3;
  #define PKW(P,B) cvtpk_s(P[B],P[B+1])
  #define PAF(k) __builtin_bit_cast(bf16x8,pw##k)
  #define VFR(i) (bf16x8){vlo[i][0],vlo[i][1],vlo[i][2],vlo[i][3],vhi[i][0],vhi[i][1],vhi[i][2],vhi[i][3]}
  #define PIN(x) asm volatile("":"+v"(x))
  #define MX3(a,b,c) __builtin_fmaxf(__builtin_fmaxf((a),(b)),(c))
  #define GAPA(MF,A0,A1,A2,A3,W0,W1,PW) do{ MF; sacc+=A0; sacc+=A1; sacc+=A2; sacc+=A3; PIN(sacc); W0; W1; PIN(PW); SBAR(); }while(0)
  #define EX(v) __builtin_amdgcn_exp2f(v)
  #define GAPB(MF,X,B) do{ MF; X[B]=EX(X[B]); X[B+1]=EX(X[B+1]); X[B+2]=EX(X[B+2]); X[B+3]=EX(X[B+3]); PIN(X); SBAR(); }while(0)
  #define VRD(i) do{ vlo[i]=vtr(vp_+(((i)>>2)*4096+((i)&3)*1024)); vhi[i]=vtr(vp_+(((i)>>2)*4096+((i)&3)*1024+512)); }while(0)
  #define KRD(G,j) do{ if(G){ kload2(kf,kp0+sl_next,j); SBAR(); } }while(0)
  #define STEP(C0,C1,P0,P1,t,GK,GV,GL) do{ SBAR(); \
    const lds_cptr vp_=vp0+sl_prev; \
    VRD(0); SBAR(); float sacc=(P0[0]+P0[1]); \
    GAPA(C0=__builtin_amdgcn_mfma_f32_32x32x16_bf16(kf[0],qr[0],f32x16{},0,0,0), P0[2],P0[3],P0[4],P0[5],     pw0[0]=PKW(P0,0), pw0[1]=PKW(P0,2), pw0); \
    VRD(4); SBAR(); GAPA(C1=__builtin_amdgcn_mfma_f32_32x32x16_bf16(kf[1],qr[0],f32x16{},0,0,0), P0[6],P0[7],P0[8],P0[9],     pw0[2]=PKW(P0,4), pw0[3]=PKW(P0,6), pw0); \
    VRD(1); SBAR(); GAPA(C0=__builtin_amdgcn_mfma_f32_32x32x16_bf16(kf[2],qr[1],C0,0,0,0),   P0[10],P0[11],P0[12],P0[13], pw1[0]=PKW(P0,8), pw1[1]=PKW(P0,10), pw1); \
    VRD(5); SBAR(); GAPA(C1=__builtin_amdgcn_mfma_f32_32x32x16_bf16(kf[3],qr[1],C1,0,0,0),   P0[14],P0[15],P1[0],P1[1],   pw1[2]=PKW(P0,12),pw1[3]=PKW(P0,14), pw1); \
    VRD(2); SBAR(); GAPA(C0=__builtin_amdgcn_mfma_f32_32x32x16_bf16(kf[4],qr[2],C0,0,0,0),   P1[2],P1[3],P1[4],P1[5],     pw2[0]=PKW(P1,0), pw2[1]=PKW(P1,2), pw2); \
    VRD(6); SBAR(); GAPA(C1=__builtin_amdgcn_mfma_f32_32x32x16_bf16(kf[5],qr[2],C1,0,0,0),   P1[6],P1[7],P1[8],P1[9],     pw2[2]=PKW(P1,4), pw2[3]=PKW(P1,6), pw2); \
    VRD(3); SBAR(); GAPA(C0=__builtin_amdgcn_mfma_f32_32x32x16_bf16(kf[6],qr[3],C0,0,0,0),   P1[10],P1[11],P1[12],P1[13], pw3[0]=PKW(P1,8), pw3[1]=PKW(P1,10), pw3); \
    VRD(7); SBAR(); GAPA(C1=__builtin_amdgcn_mfma_f32_32x32x16_bf16(kf[7],qr[3],C1,0,0,0),   P1[14],P1[15],0.f,0.f,       pw3[2]=PKW(P1,12),pw3[3]=PKW(P1,14), pw3); \
    l_reg+=sacc; \
    if(GK){DMA_K((t)+3,sl_cur);} if(GV){DMA_V((t)+1,sl_next);} \
    CMASK(C0,C1,t); CBIAS(C0,C1,t); \
    if(stat){ l_reg*=ALF(t); resc=false; } else { mhat-=alp[32+(t)]; _Pragma("unroll") for(int r=0;r<16;++r){C0[r]-=mhat;C1[r]-=mhat;} float a=MX3(C0[0],C0[1],C1[0]),b=MX3(C0[2],C0[3],C1[1]); a=MX3(a,C1[2],C1[3]); \
      _Pragma("unroll") for(int r=4;r<16;r+=4){a=MX3(a,C0[r],C0[r+1]);b=MX3(b,C0[r+2],C0[r+3]);a=MX3(a,C1[r],C1[r+1]);b=MX3(b,C1[r+2],C1[r+3]);} \
      float rm=__builtin_fmaxf(a,b); { auto rr=__builtin_amdgcn_permlane32_swap(__float_as_uint(rm),__float_as_uint(rm),false,false); rm=__builtin_fmaxf(__uint_as_float(rr[0]),__uint_as_float(rr[1])); } \
      resc=false; \
      if(__builtin_expect(__any(rm>(float)THRL),0)){ const float dl=__builtin_fmaxf(rm,0.f); mhat+=dl; \
        _Pragma("unroll") for(int r=0;r<16;++r){C0[r]-=dl;C1[r]-=dl;} \
        const float f=__builtin_amdgcn_exp2f(-dl); l_reg*=f; if(hi==0)wsf[r32]=f; resc=true; } } \
    SBAR(); \
    GAPB(o[0]=__builtin_amdgcn_mfma_f32_32x32x16_bf16(PAF(0),VFR(0),o[0],0,0,0), C0,0); \
    GAPB(o[1]=__builtin_amdgcn_mfma_f32_32x32x16_bf16(PAF(0),VFR(4),o[1],0,0,0), C0,4); \
    KRD(GL,0); GAPB(o[0]=__builtin_amdgcn_mfma_f32_32x32x16_bf16(PAF(1),VFR(1),o[0],0,0,0), C0,8); \
    KRD(GL,1); GAPB(o[1]=__builtin_amdgcn_mfma_f32_32x32x16_bf16(PAF(1),VFR(5),o[1],0,0,0), C0,12); \
    KRD(GL,2); GAPB(o[0]=__builtin_amdgcn_mfma_f32_32x32x16_bf16(PAF(2),VFR(2),o[0],0,0,0), C1,0); \
    KRD(GL,3); GAPB(o[1]=__builtin_amdgcn_mfma_f32_32x32x16_bf16(PAF(2),VFR(6),o[1],0,0,0), C1,4); \
    GAPB(o[0]=__builtin_amdgcn_mfma_f32_32x32x16_bf16(PAF(3),VFR(3),o[0],0,0,0), C1,8); \
    GAPB(o[1]=__builtin_amdgcn_mfma_f32_32x32x16_bf16(PAF(3),VFR(7),o[1],0,0,0), C1,12); \
    }while(0)
  int t=1;
  #undef CMASK
  #define CMASK(P0,P1,t) do{}while(0)
  for(;t+5<NT;t+=2){
    STEP(pB0,pB1,pA0,pA1,t,true,true,true);     WAIT_BAR(2); RESC(t); ROT();
    STEP(pA0,pA1,pB0,pB1,t+1,true,true,true);   WAIT_BAR(2); RESC(t+1); ROT();
  }
  #undef CMASK
  #define CMASK(P0,P1,t) do{int jb_=(t)-(NT-4); if(jb_>=0)cmask(P0,P1,jb_,qrel,hi);}while(0)
  #define ENDW(tt) do{ if((tt)+3<NT){WAIT_BAR(2);} else if((tt)+2<NT){WAIT_BAR(1);} else {WAIT_BAR(0);} }while(0)
  for(;t+1<NT;t+=2){
    STEP(pB0,pB1,pA0,pA1,t,(t+3<NT),(t+1<NT),(t+1<NT));       ENDW(t);   RESC(t); ROT();
    STEP(pA0,pA1,pB0,pB1,t+1,(t+4<NT),(t+2<NT),(t+2<NT));     ENDW(t+1); RESC(t+1); ROT();
  }
  STEP(pB0,pB1,pA0,pA1,NT-1,false,false,false); RESC(NT-1);
  { float sacc=pB0[0]+pB0[1]; _Pragma("unroll") for(int r=2;r<16;++r)sacc+=pB0[r]; _Pragma("unroll") for(int r=0;r<16;++r)sacc+=pB1[r]; l_reg+=sacc;
    pw0=(u32x4){PKW(pB0,0),PKW(pB0,2),PKW(pB0,4),PKW(pB0,6)};pw1=(u32x4){PKW(pB0,8),PKW(pB0,10),PKW(pB0,12),PKW(pB0,14)};pw2=(u32x4){PKW(pB1,0),PKW(pB1,2),PKW(pB1,4),PKW(pB1,6)};pw3=(u32x4){PKW(pB1,8),PKW(pB1,10),PKW(pB1,12),PKW(pB1,14)};
    SBAR(); pv(o,vb0+sl_cur,PAF(0),PAF(1),PAF(2),PAF(3)); }
  #undef PKW
  #undef PAF
  #undef VFR
  #undef PIN
  #undef MX3
  #undef GAPA
  #undef GAPB
  #undef EX
  #undef VRD
  #undef KRD
  #undef STEP
  #undef ENDW
  {auto rr=__builtin_amdgcn_permlane32_swap(__float_as_uint(l_reg),__float_as_uint(l_reg),false,false);l_reg=__uint_as_float(rr[0])+__uint_as_float(rr[1]);}
  if(hi==0)wsf[32+r32]=l_reg;asm volatile("s_waitcnt lgkmcnt(0)":::"memory");
  float rli[16];
  #pragma unroll
  for(int r=0;r<16;++r)rli[r]=__builtin_amdgcn_rcpf(wsf[32+crow(r,hi)]);
  bf16*Ow=O+(rowbase+q0+wid*QBLK)*DM+h*D;
  { bf16*stg=(bf16*)(shm+LDS_OST)+wid*2048;
    #pragma unroll
    for(int r=0;r<16;++r){const int orow=crow(r,hi);
      #pragma unroll
      for(int d0=0;d0<2;++d0)stg[orow*64+d0*32+r32]=__float2bfloat16(o[d0][r]*rli[r]);}
    asm volatile("s_waitcnt lgkmcnt(0)":::"memory");
    #pragma unroll
    for(int i=0;i<4;++i){const int row=i*8+(lane>>3),ch=lane&7; const u32x4 v=*(const u32x4*)(stg+row*64+ch*8); ATTN_STORE16(Ow+(long)row*DM+ch*8,v);} }
  asm volatile("s_waitcnt lgkmcnt(0)\n\ts_barrier":::"memory");
  #undef DMA_K
  #undef DMA_V
  #undef CMASK
  #undef CBIAS
  #undef ALF
  #undef START
  #undef RESC
  #undef ROT
}
constexpr int ATTN_LDS_BYTES=LDS_BYTES;
#undef SBAR
#undef WAIT_BAR
}
namespace xb {
#define XLAS __attribute__((address_space(3)))
#define XB_TMO      128
#define XB_XCNT(j)  (256  + 64 * (j))
#define XB_XSUB(j)  (1280 + 64 * (j))
#define XB_XGEN(j)  (2304 + 64 * (j))
#define XB_TOP      3328
#define XB_TOPGEN   3392
#define XCD_BAR_WORDS 3456
#define XB_SPIN_CAP (1u << 18)

__device__ __forceinline__ unsigned xb_ld(unsigned* p)              { return __hip_atomic_load(p, __ATOMIC_RELAXED, __HIP_MEMORY_SCOPE_AGENT); }
__device__ __forceinline__ unsigned xb_add(unsigned* p, unsigned v) { return __hip_atomic_fetch_add(p, v, __ATOMIC_RELAXED, __HIP_MEMORY_SCOPE_AGENT); }
__device__ __forceinline__ unsigned xb_xcc_id() { return (unsigned)__builtin_amdgcn_s_getreg((3 << 11) | 20) & 0xFu; }
#define XB_SPIN(cond, bar) do { unsigned _sp = 0; while (cond) { __builtin_amdgcn_s_sleep(1); \
    if ((++_sp & 255u) == 0u) { if (xb_ld(&(bar)[XB_TMO])) break; if (_sp > XB_SPIN_CAP) { atomicAdd(&(bar)[XB_TMO], 1u); break; } } } } while (0)

struct XcdBarrier {
    unsigned* bar; unsigned x;
    volatile XLAS unsigned* st;
};

__device__ __forceinline__ XcdBarrier xcd_barrier_post(unsigned* bar, volatile XLAS unsigned* st) {
    XcdBarrier b; b.bar = bar; b.x = xb_xcc_id(); b.st = st;
    if (threadIdx.x == 0) (void)xb_add(&bar[XB_XCNT(b.x)], 1u);
    return b;
}
__device__ __forceinline__ void xcd_barrier_complete(unsigned* bar, unsigned x, unsigned& nloc, unsigned& nx) {
    const unsigned G = gridDim.x * gridDim.y * gridDim.z;
    unsigned sum, cnt, mine, sp = 0u;
    for (;;) {
        sum = 0u; cnt = 0u; mine = 0u;
#pragma unroll
        for (unsigned j = 0; j < 16; ++j) { const unsigned c = xb_ld(&bar[XB_XCNT(j)]); sum += c; cnt += (c > 0u) ? 1u : 0u; mine = (j == x) ? c : mine; }
        if (sum == G) break;
        __builtin_amdgcn_s_sleep(1);
        if ((++sp & 255u) == 0u) { if (xb_ld(&bar[XB_TMO])) break; if (sp > XB_SPIN_CAP) { atomicAdd(&bar[XB_TMO], 1u); break; } }
    }
    nloc = mine > 0u ? mine : 1u; nx = cnt > 0u ? cnt : 1u;
}

__device__ __forceinline__ void xcd_barrier(const XcdBarrier& b) {
    asm volatile("s_waitcnt vmcnt(0)" ::: "memory");
    __syncthreads();
    if (threadIdx.x == 0) {
        unsigned* bar = b.bar;
        __builtin_amdgcn_s_waitcnt(0);
        unsigned nloc = b.st[0], nx = b.st[1];
        if (nloc == 0u) { xcd_barrier_complete(bar, b.x, nloc, nx); b.st[0] = nloc; b.st[1] = nx; }
        const unsigned old = xb_add(&bar[XB_XSUB(b.x)], 1u);
        const unsigned gen = old / nloc;
        if (old + 1u == (gen + 1u) * nloc) {
            __builtin_amdgcn_fence(__ATOMIC_RELEASE, "agent");
            asm volatile("s_waitcnt vmcnt(0)" ::: "memory");
            const unsigned og = xb_add(&bar[XB_TOP], 1u);
            const unsigned tg = og / nx;
            if (og + 1u == (tg + 1u) * nx) xb_add(&bar[XB_TOPGEN], 1u);
            else XB_SPIN(xb_ld(&bar[XB_TOPGEN]) == tg, bar);
            __builtin_amdgcn_fence(__ATOMIC_ACQUIRE, "agent");
            xb_add(&bar[XB_XGEN(b.x)], 1u);
            asm volatile("s_waitcnt vmcnt(0)" ::: "memory");
        } else {
            XB_SPIN(xb_ld(&bar[XB_XGEN(b.x)]) == gen, bar);
            __builtin_amdgcn_fence(__ATOMIC_ACQUIRE, "agent");
            asm volatile("s_waitcnt vmcnt(0)" ::: "memory");
        }
    }
    __syncthreads();
}
}
namespace mk {
#define LAS __attribute__((address_space(3)))
typedef unsigned short u16;
typedef pg8::f32x4 f32x4;
typedef pg8::u32x4 u32x4;
typedef pg8::bf16x8 bf16x8;
typedef unsigned u32x2 __attribute__((ext_vector_type(2)));
using pg8::cvt_pk_bf16;

constexpr int DMODEL = 1024, SEQ = 2048, MP = 65536, MS = 256, MT = MP + MS, DFF = 2816, NMIX = 6912, PAST = 4096, NPOS = 2048 + 16;
constexpr float L2E = 1.4426950408889634f;
constexpr float QC2 = 0.125f * L2E;

constexpr size_t SZ1024 = (size_t)MT * 1024 * 2, SZ512 = (size_t)MT * 512 * 2;
constexpr size_t O_CTL = 0;
constexpr size_t O_SS = 65536;
constexpr size_t O_TABC = O_SS + (size_t)MT * 64;
constexpr size_t O_TABS = O_TABC + (size_t)NPOS * 256;
constexpr size_t O_W1IN = O_TABS + (size_t)NPOS * 256;
constexpr size_t O_W1OUT = O_W1IN + (size_t)5632 * 1024 * 2;
constexpr size_t O_WMIX = O_W1OUT + (size_t)1024 * 2816 * 2;
constexpr size_t O_WBR = O_WMIX + (size_t)NMIX * 1024 * 2;
constexpr size_t O_WBF = O_WBR + (size_t)1024 * 1024 * 2;
constexpr size_t O_WOUT = O_WBF + (size_t)1024 * 512 * 2;
constexpr size_t O_W2IN = O_WOUT + (size_t)1024 * 1024 * 2;
constexpr size_t O_W2OUT = O_W2IN + (size_t)5632 * 1024 * 2;
constexpr size_t O_WPLE = O_W2OUT + (size_t)1024 * 2816 * 2;
constexpr size_t O_WPG = O_WPLE + (size_t)1024 * 256 * 2;
constexpr size_t O_XB = O_WPG + (size_t)1024 * 1024 * 2;
constexpr size_t O_RQK = O_XB + SZ1024;
constexpr size_t O_RV = O_RQK + SZ1024;
constexpr size_t O_RG = O_RV + SZ1024;
constexpr size_t O_FQ = O_RG + SZ1024;
constexpr size_t O_FK = O_FQ + SZ512;
constexpr size_t O_FV = O_FK + SZ512;
constexpr size_t O_ZG = O_FV + SZ512;
constexpr size_t WS_NEED = O_ZG + (size_t)MT * 2048 * 2;
constexpr size_t O_ACT1 = O_RQK;
constexpr size_t O_ACT2 = O_RV;
static_assert(O_ACT1 + (size_t)MT * DFF * 2 <= O_FQ, "act1 overlay");
static_assert(O_ACT2 + (size_t)MT * DFF * 2 <= O_FV, "act2 overlay");
static_assert(WS_NEED <= 1073741824ull, "ws");
constexpr size_t OUT_YP = 0, OUT_YS = OUT_YP + (size_t)MP * 1024, OUT_RSP = OUT_YS + (size_t)MS * 1024, OUT_KP = OUT_RSP + (size_t)32 * 4 * 128 * 256,
                 OUT_VP = OUT_KP + (size_t)MP * 512, OUT_LP = OUT_VP + (size_t)MP * 512, OUT_RSS = OUT_LP + (size_t)MP * 8, OUT_KS = OUT_RSS + (size_t)16 * 4 * 128 * 256,
                 OUT_VS = OUT_KS + (size_t)MS * 512, OUT_LS = OUT_VS + (size_t)MS * 512, OUT_END = OUT_LS + (size_t)MS * 8;

constexpr int LDS_BYTES = 147456;

__device__ __forceinline__ float bf2f(unsigned h) { return __uint_as_float(h << 16); }
__device__ __forceinline__ float bflo(unsigned w) { return __uint_as_float(w << 16); }
__device__ __forceinline__ float bfhi(unsigned w) { return __uint_as_float(w & 0xffff0000u); }
__device__ __forceinline__ float fast_sigmoid(float x) { return __builtin_amdgcn_rcpf(1.f + __builtin_amdgcn_exp2f(-x * L2E)); }
__device__ __forceinline__ float wave_sum(float v) {
#pragma unroll
    for (int o = 1; o < 64; o <<= 1) v += __shfl_xor(v, o);
    return v;
}
__device__ __forceinline__ float wave_max(float v) {
#pragma unroll
    for (int o = 1; o < 64; o <<= 1) v = fmaxf(v, __shfl_xor(v, o));
    return v;
}
__device__ __forceinline__ float rstd_of(const float* ss, int row) {
    const f32x4* p = (const f32x4*)(ss + (size_t)row * 16); const f32x4 a = p[0], b = p[1], c = p[2], d = p[3];
    const float s = (((a[0] + a[1]) + (a[2] + a[3])) + ((b[0] + b[1]) + (b[2] + b[3]))) + (((c[0] + c[1]) + (c[2] + c[3])) + ((d[0] + d[1]) + (d[2] + d[3])));
    return rsqrtf(s * (1.f / 1024.f) + 1e-6f);
}
__device__ __forceinline__ int gcol(int q) { return (q & 128) + (q & 96) + ((q >> 2) & 3) * 8 + ((q >> 4) & 1) * 4 + (q & 3); }

struct EpiSwiglu {
    static constexpr bool PERM = false, AFTER_DRAIN = false;
    u16* O; const float* ss;
    __device__ __forceinline__ void operator()(const f32x4 (&acc)[2][2][4][2], const pg8::Unit& u, int wr, int wc, int fr, int fq) const {
        const int col = u.pn * 128 + wc * 32 + fq * 8;
#pragma unroll
        for (int ai = 0; ai < 2; ++ai)
#pragma unroll
            for (int m = 0; m < 4; ++m) {
                const int row = u.pm * 256 + ai * 128 + wr * 64 + m * 16 + fr; const float rs = rstd_of(ss, row);
                float a[8];
#pragma unroll
                for (int n = 0; n < 2; ++n)
#pragma unroll
                    for (int e = 0; e < 4; ++e) { const float g = acc[ai][0][m][n][e] * rs, uu = acc[ai][1][m][n][e] * rs; a[n * 4 + e] = g * uu * fast_sigmoid(g); }
                u32x4 w; w.x = cvt_pk_bf16(a[0], a[1]); w.y = cvt_pk_bf16(a[2], a[3]); w.z = cvt_pk_bf16(a[4], a[5]); w.w = cvt_pk_bf16(a[6], a[7]);
                *(u32x4*)(O + (size_t)row * DFF + col) = w;
            }
    }
};
struct EpiMix {
    static constexpr bool PERM = false, AFTER_DRAIN = false;
    const float* ss; const float* tabc; const float* tabs; const float* qg; const float* kg; const float* bfg;
    u16 *RQK, *RV, *RG, *FQ, *FK, *FV, *ZG; float* out; float* lft;
    template <int MODE> static __device__ __forceinline__ void store8(const f32x4 (&acc)[2][2][4][2], u16* base, int ld, int t, int row, float rs, int ai, int m, int wc, int fq) {
#pragma unroll
        for (int bj = 0; bj < 2; ++bj) {
            float a[8];
#pragma unroll
            for (int n = 0; n < 2; ++n)
#pragma unroll
                for (int e = 0; e < 4; ++e) { const float v = acc[ai][bj][m][n][e] * rs; a[n * 4 + e] = MODE == 0 ? v : (MODE == 1 ? v * fast_sigmoid(v) : fast_sigmoid(v)); }
            u32x4 w; w.x = cvt_pk_bf16(a[0], a[1]); w.y = cvt_pk_bf16(a[2], a[3]); w.z = cvt_pk_bf16(a[4], a[5]); w.w = cvt_pk_bf16(a[6], a[7]);
            *(u32x4*)(base + (size_t)row * ld + t * 256 + bj * 128 + wc * 32 + fq * 8) = w;
        }
    }
    template <bool ISK> static __device__ __forceinline__ void headnorm(const f32x4 (&acc)[2][2][4][2], u16* dst, const float* gn, float* o, int row, float rs, int ai, int m, int head, int fq) {
        float q = 0.f;
#pragma unroll
        for (int bj = 0; bj < 2; ++bj)
#pragma unroll
            for (int n = 0; n < 2; ++n) { const f32x4 v = acc[ai][bj][m][n] * rs; q += (v[0] * v[0] + v[1] * v[1]) + (v[2] * v[2] + v[3] * v[3]); }
        q += __shfl_xor(q, 16); q += __shfl_xor(q, 32);
        const float hr = rsqrtf(q * (1.f / 64.f) + 1e-6f) * rs * (ISK ? 1.f : QC2);
#pragma unroll
        for (int bj = 0; bj < 2; ++bj)
#pragma unroll
            for (int n = 0; n < 2; ++n) {
                const int d = 32 * bj + 16 * n + 4 * fq; const f32x4 g4 = *(const f32x4*)(gn + d); const f32x4 v = acc[ai][bj][m][n] * hr * g4;
                u32x2 w; w.x = cvt_pk_bf16(v[0], v[1]); w.y = cvt_pk_bf16(v[2], v[3]);
                *(u32x2*)(dst + (size_t)row * 512 + head * 64 + d) = w;
                if (ISK) *(f32x4*)(o + head * 64 + d) = v;
            }
    }
    __device__ __forceinline__ void operator()(const f32x4 (&acc)[2][2][4][2], const pg8::Unit& u, int wr, int wc, int fr, int fq) const {
        const int pn = u.pn;
#pragma unroll
        for (int ai = 0; ai < 2; ++ai)
#pragma unroll
            for (int m = 0; m < 4; ++m) {
                const int row = u.pm * 256 + ai * 128 + wr * 64 + m * 16 + fr; const float rs = rstd_of(ss, row);
                if (pn < 4) {
                    const int pidx = row < MP ? (row & (SEQ - 1)) : SEQ + ((row - MP) & 15);
                    const int d = 16 * wc + 4 * fq;
                    const f32x4 c = *(const f32x4*)(tabc + pidx * 64 + d), s = *(const f32x4*)(tabs + pidx * 64 + d);
                    const float sc = rs * (pn >= 2 ? 0.08838834764831845f : 1.f);
#pragma unroll
                    for (int bj = 0; bj < 2; ++bj) {
                        const f32x4 x1 = acc[ai][bj][m][0] * sc, x2 = acc[ai][bj][m][1] * sc;
                        const f32x4 o1 = x1 * c - x2 * s, o2 = x1 * s + x2 * c;
                        u16* p = RQK + (size_t)row * 1024 + (pn >> 1) * 512 + (2 * (pn & 1) + bj) * 128 + d;
                        u32x2 w1, w2; w1.x = cvt_pk_bf16(o1[0], o1[1]); w1.y = cvt_pk_bf16(o1[2], o1[3]); w2.x = cvt_pk_bf16(o2[0], o2[1]); w2.y = cvt_pk_bf16(o2[2], o2[3]);
                        *(u32x2*)p = w1; *(u32x2*)(p + 64) = w2;
                    }
                } else if (pn < 8) { store8<0>(acc, RV, 1024, pn - 4, row, rs, ai, m, wc, fq);
                } else if (pn < 12) { store8<1>(acc, RG, 1024, pn - 8, row, rs, ai, m, wc, fq);
                } else if (pn >= 19) { store8<2>(acc, ZG, 2048, pn - 19, row, rs, ai, m, wc, fq);
                } else if (pn < 14) { headnorm<false>(acc, FQ, qg, nullptr, row, rs, ai, m, 4 * (pn & 1) + wc, fq);
                } else if (pn < 16) { headnorm<true>(acc, FK, kg, row < MP ? out + OUT_KP + (size_t)row * 512 : out + OUT_KS + (size_t)(row - MP) * 512, row, rs, ai, m, 4 * (pn & 1) + wc, fq);
                } else if (pn < 18) {
                    float* o = row < MP ? out + OUT_VP + (size_t)row * 512 : out + OUT_VS + (size_t)(row - MP) * 512;
#pragma unroll
                    for (int bj = 0; bj < 2; ++bj) {
                        const int col = (pn - 16) * 256 + bj * 128 + wc * 32 + fq * 8;
                        const f32x4 v0 = acc[ai][bj][m][0] * rs, v1 = acc[ai][bj][m][1] * rs;
                        u32x4 w; w.x = cvt_pk_bf16(v0[0], v0[1]); w.y = cvt_pk_bf16(v0[2], v0[3]); w.z = cvt_pk_bf16(v1[0], v1[1]); w.w = cvt_pk_bf16(v1[2], v1[3]);
                        *(u32x4*)(FV + (size_t)row * 512 + col) = w; *(f32x4*)(o + col) = v0; *(f32x4*)(o + col + 4) = v1;
                    }
                } else {
                    if (wc == 0 && fq == 0) {
                        float* o = row < MP ? out + OUT_LP + (size_t)row * 8 : out + OUT_LS + (size_t)(row - MP) * 8;
#pragma unroll
                        for (int n = 0; n < 2; ++n) { f32x4 r;
#pragma unroll
                            for (int e = 0; e < 4; ++e) { const float x = acc[ai][0][m][n][e] * rs + bfg[n * 4 + e]; r[e] = fminf(x, 0.f) - __logf(1.f + __expf(-fabsf(x))); }
                            *(f32x4*)(o + n * 4) = r;
                            if (row < MP) { float* lt = lft + ((size_t)(row >> 11) * 8 + n * 4) * SEQ + (row & (SEQ - 1)); lt[0] = r[0]; lt[SEQ] = r[1]; lt[2 * SEQ] = r[2]; lt[3 * SEQ] = r[3]; } }
                    }
                }
            }
    }
};
struct FResid {
    static constexpr bool NEED_RS = false, WRITE_SS = true; static constexpr int BATCH = 4;
    u16* XB; float* ss; float alpha;
    struct In { u32x4 x; };
    __device__ __forceinline__ In load(int row, int col) const { In r; r.x = *(const u32x4*)(XB + (size_t)row * 1024 + col); return r; }
    __device__ __forceinline__ float finish(int row, int col, const float (&v)[8], const In& in, float) const {
        const u32x4 x = in.x;
        const float r0 = bflo(x.x) + alpha * v[0], r1 = bfhi(x.x) + alpha * v[1], r2 = bflo(x.y) + alpha * v[2], r3 = bfhi(x.y) + alpha * v[3],
                    r4 = bflo(x.z) + alpha * v[4], r5 = bfhi(x.z) + alpha * v[5], r6 = bflo(x.w) + alpha * v[6], r7 = bfhi(x.w) + alpha * v[7];
        u32x4 w; w.x = cvt_pk_bf16(r0, r1); w.y = cvt_pk_bf16(r2, r3); w.z = cvt_pk_bf16(r4, r5); w.w = cvt_pk_bf16(r6, r7); *(u32x4*)(XB + (size_t)row * 1024 + col) = w;
        return ((r0 * r0 + r1 * r1) + (r2 * r2 + r3 * r3)) + ((r4 * r4 + r5 * r5) + (r6 * r6 + r7 * r7));
    }
};
template <bool SECOND> struct FGate {
    static constexpr bool NEED_RS = false, WRITE_SS = false; static constexpr int BATCH = 4;
    u16* T; const u16* ZG; float* ss;
    struct In { u32x4 g, p; };
    __device__ __forceinline__ In load(int row, int col) const { In r; r.g = *(const u32x4*)(ZG + (size_t)row * 2048 + (SECOND ? 1024 : 0) + col); if (SECOND) r.p = *(const u32x4*)(T + (size_t)row * 1024 + col); else r.p = (u32x4){0u, 0u, 0u, 0u}; return r; }
    __device__ __forceinline__ float finish(int row, int col, const float (&a)[8], const In& in, float) const {
        const u32x4 g = in.g, p = in.p;
        float v[8] = {bflo(g.x) * a[0], bfhi(g.x) * a[1], bflo(g.y) * a[2], bfhi(g.y) * a[3], bflo(g.z) * a[4], bfhi(g.z) * a[5], bflo(g.w) * a[6], bfhi(g.w) * a[7]};
        if (SECOND) { v[0] += bflo(p.x); v[1] += bfhi(p.x); v[2] += bflo(p.y); v[3] += bfhi(p.y); v[4] += bflo(p.z); v[5] += bfhi(p.z); v[6] += bflo(p.w); v[7] += bfhi(p.w); }
        u32x4 w; w.x = cvt_pk_bf16(v[0], v[1]); w.y = cvt_pk_bf16(v[2], v[3]); w.z = cvt_pk_bf16(v[4], v[5]); w.w = cvt_pk_bf16(v[6], v[7]);
        *(u32x4*)(T + (size_t)row * 1024 + col) = w; return 0.f;
    }
};
struct FPlain {
    static constexpr bool NEED_RS = false, WRITE_SS = false; static constexpr int BATCH = 4;
    u16* O; float* ss;
    struct In { int dummy; };
    __device__ __forceinline__ In load(int, int) const { In r; r.dummy = 0; return r; }
    __device__ __forceinline__ float finish(int row, int col, const float (&a)[8], const In&, float) const {
        u32x4 w; w.x = cvt_pk_bf16(a[0], a[1]); w.y = cvt_pk_bf16(a[2], a[3]); w.z = cvt_pk_bf16(a[4], a[5]); w.w = cvt_pk_bf16(a[6], a[7]);
        *(u32x4*)(O + (size_t)row * 1024 + col) = w; return 0.f;
    }
};
struct FFinal {
    static constexpr bool NEED_RS = true, WRITE_SS = false; static constexpr int BATCH = 2;
    float* yP; float* yS; const u16* XB; const u16* PLE; float* ss;
    struct In { u32x4 x, p; };
    __device__ __forceinline__ In load(int row, int col) const { In r; r.x = *(const u32x4*)(XB + (size_t)row * 1024 + col); r.p = *(const u32x4*)(PLE + (size_t)row * 1024 + col); return r; }
    __device__ __forceinline__ float finish(int row, int col, const float (&a)[8], const In& in, float rs) const {
        float* y = (row < MP ? yP + (size_t)row * 1024 : yS + (size_t)(row - MP) * 1024) + col;
        const u32x4 x = in.x, p = in.p;
        f32x4 y0, y1;
        y0[0] = bflo(x.x) + bflo(p.x) * fast_sigmoid(a[0] * rs); y0[1] = bfhi(x.x) + bfhi(p.x) * fast_sigmoid(a[1] * rs); y0[2] = bflo(x.y) + bflo(p.y) * fast_sigmoid(a[2] * rs); y0[3] = bfhi(x.y) + bfhi(p.y) * fast_sigmoid(a[3] * rs);
        y1[0] = bflo(x.z) + bflo(p.z) * fast_sigmoid(a[4] * rs); y1[1] = bfhi(x.z) + bfhi(p.z) * fast_sigmoid(a[5] * rs); y1[2] = bflo(x.w) + bflo(p.w) * fast_sigmoid(a[6] * rs); y1[3] = bfhi(x.w) + bfhi(p.w) * fast_sigmoid(a[7] * rs);
        *(f32x4*)y = y0; *(f32x4*)(y + 4) = y1; return 0.f;
    }
};
template <class F> struct EpiWrap {
    static constexpr bool PERM = false, AFTER_DRAIN = false;
    F f;
    __device__ __forceinline__ void operator()(const f32x4 (&acc)[2][2][4][2], const pg8::Unit& u, int wr, int wc, int fr, int fq) const {
        constexpr int NB = F::BATCH;
#pragma unroll
        for (int ab = 0; ab < 8 / NB; ++ab) {
            const int ai = (ab * NB) / 4, m0 = (ab * NB) % 4;
            typename F::In in[NB][2]; f32x4 sp[NB][4];
            const int row0 = u.pm * 256 + ai * 128 + wr * 64 + fr + m0 * 16, col0 = u.pn * 256 + wc * 32 + fq * 8;
#pragma unroll
            for (int m = 0; m < NB; ++m) {
                if (F::NEED_RS) { const f32x4* p = (const f32x4*)(f.ss + (size_t)(row0 + m * 16) * 16); sp[m][0] = p[0]; sp[m][1] = p[1]; sp[m][2] = p[2]; sp[m][3] = p[3]; }
#pragma unroll
                for (int bj = 0; bj < 2; ++bj) in[m][bj] = f.load(row0 + m * 16, col0 + bj * 128);
            }
            __builtin_amdgcn_sched_barrier(0);
#pragma unroll
            for (int m = 0; m < NB; ++m) {
                const int row = row0 + m * 16; float rs = 1.f;
                if (F::NEED_RS) { const f32x4 a = sp[m][0], b = sp[m][1], c = sp[m][2], d = sp[m][3];
                    const float s = (((a[0] + a[1]) + (a[2] + a[3])) + ((b[0] + b[1]) + (b[2] + b[3]))) + (((c[0] + c[1]) + (c[2] + c[3])) + ((d[0] + d[1]) + (d[2] + d[3]))); rs = rsqrtf(s * (1.f / 1024.f) + 1e-6f); }
                float q = 0.f;
#pragma unroll
                for (int bj = 0; bj < 2; ++bj) {
                    const float v[8] = {acc[ai][bj][m0 + m][0][0], acc[ai][bj][m0 + m][0][1], acc[ai][bj][m0 + m][0][2], acc[ai][bj][m0 + m][0][3], acc[ai][bj][m0 + m][1][0], acc[ai][bj][m0 + m][1][1], acc[ai][bj][m0 + m][1][2], acc[ai][bj][m0 + m][1][3]};
                    q += f.finish(row, col0 + bj * 128, v, in[m][bj], rs);
                }
                if (F::WRITE_SS) { q += __shfl_xor(q, 16); q += __shfl_xor(q, 32); if (fq == 0) f.ss[(size_t)row * 16 + u.pn * 4 + wc] = q; }
            }
        }
    }
};
template <class F> __device__ __forceinline__ void small_gemm(LAS unsigned char* lds, const u16* A, const u16* Bt, int K, const F& f, int bx, int G) {
    int tid = threadIdx.x; asm volatile("" : "+v"(tid));
    const int lane = tid & 63, w = __builtin_amdgcn_readfirstlane(tid >> 6), g = lane >> 4, c16 = lane & 15;
    LAS float* red = (LAS float*)lds;
    const int steps = K / 256;
    for (int item = bx; item < 256; item += G) {
        const int rb = item >> 4, cb = item & 15;
        const u16* ap = A + (size_t)(16 * rb + c16) * K + (size_t)w * (K / 8) + 8 * g;
        const u16* bp = Bt + (size_t)(64 * cb + c16) * K + (size_t)w * (K / 8) + 8 * g;
        f32x4 acc[4];
#pragma unroll
        for (int nt = 0; nt < 4; ++nt) acc[nt] = (f32x4){0.f, 0.f, 0.f, 0.f};
        for (int s0 = 0; s0 < steps; s0 += 4) {
            bf16x8 a[4], b[4][4];
#pragma unroll
            for (int j = 0; j < 4; ++j) if (s0 + j < steps) { a[j] = *(const bf16x8*)(ap + 32 * (s0 + j));
#pragma unroll
                for (int nt = 0; nt < 4; ++nt) b[j][nt] = *(const bf16x8*)(bp + (size_t)16 * nt * K + 32 * (s0 + j)); }
#pragma unroll
            for (int j = 0; j < 4; ++j) if (s0 + j < steps) {
#pragma unroll
                for (int nt = 0; nt < 4; ++nt) acc[nt] = __builtin_amdgcn_mfma_f32_16x16x32_bf16(a[j], b[j][nt], acc[nt], 0, 0, 0); }
        }
        __syncthreads();
#pragma unroll
        for (int nt = 0; nt < 4; ++nt)
#pragma unroll
            for (int i = 0; i < 4; ++i) red[(w * 16 + 4 * g + i) * 64 + 16 * nt + c16] = acc[nt][i];
        __syncthreads();
        if (tid < 128) {
            const int row = tid >> 3, c8 = tid & 7, p0 = 32 * (c8 >> 2) + 4 * (c8 & 3);
            f32x4 s0 = {0.f, 0.f, 0.f, 0.f}, s1 = {0.f, 0.f, 0.f, 0.f};
#pragma unroll
            for (int ww = 0; ww < 8; ++ww) { s0 += *(const LAS f32x4*)(red + (ww * 16 + row) * 64 + p0); s1 += *(const LAS f32x4*)(red + (ww * 16 + row) * 64 + p0 + 16); }
            const float v[8] = {s0[0], s0[1], s0[2], s0[3], s1[0], s1[1], s1[2], s1[3]};
            const int grow = MP + 16 * rb + row; float rs = 1.f; if (F::NEED_RS) rs = rstd_of(f.ss, grow);
            const typename F::In in = f.load(grow, 64 * cb + 8 * c8); float q = f.finish(grow, 64 * cb + 8 * c8, v, in, rs);
            if (F::WRITE_SS) { q += __shfl_xor(q, 1); q += __shfl_xor(q, 2); q += __shfl_xor(q, 4); if (c8 == 0) f.ss[(size_t)grow * 16 + cb] = q; }
        }
    }
    __syncthreads();
}
__device__ __forceinline__ int logical_col(int kind, int pr) {
    const int t = pr >> 8, q = pr & 255, g = gcol(q);
    if (kind == 0) return t * 256 + g;
    if (kind == 1) { const int bj = q >> 7; return bj * DFF + t * 128 + (g & 127); }
    const int bj = q >> 7, wc = (q >> 5) & 3, n = (q >> 4) & 1, fq = (q >> 2) & 3, e = q & 3;
    if (t < 4) return (t >> 1) * 512 + (2 * (t & 1) + bj) * 128 + 16 * wc + 4 * fq + e + 64 * n;
    if (t < 8) return 1024 + (t - 4) * 256 + g;
    if (t < 12) return 2048 + (t - 8) * 256 + g;
    if (t < 16) return (t < 14 ? 3072 : 3584) + (4 * (t & 1) + wc) * 64 + 32 * bj + 16 * n + 4 * fq + e;
    if (t < 18) return 4096 + (t - 16) * 256 + g;
    if (t == 18) return g < 8 ? 4608 + g : -1;
    return 4616 + (t - 19) * 256 + g;
}
__device__ __forceinline__ void transpose_item(const float* W, const float* gain, int K, int Nlog, int kind, u16* WT, int nblk, LAS float* scr, int item, int lane) {
    const int kb = item / nblk, nb = item % nblk, k0 = 64 * kb, n0 = 32 * nb;
    const int lc = logical_col(kind, n0 + (lane & 31));
    float tv[32];
#pragma unroll
    for (int i = 0; i < 32; ++i) { const int kk = 2 * i + (lane >> 5); tv[i] = (lc >= 0) ? W[(size_t)(k0 + kk) * Nlog + lc] : 0.f; }
#pragma unroll
    for (int i = 0; i < 32; ++i) { const int kk = 2 * i + (lane >> 5); float v = tv[i]; if (gain) v *= gain[k0 + kk]; scr[kk * 33 + (lane & 31)] = v; }
    asm volatile("s_waitcnt lgkmcnt(0)" ::: "memory");
    const int c = lane & 7;
#pragma unroll
    for (int j = 0; j < 4; ++j) { const int n = (lane >> 3) + 8 * j; const LAS float* s = scr + (8 * c) * 33 + n;
        u32x4 o; o.x = cvt_pk_bf16(s[0 * 33], s[1 * 33]); o.y = cvt_pk_bf16(s[2 * 33], s[3 * 33]); o.z = cvt_pk_bf16(s[4 * 33], s[5 * 33]); o.w = cvt_pk_bf16(s[6 * 33], s[7 * 33]);
        *(u32x4*)(WT + (size_t)(n0 + n) * K + k0 + 8 * c) = o; }
    asm volatile("s_waitcnt lgkmcnt(0)" ::: "memory");
}

constexpr int R_QS = 0, R_KS = 17408, R_KDT = 34816, R_VT = 53248, R_AS = 90112, R_RED = 99328, R_RSTD = 101376, R_END = 101632;
template <int CH>
__device__ __forceinline__ void ret_item(LAS unsigned char* lds, const u16* RQK, u16* RV, const u16* RG, const float* s0, float* sout, size_t rowbase, int nchunks, int h) {
    constexpr int TT = CH / 16, KSN = (CH + 31) / 32;
    int tid = threadIdx.x; asm volatile("" : "+v"(tid)); const int lane = tid & 63, w = __builtin_amdgcn_readfirstlane(tid >> 6), g = lane >> 4, c16 = lane & 15;
    LAS u16* Qs = (LAS u16*)(lds + R_QS); LAS u16* Ks = (LAS u16*)(lds + R_KS); LAS u16* KdT = (LAS u16*)(lds + R_KDT); LAS u16* VT = (LAS u16*)(lds + R_VT); LAS u16* As = (LAS u16*)(lds + R_AS);
    LAS float* red = (LAS float*)(lds + R_RED); LAS float* rstdv = (LAS float*)(lds + R_RSTD);
    const float lg2 = __log2f(1.f - __builtin_amdgcn_exp2f(-5.f - (float)h));
    f32x4 S[8][2];
#pragma unroll
    for (int kt = 0; kt < 8; ++kt)
#pragma unroll
        for (int nt = 0; nt < 2; ++nt)
#pragma unroll
            for (int i = 0; i < 4; ++i) S[kt][nt][i] = s0 ? s0[(size_t)(16 * kt + 4 * g + i) * 256 + 32 * w + 16 * nt + c16] : 0.f;
    __syncthreads();
    if (CH < 32) {
        for (int i = tid; i < (R_RED - R_KDT) / 4; i += 512) ((LAS unsigned*)(lds + R_KDT))[i] = 0u;
        __syncthreads();
    }
    for (int c = 0; c < nchunks; ++c) {
        const size_t row0 = rowbase + (size_t)c * CH;
        __syncthreads();
        for (int p = tid; p < CH * 16; p += 512) {
            const int r = p >> 4, cc = p & 15;
            const u32x4 q = *(const u32x4*)(RQK + (row0 + r) * 1024 + h * 128 + cc * 8);
            const u32x4 k = *(const u32x4*)(RQK + (row0 + r) * 1024 + 512 + h * 128 + cc * 8);
            *(LAS u32x4*)(Qs + r * 136 + cc * 8) = q; *(LAS u32x4*)(Ks + r * 136 + cc * 8) = k;
            const float dec = __builtin_amdgcn_exp2f(lg2 * (float)(CH - 1 - r));
            const unsigned kw[4] = {k.x, k.y, k.z, k.w};
#pragma unroll
            for (int j = 0; j < 4; ++j) { const unsigned pk = cvt_pk_bf16(bflo(kw[j]) * dec, bfhi(kw[j]) * dec); KdT[(cc * 8 + 2 * j) * 72 + r] = (u16)(pk & 0xffffu); KdT[(cc * 8 + 2 * j + 1) * 72 + r] = (u16)(pk >> 16); }
        }
        for (int p = tid; p < CH * 32; p += 512) {
            const int r = p >> 5, cc = p & 31;
            const u32x4 v = *(const u32x4*)(RV + (row0 + r) * 1024 + h * 256 + cc * 8);
            const unsigned vw[4] = {v.x, v.y, v.z, v.w};
#pragma unroll
            for (int j = 0; j < 4; ++j) { VT[(cc * 8 + 2 * j) * 72 + r] = (u16)(vw[j] & 0xffffu); VT[(cc * 8 + 2 * j + 1) * 72 + r] = (u16)(vw[j] >> 16); }
        }
        __syncthreads();
        for (int tile = w; tile < TT * TT; tile += 8) {
            const int ti = tile / TT, tj = tile % TT; f32x4 a4 = {0.f, 0.f, 0.f, 0.f};
#pragma unroll
            for (int kk = 0; kk < 4; ++kk) {
                const bf16x8 a = *(const LAS bf16x8*)(Qs + (16 * ti + c16) * 136 + 32 * kk + 8 * g), b = *(const LAS bf16x8*)(Ks + (16 * tj + c16) * 136 + 32 * kk + 8 * g);
                a4 = __builtin_amdgcn_mfma_f32_16x16x32_bf16(a, b, a4, 0, 0, 0);
            }
#pragma unroll
            for (int i = 0; i < 4; ++i) { const int ri = 16 * ti + 4 * g + i, cj = 16 * tj + c16; const int dd = ri > cj ? ri - cj : cj - ri;
                const unsigned pk = cvt_pk_bf16(a4[i] * __builtin_amdgcn_exp2f(lg2 * (float)dd), 0.f); As[ri * 72 + cj] = (u16)(pk & 0xffffu); }
        }
        bf16x8 sb[4][2];
#pragma unroll
        for (int kk = 0; kk < 4; ++kk)
#pragma unroll
            for (int nt = 0; nt < 2; ++nt) { u32x4 t; t.x = cvt_pk_bf16(S[2 * kk][nt][0], S[2 * kk][nt][1]); t.y = cvt_pk_bf16(S[2 * kk][nt][2], S[2 * kk][nt][3]);
                t.z = cvt_pk_bf16(S[2 * kk + 1][nt][0], S[2 * kk + 1][nt][1]); t.w = cvt_pk_bf16(S[2 * kk + 1][nt][2], S[2 * kk + 1][nt][3]); sb[kk][nt] = __builtin_bit_cast(bf16x8, t); }
        f32x4 O[TT][2];
#pragma unroll
        for (int tt = 0; tt < TT; ++tt) {
            f32x4 o0 = {0.f, 0.f, 0.f, 0.f}, o1 = {0.f, 0.f, 0.f, 0.f};
#pragma unroll
            for (int kk = 0; kk < 4; ++kk) {
                const u32x2 lo = *(const LAS u32x2*)(Qs + (16 * tt + c16) * 136 + 32 * kk + 4 * g), hi = *(const LAS u32x2*)(Qs + (16 * tt + c16) * 136 + 32 * kk + 16 + 4 * g);
                u32x4 t; t.x = lo.x; t.y = lo.y; t.z = hi.x; t.w = hi.y; const bf16x8 a = __builtin_bit_cast(bf16x8, t);
                o0 = __builtin_amdgcn_mfma_f32_16x16x32_bf16(a, sb[kk][0], o0, 0, 0, 0); o1 = __builtin_amdgcn_mfma_f32_16x16x32_bf16(a, sb[kk][1], o1, 0, 0, 0);
            }
#pragma unroll
            for (int i = 0; i < 4; ++i) { const float dsc = __builtin_amdgcn_exp2f(lg2 * (float)(16 * tt + 4 * g + i + 1)); o0[i] *= dsc; o1[i] *= dsc; }
            O[tt][0] = o0; O[tt][1] = o1;
        }
        __syncthreads();
#pragma unroll
        for (int tt = 0; tt < TT; ++tt)
#pragma unroll
            for (int ks = 0; ks < KSN; ++ks) {
                const bf16x8 a = *(const LAS bf16x8*)(As + (16 * tt + c16) * 72 + 32 * ks + 8 * g);
#pragma unroll
                for (int nt = 0; nt < 2; ++nt) { const bf16x8 b = *(const LAS bf16x8*)(VT + (32 * w + 16 * nt + c16) * 72 + 32 * ks + 8 * g); O[tt][nt] = __builtin_amdgcn_mfma_f32_16x16x32_bf16(a, b, O[tt][nt], 0, 0, 0); }
            }
#pragma unroll
        for (int tt = 0; tt < TT; ++tt)
#pragma unroll
            for (int i = 0; i < 4; ++i) { float q = O[tt][0][i] * O[tt][0][i] + O[tt][1][i] * O[tt][1][i]; q += __shfl_xor(q, 1); q += __shfl_xor(q, 2); q += __shfl_xor(q, 4); q += __shfl_xor(q, 8);
                if (c16 == 0) red[w * 64 + 16 * tt + 4 * g + i] = q; }
        __syncthreads();
        if (tid < CH) { float s = 0.f;
#pragma unroll
            for (int ww = 0; ww < 8; ++ww) s += red[ww * 64 + tid];
            rstdv[tid] = rsqrtf(s * (1.f / 256.f) + 1e-6f); }
        __syncthreads();
#pragma unroll
        for (int tt = 0; tt < TT; ++tt)
#pragma unroll
            for (int i = 0; i < 4; ++i) { const int tok = 16 * tt + 4 * g + i; const float rsd = rstdv[tok];
#pragma unroll
                for (int nt = 0; nt < 2; ++nt) { const size_t off = (row0 + tok) * 1024 + h * 256 + 32 * w + 16 * nt + c16; const float gt = bf2f(RG[off]);
                    const unsigned pk = cvt_pk_bf16(O[tt][nt][i] * rsd * gt, 0.f); RV[off] = (u16)(pk & 0xffffu); } }
        const float cd = __builtin_amdgcn_exp2f(lg2 * (float)CH);
#pragma unroll
        for (int kt = 0; kt < 8; ++kt)
#pragma unroll
            for (int nt = 0; nt < 2; ++nt) S[kt][nt] = S[kt][nt] * cd;
#pragma unroll
        for (int ks = 0; ks < KSN; ++ks) {
            const bf16x8 b0 = *(const LAS bf16x8*)(VT + (32 * w + c16) * 72 + 32 * ks + 8 * g), b1 = *(const LAS bf16x8*)(VT + (32 * w + 16 + c16) * 72 + 32 * ks + 8 * g);
#pragma unroll
            for (int kt = 0; kt < 8; ++kt) { const bf16x8 a = *(const LAS bf16x8*)(KdT + (16 * kt + c16) * 72 + 32 * ks + 8 * g);
                S[kt][0] = __builtin_amdgcn_mfma_f32_16x16x32_bf16(a, b0, S[kt][0], 0, 0, 0); S[kt][1] = __builtin_amdgcn_mfma_f32_16x16x32_bf16(a, b1, S[kt][1], 0, 0, 0); }
        }
    }
#pragma unroll
    for (int kt = 0; kt < 8; ++kt)
#pragma unroll
        for (int nt = 0; nt < 2; ++nt)
#pragma unroll
            for (int i = 0; i < 4; ++i) sout[(size_t)(16 * kt + 4 * g + i) * 256 + 32 * w + 16 * nt + c16] = S[kt][nt][i];
    __syncthreads();
}
constexpr int R2_QS = 0, R2_KS = 17408, R2_KDT = 34816, R2_VT = 53248, R2_AS = 90112, R2_OS = 99328, R2_RED = 133120, R2_RSTD = 135168, R2_END = 135424;
__device__ __forceinline__ void ret_prompt_item(LAS unsigned char* lds, const u16* RQK, u16* RV, const u16* RG, float* sout, size_t rowbase, int h) {
    int tid = threadIdx.x; asm volatile("" : "+v"(tid));
    const int lane = tid & 63, w = __builtin_amdgcn_readfirstlane(tid >> 6), g = lane >> 4, c16 = lane & 15;
    LAS u16* Qs = (LAS u16*)(lds + R2_QS); LAS u16* Ks = (LAS u16*)(lds + R2_KS); LAS u16* KdT = (LAS u16*)(lds + R2_KDT); LAS u16* VT = (LAS u16*)(lds + R2_VT); LAS u16* As = (LAS u16*)(lds + R2_AS);
    LAS u16* Os = (LAS u16*)(lds + R2_OS); LAS float* red = (LAS float*)(lds + R2_RED); LAS float* rstdv = (LAS float*)(lds + R2_RSTD);
#define RBAR() asm volatile("s_waitcnt lgkmcnt(0)\n\ts_barrier" ::: "memory")
    const float lg2 = __log2f(1.f - __builtin_amdgcn_exp2f(-5.f - (float)h));
    const int rq = tid >> 4, cq = tid & 15;
    const int rv = tid >> 5, cv = tid & 31;
    const u16* gq = RQK + (rowbase + rq) * 1024 + h * 128 + cq * 8;
    const size_t voff = (rowbase + rv) * 1024 + h * 256 + cv * 8;
    u32x4 pq[2], pk[2], pv[4], pgc[4];
#define RLOAD(c) do { const size_t co_ = (size_t)(c) * 64 * 1024; \
        _Pragma("unroll") for (int i_ = 0; i_ < 2; ++i_) { pq[i_] = *(const u32x4*)(gq + co_ + (size_t)i_ * 32 * 1024); pk[i_] = *(const u32x4*)(gq + co_ + (size_t)i_ * 32 * 1024 + 512); } \
        _Pragma("unroll") for (int i_ = 0; i_ < 4; ++i_) { pv[i_] = *(const u32x4*)(RV + voff + co_ + (size_t)i_ * 16 * 1024); } } while (0)
#define GLOAD(c) do { const size_t co_ = (size_t)(c) * 64 * 1024; _Pragma("unroll") for (int i_ = 0; i_ < 4; ++i_) pgc[i_] = *(const u32x4*)(RG + voff + co_ + (size_t)i_ * 16 * 1024); } while (0)
    const int hb = c16 >> 3;
    const LAS u16* kb0 = KdT + c16 * 72 + ((g ^ hb) << 3); const LAS u16* kb2 = KdT + c16 * 72 + ((g ^ hb ^ 2) << 3);
    f32x4 S[8][2];
#pragma unroll
    for (int kt = 0; kt < 8; ++kt)
#pragma unroll
        for (int nt = 0; nt < 2; ++nt) S[kt][nt] = (f32x4){0.f, 0.f, 0.f, 0.f};
    RLOAD(0);
    asm volatile("s_waitcnt lgkmcnt(0)\n\ts_barrier" ::: "memory");
    const float cd = __builtin_amdgcn_exp2f(lg2 * 64.f);
    for (int c = 0; c < 32; ++c) {
        float lg = lg2, gf = (float)(4 * g), cf = (float)c16, rqf = (float)(63 - rq); int tw = w; asm volatile("" : "+v"(lg), "+v"(gf), "+v"(cf), "+v"(rqf), "+s"(tw));
#pragma unroll
        for (int i = 0; i < 2; ++i) {
            const int r = rq + 32 * i;
            *(LAS u32x4*)(Qs + r * 136 + cq * 8) = pq[i]; *(LAS u32x4*)(Ks + r * 136 + cq * 8) = pk[i];
            const float dec = __builtin_amdgcn_exp2f(lg * (rqf - (float)(32 * i)));
            const int pc = (((r >> 3) ^ (cq & 7)) << 3) | (r & 7);
            const unsigned kw[4] = {pk[i].x, pk[i].y, pk[i].z, pk[i].w};
#pragma unroll
            for (int j = 0; j < 4; ++j) { const unsigned pkd = cvt_pk_bf16(bflo(kw[j]) * dec, bfhi(kw[j]) * dec); KdT[(cq * 8 + 2 * j) * 72 + pc] = (u16)(pkd & 0xffffu); KdT[(cq * 8 + 2 * j + 1) * 72 + pc] = (u16)(pkd >> 16); }
        }
#pragma unroll
        for (int i = 0; i < 4; ++i) {
            const int r = rv + 16 * i; const int pc = (((r >> 3) ^ (cv & 7)) << 3) | (r & 7);
            const unsigned vw[4] = {pv[i].x, pv[i].y, pv[i].z, pv[i].w};
#pragma unroll
            for (int j = 0; j < 4; ++j) { VT[(cv * 8 + 2 * j) * 72 + pc] = (u16)(vw[j] & 0xffffu); VT[(cv * 8 + 2 * j + 1) * 72 + pc] = (u16)(vw[j] >> 16); }
        }
        __builtin_amdgcn_sched_barrier(0);
        RBAR();
#pragma unroll
        for (int t2 = 0; t2 < 2; ++t2) {
            const int tile = tw + 8 * t2, ti = tile >> 2, tj = tile & 3; f32x4 a4 = {0.f, 0.f, 0.f, 0.f}; const float dbase = (gf - cf) + (float)(16 * (ti - tj));
#pragma unroll
            for (int kk = 0; kk < 4; ++kk) {
                const bf16x8 a = *(const LAS bf16x8*)(Qs + (16 * ti + c16) * 136 + 32 * kk + 8 * g), b = *(const LAS bf16x8*)(Ks + (16 * tj + c16) * 136 + 32 * kk + 8 * g);
                a4 = __builtin_amdgcn_mfma_f32_16x16x32_bf16(a, b, a4, 0, 0, 0);
            }
#pragma unroll
            for (int i = 0; i < 4; ++i) { const int ri = 16 * ti + 4 * g + i, cj = 16 * tj + c16;
                const unsigned pkd = cvt_pk_bf16(a4[i] * __builtin_amdgcn_exp2f(lg * __builtin_fabsf(dbase + (float)i)), 0.f); As[ri * 72 + cj] = (u16)(pkd & 0xffffu); }
        }
        f32x4 O[4][2];
#pragma unroll
        for (int tt = 0; tt < 4; ++tt) { O[tt][0] = (f32x4){0.f, 0.f, 0.f, 0.f}; O[tt][1] = (f32x4){0.f, 0.f, 0.f, 0.f}; }
#pragma unroll
        for (int kk = 0; kk < 4; ++kk) {
            bf16x8 sb[2];
#pragma unroll
            for (int nt = 0; nt < 2; ++nt) { u32x4 t; t.x = cvt_pk_bf16(S[2 * kk][nt][0], S[2 * kk][nt][1]); t.y = cvt_pk_bf16(S[2 * kk][nt][2], S[2 * kk][nt][3]);
                t.z = cvt_pk_bf16(S[2 * kk + 1][nt][0], S[2 * kk + 1][nt][1]); t.w = cvt_pk_bf16(S[2 * kk + 1][nt][2], S[2 * kk + 1][nt][3]); sb[nt] = __builtin_bit_cast(bf16x8, t); }
#pragma unroll
            for (int tt = 0; tt < 4; ++tt) {
                const u32x2 lo = *(const LAS u32x2*)(Qs + (16 * tt + c16) * 136 + 32 * kk + 4 * g), hi = *(const LAS u32x2*)(Qs + (16 * tt + c16) * 136 + 32 * kk + 16 + 4 * g);
                u32x4 t; t.x = lo.x; t.y = lo.y; t.z = hi.x; t.w = hi.y; const bf16x8 a = __builtin_bit_cast(bf16x8, t);
                O[tt][0] = __builtin_amdgcn_mfma_f32_16x16x32_bf16(a, sb[0], O[tt][0], 0, 0, 0); O[tt][1] = __builtin_amdgcn_mfma_f32_16x16x32_bf16(a, sb[1], O[tt][1], 0, 0, 0);
            }
            __builtin_amdgcn_sched_barrier(0);
        }
#pragma unroll
        for (int tt = 0; tt < 4; ++tt)
#pragma unroll
            for (int i = 0; i < 4; ++i) { const float dsc = __builtin_amdgcn_exp2f(lg * (gf + (float)(16 * tt + i + 1))); O[tt][0][i] *= dsc; O[tt][1][i] *= dsc; }
        RBAR();
        if (c + 1 < 32) RLOAD(c + 1);
        const int vsw0 = (4 * w + (c16 >> 3)) & 7, vsw1 = (4 * w + 2 + (c16 >> 3)) & 7;
        bf16x8 vb[2][2];
#pragma unroll
        for (int ks = 0; ks < 2; ++ks) { vb[ks][0] = *(const LAS bf16x8*)(VT + (32 * w + c16) * 72 + (((4 * ks + g) ^ vsw0) << 3)); vb[ks][1] = *(const LAS bf16x8*)(VT + (32 * w + 16 + c16) * 72 + (((4 * ks + g) ^ vsw1) << 3)); }
#pragma unroll
        for (int tt = 0; tt < 4; ++tt)
#pragma unroll
            for (int ks = 0; ks < 2; ++ks) {
                const bf16x8 a = *(const LAS bf16x8*)(As + (16 * tt + c16) * 72 + 32 * ks + 8 * g);
                O[tt][0] = __builtin_amdgcn_mfma_f32_16x16x32_bf16(a, vb[ks][0], O[tt][0], 0, 0, 0); O[tt][1] = __builtin_amdgcn_mfma_f32_16x16x32_bf16(a, vb[ks][1], O[tt][1], 0, 0, 0); __builtin_amdgcn_sched_barrier(0);
            }
#pragma unroll
        for (int tt = 0; tt < 4; ++tt)
#pragma unroll
            for (int i = 0; i < 4; ++i) { const int tok = 16 * tt + 4 * g + i;
                float q = O[tt][0][i] * O[tt][0][i] + O[tt][1][i] * O[tt][1][i]; q += __shfl_xor(q, 1); q += __shfl_xor(q, 2); q += __shfl_xor(q, 4); q += __shfl_xor(q, 8);
                if (c16 == 0) red[tok * 8 + w] = q;
#pragma unroll
                for (int nt = 0; nt < 2; ++nt) { const unsigned pkd = cvt_pk_bf16(O[tt][nt][i], 0.f); Os[tok * 264 + 32 * w + 16 * nt + c16] = (u16)(pkd & 0xffffu); } }
        __builtin_amdgcn_sched_barrier(0);
        GLOAD(c);
#pragma unroll
        for (int kt = 0; kt < 8; ++kt) { S[kt][0] = S[kt][0] * cd; S[kt][1] = S[kt][1] * cd; }
#pragma unroll
        for (int ks = 0; ks < 2; ++ks)
#pragma unroll
            for (int kt = 0; kt < 8; ++kt) { const bf16x8 a = *(const LAS bf16x8*)(((kt & 1) ? kb2 : kb0) + 16 * kt * 72 + (((4 * ks) ^ ((kt & 2) ? 4 : 0)) << 3));
                S[kt][0] = __builtin_amdgcn_mfma_f32_16x16x32_bf16(a, vb[ks][0], S[kt][0], 0, 0, 0); S[kt][1] = __builtin_amdgcn_mfma_f32_16x16x32_bf16(a, vb[ks][1], S[kt][1], 0, 0, 0); if (kt & 1) __builtin_amdgcn_sched_barrier(0); }
        RBAR();
#pragma unroll
        for (int i = 0; i < 4; ++i) {
            const int tok = rv + 16 * i; const f32x4 p0 = *(const LAS f32x4*)(red + tok * 8), p1 = *(const LAS f32x4*)(red + tok * 8 + 4);
            const float rsd = rsqrtf((((p0[0] + p0[1]) + (p0[2] + p0[3])) + ((p1[0] + p1[1]) + (p1[2] + p1[3]))) * (1.f / 256.f) + 1e-6f);
            const u32x4 o = *(const LAS u32x4*)(Os + tok * 264 + cv * 8); const u32x4 gt = pgc[i]; u32x4 r;
            r.x = cvt_pk_bf16(bflo(o.x) * rsd * bflo(gt.x), bfhi(o.x) * rsd * bfhi(gt.x)); r.y = cvt_pk_bf16(bflo(o.y) * rsd * bflo(gt.y), bfhi(o.y) * rsd * bfhi(gt.y));
            r.z = cvt_pk_bf16(bflo(o.z) * rsd * bflo(gt.z), bfhi(o.z) * rsd * bfhi(gt.z)); r.w = cvt_pk_bf16(bflo(o.w) * rsd * bflo(gt.w), bfhi(o.w) * rsd * bfhi(gt.w));
            *(u32x4*)(RV + voff + (size_t)c * 64 * 1024 + (size_t)i * 16 * 1024) = r;
        }
    }
#pragma unroll
    for (int kt = 0; kt < 8; ++kt)
#pragma unroll
        for (int nt = 0; nt < 2; ++nt)
#pragma unroll
            for (int i = 0; i < 4; ++i) sout[(size_t)(16 * kt + 4 * g + i) * 256 + 32 * w + 16 * nt + c16] = S[kt][nt][i];
    __syncthreads();
#undef RBAR
#undef RLOAD
#undef GLOAD
}
constexpr int F2_BIAS = 0, F2_WS = 16512, F2_AW = 16640, F2_P = 17408, F2_M = 50176, F2_L = 50688, F2_ACC = 51200, F2_END = 83968;
__device__ __forceinline__ void fox_sample_item2(LAS unsigned char* lds, int b, int h, u16* FQ, const u16* FK, const u16* FV, const float* ck, const float* cv, const float* clf, const float* lfnew) {
    int tid = threadIdx.x; asm volatile("" : "+v"(tid));
    const int lane = tid & 63, w = __builtin_amdgcn_readfirstlane(tid >> 6), g = lane >> 4, c16 = lane & 15;
    LAS float* BIAS = (LAS float*)(lds + F2_BIAS); LAS float* WS = (LAS float*)(lds + F2_WS); LAS float* Aw = (LAS float*)(lds + F2_AW) + w * 16;
    LAS float* Pw = (LAS float*)(lds + F2_P) + w * 1024; LAS float* Mx = (LAS float*)(lds + F2_M); LAS float* Lx = (LAS float*)(lds + F2_L); LAS float* ACC = (LAS float*)(lds + F2_ACC);
    const size_t srow = (size_t)MP + (size_t)b * 16;
    __syncthreads();
    bf16x8 qa[2];
#pragma unroll
    for (int ks = 0; ks < 2; ++ks) qa[ks] = *(const bf16x8*)(FQ + (srow + c16) * 512 + h * 64 + 32 * ks + 8 * g);
    {
        float v[8]; float run = 0.f;
#pragma unroll
        for (int j = 0; j < 8; ++j) { run += clf[((size_t)b * PAST + 8 * tid + j) * 8 + h]; v[j] = run; }
        float tot = run;
#pragma unroll
        for (int o = 1; o < 64; o <<= 1) { const float u = __shfl_up(tot, o); if (lane >= o) tot += u; }
        if (lane == 63) WS[w] = tot;
        __syncthreads();
        float base = tot - run, all = 0.f;
#pragma unroll
        for (int ww = 0; ww < 8; ++ww) { const float x = WS[ww]; all += x; if (ww < w) base += x; }
#pragma unroll
        for (int j = 0; j < 8; ++j) BIAS[8 * tid + j] = (all - (base + v[j])) * L2E;
        if (tid == 0) { float cn = 0.f; for (int t = 0; t < 16; ++t) { cn += lfnew[((size_t)b * 16 + t) * 8 + h]; BIAS[PAST + t] = -cn * L2E; } }
    }
    __syncthreads();
    float mrun[4], lrun[4], acc[16];
#pragma unroll
    for (int i = 0; i < 4; ++i) { mrun[i] = -INFINITY; lrun[i] = 0.f; }
#pragma unroll
    for (int t = 0; t < 16; ++t) acc[t] = 0.f;
    const int niter = (w == 0) ? 9 : 8;
    for (int it = 0; it < niter; ++it) {
        const bool isnew = it == 8;
        const int key0 = isnew ? 0 : 512 * w + 64 * it;
        f32x4 s[4];
        if (!isnew) {
            f32x4 kf[4][2][2];
#pragma unroll
            for (int t = 0; t < 4; ++t) { const f32x4* kp = (const f32x4*)(ck + (((size_t)b * PAST + key0 + 16 * t + c16) * 8 + h) * 64 + 8 * g);
#pragma unroll
                for (int ks = 0; ks < 2; ++ks) { kf[t][ks][0] = kp[8 * ks]; kf[t][ks][1] = kp[8 * ks + 1]; } }
#pragma unroll
            for (int t = 0; t < 4; ++t) { f32x4 a4 = {0.f, 0.f, 0.f, 0.f};
#pragma unroll
                for (int ks = 0; ks < 2; ++ks) { u32x4 kb; kb.x = cvt_pk_bf16(kf[t][ks][0][0], kf[t][ks][0][1]); kb.y = cvt_pk_bf16(kf[t][ks][0][2], kf[t][ks][0][3]); kb.z = cvt_pk_bf16(kf[t][ks][1][0], kf[t][ks][1][1]); kb.w = cvt_pk_bf16(kf[t][ks][1][2], kf[t][ks][1][3]);
                    a4 = __builtin_amdgcn_mfma_f32_16x16x32_bf16(qa[ks], __builtin_bit_cast(bf16x8, kb), a4, 0, 0, 0); }
                const float bl = BIAS[key0 + 16 * t + c16];
                s[t] = a4 + bl; }
        } else {
            f32x4 a4 = {0.f, 0.f, 0.f, 0.f};
#pragma unroll
            for (int ks = 0; ks < 2; ++ks) { const bf16x8 kb = *(const bf16x8*)(FK + (srow + c16) * 512 + h * 64 + 32 * ks + 8 * g); a4 = __builtin_amdgcn_mfma_f32_16x16x32_bf16(qa[ks], kb, a4, 0, 0, 0); }
            const float bl = BIAS[PAST + c16];
#pragma unroll
            for (int i = 0; i < 4; ++i) s[0][i] = (c16 > 4 * g + i) ? -INFINITY : a4[i] + bl;
#pragma unroll
            for (int t = 1; t < 4; ++t) s[t] = (f32x4){-INFINITY, -INFINITY, -INFINITY, -INFINITY};
        }
#pragma unroll
        for (int i = 0; i < 4; ++i) {
            float tm = fmaxf(fmaxf(s[0][i], s[1][i]), fmaxf(s[2][i], s[3][i]));
            tm = fmaxf(tm, __shfl_xor(tm, 1)); tm = fmaxf(tm, __shfl_xor(tm, 2)); tm = fmaxf(tm, __shfl_xor(tm, 4)); tm = fmaxf(tm, __shfl_xor(tm, 8));
            const float mn = fmaxf(mrun[i], tm), al = __builtin_amdgcn_exp2f(mrun[i] - mn);
            float ps = 0.f;
#pragma unroll
            for (int t = 0; t < 4; ++t) { const float p = __builtin_amdgcn_exp2f(s[t][i] - mn); s[t][i] = p; ps += p; }
            lrun[i] = lrun[i] * al + ps; mrun[i] = mn;
            if (c16 == 0) Aw[4 * g + i] = al;
        }
#pragma unroll
        for (int t = 0; t < 4; ++t) *(LAS f32x4*)(Pw + (16 * t + c16) * 16 + 4 * g) = s[t];
        asm volatile("s_waitcnt lgkmcnt(0)" ::: "memory"); __builtin_amdgcn_wave_barrier();
#pragma unroll
        for (int j = 0; j < 4; ++j) { const f32x4 al = *(const LAS f32x4*)(Aw + 4 * j); acc[4 * j] *= al[0]; acc[4 * j + 1] *= al[1]; acc[4 * j + 2] *= al[2]; acc[4 * j + 3] *= al[3]; }
        const int nk = isnew ? 16 : 64;
#pragma unroll 4
        for (int kk = 0; kk < nk; ++kk) {
            const float v = isnew ? bf2f(FV[(srow + kk) * 512 + h * 64 + lane]) : cv[(((size_t)b * PAST + key0 + kk) * 8 + h) * 64 + lane];
#pragma unroll
            for (int j = 0; j < 4; ++j) { const f32x4 p = *(const LAS f32x4*)(Pw + kk * 16 + 4 * j); acc[4 * j] += p[0] * v; acc[4 * j + 1] += p[1] * v; acc[4 * j + 2] += p[2] * v; acc[4 * j + 3] += p[3] * v; }
        }
        asm volatile("s_waitcnt lgkmcnt(0)" ::: "memory"); __builtin_amdgcn_wave_barrier();
    }
#pragma unroll
    for (int i = 0; i < 4; ++i) { float l = lrun[i]; l += __shfl_xor(l, 1); l += __shfl_xor(l, 2); l += __shfl_xor(l, 4); l += __shfl_xor(l, 8); if (c16 == 0) { Mx[w * 16 + 4 * g + i] = mrun[i]; Lx[w * 16 + 4 * g + i] = l; } }
#pragma unroll
    for (int t = 0; t < 16; ++t) ACC[(w * 16 + t) * 64 + lane] = acc[t];
    __syncthreads();
    for (int e = tid; e < 1024; e += 512) {
        const int t = e >> 6, d = e & 63; float mm = -INFINITY;
#pragma unroll
        for (int ww = 0; ww < 8; ++ww) mm = fmaxf(mm, Mx[ww * 16 + t]);
        float num = 0.f, den = 0.f;
#pragma unroll
        for (int ww = 0; ww < 8; ++ww) { const float f = __builtin_amdgcn_exp2f(Mx[ww * 16 + t] - mm); num += ACC[(ww * 16 + t) * 64 + d] * f; den += Lx[ww * 16 + t] * f; }
        const unsigned pk = cvt_pk_bf16(num / den, 0.f); FQ[(srow + t) * 512 + h * 64 + d] = (u16)(pk & 0xffffu);
    }
    __syncthreads();
}
constexpr int F_Q = 0, F_BIAS = 4096, F_WS = 20736, F_P = 24576, F_M = 57344, F_L = 57856, F_ACC = 58368, F_END = 91136;
__device__ __forceinline__ void fox_sample_item(LAS unsigned char* lds, int b, int h, u16* FQ, const u16* FK, const u16* FV, const float* ck, const float* cv, const float* clf, const float* lfnew) {
    int tid = threadIdx.x; asm volatile("" : "+v"(tid)); const int lane = tid & 63, w = __builtin_amdgcn_readfirstlane(tid >> 6);
    LAS float* QF = (LAS float*)(lds + F_Q); LAS float* BIAS = (LAS float*)(lds + F_BIAS); LAS float* WS = (LAS float*)(lds + F_WS);
    LAS float* Pw = (LAS float*)(lds + F_P) + w * 1024; LAS float* Mx = (LAS float*)(lds + F_M); LAS float* Lx = (LAS float*)(lds + F_L); LAS float* ACC = (LAS float*)(lds + F_ACC);
    const size_t srow = (size_t)MP + (size_t)b * 16;
    __syncthreads();
    for (int e = tid; e < 1024; e += 512) QF[e] = bf2f(FQ[(srow + (e >> 6)) * 512 + h * 64 + (e & 63)]);
    {
        float v[8]; float run = 0.f;
#pragma unroll
        for (int j = 0; j < 8; ++j) { run += clf[((size_t)b * PAST + 8 * tid + j) * 8 + h]; v[j] = run; }
        float tot = run;
#pragma unroll
        for (int o = 1; o < 64; o <<= 1) { const float u = __shfl_up(tot, o); if (lane >= o) tot += u; }
        if (lane == 63) WS[w] = tot;
        __syncthreads();
        float base = tot - run, all = 0.f;
#pragma unroll
        for (int ww = 0; ww < 8; ++ww) { const float x = WS[ww]; all += x; if (ww < w) base += x; }
#pragma unroll
        for (int j = 0; j < 8; ++j) BIAS[8 * tid + j] = (all - (base + v[j])) * L2E;
        if (tid == 0) { float cn = 0.f; for (int t = 0; t < 16; ++t) { cn += lfnew[((size_t)b * 16 + t) * 8 + h]; BIAS[PAST + t] = -cn * L2E; } }
    }
    __syncthreads();
    float mrun[16], lrun[16], acc[16];
#pragma unroll
    for (int t = 0; t < 16; ++t) { mrun[t] = -INFINITY; lrun[t] = 0.f; acc[t] = 0.f; }
    const int ntile = (w == 0) ? 9 : 8;
    for (int tile = 0; tile < ntile; ++tile) {
        const bool isnew = tile == 8;
        const int key0 = isnew ? 0 : 512 * w + 64 * tile;
        float s[16];
        {
            f32x4 k[16];
            if (!isnew) { const f32x4* kp = (const f32x4*)(ck + (((size_t)b * PAST + key0 + lane) * 8 + h) * 64);
#pragma unroll
                for (int i = 0; i < 16; ++i) k[i] = kp[i];
            } else { const u32x4* kp = (const u32x4*)(FK + (srow + (lane & 15)) * 512 + h * 64);
#pragma unroll
                for (int i = 0; i < 8; ++i) { const u32x4 x = kp[i]; k[2 * i] = (f32x4){bflo(x.x), bfhi(x.x), bflo(x.y), bfhi(x.y)}; k[2 * i + 1] = (f32x4){bflo(x.z), bfhi(x.z), bflo(x.w), bfhi(x.w)}; } }
            const float bias = isnew ? BIAS[PAST + (lane & 15)] : BIAS[key0 + lane];
#pragma unroll
            for (int t = 0; t < 16; ++t) { float a = 0.f;
#pragma unroll
                for (int i = 0; i < 16; ++i) { const f32x4 q = *(const LAS f32x4*)(QF + t * 64 + 4 * i); a += (q[0] * k[i][0] + q[1] * k[i][1]) + (q[2] * k[i][2] + q[3] * k[i][3]); }
                a += bias; if (isnew && (lane > t || lane >= 16)) a = -INFINITY; s[t] = a; }
        }
#pragma unroll
        for (int t = 0; t < 16; ++t) {
            const float tm = wave_max(s[t]), mn = fmaxf(mrun[t], tm), al = __builtin_amdgcn_exp2f(mrun[t] - mn), p = __builtin_amdgcn_exp2f(s[t] - mn);
            Pw[lane * 16 + t] = p; acc[t] *= al; lrun[t] = lrun[t] * al + wave_sum(p); mrun[t] = mn;
        }
        asm volatile("s_waitcnt lgkmcnt(0)" ::: "memory"); __builtin_amdgcn_wave_barrier();
        const int nk = isnew ? 16 : 64;
        for (int kk = 0; kk < nk; ++kk) {
            const float v = isnew ? bf2f(FV[(srow + kk) * 512 + h * 64 + lane]) : cv[(((size_t)b * PAST + key0 + kk) * 8 + h) * 64 + lane];
#pragma unroll
            for (int i = 0; i < 4; ++i) { const f32x4 p = *(const LAS f32x4*)(Pw + kk * 16 + 4 * i); acc[4 * i] += p[0] * v; acc[4 * i + 1] += p[1] * v; acc[4 * i + 2] += p[2] * v; acc[4 * i + 3] += p[3] * v; }
        }
        asm volatile("s_waitcnt lgkmcnt(0)" ::: "memory"); __builtin_amdgcn_wave_barrier();
    }
#pragma unroll
    for (int t = 0; t < 16; ++t) { ACC[(w * 16 + t) * 64 + lane] = acc[t]; if (lane == 0) { Mx[w * 16 + t] = mrun[t]; Lx[w * 16 + t] = lrun[t]; } }
    __syncthreads();
    for (int e = tid; e < 1024; e += 512) {
        const int t = e >> 6, d = e & 63; float mm = -INFINITY;
#pragma unroll
        for (int ww = 0; ww < 8; ++ww) mm = fmaxf(mm, Mx[ww * 16 + t]);
        float num = 0.f, den = 0.f;
#pragma unroll
        for (int ww = 0; ww < 8; ++ww) { const float f = __builtin_amdgcn_exp2f(Mx[ww * 16 + t] - mm); num += ACC[(ww * 16 + t) * 64 + d] * f; den += Lx[ww * 16 + t] * f; }
        const unsigned pk = cvt_pk_bf16(num / den, 0.f); FQ[(srow + t) * 512 + h * 64 + d] = (u16)(pk & 0xffffu);
    }
    __syncthreads();
}

struct Args { const float* in[25]; float* out; unsigned char* ws; };
constexpr int P4_RET = 128, P4_FS = 128, P4_FP = 2048, P4_RS = 64, P4_ITEMS = P4_RET + P4_FS + P4_FP + P4_RS;

__device__ __forceinline__ unsigned char* kern_ptr(int k) {
    const __attribute__((address_space(4))) char* p = (const __attribute__((address_space(4))) char*)__builtin_amdgcn_kernarg_segment_ptr();
    asm volatile("" : "+s"(p));
    return *(unsigned char* const __attribute__((address_space(4)))*)(p + 8 * k);
}
__global__ void __launch_bounds__(512, 2) fwd(Args a) {
    extern __shared__ __attribute__((aligned(16))) unsigned char lds_raw[];
    LAS unsigned char* lds = (LAS unsigned char*)lds_raw;
    cg::grid_group grid = cg::this_grid();
    const int tid = threadIdx.x, lane = tid & 63, wave = __builtin_amdgcn_readfirstlane(tid >> 6);
    const int G = gridDim.x, bx = blockIdx.x;
#define WSB() kern_ptr(26)
#define OUTB() ((float*)kern_ptr(25))
#define INP(k) ((const float*)kern_ptr(k))
#define P16(off) ((u16*)(WSB() + (off)))
#define PF32(off) ((float*)(WSB() + (off)))
    unsigned* ctl = (unsigned*)(WSB() + O_CTL);
    LAS unsigned* misc = (LAS unsigned*)(lds + LDS_BYTES - 128);
    if (tid < 32) misc[tid] = 0u;
    __syncthreads();
    const xb::XcdBarrier bar = xb::xcd_barrier_post(ctl + 4096, (volatile XLAS unsigned*)(misc + 8));
#ifdef PROBE_PH
    unsigned long long pr_t0 = __builtin_amdgcn_s_memrealtime(), pr_acc = 0; int pr_n = 0;
#define GSYNC() do { xb::xcd_barrier(bar); if (pr_n == PROBE_PH) pr_acc = __builtin_amdgcn_s_memrealtime() - pr_t0; ++pr_n; pr_t0 = __builtin_amdgcn_s_memrealtime(); } while (0)
#else
#define GSYNC() xb::xcd_barrier(bar)
#endif

#ifndef PHM
#define PHM 0xffff
#endif
#define PH(k) if constexpr (((PHM)>>(k))&1)
    PH(0) {
        LAS float* scr = (LAS float*)(lds + wave * 16384);
        const int gw = bx * 8 + wave, NGW = G * 8;
        constexpr int I0 = 16 * 176, I1 = 44 * 32, I2 = 16 * 216, I3 = 16 * 32, I4 = 8 * 32, I5 = 16 * 32, I8 = 4 * 32;
        constexpr int NIT = I0 + I1 + I2 + I3 + I4 + I5 + I0 + I1 + I8 + I3;
        for (int it = gw; it < NIT; it += NGW) {
            int r = it;
            if (r < I0) { transpose_item(INP(9), INP(8), 1024, 5632, 1, P16(O_W1IN), 176, scr, r, lane); continue; } r -= I0;
            if (r < I1) { transpose_item(INP(10), nullptr, 2816, 1024, 0, P16(O_W1OUT), 32, scr, r, lane); continue; } r -= I1;
            if (r < I2) { transpose_item(INP(12), INP(11), 1024, 6664, 2, P16(O_WMIX), 216, scr, r, lane); continue; } r -= I2;
            if (r < I3) { transpose_item(INP(16), nullptr, 1024, 1024, 0, P16(O_WBR), 32, scr, r, lane); continue; } r -= I3;
            if (r < I4) { transpose_item(INP(17), nullptr, 512, 1024, 0, P16(O_WBF), 32, scr, r, lane); continue; } r -= I4;
            if (r < I5) { transpose_item(INP(18), nullptr, 1024, 1024, 0, P16(O_WOUT), 32, scr, r, lane); continue; } r -= I5;
            if (r < I0) { transpose_item(INP(20), INP(19), 1024, 5632, 1, P16(O_W2IN), 176, scr, r, lane); continue; } r -= I0;
            if (r < I1) { transpose_item(INP(21), nullptr, 2816, 1024, 0, P16(O_W2OUT), 32, scr, r, lane); continue; } r -= I1;
            if (r < I8) { transpose_item(INP(23), nullptr, 256, 1024, 0, P16(O_WPLE), 32, scr, r, lane); continue; } r -= I8;
            transpose_item(INP(24), INP(22), 1024, 1024, 0, P16(O_WPG), 32, scr, r, lane);
        }
        for (int rb = gw * 4; rb < MT; rb += NGW * 4) {
            f32x4 v[4][4]; float s[4];
#pragma unroll
            for (int r = 0; r < 4; ++r) { const int row = rb + r; const f32x4* xr = (const f32x4*)(row < MP ? INP(0) + (size_t)row * 1024 : INP(1) + (size_t)(row - MP) * 1024) + lane;
#pragma unroll
                for (int j = 0; j < 4; ++j) v[r][j] = xr[64 * j]; }
#pragma unroll
            for (int r = 0; r < 4; ++r) { float q = 0.f;
#pragma unroll
                for (int j = 0; j < 4; ++j) q += (v[r][j][0] * v[r][j][0] + v[r][j][1] * v[r][j][1]) + (v[r][j][2] * v[r][j][2] + v[r][j][3] * v[r][j][3]);
                s[r] = wave_sum(q);
                u32x2* o = (u32x2*)(P16(O_XB) + (size_t)(rb + r) * 1024) + lane;
#pragma unroll
                for (int j = 0; j < 4; ++j) { u32x2 w; w.x = cvt_pk_bf16(v[r][j][0], v[r][j][1]); w.y = cvt_pk_bf16(v[r][j][2], v[r][j][3]); o[64 * j] = w; } }
            { const int r = lane >> 4, c = lane & 15; const float sv = r == 0 ? s[0] : (r == 1 ? s[1] : (r == 2 ? s[2] : s[3])); PF32(O_SS)[(size_t)(rb + r) * 16 + c] = c == 0 ? sv : 0.f; }
        }
        for (int i = bx * 512 + tid; i < NPOS * 64; i += G * 512) {
            const int pi = i >> 6, f = i & 63; const float pos = pi < SEQ ? (float)pi : (float)(PAST + pi - SEQ);
            const float freq = __builtin_amdgcn_exp2f(-(float)f * (13.287712379549449f / 64.f)); const float ang = pos * freq;
            double rev = (double)ang * 0.15915494309189535; rev -= floor(rev); const float rf = (float)rev;
            PF32(O_TABC)[i] = __builtin_amdgcn_cosf(rf); PF32(O_TABS)[i] = __builtin_amdgcn_sinf(rf);
        }
    }
    grid.sync(); GSYNC();
    PH(1) { pg8::Gemm g{P16(O_XB), P16(O_W1IN), MT, 5632, 1024}; pg8::StaticOrder S; S.init(MT, 5632, G, bx); EpiSwiglu E{P16(O_ACT1), PF32(O_SS)};
      pg8::gemm_phase<EpiSwiglu, pg8::StaticOrder, true, true>(lds, g, S, E); }
    GSYNC();
    PH(2) { const FResid f{P16(O_XB), PF32(O_SS), 0.5f};
      small_gemm<FResid>(lds, P16(O_ACT1) + (size_t)MP * DFF, P16(O_W1OUT), DFF, f, bx, G);
      pg8::Gemm g{P16(O_ACT1), P16(O_W1OUT), MP, 1024, DFF}; pg8::StaticOrder S; S.init(MP, 1024, G, bx); const EpiWrap<FResid> E{f};
      pg8::gemm_phase<EpiWrap<FResid>, pg8::StaticOrder, true, true>(lds, g, S, E); }
    GSYNC();
    PH(3) { pg8::Gemm g{P16(O_XB), P16(O_WMIX), MT, NMIX, 1024}; pg8::StaticOrder S; S.init(MT, NMIX, G, bx);
      EpiMix E{PF32(O_SS), PF32(O_TABC), PF32(O_TABS), INP(14), INP(15), INP(13), P16(O_RQK), P16(O_RV), P16(O_RG), P16(O_FQ), P16(O_FK), P16(O_FV), P16(O_ZG), OUTB(), OUTB() + OUT_YP};
      pg8::gemm_phase<EpiMix, pg8::StaticOrder, true, true>(lds, g, S, E); }
    GSYNC();
    {
        LAS unsigned* slot = misc;
        float dbound;
        { float gq_ = __builtin_fabsf(INP(14)[lane]), gk_ = __builtin_fabsf(INP(15)[lane]);
#pragma unroll
          for (int o_ = 1; o_ < 64; o_ <<= 1) { gq_ = fmaxf(gq_, __shfl_xor(gq_, o_)); gk_ = fmaxf(gk_, __shfl_xor(gk_, o_)); }
          dbound = gq_ * gk_ * (64.f * 0.125f * L2E * 1.02f) + 1.f; if (tid == 0) misc[2] = __float_as_uint(dbound); }
        for (;;) {
            __syncthreads();
            if (tid == 0) slot[0] = atomicAdd(ctl, 1u);
            __syncthreads();
            const int it = (int)slot[0];
            if (it >= P4_ITEMS) break;
#ifdef PROBE_ITEM
            const unsigned long long pi_t0 = __builtin_amdgcn_s_memrealtime();
#endif
            if (it < P4_RET) { const int b = it >> 2, h = it & 3;
                PH(10) ret_prompt_item(lds, P16(O_RQK), P16(O_RV), P16(O_RG), OUTB() + OUT_RSP + (size_t)(b * 4 + h) * 32768, (size_t)b * SEQ, h);
            } else if (it < P4_RET + P4_FS) { const int j = it - P4_RET, b = j >> 3, h = j & 7;
                PH(11) fox_sample_item2(lds, b, h, P16(O_FQ), P16(O_FK), P16(O_FV), INP(5), INP(6), INP(7), OUTB() + OUT_LS);
            } else if (it < P4_RET + P4_FS + P4_FP) { const int j = it - P4_RET - P4_FS, qb = 7 - (j >> 8), bh = j & 255;
                PH(12) attn_body::attn_unit<8>(bh >> 3, bh & 7, qb, (const attn_body::bf16*)P16(O_FQ), (const attn_body::bf16*)P16(O_FK), (const attn_body::bf16*)P16(O_FV), (attn_body::bf16*)P16(O_FQ), OUTB() + OUT_YP, __uint_as_float(misc[2]), (char*)lds_raw);
            } else { const int j = it - P4_RET - P4_FS - P4_FP, b = j >> 2, h = j & 3;
                PH(13) ret_item<16>(lds, P16(O_RQK), P16(O_RV), P16(O_RG), INP(4) + (size_t)(b * 4 + h) * 32768, OUTB() + OUT_RSS + (size_t)(b * 4 + h) * 32768, (size_t)MP + (size_t)b * 16, 1, h);
            }
#ifdef PROBE_ITEM
            { const int kind = it < P4_RET ? 0 : (it < P4_RET + P4_FS ? 1 : (it < P4_RET + P4_FS + P4_FP ? 2 : 3));
              if (kind == PROBE_ITEM && tid == 0) atomicMax(ctl + 16, (unsigned)(__builtin_amdgcn_s_memrealtime() - pi_t0)); }
#endif
        }
    }
    GSYNC();
    {
        for (size_t i = (size_t)bx * 512 + tid; i < (size_t)MT * 32; i += (size_t)G * 512) {
            const size_t e8 = i * 8; const float* src = e8 < (size_t)MP * 256 ? INP(2) + e8 : INP(3) + (e8 - (size_t)MP * 256);
            const f32x4 v0 = *(const f32x4*)src, v1 = *(const f32x4*)(src + 4);
            u32x4 w; w.x = cvt_pk_bf16(v0[0], v0[1]); w.y = cvt_pk_bf16(v0[2], v0[3]); w.z = cvt_pk_bf16(v1[0], v1[1]); w.w = cvt_pk_bf16(v1[2], v1[3]);
            *(u32x4*)(P16(O_FV) + e8) = w;
        }
        PH(5) { const FGate<false> f0{P16(O_RG), P16(O_ZG), nullptr}; const FGate<true> f1{P16(O_RG), P16(O_ZG), nullptr};
          small_gemm<FGate<false>>(lds, P16(O_RV) + (size_t)MP * 1024, P16(O_WBR), 1024, f0, bx, G);
          small_gemm<FGate<true>>(lds, P16(O_FQ) + (size_t)MP * 512, P16(O_WBF), 512, f1, bx, G);
          { pg8::Gemm g{P16(O_RV), P16(O_WBR), MP, 1024, 1024}; pg8::StaticOrder S; S.init(MP, 1024, G, bx); const EpiWrap<FGate<false>> E{f0};
            pg8::gemm_phase<EpiWrap<FGate<false>>, pg8::StaticOrder, true, true>(lds, g, S, E); }
          { pg8::Gemm g{P16(O_FQ), P16(O_WBF), MP, 1024, 512}; pg8::StaticOrder S; S.init(MP, 1024, G, bx); const EpiWrap<FGate<true>> E{f1};
            pg8::gemm_phase<EpiWrap<FGate<true>>, pg8::StaticOrder, true, true>(lds, g, S, E); } }
    }
    GSYNC();
    PH(6) { const FResid f{P16(O_XB), PF32(O_SS), 1.0f};
      small_gemm<FResid>(lds, P16(O_RG) + (size_t)MP * 1024, P16(O_WOUT), 1024, f, bx, G);
      pg8::Gemm g{P16(O_RG), P16(O_WOUT), MP, 1024, 1024}; pg8::StaticOrder S; S.init(MP, 1024, G, bx); const EpiWrap<FResid> E{f};
      pg8::gemm_phase<EpiWrap<FResid>, pg8::StaticOrder, true, true>(lds, g, S, E); }
    GSYNC();
    PH(7) { pg8::Gemm g{P16(O_XB), P16(O_W2IN), MT, 5632, 1024}; pg8::StaticOrder S; S.init(MT, 5632, G, bx); EpiSwiglu E{P16(O_ACT2), PF32(O_SS)};
      pg8::gemm_phase<EpiSwiglu, pg8::StaticOrder, true, true>(lds, g, S, E); }
    GSYNC();
    PH(8) { const FResid f{P16(O_XB), PF32(O_SS), 0.5f}; const FPlain fp{P16(O_RQK), nullptr};
      small_gemm<FResid>(lds, P16(O_ACT2) + (size_t)MP * DFF, P16(O_W2OUT), DFF, f, bx, G);
      small_gemm<FPlain>(lds, P16(O_FV) + (size_t)MP * 256, P16(O_WPLE), 256, fp, bx, G);
      { pg8::Gemm g{P16(O_ACT2), P16(O_W2OUT), MP, 1024, DFF}; pg8::StaticOrder S; S.init(MP, 1024, G, bx); const EpiWrap<FResid> E{f};
        pg8::gemm_phase<EpiWrap<FResid>, pg8::StaticOrder, true, true>(lds, g, S, E); }
      { pg8::Gemm g{P16(O_FV), P16(O_WPLE), MP, 1024, 256}; pg8::StaticOrder S; S.init(MP, 1024, G, bx); const EpiWrap<FPlain> E{fp};
        pg8::gemm_phase<EpiWrap<FPlain>, pg8::StaticOrder, true, true>(lds, g, S, E); } }
    GSYNC();
    PH(9) { const FFinal f{OUTB() + OUT_YP, OUTB() + OUT_YS, P16(O_XB), P16(O_RQK), PF32(O_SS)};
      small_gemm<FFinal>(lds, P16(O_XB) + (size_t)MP * 1024, P16(O_WPG), 1024, f, bx, G);
      pg8::Gemm g{P16(O_XB), P16(O_WPG), MP, 1024, 1024}; pg8::StaticOrder S; S.init(MP, 1024, G, bx); const EpiWrap<FFinal> E{f};
      pg8::gemm_phase<EpiWrap<FFinal>, pg8::StaticOrder, true, true>(lds, g, S, E); }
#ifdef PROBE_ITEM
    GSYNC();
    if (bx == 0) { const unsigned long long t1 = __builtin_amdgcn_s_memrealtime(); const unsigned long long dur = __hip_atomic_load(ctl + 16, __ATOMIC_RELAXED, __HIP_MEMORY_SCOPE_AGENT); while (__builtin_amdgcn_s_memrealtime() - t1 < dur) __builtin_amdgcn_s_sleep(8); }
#endif
#ifdef PROBE_PH
    if (pr_n == PROBE_PH) pr_acc = __builtin_amdgcn_s_memrealtime() - pr_t0;
    if (bx == 0) { const unsigned long long t1 = __builtin_amdgcn_s_memrealtime(); while (__builtin_amdgcn_s_memrealtime() - t1 < pr_acc) __builtin_amdgcn_s_sleep(8); }
#endif
}
}

extern "C" void kernel_launch(void* const* d_in, const int* in_sizes, int n_in, void* d_out, int out_size, void* d_ws, size_t ws_size, hipStream_t stream) {
    static int grid = 0;
    if (grid == 0) {
        if (n_in != 25 || (size_t)out_size != mk::OUT_END || ws_size < mk::WS_NEED) { fprintf(stderr, "kernel_launch: unexpected shapes (n_in %d out %d ws %zu need %zu)\n", n_in, out_size, ws_size, (size_t)mk::WS_NEED); grid = -1; return; }
        int dev = 0, cus = 0, per_cu = 0;
        hipGetDevice(&dev); hipDeviceGetAttribute(&cus, hipDeviceAttributeMultiprocessorCount, dev);
        if (hipFuncSetAttribute((const void*)mk::fwd, hipFuncAttributeMaxDynamicSharedMemorySize, mk::LDS_BYTES) != hipSuccess) { fprintf(stderr, "kernel_launch: hipFuncSetAttribute failed\n"); grid = -1; return; }
        hipOccupancyMaxActiveBlocksPerMultiprocessor(&per_cu, (const void*)mk::fwd, 512, mk::LDS_BYTES);
        if (per_cu < 1) { fprintf(stderr, "kernel_launch: occupancy query says %d blocks per CU\n", per_cu); per_cu = 1; }
        grid = cus;
    }
    if (grid < 0) return;
    if (hipMemsetAsync((char*)d_ws + mk::O_CTL, 0, 65536, stream) != hipSuccess) { fprintf(stderr, "kernel_launch: memset failed\n"); return; }
    mk::Args a{};
    for (int i = 0; i < 25; ++i) a.in[i] = (const float*)d_in[i];
    a.out = (float*)d_out; a.ws = (unsigned char*)d_ws;
    void* args[] = {&a};
    hipError_t e = hipLaunchCooperativeKernel((const void*)mk::fwd, dim3(grid), dim3(512), args, mk::LDS_BYTES, stream);
    if (e != hipSuccess) fprintf(stderr, "cooperative launch failed: %s (grid %d)\n", hipGetErrorString(e), grid);
}
```

```cpp
#include <hip/hip_runtime.h>
#include <hip/hip_cooperative_groups.h>
#include <cstdio>
#include <cstdint>
#include <hip/hip_bf16.h>
#include <cmath>
namespace cg = cooperative_groups;
namespace pg8 {
#define PG8_LAS __attribute__((address_space(3)))
typedef unsigned short bf16_t;
typedef short bf16x8 __attribute__((ext_vector_type(8)));
typedef float f32x4 __attribute__((ext_vector_type(4)));
typedef unsigned u32x4 __attribute__((ext_vector_type(4)));
constexpr int BM = 256, BK = 64, HALF = 128, HTB = HALF * BK * 2  , STAGE_BYTES = 8 * HTB, NXCD = 8, WGM = 8;

__host__ __device__ __forceinline__ int lds_byte(int r, int c) { const int st = (r >> 4) * 2 + (c >> 5), rr = r & 15, cc = c & 31, ob = rr * 64 + cc * 2; return st * 1024 + (ob ^ (((ob >> 9) & 1) << 5)); }
__host__ __device__ __forceinline__ void stage_rc(int b, int& R, int& C) { const int st = b / 1024, sb = b % 1024, swz = sb ^ (((sb >> 9) & 1) << 5); R = (st >> 1) * 16 + swz / 64; C = (st & 1) * 32 + (swz % 64) / 2; }
__host__ __device__ __forceinline__ int perm32(int rho) { const int n = rho >> 4, i = rho & 15; return 8 * (i >> 2) + 4 * n + (i & 3); }

struct Unit { int pm, pn; };
struct Gemm { const bf16_t* A; const bf16_t* Bt; int M, N, K; };

struct StaticOrder {
    int nM, nN, nwg, G, c;
    __host__ __device__ void init(int M, int N, int G_, int c_) { nM = M / BM; nN = N / BM; nwg = nM * nN; G = G_; c = c_; }
    __host__ __device__ bool next(int i, Unit& u) const {
        const long L = (long)i * G + c; if (L >= nwg) return false;
        int wgid = (int)L; { const int q = nwg / NXCD, r = nwg % NXCD, xcd = wgid % NXCD, off = wgid / NXCD; wgid = (xcd < r ? xcd * (q + 1) : r * (q + 1) + (xcd - r) * q) + off; }
        const int nig = WGM * nN, gid = wgid / nig, fm = gid * WGM, gsz = (nM - fm) < WGM ? (nM - fm) : WGM;
        u.pm = fm + ((wgid % nig) % gsz); u.pn = (wgid % nig) / gsz; return true;
    }
    __device__ __forceinline__ void a_ready(const Unit&) const {}
    __device__ __forceinline__ void done(const Unit&) const {}
};

typedef float f32x2c __attribute__((ext_vector_type(2))); typedef __bf16 bf16x2c __attribute__((ext_vector_type(2)));
__device__ __forceinline__ unsigned cvt_pk_bf16(float lo, float hi) { f32x2c v = {lo, hi}; bf16x2c b = __builtin_convertvector(v, bf16x2c); return __builtin_bit_cast(unsigned, b); }
typedef float f32x2 __attribute__((ext_vector_type(2)));
template <class Epi, class Sched, bool ALIGN_EPI = false, bool SP2 = false>
__device__ __forceinline__ void gemm_phase(PG8_LAS unsigned char* lds, const Gemm g, const Sched& S, const Epi& E) {
    int tid = threadIdx.x; asm volatile("" : "+v"(tid)); const int wid = __builtin_amdgcn_readfirstlane(tid >> 6), lane = tid & 63, wr = wid >> 2, wc = wid & 3, fr = lane & 15, fq = lane >> 4;
    const int K = g.K, nt = K / BK;
    unsigned voffA[2], voffB[2];
#pragma unroll
    for (int i = 0; i < 2; ++i) { int R, C; stage_rc(tid * 16 + i * 8192, R, C); const int Rb = Epi::PERM ? ((R & ~31) + perm32(R & 31)) : R;
        voffA[i] = (unsigned)(R * K + C) * 2u; voffB[i] = (unsigned)(Rb * K + C) * 2u; }
    const size_t kstep = (size_t)(BK * 2);
    const size_t hstep = (size_t)HALF * K * 2;
    const size_t tstep = 2 * hstep;
    const unsigned ldsw = (unsigned)wid * 1024u;
    const int aoff = lds_byte(wr * 64 + fr, fq * 8), boff = lds_byte(wc * 32 + fr, fq * 8);
#define PG8_SA(b, h) (((b) * 2 + (h)) * HTB)
#define PG8_SB(b, h) ((4 + (b) * 2 + (h)) * HTB)
#define PG8_STAGE(bufoff, gbase, voff) do { _Pragma("unroll") for (int _i = 0; _i < 2; ++_i) \
        __builtin_amdgcn_global_load_lds((const unsigned*)((const char*)(gbase) + (voff)[_i]), (PG8_LAS unsigned*)(lds + (bufoff) + ldsw + _i * 8192), 16, 0, 0); } while (0)
#define PG8_LDA(dst, b, h) do { _Pragma("unroll") for (int m = 0; m < 4; ++m) _Pragma("unroll") for (int k = 0; k < 2; ++k) dst[m][k] = *(const PG8_LAS bf16x8*)(lds + PG8_SA(b, h) + aoff + m * 2048 + k * 1024); } while (0)
#define PG8_LDB(dst, b, h) do { _Pragma("unroll") for (int n = 0; n < 2; ++n) _Pragma("unroll") for (int k = 0; k < 2; ++k) dst[n][k] = *(const PG8_LAS bf16x8*)(lds + PG8_SB(b, h) + boff + n * 2048 + k * 1024); } while (0)
#define PG8_MMA(ai, bj, At, Bt) do { __builtin_amdgcn_s_setprio(1); _Pragma("unroll") for (int m = 0; m < 4; ++m) _Pragma("unroll") for (int n = 0; n < 2; ++n) _Pragma("unroll") for (int k = 0; k < 2; ++k) \
        acc[ai][bj][m][n] = __builtin_amdgcn_mfma_f32_16x16x32_bf16(Bt[n][k], At[m][k], acc[ai][bj][m][n], 0, 0, 0); __builtin_amdgcn_s_setprio(0); } while (0)
#define PG8_WAIT_V(n) asm volatile("s_waitcnt vmcnt(" #n ")" ::: "memory")
#define PG8_WAIT_L(n) asm volatile("s_waitcnt lgkmcnt(" #n ")" ::: "memory")
#define PG8_BAR __builtin_amdgcn_s_barrier()
#define PG8_SCHED __builtin_amdgcn_sched_barrier(0)
    Unit cur, nxt; int ui = 0;
    if (!S.next(0, cur)) return;
    f32x4 acc[2][2][4][2];
#pragma unroll
    for (int a = 0; a < 2; ++a)
#pragma unroll
        for (int b = 0; b < 2; ++b)
#pragma unroll
            for (int m = 0; m < 4; ++m)
#pragma unroll
                for (int n = 0; n < 2; ++n) acc[a][b][m][n] = (f32x4){0.f, 0.f, 0.f, 0.f};
    bf16x8 At[4][2], B0[2][2], B1[2][2];
    const char* cA = (const char*)g.A + (size_t)cur.pm * tstep; const char* cB = (const char*)g.Bt + (size_t)cur.pn * tstep;
    S.a_ready(cur);
    if constexpr (SP2) {
        PG8_STAGE(PG8_SB(0, 0), cB, voffB); PG8_STAGE(PG8_SB(0, 1), cB + hstep, voffB); PG8_STAGE(PG8_SA(0, 0), cA, voffA); PG8_STAGE(PG8_SA(0, 1), cA + hstep, voffA);
        if (wr == 1) PG8_BAR;
        PG8_WAIT_V(2); PG8_BAR;
        PG8_STAGE(PG8_SB(1, 0), cB + kstep, voffB); PG8_STAGE(PG8_SA(1, 0), cA + kstep, voffA); PG8_STAGE(PG8_SB(1, 1), cB + hstep + kstep, voffB);
        PG8_WAIT_V(6); PG8_BAR;
    } else {
        PG8_STAGE(PG8_SB(0, 0), cB, voffB); PG8_STAGE(PG8_SA(0, 0), cA, voffA); PG8_STAGE(PG8_SB(0, 1), cB + hstep, voffB); PG8_STAGE(PG8_SA(0, 1), cA + hstep, voffA);
        if (wr == 1) PG8_BAR;
        PG8_WAIT_V(4); PG8_BAR;
        PG8_STAGE(PG8_SB(1, 0), cB + kstep, voffB); PG8_STAGE(PG8_SA(1, 0), cA + kstep, voffA); PG8_STAGE(PG8_SB(1, 1), cB + hstep + kstep, voffB);
        PG8_WAIT_V(6); PG8_BAR;
    }
    for (;;) {
        const bool has_next = S.next(ui + 1, nxt);
        const char* nA = has_next ? (const char*)g.A + (size_t)nxt.pm * tstep : cA; const char* nB = has_next ? (const char*)g.Bt + (size_t)nxt.pn * tstep : cB;
        for (int t = 0; t < nt; t += 2) {
            const bool last = (t == nt - 2);
            const char* a1 = cA + (size_t)(t + 1) * kstep;
            const char* a2 = last ? nA : cA + (size_t)(t + 2) * kstep; const char* b2 = last ? nB : cB + (size_t)(t + 2) * kstep;
            const char* a3 = a2 + kstep; const char* b3 = b2 + kstep;
            if (last && has_next) S.a_ready(nxt);
            if constexpr (SP2) {
            PG8_LDB(B0, 0, 0); PG8_LDB(B1, 0, 1); PG8_SCHED; PG8_LDA(At, 0, 0); PG8_STAGE(PG8_SA(1, 1), a1 + hstep, voffA);
            PG8_WAIT_V(8); PG8_WAIT_L(0); PG8_BAR; PG8_MMA(0, 0, At, B0); PG8_MMA(0, 1, At, B1); PG8_BAR; PG8_SCHED;
            PG8_LDA(At, 0, 1); PG8_STAGE(PG8_SB(0, 0), b2, voffB); PG8_STAGE(PG8_SB(0, 1), b2 + hstep, voffB); PG8_STAGE(PG8_SA(0, 0), a2, voffA);
            PG8_WAIT_V(8); PG8_WAIT_L(0); PG8_BAR; PG8_MMA(1, 0, At, B0); PG8_MMA(1, 1, At, B1); PG8_BAR; PG8_SCHED;
            PG8_LDB(B0, 1, 0); PG8_LDB(B1, 1, 1); PG8_SCHED; PG8_LDA(At, 1, 0); PG8_STAGE(PG8_SA(0, 1), a2 + hstep, voffA);
            PG8_WAIT_V(8); PG8_WAIT_L(0); PG8_BAR; PG8_MMA(0, 0, At, B0); PG8_MMA(0, 1, At, B1); PG8_BAR; PG8_SCHED;
            PG8_LDA(At, 1, 1); PG8_STAGE(PG8_SB(1, 0), b3, voffB); PG8_STAGE(PG8_SB(1, 1), b3 + hstep, voffB); PG8_STAGE(PG8_SA(1, 0), a3, voffA);
            PG8_WAIT_V(8); PG8_WAIT_L(0); PG8_BAR; PG8_MMA(1, 0, At, B0); PG8_MMA(1, 1, At, B1); PG8_BAR; PG8_SCHED;
            } else {
            PG8_LDB(B0, 0, 0); PG8_SCHED; PG8_LDA(At, 0, 0); PG8_STAGE(PG8_SA(1, 1), a1 + hstep, voffA);
            PG8_WAIT_L(8); PG8_BAR; PG8_WAIT_L(0); PG8_MMA(0, 0, At, B0); PG8_BAR; PG8_SCHED;
            PG8_LDB(B1, 0, 1); PG8_STAGE(PG8_SB(0, 0), b2, voffB);
            PG8_BAR; PG8_WAIT_L(0); PG8_MMA(0, 1, At, B1); PG8_BAR;
            PG8_LDA(At, 0, 1); PG8_STAGE(PG8_SA(0, 0), a2, voffA);
            PG8_BAR; PG8_WAIT_L(0); PG8_MMA(1, 0, At, B0); PG8_BAR; PG8_SCHED;
            PG8_STAGE(PG8_SB(0, 1), b2 + hstep, voffB);
            PG8_WAIT_V(6); PG8_BAR; PG8_MMA(1, 1, At, B1); PG8_BAR;
            PG8_LDB(B0, 1, 0); PG8_SCHED; PG8_LDA(At, 1, 0); PG8_STAGE(PG8_SA(0, 1), a2 + hstep, voffA);
            PG8_WAIT_L(8); PG8_BAR; PG8_WAIT_L(0); PG8_MMA(0, 0, At, B0); PG8_BAR; PG8_SCHED;
            PG8_LDB(B1, 1, 1); PG8_STAGE(PG8_SB(1, 0), b3, voffB);
            PG8_BAR; PG8_WAIT_L(0); PG8_MMA(0, 1, At, B1); PG8_BAR;
            PG8_LDA(At, 1, 1); PG8_STAGE(PG8_SA(1, 0), a3, voffA);
            PG8_BAR; PG8_WAIT_L(0); PG8_MMA(1, 0, At, B0); PG8_BAR; PG8_SCHED;
            PG8_STAGE(PG8_SB(1, 1), b3 + hstep, voffB);
            PG8_WAIT_V(6); PG8_BAR; PG8_MMA(1, 1, At, B1); PG8_BAR;
            }
        }
        if constexpr (ALIGN_EPI) { if (wr == 0) PG8_BAR; }
        if constexpr (!Epi::AFTER_DRAIN) { E(acc, cur, wr, wc, fr, fq); S.done(cur); }
        if (!has_next) break;
#pragma unroll
        for (int a = 0; a < 2; ++a)
#pragma unroll
            for (int b = 0; b < 2; ++b)
#pragma unroll
                for (int m = 0; m < 4; ++m)
#pragma unroll
                    for (int n = 0; n < 2; ++n) acc[a][b][m][n] = (f32x4){0.f, 0.f, 0.f, 0.f};
        cur = nxt; cA = nA; cB = nB; ++ui;
        if constexpr (ALIGN_EPI) { if (wr == 1) PG8_BAR; }
    }
    PG8_WAIT_V(0);
    if constexpr (!ALIGN_EPI) { if (wr == 0) PG8_BAR; }
    PG8_BAR;
    if constexpr (Epi::AFTER_DRAIN) { E.fused(acc, cur, wr, wc, fr, fq, lds, wid, lane); S.done(cur); }
#undef PG8_SA
#undef PG8_SB
#undef PG8_STAGE
#undef PG8_LDA
#undef PG8_LDB
#undef PG8_MMA
#undef PG8_WAIT_V
#undef PG8_WAIT_L
#undef PG8_BAR
#undef PG8_SCHED
}
}
namespace attn_body {
using bf16=__hip_bfloat16;
using bf16x8=__attribute__((ext_vector_type(8)))short;
using s16x4=__attribute__((ext_vector_type(4)))short;
using f32x16=__attribute__((ext_vector_type(16)))float;
using u32x4=__attribute__((ext_vector_type(4)))unsigned;
using f32x4v=__attribute__((ext_vector_type(4)))float;
constexpr int BATCH=32,NHEAD=8,SEQ=2048,D=64,DM=NHEAD*D;
constexpr int NW=8,QBLK=32,QB=QBLK*NW,KVBLK=64,NQB=SEQ/QB;
constexpr int ATTN_PITCH=DM, ATTN_UNIT_ROWS=QB;
__device__ __forceinline__ int crow(int r,int hi){return (r&3)+8*(r>>2)+4*hi;}
#define SBAR() __builtin_amdgcn_sched_barrier(0)
__device__ __forceinline__ void cmask(f32x16&p0,f32x16&p1,int jb,int qrel,int hi){
  const float NEG=-INFINITY; int kb=64*jb+4*hi;
  #pragma unroll
  for(int r=0;r<16;++r){int kv=kb+(r&3)+8*(r>>2); if(kv>qrel)p0[r]=NEG; if(kv+32>qrel)p1[r]=NEG;}
}

constexpr int NSLOT=3, SLOTB=8192;
constexpr int LDS_K=0, LDS_V=NSLOT*SLOTB, LDS_WS=2*NSLOT*SLOTB, LDS_OST=LDS_WS+NW*64*4, LDS_CB=LDS_OST+NW*4096, LDS_CBX=LDS_CB+2048*4, LDS_AL=LDS_CBX+256, LDS_BYTES=LDS_AL+256;
constexpr float C2=0.125f*1.4426950408889634f;
__device__ __forceinline__ void glds16(const void*gsrc,unsigned lds_dst){unsigned keep;
  asm volatile("s_mov_b32 %0, m0\n\ts_mov_b32 m0, %2\n\ts_nop 0\n\tglobal_load_lds_dwordx4 %1, off\n\ts_mov_b32 m0, %0":"=&s"(keep):"v"(gsrc),"s"(lds_dst):"memory");}
__device__ __forceinline__ float max3f(float a,float b,float c){float r;asm("v_max3_f32 %0, %1, %2, %3":"=v"(r):"v"(a),"v"(b),"v"(c));return r;}
__device__ __forceinline__ float max2f(float a,float b){float r;asm("v_max_f32_e32 %0, %1, %2":"=v"(r):"v"(a),"v"(b));return r;}
__device__ __forceinline__ float fadd_s(float a,float b){float r;asm("v_add_f32_e32 %0, %1, %2":"=v"(r):"v"(a),"v"(b));return r;}
__device__ __forceinline__ float fsub_s(float a,float b){float r;asm("v_sub_f32_e32 %0, %1, %2":"=v"(r):"v"(a),"v"(b));return r;}
typedef float f32x2_t __attribute__((ext_vector_type(2))); typedef __bf16 bf16x2_t __attribute__((ext_vector_type(2)));
__device__ __forceinline__ unsigned cvtpk_s(float lo,float hi){f32x2_t v={lo,hi};bf16x2_t b=__builtin_convertvector(v,bf16x2_t);return __builtin_bit_cast(unsigned,b);}
#define WAIT_BAR(N) asm volatile("s_waitcnt vmcnt(" #N ") lgkmcnt(0)\n\ts_barrier":::"memory")

__device__ __forceinline__ void qkt(f32x16&p0,f32x16&p1,const char*Kslot,const bf16x8*qr,int r32,int hi){ const f32x16 negm=f32x16{};
  const char*kb=Kslot+hi*1024+r32*16;
  #pragma unroll
  for(int d0=0;d0<4;++d0){
    const bf16x8 b0=*reinterpret_cast<const bf16x8*>(kb+d0*2048);
    const bf16x8 b1=*reinterpret_cast<const bf16x8*>(kb+d0*2048+512);
    if(d0==0){p0=__builtin_amdgcn_mfma_f32_32x32x16_bf16(b0,qr[0],negm,0,0,0);p1=__builtin_amdgcn_mfma_f32_32x32x16_bf16(b1,qr[0],negm,0,0,0);}
    else{p0=__builtin_amdgcn_mfma_f32_32x32x16_bf16(b0,qr[d0],p0,0,0,0);p1=__builtin_amdgcn_mfma_f32_32x32x16_bf16(b1,qr[d0],p1,0,0,0);}}
}
typedef __attribute__((address_space(3))) const char* lds_cptr;
typedef short v4i16_t __attribute__((ext_vector_type(4)));
__device__ __forceinline__ void kload8(bf16x8*kf,lds_cptr kp){
  kf[0]=*(const __attribute__((address_space(3))) bf16x8*)(kp);      kf[1]=*(const __attribute__((address_space(3))) bf16x8*)(kp+512);
  kf[2]=*(const __attribute__((address_space(3))) bf16x8*)(kp+2048); kf[3]=*(const __attribute__((address_space(3))) bf16x8*)(kp+2560);
  kf[4]=*(const __attribute__((address_space(3))) bf16x8*)(kp+4096); kf[5]=*(const __attribute__((address_space(3))) bf16x8*)(kp+4608);
  kf[6]=*(const __attribute__((address_space(3))) bf16x8*)(kp+6144); kf[7]=*(const __attribute__((address_space(3))) bf16x8*)(kp+6656);
}
__device__ __forceinline__ void kload2(bf16x8*kf,lds_cptr kp,int j){ kf[2*j]=*(const __attribute__((address_space(3))) bf16x8*)(kp+j*2048); kf[2*j+1]=*(const __attribute__((address_space(3))) bf16x8*)(kp+j*2048+512); }
__device__ __forceinline__ s16x4 vtr(lds_cptr p){ return __builtin_bit_cast(s16x4,__builtin_amdgcn_ds_read_tr16_b64_v4i16((__attribute__((address_space(3))) v4i16_t*)p)); }
__device__ __forceinline__ float rowmax(const f32x16&p0,const f32x16&p1){
  float a=max3f(p0[0],p0[1],p1[0]),b=max3f(p0[2],p0[3],p1[1]);a=max3f(a,p1[2],p1[3]);
  #pragma unroll
  for(int r=4;r<16;r+=4){a=max3f(a,p0[r],p0[r+1]);b=max3f(b,p0[r+2],p0[r+3]);a=max3f(a,p1[r],p1[r+1]);b=max3f(b,p1[r+2],p1[r+3]);}
  const float m=max2f(a,b);
  auto rr=__builtin_amdgcn_permlane32_swap(__float_as_uint(m),__float_as_uint(m),false,false);
  return max2f(__uint_as_float(rr[0]),__uint_as_float(rr[1]));
}
__device__ __forceinline__ void pv(f32x16*o,int vb,bf16x8 pa0,bf16x8 pa1,bf16x8 pa2,bf16x8 pa3){
  #pragma unroll
  for(int d0=0;d0<2;++d0){s16x4 lo[4],hi[4];
    #pragma unroll
    for(int ks=0;ks<4;++ks){
      asm volatile("ds_read_b64_tr_b16 %0,%1 offset:%c2":"=&v"(lo[ks]):"v"(vb),"i"(d0*4096+ks*1024):"memory");
      asm volatile("ds_read_b64_tr_b16 %0,%1 offset:%c2":"=&v"(hi[ks]):"v"(vb),"i"(d0*4096+ks*1024+512):"memory");}
    asm volatile("s_waitcnt lgkmcnt(0)":::"memory");SBAR();
    #define PK(k) (bf16x8){lo[k][0],lo[k][1],lo[k][2],lo[k][3],hi[k][0],hi[k][1],hi[k][2],hi[k][3]}
    o[d0]=__builtin_amdgcn_mfma_f32_32x32x16_bf16(pa0,PK(0),o[d0],0,0,0);
    o[d0]=__builtin_amdgcn_mfma_f32_32x32x16_bf16(pa1,PK(1),o[d0],0,0,0);
    o[d0]=__builtin_amdgcn_mfma_f32_32x32x16_bf16(pa2,PK(2),o[d0],0,0,0);
    o[d0]=__builtin_amdgcn_mfma_f32_32x32x16_bf16(pa3,PK(3),o[d0],0,0,0);
    #undef PK
  }
}

#ifndef ATTN_STORE16
#define ATTN_STORE16(p,v) (*(u32x4*)(p)=(v))
#endif
template<int THRL> __device__ __forceinline__ void attn_unit(int b,int h,int qb,const bf16*Q,const bf16*__restrict__ K,const bf16*__restrict__ V,bf16*O,const float*__restrict__ LFT,const float Dd,char*shm){
  int tid=threadIdx.x; asm volatile("":"+v"(tid)); const int lane=tid&63,r32=lane&31,hi=lane>>5; const int wid=__builtin_amdgcn_readfirstlane(tid>>6);
  const long rowbase=(long)b*SEQ; const int q0=qb*QB;
  const bf16*Qw=Q+(rowbase+q0+wid*QBLK)*DM+h*D;
  const bf16*Kh=K+rowbase*DM+h*D,*Vh=V+rowbase*DM+h*D;
  const unsigned lds0=(unsigned)(uintptr_t)shm;
  float*wsf=(float*)(shm+LDS_WS)+wid*64;
  const bf16*ksrc=Kh+(long)lane*DM+wid*8;
  const bf16*vsrc=Vh+(long)(16*(wid&3)+(lane>>2))*DM+(wid>>2)*32+(lane&3)*8;
  const unsigned kdst=lds0+LDS_K+wid*1024, vdst=lds0+LDS_V+wid*1024;
  #define DMA_K(t,slot) glds16(ksrc+(long)(t)*KVBLK*DM,(unsigned)__builtin_amdgcn_readfirstlane(kdst+(slot)))
  #define DMA_V(t,slot) glds16(vsrc+(long)(t)*KVBLK*DM,(unsigned)__builtin_amdgcn_readfirstlane(vdst+(slot)))
  const int vb0=(int)(lds0+LDS_V)+((lane>>4)&1)*32+(lane&3)*8+(4*hi+((lane&15)>>2))*64;
  const char*Kbase=shm+LDS_K; bf16x8 kf[8];
  const lds_cptr shm3=(lds_cptr)shm; const lds_cptr kp0=shm3+LDS_K+hi*1024+r32*16; const lds_cptr vp0=shm3+LDS_V+((lane>>4)&1)*32+(lane&3)*8+(4*hi+((lane&15)>>2))*64;
  int NT=(q0+QB)/KVBLK;
  typedef __attribute__((address_space(3))) const f32x4v* lds_f4p;
  typedef __attribute__((address_space(3))) float* lds_fp;
  bool stat; int t0;
  {
    lds_fp cbw=(lds_fp)(shm3+LDS_CB); lds_fp cbx=(lds_fp)(shm3+LDS_CBX); lds_fp alw=(lds_fp)(shm3+LDS_AL);
    const float L2E=1.4426950408889634f;
    const int nk=q0+QB; float v0=0.f,v1=0.f,v2=0.f,v3=0.f;
    if(4*tid<nk){ const f32x4v l4=*(const f32x4v*)(LFT+((long)(b*NHEAD+h))*SEQ+4*tid); v0=l4[0]; v1=l4[1]; v2=l4[2]; v3=l4[3]; }
    v1+=v0; v2+=v1; v3+=v2; float tot=v3;
    #pragma unroll
    for(int o_=1;o_<64;o_<<=1){ float u_=__shfl_up(tot,o_); if(lane>=o_)tot+=u_; }
    if(lane==63)cbx[wid]=tot;
    if(tid==0){cbx[48]=0.f;}
    asm volatile("s_waitcnt vmcnt(0) lgkmcnt(0)\n\ts_barrier":::"memory");
    float base=tot-v3;
    #pragma unroll
    for(int w_=0;w_<NW;++w_){ float x_=cbx[w_]; if(w_<wid)base+=x_; }
    v0+=base;v1+=base;v2+=base;v3+=base;
    if(4*tid<nk && ((4*tid+3)&63)==63)cbx[16+((4*tid+3)>>6)]=v3;
    if(4*tid==q0)cbx[8]=v0;
    asm volatile("s_waitcnt vmcnt(0) lgkmcnt(0)\n\ts_barrier":::"memory");
    const float cq0=cbx[8];
    if(4*tid<nk){ const float ce=cbx[16+(tid>>4)]; cbw[4*tid]=(ce-v0)*L2E-Dd; cbw[4*tid+1]=(ce-v1)*L2E-Dd; cbw[4*tid+2]=(ce-v2)*L2E-Dd; cbw[4*tid+3]=(ce-v3)*L2E-Dd; }
    bool skip_=false;
    if(tid<NT){ const float ce=cbx[16+tid], cp=(tid>0)?cbx[16+tid-1]:0.f; const float dl_=(cp-ce)*L2E;
      alw[tid]=__builtin_amdgcn_exp2f(-dl_); alw[32+tid]=dl_; if(dl_+2.f*Dd>110.f)cbx[48]=1.f;
      skip_=(tid<NT-4)&&((ce-cq0)*L2E>2.f*Dd+160.f); }
    const unsigned long long bal_=__ballot(skip_);
    if(tid==0)cbx[49]=(float)(__popcll(bal_)&~1);
    asm volatile("s_waitcnt vmcnt(0) lgkmcnt(0)\n\ts_barrier":::"memory");
    stat=(cbx[48]==0.f); t0=(int)cbx[49];
    stat=__builtin_amdgcn_readfirstlane((int)stat)!=0; t0=__builtin_amdgcn_readfirstlane(t0);
#ifdef FORCE_EXACT
    stat=false;
#endif
  }
  NT-=t0; ksrc+=(long)t0*KVBLK*DM; vsrc+=(long)t0*KVBLK*DM;
  typedef __attribute__((address_space(3))) const float* lds_cfp;
  const lds_cfp alp=(lds_cfp)(shm3+LDS_AL)+t0;
  const int tdw=NT-4+(wid>>1);
  #define ALF(t) (((t)>tdw)?1.f:alp[t])
  const lds_f4p cbp=(lds_f4p)(shm3+LDS_CB)+hi+16*t0;
  #define CBIAS(P0,P1,t) do{ const lds_f4p bp_=cbp+16*(t); _Pragma("unroll") for(int a_=0;a_<4;++a_){ const f32x4v b0_=bp_[2*a_], b1_=bp_[8+2*a_]; \
      P0[4*a_]+=b0_[0];P0[4*a_+1]+=b0_[1];P0[4*a_+2]+=b0_[2];P0[4*a_+3]+=b0_[3]; P1[4*a_]+=b1_[0];P1[4*a_+1]+=b1_[1];P1[4*a_+2]+=b1_[2];P1[4*a_+3]+=b1_[3]; } }while(0)
  DMA_K(0,0);DMA_V(0,0);DMA_K(1,SLOTB);
  bf16x8 qr[4];
  #pragma unroll
  for(int d0=0;d0<4;++d0)qr[d0]=*reinterpret_cast<const bf16x8*>(&Qw[(long)r32*DM+d0*16+hi*8]);
  float mhat=0.f,l_reg=0.f;f32x16 o[2];o[0]=f32x16{};o[1]=f32x16{};
  const int qrel=wid*QBLK+r32;
  #define CMASK(P0,P1,t) do{int jb_=(t)-(NT-4); if(jb_>=0)cmask(P0,P1,jb_,qrel,hi);}while(0)
  bool resc=false;
  #define START(P0,P1) do{ resc=false; \
    if(!stat){ const float rm=rowmax(P0,P1); const float dl=rm; mhat=fadd_s(mhat,dl); \
      _Pragma("unroll") for(int r=0;r<16;++r){P0[r]=fsub_s(P0[r],dl);P1[r]=fsub_s(P1[r],dl);} \
      } \
    _Pragma("unroll") for(int r=0;r<16;++r)P0[r]=__builtin_amdgcn_exp2f(P0[r]); }while(0)
  #define RESC(t) do{ if(stat){ const float al_=ALF(t); _Pragma("unroll") for(int d_=0;d_<2;++d_) _Pragma("unroll") for(int r=0;r<16;++r)o[d_][r]*=al_; } \
    else if(resc){ asm volatile("s_waitcnt lgkmcnt(0)":::"memory"); \
      _Pragma("unroll") for(int d_=0;d_<2;++d_) _Pragma("unroll") for(int r=0;r<16;++r)o[d_][r]*=wsf[crow(r,hi)]; } }while(0)
  f32x16 pA0,pA1,pB0,pB1;
  int sl_prev=0,sl_cur=0,sl_next=SLOTB;
  #define ROT() do{sl_prev=sl_cur;sl_cur=sl_next;sl_next=(sl_next==(NSLOT-1)*SLOTB)?0:sl_next+SLOTB;}while(0)
  DMA_K(2,2*SLOTB);
  WAIT_BAR(3);
  qkt(pA0,pA1,Kbase,qr,r32,hi);asm volatile("s_nop 15\n\ts_nop 7":"+v"(pA0),"+v"(pA1));CMASK(pA0,pA1,0);CBIAS(pA0,pA1,0);
  START(pA0,pA1);
  _Pragma("unroll") for(int r=0;r<16;++r)pA1[r]=__builtin_amdgcn_exp2f(pA1[r]);
  WAIT_BAR(0);
  DMA_K(3,0);DMA_V(1,SLOTB);
  ROT();
  kload8(kf,kp0+sl_cur);
  WAIT_BAR(2);
  s16x4 vlo[8],vhi[8]; u32x4 pw0,pw1,pw2,pw3;
  #define PKW(P,B) cvtpk_s(P[B],P[B+1])
  #define PAF(k) __builtin_bit_cast(bf16x8,pw##k)
  #define VFR(i) (bf16x8){vlo[i][0],vlo[i][1],vlo[i][2],vlo[i][3],vhi[i][0],vhi[i][1],vhi[i][2],vhi[i][3]}
  #define PIN(x) asm volatile("":"+v"(x))
  #define MX3(a,b,c) __builtin_fmaxf(__builtin_fmaxf((a),(b)),(c))
  #define GAPA(MF,A0,A1,A2,A3,W0,W1,PW) do{ MF; sacc+=A0; sacc+=A1; sacc+=A2; sacc+=A3; PIN(sacc); W0; W1; PIN(PW); SBAR(); }while(0)
  #define EX(v) __builtin_amdgcn_exp2f(v)
  #define GAPB(MF,X,B) do{ MF; X[B]=EX(X[B]); X[B+1]=EX(X[B+1]); X[B+2]=EX(X[B+2]); X[B+3]=EX(X[B+3]); PIN(X); SBAR(); }while(0)
  #define VRD(i) do{ vlo[i]=vtr(vp_+(((i)>>2)*4096+((i)&3)*1024)); vhi[i]=vtr(vp_+(((i)>>2)*4096+((i)&3)*1024+512)); }while(0)
  #define KRD(G,j) do{ if(G){ kload2(kf,kp0+sl_next,j); SBAR(); } }while(0)
  #define STEP(C0,C1,P0,P1,t,GK,GV,GL) do{ SBAR(); \
    const lds_cptr vp_=vp0+sl_prev; \
    VRD(0); SBAR(); float sacc=(P0[0]+P0[1]); \
    GAPA(C0=__builtin_amdgcn_mfma_f32_32x32x16_bf16(kf[0],qr[0],f32x16{},0,0,0), P0[2],P0[3],P0[4],P0[5],     pw0[0]=PKW(P0,0), pw0[1]=PKW(P0,2), pw0); \
    VRD(4); SBAR(); GAPA(C1=__builtin_amdgcn_mfma_f32_32x32x16_bf16(kf[1],qr[0],f32x16{},0,0,0), P0[6],P0[7],P0[8],P0[9],     pw0[2]=PKW(P0,4), pw0[3]=PKW(P0,6), pw0); \
    VRD(1); SBAR(); GAPA(C0=__builtin_amdgcn_mfma_f32_32x32x16_bf16(kf[2],qr[1],C0,0,0,0),   P0[10],P0[11],P0[12],P0[13], pw1[0]=PKW(P0,8), pw1[1]=PKW(P0,10), pw1); \
    VRD(5); SBAR(); GAPA(C1=__builtin_amdgcn_mfma_f32_32x32x16_bf16(kf[3],qr[1],C1,0,0,0),   P0[14],P0[15],P1[0],P1[1],   pw1[2]=PKW(P0,12),pw1[3]=PKW(P0,14), pw1); \
    VRD(2); SBAR(); GAPA(C0=__builtin_amdgcn_mfma_f32_32x32x16_bf16(kf[4],qr[2],C0,0,0,0),   P1[2],P1[3],P1[4],P1[5],     pw2[0]=PKW(P1,0), pw2[1]=PKW(P1,2), pw2); \
    VRD(6); SBAR(); GAPA(C1=__builtin_amdgcn_mfma_f32_32x32x16_bf16(kf[5],qr[2],C1,0,0,0),   P1[6],P1[7],P1[8],P1[9],     pw2[2]=PKW(P1,4), pw2[3]=PKW(P1,6), pw2); \
    VRD(3); SBAR(); GAPA(C0=__builtin_amdgcn_mfma_f32_32x32x16_bf16(kf[6],qr[3],C0,0,0,0),   P1[10],P1[11],P1[12],P1[13], pw3[0]=PKW(P1,8), pw3[1]=PKW(P1,10), pw3); \
    VRD(7); SBAR(); GAPA(C1=__builtin_amdgcn_mfma_f32_32x32x16_bf16(kf[7],qr[3],C1,0,0,0),   P1[14],P1[15],0.f,0.f,       pw3[2]=PKW(P1,12),pw3[3]=PKW(P1,14), pw3); \
    l_reg+=sacc; \
    if(GK){DMA_K((t)+3,sl_cur);} if(GV){DMA_V((t)+1,sl_next);} \
    CMASK(C0,C1,t); CBIAS(C0,C1,t); \
    if(stat){ l_reg*=ALF(t); resc=false; } else { mhat-=alp[32+(t)]; _Pragma("unroll") for(int r=0;r<16;++r){C0[r]-=mhat;C1[r]-=mhat;} float a=MX3(C0[0],C0[1],C1[0]),b=MX3(C0[2],C0[3],C1[1]); a=MX3(a,C1[2],C1[3]); \
      _Pragma("unroll") for(int r=4;r<16;r+=4){a=MX3(a,C0[r],C0[r+1]);b=MX3(b,C0[r+2],C0[r+3]);a=MX3(a,C1[r],C1[r+1]);b=MX3(b,C1[r+2],C1[r+3]);} \
      float rm=__builtin_fmaxf(a,b); { auto rr=__builtin_amdgcn_permlane32_swap(__float_as_uint(rm),__float_as_uint(rm),false,false); rm=__builtin_fmaxf(__uint_as_float(rr[0]),__uint_as_float(rr[1])); } \
      resc=false; \
      if(__builtin_expect(__any(rm>(float)THRL),0)){ const float dl=__builtin_fmaxf(rm,0.f); mhat+=dl; \
        _Pragma("unroll") for(int r=0;r<16;++r){C0[r]-=dl;C1[r]-=dl;} \
        const float f=__builtin_amdgcn_exp2f(-dl); l_reg*=f; if(hi==0)wsf[r32]=f; resc=true; } } \
    SBAR(); \
    GAPB(o[0]=__builtin_amdgcn_mfma_f32_32x32x16_bf16(PAF(0),VFR(0),o[0],0,0,0), C0,0); \
    GAPB(o[1]=__builtin_amdgcn_mfma_f32_32x32x16_bf16(PAF(0),VFR(4),o[1],0,0,0), C0,4); \
    KRD(GL,0); GAPB(o[0]=__builtin_amdgcn_mfma_f32_32x32x16_bf16(PAF(1),VFR(1),o[0],0,0,0), C0,8); \
    KRD(GL,1); GAPB(o[1]=__builtin_amdgcn_mfma_f32_32x32x16_bf16(PAF(1),VFR(5),o[1],0,0,0), C0,12); \
    KRD(GL,2); GAPB(o[0]=__builtin_amdgcn_mfma_f32_32x32x16_bf16(PAF(2),VFR(2),o[0],0,0,0), C1,0); \
    KRD(GL,3); GAPB(o[1]=__builtin_amdgcn_mfma_f32_32x32x16_bf16(PAF(2),VFR(6),o[1],0,0,0), C1,4); \
    GAPB(o[0]=__builtin_amdgcn_mfma_f32_32x32x16_bf16(PAF(3),VFR(3),o[0],0,0,0), C1,8); \
    GAPB(o[1]=__builtin_amdgcn_mfma_f32_32x32x16_bf16(PAF(3),VFR(7),o[1],0,0,0), C1,12); \
    }while(0)
  int t=1;
  #undef CMASK
  #define CMASK(P0,P1,t) do{}while(0)
  for(;t+5<NT;t+=2){
    STEP(pB0,pB1,pA0,pA1,t,true,true,true);     WAIT_BAR(2); RESC(t); ROT();
    STEP(pA0,pA1,pB0,pB1,t+1,true,true,true);   WAIT_BAR(2); RESC(t+1); ROT();
  }
  #undef CMASK
  #define CMASK(P0,P1,t) do{int jb_=(t)-(NT-4); if(jb_>=0)cmask(P0,P1,jb_,qrel,hi);}while(0)
  #define ENDW(tt) do{ if((tt)+3<NT){WAIT_BAR(2);} else if((tt)+2<NT){WAIT_BAR(1);} else {WAIT_BAR(0);} }while(0)
  for(;t+1<NT;t+=2){
    STEP(pB0,pB1,pA0,pA1,t,(t+3<NT),(t+1<NT),(t+1<NT));       ENDW(t);   RESC(t); ROT();
    STEP(pA0,pA1,pB0,pB1,t+1,(t+4<NT),(t+2<NT),(t+2<NT));     ENDW(t+1); RESC(t+1); ROT();
  }
  STEP(pB0,pB1,pA0,pA1,NT-1,false,false,false); RESC(NT-1);
  { float sacc=pB0[0]+pB0[1]; _Pragma("unroll") for(int r=2;r<16;++r)sacc+=pB0[r]; _Pragma("unroll") for(int r=0;r<16;++r)sacc+=pB1[r]; l_reg+=sacc;
    pw0=(u32x4){PKW(pB0,0),PKW(pB0,2),PKW(pB0,4),PKW(pB0,6)};pw1=(u32x4){PKW(pB0,8),PKW(pB0,10),PKW(pB0,12),PKW(pB0,14)};pw2=(u32x4){PKW(pB1,0),PKW(pB1,2),PKW(pB1,4),PKW(pB1,6)};pw3=(u32x4){PKW(pB1,8),PKW(pB1,10),PKW(pB1,12),PKW(pB1,14)};
    SBAR(); pv(o,vb0+sl_cur,PAF(0),PAF(1),PAF(2),PAF(3)); }
  #undef PKW
  #undef PAF
  #undef VFR
  #undef PIN
  #undef MX3
  #undef GAPA
  #undef GAPB
  #undef EX
  #undef VRD
  #undef KRD
  #undef STEP
  #undef ENDW
  {auto rr=__builtin_amdgcn_permlane32_swap(__float_as_uint(l_reg),__float_as_uint(l_reg),false,false);l_reg=__uint_as_float(rr[0])+__uint_as_float(rr[1]);}
  if(hi==0)wsf[32+r32]=l_reg;asm volatile("s_waitcnt lgkmcnt(0)":::"memory");
  float rli[16];
  #pragma unroll
  for(int r=0;r<16;++r)rli[r]=__builtin_amdgcn_rcpf(wsf[32+crow(r,hi)]);
  bf16*Ow=O+(rowbase+q0+wid*QBLK)*DM+h*D;
  { bf16*stg=(bf16*)(shm+LDS_OST)+wid*2048;
    #pragma unroll
    for(int r=0;r<16;++r){const int orow=crow(r,hi);
      #pragma unroll
      for(int d0=0;d0<2;++d0)stg[orow*64+d0*32+r32]=__float2bfloat16(o[d0][r]*rli[r]);}
    asm volatile("s_waitcnt lgkmcnt(0)":::"memory");
    #pragma unroll
    for(int i=0;i<4;++i){const int row=i*8+(lane>>3),ch=lane&7; const u32x4 v=*(const u32x4*)(stg+row*64+ch*8); ATTN_STORE16(Ow+(long)row*DM+ch*8,v);} }
  asm volatile("s_waitcnt lgkmcnt(0)\n\ts_barrier":::"memory");
  #undef DMA_K
  #undef DMA_V
  #undef CMASK
  #undef CBIAS
  #undef ALF
  #undef START
  #undef RESC
  #undef ROT
}
constexpr int ATTN_LDS_BYTES=LDS_BYTES;
#undef SBAR
#undef WAIT_BAR
}
namespace xb {
#define XLAS __attribute__((address_space(3)))
#define XB_TMO      128
#define XB_XCNT(j)  (256  + 64 * (j))
#define XB_XSUB(j)  (1280 + 64 * (j))
#define XB_XGEN(j)  (2304 + 64 * (j))
#define XB_TOP      3328
#define XB_TOPGEN   3392
#define XCD_BAR_WORDS 3456
#define XB_SPIN_CAP (1u << 18)

__device__ __forceinline__ unsigned xb_ld(unsigned* p)              { return __hip_atomic_load(p, __ATOMIC_RELAXED, __HIP_MEMORY_SCOPE_AGENT); }
__device__ __forceinline__ unsigned xb_add(unsigned* p, unsigned v) { return __hip_atomic_fetch_add(p, v, __ATOMIC_RELAXED, __HIP_MEMORY_SCOPE_AGENT); }
__device__ __forceinline__ unsigned xb_xcc_id() { return (unsigned)__builtin_amdgcn_s_getreg((3 << 11) | 20) & 0xFu; }
#define XB_SPIN(cond, bar) do { unsigned _sp = 0; while (cond) { __builtin_amdgcn_s_sleep(1); \
    if ((++_sp & 255u) == 0u) { if (xb_ld(&(bar)[XB_TMO])) break; if (_sp > XB_SPIN_CAP) { atomicAdd(&(bar)[XB_TMO], 1u); break; } } } } while (0)

struct XcdBarrier {
    unsigned* bar; unsigned x;
    volatile XLAS unsigned* st;
};

__device__ __forceinline__ XcdBarrier xcd_barrier_post(unsigned* bar, volatile XLAS unsigned* st) {
    XcdBarrier b; b.bar = bar; b.x = xb_xcc_id(); b.st = st;
    if (threadIdx.x == 0) (void)xb_add(&bar[XB_XCNT(b.x)], 1u);
    return b;
}
__device__ __forceinline__ void xcd_barrier_complete(unsigned* bar, unsigned x, unsigned& nloc, unsigned& nx) {
    const unsigned G = gridDim.x * gridDim.y * gridDim.z;
    unsigned sum, cnt, mine, sp = 0u;
    for (;;) {
        sum = 0u; cnt = 0u; mine = 0u;
#pragma unroll
        for (unsigned j = 0; j < 16; ++j) { const unsigned c = xb_ld(&bar[XB_XCNT(j)]); sum += c; cnt += (c > 0u) ? 1u : 0u; mine = (j == x) ? c : mine; }
        if (sum == G) break;
        __builtin_amdgcn_s_sleep(1);
        if ((++sp & 255u) == 0u) { if (xb_ld(&bar[XB_TMO])) break; if (sp > XB_SPIN_CAP) { atomicAdd(&bar[XB_TMO], 1u); break; } }
    }
    nloc = mine > 0u ? mine : 1u; nx = cnt > 0u ? cnt : 1u;
}

__device__ __forceinline__ void xcd_barrier(const XcdBarrier& b) {
    asm volatile("s_waitcnt vmcnt(0)" ::: "memory");
    __syncthreads();
    if (threadIdx.x == 0) {
        unsigned* bar = b.bar;
        __builtin_amdgcn_s_waitcnt(0);
        unsigned nloc = b.st[0], nx = b.st[1];
        if (nloc == 0u) { xcd_barrier_complete(bar, b.x, nloc, nx); b.st[0] = nloc; b.st[1] = nx; }
        const unsigned old = xb_add(&bar[XB_XSUB(b.x)], 1u);
        const unsigned gen = old / nloc;
        if (old + 1u == (gen + 1u) * nloc) {
            __builtin_amdgcn_fence(__ATOMIC_RELEASE, "agent");
            asm volatile("s_waitcnt vmcnt(0)" ::: "memory");
            const unsigned og = xb_add(&bar[XB_TOP], 1u);
            const unsigned tg = og / nx;
            if (og + 1u == (tg + 1u) * nx) xb_add(&bar[XB_TOPGEN], 1u);
            else XB_SPIN(xb_ld(&bar[XB_TOPGEN]) == tg, bar);
            __builtin_amdgcn_fence(__ATOMIC_ACQUIRE, "agent");
            xb_add(&bar[XB_XGEN(b.x)], 1u);
            asm volatile("s_waitcnt vmcnt(0)" ::: "memory");
        } else {
            XB_SPIN(xb_ld(&bar[XB_XGEN(b.x)]) == gen, bar);
            __builtin_amdgcn_fence(__ATOMIC_ACQUIRE, "agent");
            asm volatile("s_waitcnt vmcnt(0)" ::: "memory");
        }
    }
    __syncthreads();
}
}
namespace mk {
#define LAS __attribute__((address_space(3)))
typedef unsigned short u16;
typedef pg8::f32x4 f32x4;
typedef pg8::u32x4 u32x4;
typedef pg8::bf16x8 bf16x8;
typedef unsigned u32x2 __attribute__((ext_vector_type(2)));
using pg8::cvt_pk_bf16;

constexpr int DMODEL = 1024, SEQ = 2048, MP = 65536, MS = 256, MT = MP + MS, DFF = 2816, NMIX = 6912, PAST = 4096, NPOS = 2048 + 16;
constexpr float L2E = 1.4426950408889634f;
constexpr float QC2 = 0.125f * L2E;

constexpr size_t SZ1024 = (size_t)MT * 1024 * 2, SZ512 = (size_t)MT * 512 * 2;
constexpr size_t O_CTL = 0;
constexpr size_t O_SS = 65536;
constexpr size_t O_TABC = O_SS + (size_t)MT * 64;
constexpr size_t O_TABS = O_TABC + (size_t)NPOS * 256;
constexpr size_t O_W1IN = O_TABS + (size_t)NPOS * 256;
constexpr size_t O_W1OUT = O_W1IN + (size_t)5632 * 1024 * 2;
constexpr size_t O_WMIX = O_W1OUT + (size_t)1024 * 2816 * 2;
constexpr size_t O_WBR = O_WMIX + (size_t)NMIX * 1024 * 2;
constexpr size_t O_WBF = O_WBR + (size_t)1024 * 1024 * 2;
constexpr size_t O_WOUT = O_WBF + (size_t)1024 * 512 * 2;
constexpr size_t O_W2IN = O_WOUT + (size_t)1024 * 1024 * 2;
constexpr size_t O_W2OUT = O_W2IN + (size_t)5632 * 1024 * 2;
constexpr size_t O_WPLE = O_W2OUT + (size_t)1024 * 2816 * 2;
constexpr size_t O_WPG = O_WPLE + (size_t)1024 * 256 * 2;
constexpr size_t O_XB = O_WPG + (size_t)1024 * 1024 * 2;
constexpr size_t O_RQK = O_XB + SZ1024;
constexpr size_t O_RV = O_RQK + SZ1024;
constexpr size_t O_RG = O_RV + SZ1024;
constexpr size_t O_FQ = O_RG + SZ1024;
constexpr size_t O_FK = O_FQ + SZ512;
constexpr size_t O_FV = O_FK + SZ512;
constexpr size_t O_ZG = O_FV + SZ512;
constexpr size_t WS_NEED = O_ZG + (size_t)MT * 2048 * 2;
constexpr size_t O_ACT1 = O_RQK;
constexpr size_t O_ACT2 = O_RV;
static_assert(O_ACT1 + (size_t)MT * DFF * 2 <= O_FQ, "act1 overlay");
static_assert(O_ACT2 + (size_t)MT * DFF * 2 <= O_FV, "act2 overlay");
static_assert(WS_NEED <= 1073741824ull, "ws");
constexpr size_t OUT_YP = 0, OUT_YS = OUT_YP + (size_t)MP * 1024, OUT_RSP = OUT_YS + (size_t)MS * 1024, OUT_KP = OUT_RSP + (size_t)32 * 4 * 128 * 256,
                 OUT_VP = OUT_KP + (size_t)MP * 512, OUT_LP = OUT_VP + (size_t)MP * 512, OUT_RSS = OUT_LP + (size_t)MP * 8, OUT_KS = OUT_RSS + (size_t)16 * 4 * 128 * 256,
                 OUT_VS = OUT_KS + (size_t)MS * 512, OUT_LS = OUT_VS + (size_t)MS * 512, OUT_END = OUT_LS + (size_t)MS * 8;

constexpr int LDS_BYTES = 147456;

__device__ __forceinline__ float bf2f(unsigned h) { return __uint_as_float(h << 16); }
__device__ __forceinline__ float bflo(unsigned w) { return __uint_as_float(w << 16); }
__device__ __forceinline__ float bfhi(unsigned w) { return __uint_as_float(w & 0xffff0000u); }
__device__ __forceinline__ float fast_sigmoid(float x) { return __builtin_amdgcn_rcpf(1.f + __builtin_amdgcn_exp2f(-x * L2E)); }
__device__ __forceinline__ float wave_sum(float v) {
#pragma unroll
    for (int o = 1; o < 64; o <<= 1) v += __shfl_xor(v, o);
    return v;
}
__device__ __forceinline__ float wave_max(float v) {
#pragma unroll
    for (int o = 1; o < 64; o <<= 1) v = fmaxf(v, __shfl_xor(v, o));
    return v;
}
__device__ __forceinline__ float rstd_of(const float* ss, int row) {
    const f32x4* p = (const f32x4*)(ss + (size_t)row * 16); const f32x4 a = p[0], b = p[1], c = p[2], d = p[3];
    const float s = (((a[0] + a[1]) + (a[2] + a[3])) + ((b[0] + b[1]) + (b[2] + b[3]))) + (((c[0] + c[1]) + (c[2] + c[3])) + ((d[0] + d[1]) + (d[2] + d[3])));
    return rsqrtf(s * (1.f / 1024.f) + 1e-6f);
}
__device__ __forceinline__ int gcol(int q) { return (q & 128) + (q & 96) + ((q >> 2) & 3) * 8 + ((q >> 4) & 1) * 4 + (q & 3); }


constexpr int RS_TAB_OFF = 147456 - 128 - 1024;
__device__ __forceinline__ const LAS float* rs_table_fill(const float* ss, int pm) {
    LAS float* tab = (LAS float*)(uintptr_t)RS_TAB_OFF;
    const int t = threadIdx.x;
    if (t < 256) tab[t] = rstd_of(ss, pm * 256 + t);
    asm volatile("s_waitcnt lgkmcnt(0)" ::: "memory"); __builtin_amdgcn_s_barrier(); asm volatile("" ::: "memory");
    return tab;
}
struct EpiSwiglu {
    static constexpr bool PERM = false, AFTER_DRAIN = false;
    u16* O; const float* ss;
    __device__ __forceinline__ void operator()(const f32x4 (&acc)[2][2][4][2], const pg8::Unit& u, int wr, int wc, int fr, int fq) const {
        const int col = u.pn * 128 + wc * 32 + fq * 8; const LAS float* rst = rs_table_fill(ss, u.pm);
#pragma unroll
        for (int ai = 0; ai < 2; ++ai)
#pragma unroll
            for (int m = 0; m < 4; ++m) {
                const int row = u.pm * 256 + ai * 128 + wr * 64 + m * 16 + fr; const float rs = rst[ai * 128 + wr * 64 + m * 16 + fr];
                float a[8];
#pragma unroll
                for (int n = 0; n < 2; ++n)
#pragma unroll
                    for (int e = 0; e < 4; ++e) { const float g = acc[ai][0][m][n][e] * rs, uu = acc[ai][1][m][n][e] * rs; a[n * 4 + e] = g * uu * fast_sigmoid(g); }
                u32x4 w; w.x = cvt_pk_bf16(a[0], a[1]); w.y = cvt_pk_bf16(a[2], a[3]); w.z = cvt_pk_bf16(a[4], a[5]); w.w = cvt_pk_bf16(a[6], a[7]);
                *(u32x4*)(O + (size_t)row * DFF + col) = w;
            }
    }
};
struct EpiMix {
    static constexpr bool PERM = false, AFTER_DRAIN = false;
    const float* ss; const float* tabc; const float* tabs; const float* qg; const float* kg; const float* bfg;
    u16 *RQK, *RV, *RG, *FQ, *FK, *FV, *ZG; float* out; float* lft;
    template <int MODE> static __device__ __forceinline__ void store8(const f32x4 (&acc)[2][2][4][2], u16* base, int ld, int t, int row, float rs, int ai, int m, int wc, int fq) {
#pragma unroll
        for (int bj = 0; bj < 2; ++bj) {
            float a[8];
#pragma unroll
            for (int n = 0; n < 2; ++n)
#pragma unroll
                for (int e = 0; e < 4; ++e) { const float v = acc[ai][bj][m][n][e] * rs; a[n * 4 + e] = MODE == 0 ? v : (MODE == 1 ? v * fast_sigmoid(v) : fast_sigmoid(v)); }
            u32x4 w; w.x = cvt_pk_bf16(a[0], a[1]); w.y = cvt_pk_bf16(a[2], a[3]); w.z = cvt_pk_bf16(a[4], a[5]); w.w = cvt_pk_bf16(a[6], a[7]);
            *(u32x4*)(base + (size_t)row * ld + t * 256 + bj * 128 + wc * 32 + fq * 8) = w;
        }
    }
    template <bool ISK> static __device__ __forceinline__ void headnorm(const f32x4 (&acc)[2][2][4][2], u16* dst, const float* gn, float* o, int row, float rs, int ai, int m, int head, int fq) {
        float q = 0.f;
#pragma unroll
        for (int bj = 0; bj < 2; ++bj)
#pragma unroll
            for (int n = 0; n < 2; ++n) { const f32x4 v = acc[ai][bj][m][n] * rs; q += (v[0] * v[0] + v[1] * v[1]) + (v[2] * v[2] + v[3] * v[3]); }
        q += __shfl_xor(q, 16); q += __shfl_xor(q, 32);
        const float hr = rsqrtf(q * (1.f / 64.f) + 1e-6f) * rs * (ISK ? 1.f : QC2);
#pragma unroll
        for (int bj = 0; bj < 2; ++bj)
#pragma unroll
            for (int n = 0; n < 2; ++n) {
                const int d = 32 * bj + 16 * n + 4 * fq; const f32x4 g4 = *(const f32x4*)(gn + d); const f32x4 v = acc[ai][bj][m][n] * hr * g4;
                u32x2 w; w.x = cvt_pk_bf16(v[0], v[1]); w.y = cvt_pk_bf16(v[2], v[3]);
                *(u32x2*)(dst + (size_t)row * 512 + head * 64 + d) = w;
                if (ISK) *(f32x4*)(o + head * 64 + d) = v;
            }
    }
    __device__ __forceinline__ void operator()(const f32x4 (&acc)[2][2][4][2], const pg8::Unit& u, int wr, int wc, int fr, int fq) const {
        const int pn = u.pn; const LAS float* rst = rs_table_fill(ss, u.pm);
#pragma unroll
        for (int ai = 0; ai < 2; ++ai)
#pragma unroll
            for (int m = 0; m < 4; ++m) {
                const int row = u.pm * 256 + ai * 128 + wr * 64 + m * 16 + fr; const float rs = rst[ai * 128 + wr * 64 + m * 16 + fr];
                if (pn < 4) {
                    const int pidx = row < MP ? (row & (SEQ - 1)) : SEQ + ((row - MP) & 15);
                    const int d = 16 * wc + 4 * fq;
                    const f32x4 c = *(const f32x4*)(tabc + pidx * 64 + d), s = *(const f32x4*)(tabs + pidx * 64 + d);
                    const float sc = rs * (pn >= 2 ? 0.08838834764831845f : 1.f);
#pragma unroll
                    for (int bj = 0; bj < 2; ++bj) {
                        const f32x4 x1 = acc[ai][bj][m][0] * sc, x2 = acc[ai][bj][m][1] * sc;
                        const f32x4 o1 = x1 * c - x2 * s, o2 = x1 * s + x2 * c;
                        u16* p = RQK + (size_t)row * 1024 + (pn >> 1) * 512 + (2 * (pn & 1) + bj) * 128 + d;
                        u32x2 w1, w2; w1.x = cvt_pk_bf16(o1[0], o1[1]); w1.y = cvt_pk_bf16(o1[2], o1[3]); w2.x = cvt_pk_bf16(o2[0], o2[1]); w2.y = cvt_pk_bf16(o2[2], o2[3]);
                        *(u32x2*)p = w1; *(u32x2*)(p + 64) = w2;
                    }
                } else if (pn < 8) { store8<0>(acc, RV, 1024, pn - 4, row, rs, ai, m, wc, fq);
                } else if (pn < 12) { store8<1>(acc, RG, 1024, pn - 8, row, rs, ai, m, wc, fq);
                } else if (pn >= 19) { store8<2>(acc, ZG, 2048, pn - 19, row, rs, ai, m, wc, fq);
                } else if (pn < 14) { headnorm<false>(acc, FQ, qg, nullptr, row, rs, ai, m, 4 * (pn & 1) + wc, fq);
                } else if (pn < 16) { headnorm<true>(acc, FK, kg, row < MP ? out + OUT_KP + (size_t)row * 512 : out + OUT_KS + (size_t)(row - MP) * 512, row, rs, ai, m, 4 * (pn & 1) + wc, fq);
                } else if (pn < 18) {
                    float* o = row < MP ? out + OUT_VP + (size_t)row * 512 : out + OUT_VS + (size_t)(row - MP) * 512;
#pragma unroll
                    for (int bj = 0; bj < 2; ++bj) {
                        const int col = (pn - 16) * 256 + bj * 128 + wc * 32 + fq * 8;
                        const f32x4 v0 = acc[ai][bj][m][0] * rs, v1 = acc[ai][bj][m][1] * rs;
                        u32x4 w; w.x = cvt_pk_bf16(v0[0], v0[1]); w.y = cvt_pk_bf16(v0[2], v0[3]); w.z = cvt_pk_bf16(v1[0], v1[1]); w.w = cvt_pk_bf16(v1[2], v1[3]);
                        *(u32x4*)(FV + (size_t)row * 512 + col) = w; *(f32x4*)(o + col) = v0; *(f32x4*)(o + col + 4) = v1;
                    }
                } else {
                    if (wc == 0 && fq == 0) {
                        float* o = row < MP ? out + OUT_LP + (size_t)row * 8 : out + OUT_LS + (size_t)(row - MP) * 8;
#pragma unroll
                        for (int n = 0; n < 2; ++n) { f32x4 r;
#pragma unroll
                            for (int e = 0; e < 4; ++e) { const float x = acc[ai][0][m][n][e] * rs + bfg[n * 4 + e]; r[e] = fminf(x, 0.f) - __logf(1.f + __expf(-fabsf(x))); }
                            *(f32x4*)(o + n * 4) = r;
                            if (row < MP) { float* lt = lft + ((size_t)(row >> 11) * 8 + n * 4) * SEQ + (row & (SEQ - 1)); lt[0] = r[0]; lt[SEQ] = r[1]; lt[2 * SEQ] = r[2]; lt[3 * SEQ] = r[3]; } }
                    }
                }
            }
    }
};
struct FResid {
    static constexpr bool NEED_RS = false, WRITE_SS = true; static constexpr int BATCH = 4;
    u16* XB; float* ss; float alpha;
    struct In { u32x4 x; };
    __device__ __forceinline__ In load(int row, int col) const { In r; r.x = *(const u32x4*)(XB + (size_t)row * 1024 + col); return r; }
    __device__ __forceinline__ float finish(int row, int col, const float (&v)[8], const In& in, float) const {
        const u32x4 x = in.x;
        const float r0 = bflo(x.x) + alpha * v[0], r1 = bfhi(x.x) + alpha * v[1], r2 = bflo(x.y) + alpha * v[2], r3 = bfhi(x.y) + alpha * v[3],
                    r4 = bflo(x.z) + alpha * v[4], r5 = bfhi(x.z) + alpha * v[5], r6 = bflo(x.w) + alpha * v[6], r7 = bfhi(x.w) + alpha * v[7];
        u32x4 w; w.x = cvt_pk_bf16(r0, r1); w.y = cvt_pk_bf16(r2, r3); w.z = cvt_pk_bf16(r4, r5); w.w = cvt_pk_bf16(r6, r7); *(u32x4*)(XB + (size_t)row * 1024 + col) = w;
        return ((r0 * r0 + r1 * r1) + (r2 * r2 + r3 * r3)) + ((r4 * r4 + r5 * r5) + (r6 * r6 + r7 * r7));
    }
};
template <bool SECOND> struct FGate {
    static constexpr bool NEED_RS = false, WRITE_SS = false; static constexpr int BATCH = 4;
    u16* T; const u16* ZG; float* ss;
    struct In { u32x4 g, p; };
    __device__ __forceinline__ In load(int row, int col) const { In r; r.g = *(const u32x4*)(ZG + (size_t)row * 2048 + (SECOND ? 1024 : 0) + col); if (SECOND) r.p = *(const u32x4*)(T + (size_t)row * 1024 + col); else r.p = (u32x4){0u, 0u, 0u, 0u}; return r; }
    __device__ __forceinline__ float finish(int row, int col, const float (&a)[8], const In& in, float) const {
        const u32x4 g = in.g, p = in.p;
        float v[8] = {bflo(g.x) * a[0], bfhi(g.x) * a[1], bflo(g.y) * a[2], bfhi(g.y) * a[3], bflo(g.z) * a[4], bfhi(g.z) * a[5], bflo(g.w) * a[6], bfhi(g.w) * a[7]};
        if (SECOND) { v[0] += bflo(p.x); v[1] += bfhi(p.x); v[2] += bflo(p.y); v[3] += bfhi(p.y); v[4] += bflo(p.z); v[5] += bfhi(p.z); v[6] += bflo(p.w); v[7] += bfhi(p.w); }
        u32x4 w; w.x = cvt_pk_bf16(v[0], v[1]); w.y = cvt_pk_bf16(v[2], v[3]); w.z = cvt_pk_bf16(v[4], v[5]); w.w = cvt_pk_bf16(v[6], v[7]);
        *(u32x4*)(T + (size_t)row * 1024 + col) = w; return 0.f;
    }
};
struct FPlain {
    static constexpr bool NEED_RS = false, WRITE_SS = false; static constexpr int BATCH = 4;
    u16* O; float* ss;
    struct In { int dummy; };
    __device__ __forceinline__ In load(int, int) const { In r; r.dummy = 0; return r; }
    __device__ __forceinline__ float finish(int row, int col, const float (&a)[8], const In&, float) const {
        u32x4 w; w.x = cvt_pk_bf16(a[0], a[1]); w.y = cvt_pk_bf16(a[2], a[3]); w.z = cvt_pk_bf16(a[4], a[5]); w.w = cvt_pk_bf16(a[6], a[7]);
        *(u32x4*)(O + (size_t)row * 1024 + col) = w; return 0.f;
    }
};
struct FFinal {
    static constexpr bool NEED_RS = true, WRITE_SS = false; static constexpr int BATCH = 2;
    float* yP; float* yS; const u16* XB; const u16* PLE; float* ss;
    struct In { u32x4 x, p; };
    __device__ __forceinline__ In load(int row, int col) const { In r; r.x = *(const u32x4*)(XB + (size_t)row * 1024 + col); r.p = *(const u32x4*)(PLE + (size_t)row * 1024 + col); return r; }
    __device__ __forceinline__ float finish(int row, int col, const float (&a)[8], const In& in, float rs) const {
        float* y = (row < MP ? yP + (size_t)row * 1024 : yS + (size_t)(row - MP) * 1024) + col;
        const u32x4 x = in.x, p = in.p;
        f32x4 y0, y1;
        y0[0] = bflo(x.x) + bflo(p.x) * fast_sigmoid(a[0] * rs); y0[1] = bfhi(x.x) + bfhi(p.x) * fast_sigmoid(a[1] * rs); y0[2] = bflo(x.y) + bflo(p.y) * fast_sigmoid(a[2] * rs); y0[3] = bfhi(x.y) + bfhi(p.y) * fast_sigmoid(a[3] * rs);
        y1[0] = bflo(x.z) + bflo(p.z) * fast_sigmoid(a[4] * rs); y1[1] = bfhi(x.z) + bfhi(p.z) * fast_sigmoid(a[5] * rs); y1[2] = bflo(x.w) + bflo(p.w) * fast_sigmoid(a[6] * rs); y1[3] = bfhi(x.w) + bfhi(p.w) * fast_sigmoid(a[7] * rs);
        *(f32x4*)y = y0; *(f32x4*)(y + 4) = y1; return 0.f;
    }
};
template <class F> struct EpiWrap {
    static constexpr bool PERM = false, AFTER_DRAIN = false;
    F f;
    __device__ __forceinline__ void operator()(const f32x4 (&acc)[2][2][4][2], const pg8::Unit& u, int wr, int wc, int fr, int fq) const {
        constexpr int NB = F::BATCH; const LAS float* rst = nullptr; if (F::NEED_RS) rst = rs_table_fill(f.ss, u.pm);
#pragma unroll
        for (int ab = 0; ab < 8 / NB; ++ab) {
            const int ai = (ab * NB) / 4, m0 = (ab * NB) % 4;
            typename F::In in[NB][2];
            const int row0 = u.pm * 256 + ai * 128 + wr * 64 + fr + m0 * 16, col0 = u.pn * 256 + wc * 32 + fq * 8;
#pragma unroll
            for (int m = 0; m < NB; ++m) {
#pragma unroll
                for (int bj = 0; bj < 2; ++bj) in[m][bj] = f.load(row0 + m * 16, col0 + bj * 128);
            }
            __builtin_amdgcn_sched_barrier(0);
#pragma unroll
            for (int m = 0; m < NB; ++m) {
                const int row = row0 + m * 16; float rs = 1.f;
                if (F::NEED_RS) rs = rst[ai * 128 + wr * 64 + (m0 + m) * 16 + fr];
                float q = 0.f;
#pragma unroll
                for (int bj = 0; bj < 2; ++bj) {
                    const float v[8] = {acc[ai][bj][m0 + m][0][0], acc[ai][bj][m0 + m][0][1], acc[ai][bj][m0 + m][0][2], acc[ai][bj][m0 + m][0][3], acc[ai][bj][m0 + m][1][0], acc[ai][bj][m0 + m][1][1], acc[ai][bj][m0 + m][1][2], acc[ai][bj][m0 + m][1][3]};
                    q += f.finish(row, col0 + bj * 128, v, in[m][bj], rs);
                }
                if (F::WRITE_SS) { q += __shfl_xor(q, 16); q += __shfl_xor(q, 32); if (fq == 0) f.ss[(size_t)row * 16 + u.pn * 4 + wc] = q; }
            }
        }
    }
};
template <class F> __device__ __forceinline__ void small_gemm(LAS unsigned char* lds, const u16* A, const u16* Bt, int K, const F& f, int bx, int G) {
    int tid = threadIdx.x; asm volatile("" : "+v"(tid));
    const int lane = tid & 63, w = __builtin_amdgcn_readfirstlane(tid >> 6), g = lane >> 4, c16 = lane & 15;
    LAS float* red = (LAS float*)lds;
    const int steps = K / 256;
    for (int item = bx; item < 256; item += G) {
        const int rb = item >> 4, cb = item & 15;
        const u16* ap = A + (size_t)(16 * rb + c16) * K + (size_t)w * (K / 8) + 8 * g;
        const u16* bp = Bt + (size_t)(64 * cb + c16) * K + (size_t)w * (K / 8) + 8 * g;
        f32x4 acc[4];
#pragma unroll
        for (int nt = 0; nt < 4; ++nt) acc[nt] = (f32x4){0.f, 0.f, 0.f, 0.f};
        for (int s0 = 0; s0 < steps; s0 += 4) {
            bf16x8 a[4], b[4][4];
#pragma unroll
            for (int j = 0; j < 4; ++j) if (s0 + j < steps) { a[j] = *(const bf16x8*)(ap + 32 * (s0 + j));
#pragma unroll
                for (int nt = 0; nt < 4; ++nt) b[j][nt] = *(const bf16x8*)(bp + (size_t)16 * nt * K + 32 * (s0 + j)); }
#pragma unroll
            for (int j = 0; j < 4; ++j) if (s0 + j < steps) {
#pragma unroll
                for (int nt = 0; nt < 4; ++nt) acc[nt] = __builtin_amdgcn_mfma_f32_16x16x32_bf16(a[j], b[j][nt], acc[nt], 0, 0, 0); }
        }
        __syncthreads();
#pragma unroll
        for (int nt = 0; nt < 4; ++nt)
#pragma unroll
            for (int i = 0; i < 4; ++i) red[(w * 16 + 4 * g + i) * 64 + 16 * nt + c16] = acc[nt][i];
        __syncthreads();
        if (tid < 128) {
            const int row = tid >> 3, c8 = tid & 7, p0 = 32 * (c8 >> 2) + 4 * (c8 & 3);
            f32x4 s0 = {0.f, 0.f, 0.f, 0.f}, s1 = {0.f, 0.f, 0.f, 0.f};
#pragma unroll
            for (int ww = 0; ww < 8; ++ww) { s0 += *(const LAS f32x4*)(red + (ww * 16 + row) * 64 + p0); s1 += *(const LAS f32x4*)(red + (ww * 16 + row) * 64 + p0 + 16); }
            const float v[8] = {s0[0], s0[1], s0[2], s0[3], s1[0], s1[1], s1[2], s1[3]};
            const int grow = MP + 16 * rb + row; float rs = 1.f; if (F::NEED_RS) rs = rstd_of(f.ss, grow);
            const typename F::In in = f.load(grow, 64 * cb + 8 * c8); float q = f.finish(grow, 64 * cb + 8 * c8, v, in, rs);
            if (F::WRITE_SS) { q += __shfl_xor(q, 1); q += __shfl_xor(q, 2); q += __shfl_xor(q, 4); if (c8 == 0) f.ss[(size_t)grow * 16 + cb] = q; }
        }
    }
    __syncthreads();
}
__device__ __forceinline__ int logical_col(int kind, int pr) {
    const int t = pr >> 8, q = pr & 255, g = gcol(q);
    if (kind == 0) return t * 256 + g;
    if (kind == 1) { const int bj = q >> 7; return bj * DFF + t * 128 + (g & 127); }
    const int bj = q >> 7, wc = (q >> 5) & 3, n = (q >> 4) & 1, fq = (q >> 2) & 3, e = q & 3;
    if (t < 4) return (t >> 1) * 512 + (2 * (t & 1) + bj) * 128 + 16 * wc + 4 * fq + e + 64 * n;
    if (t < 8) return 1024 + (t - 4) * 256 + g;
    if (t < 12) return 2048 + (t - 8) * 256 + g;
    if (t < 16) return (t < 14 ? 3072 : 3584) + (4 * (t & 1) + wc) * 64 + 32 * bj + 16 * n + 4 * fq + e;
    if (t < 18) return 4096 + (t - 16) * 256 + g;
    if (t == 18) return g < 8 ? 4608 + g : -1;
    return 4616 + (t - 19) * 256 + g;
}
__device__ __forceinline__ void transpose_item(const float* W, const float* gain, int K, int Nlog, int kind, u16* WT, int nblk, LAS float* scr, int item, int lane) {
    const int kb = item / nblk, nb = item % nblk, k0 = 64 * kb, n0 = 32 * nb;
    const int lc = logical_col(kind, n0 + (lane & 31));
    float tv[32];
#pragma unroll
    for (int i = 0; i < 32; ++i) { const int kk = 2 * i + (lane >> 5); tv[i] = (lc >= 0) ? W[(size_t)(k0 + kk) * Nlog + lc] : 0.f; }
#pragma unroll
    for (int i = 0; i < 32; ++i) { const int kk = 2 * i + (lane >> 5); float v = tv[i]; if (gain) v *= gain[k0 + kk]; scr[kk * 33 + (lane & 31)] = v; }
    asm volatile("s_waitcnt lgkmcnt(0)" ::: "memory");
    const int c = lane & 7;
#pragma unroll
    for (int j = 0; j < 4; ++j) { const int n = (lane >> 3) + 8 * j; const LAS float* s = scr + (8 * c) * 33 + n;
        u32x4 o; o.x = cvt_pk_bf16(s[0 * 33], s[1 * 33]); o.y = cvt_pk_bf16(s[2 * 33], s[3 * 33]); o.z = cvt_pk_bf16(s[4 * 33], s[5 * 33]); o.w = cvt_pk_bf16(s[6 * 33], s[7 * 33]);
        *(u32x4*)(WT + (size_t)(n0 + n) * K + k0 + 8 * c) = o; }
    asm volatile("s_waitcnt lgkmcnt(0)" ::: "memory");
}

constexpr int R_QS = 0, R_KS = 17408, R_KDT = 34816, R_VT = 53248, R_AS = 90112, R_RED = 99328, R_RSTD = 101376, R_END = 101632;
template <int CH>
__device__ __forceinline__ void ret_item(LAS unsigned char* lds, const u16* RQK, u16* RV, const u16* RG, const float* s0, float* sout, size_t rowbase, int nchunks, int h) {
    constexpr int TT = CH / 16, KSN = (CH + 31) / 32;
    int tid = threadIdx.x; asm volatile("" : "+v"(tid)); const int lane = tid & 63, w = __builtin_amdgcn_readfirstlane(tid >> 6), g = lane >> 4, c16 = lane & 15;
    LAS u16* Qs = (LAS u16*)(lds + R_QS); LAS u16* Ks = (LAS u16*)(lds + R_KS); LAS u16* KdT = (LAS u16*)(lds + R_KDT); LAS u16* VT = (LAS u16*)(lds + R_VT); LAS u16* As = (LAS u16*)(lds + R_AS);
    LAS float* red = (LAS float*)(lds + R_RED); LAS float* rstdv = (LAS float*)(lds + R_RSTD);
    const float lg2 = __log2f(1.f - __builtin_amdgcn_exp2f(-5.f - (float)h));
    f32x4 S[8][2];
#pragma unroll
    for (int kt = 0; kt < 8; ++kt)
#pragma unroll
        for (int nt = 0; nt < 2; ++nt)
#pragma unroll
            for (int i = 0; i < 4; ++i) S[kt][nt][i] = s0 ? s0[(size_t)(16 * kt + 4 * g + i) * 256 + 32 * w + 16 * nt + c16] : 0.f;
    __syncthreads();
    if (CH < 32) {
        for (int i = tid; i < (R_RED - R_KDT) / 4; i += 512) ((LAS unsigned*)(lds + R_KDT))[i] = 0u;
        __syncthreads();
    }
    for (int c = 0; c < nchunks; ++c) {
        const size_t row0 = rowbase + (size_t)c * CH;
        __syncthreads();
        for (int p = tid; p < CH * 16; p += 512) {
            const int r = p >> 4, cc = p & 15;
            const u32x4 q = *(const u32x4*)(RQK + (row0 + r) * 1024 + h * 128 + cc * 8);
            const u32x4 k = *(const u32x4*)(RQK + (row0 + r) * 1024 + 512 + h * 128 + cc * 8);
            *(LAS u32x4*)(Qs + r * 136 + cc * 8) = q; *(LAS u32x4*)(Ks + r * 136 + cc * 8) = k;
            const float dec = __builtin_amdgcn_exp2f(lg2 * (float)(CH - 1 - r));
            const unsigned kw[4] = {k.x, k.y, k.z, k.w};
#pragma unroll
            for (int j = 0; j < 4; ++j) { const unsigned pk = cvt_pk_bf16(bflo(kw[j]) * dec, bfhi(kw[j]) * dec); KdT[(cc * 8 + 2 * j) * 72 + r] = (u16)(pk & 0xffffu); KdT[(cc * 8 + 2 * j + 1) * 72 + r] = (u16)(pk >> 16); }
        }
        for (int p = tid; p < CH * 32; p += 512) {
            const int r = p >> 5, cc = p & 31;
            const u32x4 v = *(const u32x4*)(RV + (row0 + r) * 1024 + h * 256 + cc * 8);
            const unsigned vw[4] = {v.x, v.y, v.z, v.w};
#pragma unroll
            for (int j = 0; j < 4; ++j) { VT[(cc * 8 + 2 * j) * 72 + r] = (u16)(vw[j] & 0xffffu); VT[(cc * 8 + 2 * j + 1) * 72 + r] = (u16)(vw[j] >> 16); }
        }
        __syncthreads();
        for (int tile = w; tile < TT * TT; tile += 8) {
            const int ti = tile / TT, tj = tile % TT; f32x4 a4 = {0.f, 0.f, 0.f, 0.f};
#pragma unroll
            for (int kk = 0; kk < 4; ++kk) {
                const bf16x8 a = *(const LAS bf16x8*)(Qs + (16 * ti + c16) * 136 + 32 * kk + 8 * g), b = *(const LAS bf16x8*)(Ks + (16 * tj + c16) * 136 + 32 * kk + 8 * g);
                a4 = __builtin_amdgcn_mfma_f32_16x16x32_bf16(a, b, a4, 0, 0, 0);
            }
#pragma unroll
            for (int i = 0; i < 4; ++i) { const int ri = 16 * ti + 4 * g + i, cj = 16 * tj + c16; const int dd = ri > cj ? ri - cj : cj - ri;
                const unsigned pk = cvt_pk_bf16(a4[i] * __builtin_amdgcn_exp2f(lg2 * (float)dd), 0.f); As[ri * 72 + cj] = (u16)(pk & 0xffffu); }
        }
        bf16x8 sb[4][2];
#pragma unroll
        for (int kk = 0; kk < 4; ++kk)
#pragma unroll
            for (int nt = 0; nt < 2; ++nt) { u32x4 t; t.x = cvt_pk_bf16(S[2 * kk][nt][0], S[2 * kk][nt][1]); t.y = cvt_pk_bf16(S[2 * kk][nt][2], S[2 * kk][nt][3]);
                t.z = cvt_pk_bf16(S[2 * kk + 1][nt][0], S[2 * kk + 1][nt][1]); t.w = cvt_pk_bf16(S[2 * kk + 1][nt][2], S[2 * kk + 1][nt][3]); sb[kk][nt] = __builtin_bit_cast(bf16x8, t); }
        f32x4 O[TT][2];
#pragma unroll
        for (int tt = 0; tt < TT; ++tt) {
            f32x4 o0 = {0.f, 0.f, 0.f, 0.f}, o1 = {0.f, 0.f, 0.f, 0.f};
#pragma unroll
            for (int kk = 0; kk < 4; ++kk) {
                const u32x2 lo = *(const LAS u32x2*)(Qs + (16 * tt + c16) * 136 + 32 * kk + 4 * g), hi = *(const LAS u32x2*)(Qs + (16 * tt + c16) * 136 + 32 * kk + 16 + 4 * g);
                u32x4 t; t.x = lo.x; t.y = lo.y; t.z = hi.x; t.w = hi.y; const bf16x8 a = __builtin_bit_cast(bf16x8, t);
                o0 = __builtin_amdgcn_mfma_f32_16x16x32_bf16(a, sb[kk][0], o0, 0, 0, 0); o1 = __builtin_amdgcn_mfma_f32_16x16x32_bf16(a, sb[kk][1], o1, 0, 0, 0);
            }
#pragma unroll
            for (int i = 0; i < 4; ++i) { const float dsc = __builtin_amdgcn_exp2f(lg2 * (float)(16 * tt + 4 * g + i + 1)); o0[i] *= dsc; o1[i] *= dsc; }
            O[tt][0] = o0; O[tt][1] = o1;
        }
        __syncthreads();
#pragma unroll
        for (int tt = 0; tt < TT; ++tt)
#pragma unroll
            for (int ks = 0; ks < KSN; ++ks) {
                const bf16x8 a = *(const LAS bf16x8*)(As + (16 * tt + c16) * 72 + 32 * ks + 8 * g);
#pragma unroll
                for (int nt = 0; nt < 2; ++nt) { const bf16x8 b = *(const LAS bf16x8*)(VT + (32 * w + 16 * nt + c16) * 72 + 32 * ks + 8 * g); O[tt][nt] = __builtin_amdgcn_mfma_f32_16x16x32_bf16(a, b, O[tt][nt], 0, 0, 0); }
            }
#pragma unroll
        for (int tt = 0; tt < TT; ++tt)
#pragma unroll
            for (int i = 0; i < 4; ++i) { float q = O[tt][0][i] * O[tt][0][i] + O[tt][1][i] * O[tt][1][i]; q += __shfl_xor(q, 1); q += __shfl_xor(q, 2); q += __shfl_xor(q, 4); q += __shfl_xor(q, 8);
                if (c16 == 0) red[w * 64 + 16 * tt + 4 * g + i] = q; }
        __syncthreads();
        if (tid < CH) { float s = 0.f;
#pragma unroll
            for (int ww = 0; ww < 8; ++ww) s += red[ww * 64 + tid];
            rstdv[tid] = rsqrtf(s * (1.f / 256.f) + 1e-6f); }
        __syncthreads();
#pragma unroll
        for (int tt = 0; tt < TT; ++tt)
#pragma unroll
            for (int i = 0; i < 4; ++i) { const int tok = 16 * tt + 4 * g + i; const float rsd = rstdv[tok];
#pragma unroll
                for (int nt = 0; nt < 2; ++nt) { const size_t off = (row0 + tok) * 1024 + h * 256 + 32 * w + 16 * nt + c16; const float gt = bf2f(RG[off]);
                    const unsigned pk = cvt_pk_bf16(O[tt][nt][i] * rsd * gt, 0.f); RV[off] = (u16)(pk & 0xffffu); } }
        const float cd = __builtin_amdgcn_exp2f(lg2 * (float)CH);
#pragma unroll
        for (int kt = 0; kt < 8; ++kt)
#pragma unroll
            for (int nt = 0; nt < 2; ++nt) S[kt][nt] = S[kt][nt] * cd;
#pragma unroll
        for (int ks = 0; ks < KSN; ++ks) {
            const bf16x8 b0 = *(const LAS bf16x8*)(VT + (32 * w + c16) * 72 + 32 * ks + 8 * g), b1 = *(const LAS bf16x8*)(VT + (32 * w + 16 + c16) * 72 + 32 * ks + 8 * g);
#pragma unroll
            for (int kt = 0; kt < 8; ++kt) { const bf16x8 a = *(const LAS bf16x8*)(KdT + (16 * kt + c16) * 72 + 32 * ks + 8 * g);
                S[kt][0] = __builtin_amdgcn_mfma_f32_16x16x32_bf16(a, b0, S[kt][0], 0, 0, 0); S[kt][1] = __builtin_amdgcn_mfma_f32_16x16x32_bf16(a, b1, S[kt][1], 0, 0, 0); }
        }
    }
#pragma unroll
    for (int kt = 0; kt < 8; ++kt)
#pragma unroll
        for (int nt = 0; nt < 2; ++nt)
#pragma unroll
            for (int i = 0; i < 4; ++i) sout[(size_t)(16 * kt + 4 * g + i) * 256 + 32 * w + 16 * nt + c16] = S[kt][nt][i];
    __syncthreads();
}
constexpr int R2_QS = 0, R2_KS = 17408, R2_KDT = 34816, R2_VT = 53248, R2_AS = 90112, R2_OS = 99328, R2_RED = 133120, R2_RSTD = 135168, R2_END = 135424;
__device__ __forceinline__ void ret_prompt_item(LAS unsigned char* lds, const u16* RQK, u16* RV, const u16* RG, float* sout, size_t rowbase, int h) {
    int tid = threadIdx.x; asm volatile("" : "+v"(tid));
    const int lane = tid & 63, w = __builtin_amdgcn_readfirstlane(tid >> 6), g = lane >> 4, c16 = lane & 15;
    LAS u16* Qs = (LAS u16*)(lds + R2_QS); LAS u16* Ks = (LAS u16*)(lds + R2_KS); LAS u16* KdT = (LAS u16*)(lds + R2_KDT); LAS u16* VT = (LAS u16*)(lds + R2_VT); LAS u16* As = (LAS u16*)(lds + R2_AS);
    LAS u16* Os = (LAS u16*)(lds + R2_OS); LAS float* red = (LAS float*)(lds + R2_RED); LAS float* rstdv = (LAS float*)(lds + R2_RSTD);
#define RBAR() asm volatile("s_waitcnt lgkmcnt(0)\n\ts_barrier" ::: "memory")
    const float lg2 = __log2f(1.f - __builtin_amdgcn_exp2f(-5.f - (float)h));
    const int rq = tid >> 4, cq = tid & 15;
    const int rv = tid >> 5, cv = tid & 31;
    const u16* gq = RQK + (rowbase + rq) * 1024 + h * 128 + cq * 8;
    const size_t voff = (rowbase + rv) * 1024 + h * 256 + cv * 8;
    u32x4 pq[2], pk[2], pv[4], pgc[4];
#define RLOAD(c) do { const size_t co_ = (size_t)(c) * 64 * 1024; \
        _Pragma("unroll") for (int i_ = 0; i_ < 2; ++i_) { pq[i_] = *(const u32x4*)(gq + co_ + (size_t)i_ * 32 * 1024); pk[i_] = *(const u32x4*)(gq + co_ + (size_t)i_ * 32 * 1024 + 512); } \
        _Pragma("unroll") for (int i_ = 0; i_ < 4; ++i_) { pv[i_] = *(const u32x4*)(RV + voff + co_ + (size_t)i_ * 16 * 1024); } } while (0)
#define GLOAD(c) do { const size_t co_ = (size_t)(c) * 64 * 1024; _Pragma("unroll") for (int i_ = 0; i_ < 4; ++i_) pgc[i_] = *(const u32x4*)(RG + voff + co_ + (size_t)i_ * 16 * 1024); } while (0)
    const int hb = c16 >> 3;
    const LAS u16* kb0 = KdT + c16 * 72 + ((g ^ hb) << 3); const LAS u16* kb2 = KdT + c16 * 72 + ((g ^ hb ^ 2) << 3);
    f32x4 S[8][2];
#pragma unroll
    for (int kt = 0; kt < 8; ++kt)
#pragma unroll
        for (int nt = 0; nt < 2; ++nt) S[kt][nt] = (f32x4){0.f, 0.f, 0.f, 0.f};
    RLOAD(0);
    asm volatile("s_waitcnt lgkmcnt(0)\n\ts_barrier" ::: "memory");
    const float cd = __builtin_amdgcn_exp2f(lg2 * 64.f);
    for (int c = 0; c < 32; ++c) {
        float lg = lg2, gf = (float)(4 * g), cf = (float)c16, rqf = (float)(63 - rq); int tw = w; asm volatile("" : "+v"(lg), "+v"(gf), "+v"(cf), "+v"(rqf), "+s"(tw));
#pragma unroll
        for (int i = 0; i < 2; ++i) {
            const int r = rq + 32 * i;
            *(LAS u32x4*)(Qs + r * 136 + cq * 8) = pq[i]; *(LAS u32x4*)(Ks + r * 136 + cq * 8) = pk[i];
            const float dec = __builtin_amdgcn_exp2f(lg * (rqf - (float)(32 * i)));
            const int pc = (((r >> 3) ^ (cq & 7)) << 3) | (r & 7);
            const unsigned kw[4] = {pk[i].x, pk[i].y, pk[i].z, pk[i].w};
#pragma unroll
            for (int j = 0; j < 4; ++j) { const unsigned pkd = cvt_pk_bf16(bflo(kw[j]) * dec, bfhi(kw[j]) * dec); KdT[(cq * 8 + 2 * j) * 72 + pc] = (u16)(pkd & 0xffffu); KdT[(cq * 8 + 2 * j + 1) * 72 + pc] = (u16)(pkd >> 16); }
        }
#pragma unroll
        for (int i = 0; i < 4; ++i) {
            const int r = rv + 16 * i; const int pc = (((r >> 3) ^ (cv & 7)) << 3) | (r & 7);
            const unsigned vw[4] = {pv[i].x, pv[i].y, pv[i].z, pv[i].w};
#pragma unroll
            for (int j = 0; j < 4; ++j) { VT[(cv * 8 + 2 * j) * 72 + pc] = (u16)(vw[j] & 0xffffu); VT[(cv * 8 + 2 * j + 1) * 72 + pc] = (u16)(vw[j] >> 16); }
        }
        __builtin_amdgcn_sched_barrier(0);
        RBAR();
#pragma unroll
        for (int t2 = 0; t2 < 2; ++t2) {
            const int tile = tw + 8 * t2, ti = tile >> 2, tj = tile & 3; f32x4 a4 = {0.f, 0.f, 0.f, 0.f}; const float dbase = (gf - cf) + (float)(16 * (ti - tj));
#pragma unroll
            for (int kk = 0; kk < 4; ++kk) {
                const bf16x8 a = *(const LAS bf16x8*)(Qs + (16 * ti + c16) * 136 + 32 * kk + 8 * g), b = *(const LAS bf16x8*)(Ks + (16 * tj + c16) * 136 + 32 * kk + 8 * g);
                a4 = __builtin_amdgcn_mfma_f32_16x16x32_bf16(a, b, a4, 0, 0, 0);
            }
#pragma unroll
            for (int i = 0; i < 4; ++i) { const int ri = 16 * ti + 4 * g + i, cj = 16 * tj + c16;
                const unsigned pkd = cvt_pk_bf16(a4[i] * __builtin_amdgcn_exp2f(lg * __builtin_fabsf(dbase + (float)i)), 0.f); As[ri * 72 + cj] = (u16)(pkd & 0xffffu); }
        }
        f32x4 O[4][2];
#pragma unroll
        for (int tt = 0; tt < 4; ++tt) { O[tt][0] = (f32x4){0.f, 0.f, 0.f, 0.f}; O[tt][1] = (f32x4){0.f, 0.f, 0.f, 0.f}; }
#pragma unroll
        for (int kk = 0; kk < 4; ++kk) {
            bf16x8 sb[2];
#pragma unroll
            for (int nt = 0; nt < 2; ++nt) { u32x4 t; t.x = cvt_pk_bf16(S[2 * kk][nt][0], S[2 * kk][nt][1]); t.y = cvt_pk_bf16(S[2 * kk][nt][2], S[2 * kk][nt][3]);
                t.z = cvt_pk_bf16(S[2 * kk + 1][nt][0], S[2 * kk + 1][nt][1]); t.w = cvt_pk_bf16(S[2 * kk + 1][nt][2], S[2 * kk + 1][nt][3]); sb[nt] = __builtin_bit_cast(bf16x8, t); }
#pragma unroll
            for (int tt = 0; tt < 4; ++tt) {
                const u32x2 lo = *(const LAS u32x2*)(Qs + (16 * tt + c16) * 136 + 32 * kk + 4 * g), hi = *(const LAS u32x2*)(Qs + (16 * tt + c16) * 136 + 32 * kk + 16 + 4 * g);
                u32x4 t; t.x = lo.x; t.y = lo.y; t.z = hi.x; t.w = hi.y; const bf16x8 a = __builtin_bit_cast(bf16x8, t);
                O[tt][0] = __builtin_amdgcn_mfma_f32_16x16x32_bf16(a, sb[0], O[tt][0], 0, 0, 0); O[tt][1] = __builtin_amdgcn_mfma_f32_16x16x32_bf16(a, sb[1], O[tt][1], 0, 0, 0);
            }
            __builtin_amdgcn_sched_barrier(0);
        }
#pragma unroll
        for (int tt = 0; tt < 4; ++tt)
#pragma unroll
            for (int i = 0; i < 4; ++i) { const float dsc = __builtin_amdgcn_exp2f(lg * (gf + (float)(16 * tt + i + 1))); O[tt][0][i] *= dsc; O[tt][1][i] *= dsc; }
        RBAR();
        if (c + 1 < 32) RLOAD(c + 1);
        const int vsw0 = (4 * w + (c16 >> 3)) & 7, vsw1 = (4 * w + 2 + (c16 >> 3)) & 7;
        bf16x8 vb[2][2];
#pragma unroll
        for (int ks = 0; ks < 2; ++ks) { vb[ks][0] = *(const LAS bf16x8*)(VT + (32 * w + c16) * 72 + (((4 * ks + g) ^ vsw0) << 3)); vb[ks][1] = *(const LAS bf16x8*)(VT + (32 * w + 16 + c16) * 72 + (((4 * ks + g) ^ vsw1) << 3)); }
#pragma unroll
        for (int tt = 0; tt < 4; ++tt)
#pragma unroll
            for (int ks = 0; ks < 2; ++ks) {
                const bf16x8 a = *(const LAS bf16x8*)(As + (16 * tt + c16) * 72 + 32 * ks + 8 * g);
                O[tt][0] = __builtin_amdgcn_mfma_f32_16x16x32_bf16(a, vb[ks][0], O[tt][0], 0, 0, 0); O[tt][1] = __builtin_amdgcn_mfma_f32_16x16x32_bf16(a, vb[ks][1], O[tt][1], 0, 0, 0); __builtin_amdgcn_sched_barrier(0);
            }
#pragma unroll
        for (int tt = 0; tt < 4; ++tt)
#pragma unroll
            for (int i = 0; i < 4; ++i) { const int tok = 16 * tt + 4 * g + i;
                float q = O[tt][0][i] * O[tt][0][i] + O[tt][1][i] * O[tt][1][i]; q += __shfl_xor(q, 1); q += __shfl_xor(q, 2); q += __shfl_xor(q, 4); q += __shfl_xor(q, 8);
                if (c16 == 0) red[tok * 8 + w] = q;
#pragma unroll
                for (int nt = 0; nt < 2; ++nt) { const unsigned pkd = cvt_pk_bf16(O[tt][nt][i], 0.f); Os[tok * 264 + 32 * w + 16 * nt + c16] = (u16)(pkd & 0xffffu); } }
        __builtin_amdgcn_sched_barrier(0);
        GLOAD(c);
#pragma unroll
        for (int kt = 0; kt < 8; ++kt) { S[kt][0] = S[kt][0] * cd; S[kt][1] = S[kt][1] * cd; }
#pragma unroll
        for (int ks = 0; ks < 2; ++ks)
#pragma unroll
            for (int kt = 0; kt < 8; ++kt) { const bf16x8 a = *(const LAS bf16x8*)(((kt & 1) ? kb2 : kb0) + 16 * kt * 72 + (((4 * ks) ^ ((kt & 2) ? 4 : 0)) << 3));
                S[kt][0] = __builtin_amdgcn_mfma_f32_16x16x32_bf16(a, vb[ks][0], S[kt][0], 0, 0, 0); S[kt][1] = __builtin_amdgcn_mfma_f32_16x16x32_bf16(a, vb[ks][1], S[kt][1], 0, 0, 0); if (kt & 1) __builtin_amdgcn_sched_barrier(0); }
        RBAR();
#pragma unroll
        for (int i = 0; i < 4; ++i) {
            const int tok = rv + 16 * i; const f32x4 p0 = *(const LAS f32x4*)(red + tok * 8), p1 = *(const LAS f32x4*)(red + tok * 8 + 4);
            const float rsd = rsqrtf((((p0[0] + p0[1]) + (p0[2] + p0[3])) + ((p1[0] + p1[1]) + (p1[2] + p1[3]))) * (1.f / 256.f) + 1e-6f);
            const u32x4 o = *(const LAS u32x4*)(Os + tok * 264 + cv * 8); const u32x4 gt = pgc[i]; u32x4 r;
            r.x = cvt_pk_bf16(bflo(o.x) * rsd * bflo(gt.x), bfhi(o.x) * rsd * bfhi(gt.x)); r.y = cvt_pk_bf16(bflo(o.y) * rsd * bflo(gt.y), bfhi(o.y) * rsd * bfhi(gt.y));
            r.z = cvt_pk_bf16(bflo(o.z) * rsd * bflo(gt.z), bfhi(o.z) * rsd * bfhi(gt.z)); r.w = cvt_pk_bf16(bflo(o.w) * rsd * bflo(gt.w), bfhi(o.w) * rsd * bfhi(gt.w));
            *(u32x4*)(RV + voff + (size_t)c * 64 * 1024 + (size_t)i * 16 * 1024) = r;
        }
    }
#pragma unroll
    for (int kt = 0; kt < 8; ++kt)
#pragma unroll
        for (int nt = 0; nt < 2; ++nt)
#pragma unroll
            for (int i = 0; i < 4; ++i) sout[(size_t)(16 * kt + 4 * g + i) * 256 + 32 * w + 16 * nt + c16] = S[kt][nt][i];
    __syncthreads();
#undef RBAR
#undef RLOAD
#undef GLOAD
}
constexpr int F2_BIAS = 0, F2_WS = 16512, F2_AW = 16640, F2_P = 17408, F2_M = 50176, F2_L = 50688, F2_ACC = 51200, F2_END = 83968;
__device__ __forceinline__ void fox_sample_item2(LAS unsigned char* lds, int b, int h, u16* FQ, const u16* FK, const u16* FV, const float* ck, const float* cv, const float* clf, const float* lfnew) {
    int tid = threadIdx.x; asm volatile("" : "+v"(tid));
    const int lane = tid & 63, w = __builtin_amdgcn_readfirstlane(tid >> 6), g = lane >> 4, c16 = lane & 15;
    LAS float* BIAS = (LAS float*)(lds + F2_BIAS); LAS float* WS = (LAS float*)(lds + F2_WS); LAS float* Aw = (LAS float*)(lds + F2_AW) + w * 16;
    LAS float* Pw = (LAS float*)(lds + F2_P) + w * 1024; LAS float* Mx = (LAS float*)(lds + F2_M); LAS float* Lx = (LAS float*)(lds + F2_L); LAS float* ACC = (LAS float*)(lds + F2_ACC);
    const size_t srow = (size_t)MP + (size_t)b * 16;
    __syncthreads();
    bf16x8 qa[2];
#pragma unroll
    for (int ks = 0; ks < 2; ++ks) qa[ks] = *(const bf16x8*)(FQ + (srow + c16) * 512 + h * 64 + 32 * ks + 8 * g);
    {
        float v[8]; float run = 0.f;
#pragma unroll
        for (int j = 0; j < 8; ++j) { run += clf[((size_t)b * PAST + 8 * tid + j) * 8 + h]; v[j] = run; }
        float tot = run;
#pragma unroll
        for (int o = 1; o < 64; o <<= 1) { const float u = __shfl_up(tot, o); if (lane >= o) tot += u; }
        if (lane == 63) WS[w] = tot;
        __syncthreads();
        float base = tot - run, all = 0.f;
#pragma unroll
        for (int ww = 0; ww < 8; ++ww) { const float x = WS[ww]; all += x; if (ww < w) base += x; }
#pragma unroll
        for (int j = 0; j < 8; ++j) BIAS[8 * tid + j] = (all - (base + v[j])) * L2E;
        if (tid == 0) { float cn = 0.f; for (int t = 0; t < 16; ++t) { cn += lfnew[((size_t)b * 16 + t) * 8 + h]; BIAS[PAST + t] = -cn * L2E; } }
    }
    __syncthreads();
    float mrun[4], lrun[4], acc[16];
#pragma unroll
    for (int i = 0; i < 4; ++i) { mrun[i] = -INFINITY; lrun[i] = 0.f; }
#pragma unroll
    for (int t = 0; t < 16; ++t) acc[t] = 0.f;
    const int niter = (w == 0) ? 9 : 8;
    for (int it = 0; it < niter; ++it) {
        const bool isnew = it == 8;
        const int key0 = isnew ? 0 : 512 * w + 64 * it;
        f32x4 s[4];
        if (!isnew) {
            f32x4 kf[4][2][2];
#pragma unroll
            for (int t = 0; t < 4; ++t) { const f32x4* kp = (const f32x4*)(ck + (((size_t)b * PAST + key0 + 16 * t + c16) * 8 + h) * 64 + 8 * g);
#pragma unroll
                for (int ks = 0; ks < 2; ++ks) { kf[t][ks][0] = kp[8 * ks]; kf[t][ks][1] = kp[8 * ks + 1]; } }
#pragma unroll
            for (int t = 0; t < 4; ++t) { f32x4 a4 = {0.f, 0.f, 0.f, 0.f};
#pragma unroll
                for (int ks = 0; ks < 2; ++ks) { u32x4 kb; kb.x = cvt_pk_bf16(kf[t][ks][0][0], kf[t][ks][0][1]); kb.y = cvt_pk_bf16(kf[t][ks][0][2], kf[t][ks][0][3]); kb.z = cvt_pk_bf16(kf[t][ks][1][0], kf[t][ks][1][1]); kb.w = cvt_pk_bf16(kf[t][ks][1][2], kf[t][ks][1][3]);
                    a4 = __builtin_amdgcn_mfma_f32_16x16x32_bf16(qa[ks], __builtin_bit_cast(bf16x8, kb), a4, 0, 0, 0); }
                const float bl = BIAS[key0 + 16 * t + c16];
                s[t] = a4 + bl; }
        } else {
            f32x4 a4 = {0.f, 0.f, 0.f, 0.f};
#pragma unroll
            for (int ks = 0; ks < 2; ++ks) { const bf16x8 kb = *(const bf16x8*)(FK + (srow + c16) * 512 + h * 64 + 32 * ks + 8 * g); a4 = __builtin_amdgcn_mfma_f32_16x16x32_bf16(qa[ks], kb, a4, 0, 0, 0); }
            const float bl = BIAS[PAST + c16];
#pragma unroll
            for (int i = 0; i < 4; ++i) s[0][i] = (c16 > 4 * g + i) ? -INFINITY : a4[i] + bl;
#pragma unroll
            for (int t = 1; t < 4; ++t) s[t] = (f32x4){-INFINITY, -INFINITY, -INFINITY, -INFINITY};
        }
#pragma unroll
        for (int i = 0; i < 4; ++i) {
            float tm = fmaxf(fmaxf(s[0][i], s[1][i]), fmaxf(s[2][i], s[3][i]));
            tm = fmaxf(tm, __shfl_xor(tm, 1)); tm = fmaxf(tm, __shfl_xor(tm, 2)); tm = fmaxf(tm, __shfl_xor(tm, 4)); tm = fmaxf(tm, __shfl_xor(tm, 8));
            const float mn = fmaxf(mrun[i], tm), al = __builtin_amdgcn_exp2f(mrun[i] - mn);
            float ps = 0.f;
#pragma unroll
            for (int t = 0; t < 4; ++t) { const float p = __builtin_amdgcn_exp2f(s[t][i] - mn); s[t][i] = p; ps += p; }
            lrun[i] = lrun[i] * al + ps; mrun[i] = mn;
            if (c16 == 0) Aw[4 * g + i] = al;
        }
#pragma unroll
        for (int t = 0; t < 4; ++t) *(LAS f32x4*)(Pw + (16 * t + c16) * 16 + 4 * g) = s[t];
        asm volatile("s_waitcnt lgkmcnt(0)" ::: "memory"); __builtin_amdgcn_wave_barrier();
#pragma unroll
        for (int j = 0; j < 4; ++j) { const f32x4 al = *(const LAS f32x4*)(Aw + 4 * j); acc[4 * j] *= al[0]; acc[4 * j + 1] *= al[1]; acc[4 * j + 2] *= al[2]; acc[4 * j + 3] *= al[3]; }
        const int nk = isnew ? 16 : 64;
#pragma unroll 4
        for (int kk = 0; kk < nk; ++kk) {
            const float v = isnew ? bf2f(FV[(srow + kk) * 512 + h * 64 + lane]) : cv[(((size_t)b * PAST + key0 + kk) * 8 + h) * 64 + lane];
#pragma unroll
            for (int j = 0; j < 4; ++j) { const f32x4 p = *(const LAS f32x4*)(Pw + kk * 16 + 4 * j); acc[4 * j] += p[0] * v; acc[4 * j + 1] += p[1] * v; acc[4 * j + 2] += p[2] * v; acc[4 * j + 3] += p[3] * v; }
        }
        asm volatile("s_waitcnt lgkmcnt(0)" ::: "memory"); __builtin_amdgcn_wave_barrier();
    }
#pragma unroll
    for (int i = 0; i < 4; ++i) { float l = lrun[i]; l += __shfl_xor(l, 1); l += __shfl_xor(l, 2); l += __shfl_xor(l, 4); l += __shfl_xor(l, 8); if (c16 == 0) { Mx[w * 16 + 4 * g + i] = mrun[i]; Lx[w * 16 + 4 * g + i] = l; } }
#pragma unroll
    for (int t = 0; t < 16; ++t) ACC[(w * 16 + t) * 64 + lane] = acc[t];
    __syncthreads();
    for (int e = tid; e < 1024; e += 512) {
        const int t = e >> 6, d = e & 63; float mm = -INFINITY;
#pragma unroll
        for (int ww = 0; ww < 8; ++ww) mm = fmaxf(mm, Mx[ww * 16 + t]);
        float num = 0.f, den = 0.f;
#pragma unroll
        for (int ww = 0; ww < 8; ++ww) { const float f = __builtin_amdgcn_exp2f(Mx[ww * 16 + t] - mm); num += ACC[(ww * 16 + t) * 64 + d] * f; den += Lx[ww * 16 + t] * f; }
        const unsigned pk = cvt_pk_bf16(num / den, 0.f); FQ[(srow + t) * 512 + h * 64 + d] = (u16)(pk & 0xffffu);
    }
    __syncthreads();
}
constexpr int F_Q = 0, F_BIAS = 4096, F_WS = 20736, F_P = 24576, F_M = 57344, F_L = 57856, F_ACC = 58368, F_END = 91136;
__device__ __forceinline__ void fox_sample_item(LAS unsigned char* lds, int b, int h, u16* FQ, const u16* FK, const u16* FV, const float* ck, const float* cv, const float* clf, const float* lfnew) {
    int tid = threadIdx.x; asm volatile("" : "+v"(tid)); const int lane = tid & 63, w = __builtin_amdgcn_readfirstlane(tid >> 6);
    LAS float* QF = (LAS float*)(lds + F_Q); LAS float* BIAS = (LAS float*)(lds + F_BIAS); LAS float* WS = (LAS float*)(lds + F_WS);
    LAS float* Pw = (LAS float*)(lds + F_P) + w * 1024; LAS float* Mx = (LAS float*)(lds + F_M); LAS float* Lx = (LAS float*)(lds + F_L); LAS float* ACC = (LAS float*)(lds + F_ACC);
    const size_t srow = (size_t)MP + (size_t)b * 16;
    __syncthreads();
    for (int e = tid; e < 1024; e += 512) QF[e] = bf2f(FQ[(srow + (e >> 6)) * 512 + h * 64 + (e & 63)]);
    {
        float v[8]; float run = 0.f;
#pragma unroll
        for (int j = 0; j < 8; ++j) { run += clf[((size_t)b * PAST + 8 * tid + j) * 8 + h]; v[j] = run; }
        float tot = run;
#pragma unroll
        for (int o = 1; o < 64; o <<= 1) { const float u = __shfl_up(tot, o); if (lane >= o) tot += u; }
        if (lane == 63) WS[w] = tot;
        __syncthreads();
        float base = tot - run, all = 0.f;
#pragma unroll
        for (int ww = 0; ww < 8; ++ww) { const float x = WS[ww]; all += x; if (ww < w) base += x; }
#pragma unroll
        for (int j = 0; j < 8; ++j) BIAS[8 * tid + j] = (all - (base + v[j])) * L2E;
        if (tid == 0) { float cn = 0.f; for (int t = 0; t < 16; ++t) { cn += lfnew[((size_t)b * 16 + t) * 8 + h]; BIAS[PAST + t] = -cn * L2E; } }
    }
    __syncthreads();
    float mrun[16], lrun[16], acc[16];
#pragma unroll
    for (int t = 0; t < 16; ++t) { mrun[t] = -INFINITY; lrun[t] = 0.f; acc[t] = 0.f; }
    const int ntile = (w == 0) ? 9 : 8;
    for (int tile = 0; tile < ntile; ++tile) {
        const bool isnew = tile == 8;
        const int key0 = isnew ? 0 : 512 * w + 64 * tile;
        float s[16];
        {
            f32x4 k[16];
            if (!isnew) { const f32x4* kp = (const f32x4*)(ck + (((size_t)b * PAST + key0 + lane) * 8 + h) * 64);
#pragma unroll
                for (int i = 0; i < 16; ++i) k[i] = kp[i];
            } else { const u32x4* kp = (const u32x4*)(FK + (srow + (lane & 15)) * 512 + h * 64);
#pragma unroll
                for (int i = 0; i < 8; ++i) { const u32x4 x = kp[i]; k[2 * i] = (f32x4){bflo(x.x), bfhi(x.x), bflo(x.y), bfhi(x.y)}; k[2 * i + 1] = (f32x4){bflo(x.z), bfhi(x.z), bflo(x.w), bfhi(x.w)}; } }
            const float bias = isnew ? BIAS[PAST + (lane & 15)] : BIAS[key0 + lane];
#pragma unroll
            for (int t = 0; t < 16; ++t) { float a = 0.f;
#pragma unroll
                for (int i = 0; i < 16; ++i) { const f32x4 q = *(const LAS f32x4*)(QF + t * 64 + 4 * i); a += (q[0] * k[i][0] + q[1] * k[i][1]) + (q[2] * k[i][2] + q[3] * k[i][3]); }
                a += bias; if (isnew && (lane > t || lane >= 16)) a = -INFINITY; s[t] = a; }
        }
#pragma unroll
        for (int t = 0; t < 16; ++t) {
            const float tm = wave_max(s[t]), mn = fmaxf(mrun[t], tm), al = __builtin_amdgcn_exp2f(mrun[t] - mn), p = __builtin_amdgcn_exp2f(s[t] - mn);
            Pw[lane * 16 + t] = p; acc[t] *= al; lrun[t] = lrun[t] * al + wave_sum(p); mrun[t] = mn;
        }
        asm volatile("s_waitcnt lgkmcnt(0)" ::: "memory"); __builtin_amdgcn_wave_barrier();
        const int nk = isnew ? 16 : 64;
        for (int kk = 0; kk < nk; ++kk) {
            const float v = isnew ? bf2f(FV[(srow + kk) * 512 + h * 64 + lane]) : cv[(((size_t)b * PAST + key0 + kk) * 8 + h) * 64 + lane];
#pragma unroll
            for (int i = 0; i < 4; ++i) { const f32x4 p = *(const LAS f32x4*)(Pw + kk * 16 + 4 * i); acc[4 * i] += p[0] * v; acc[4 * i + 1] += p[1] * v; acc[4 * i + 2] += p[2] * v; acc[4 * i + 3] += p[3] * v; }
        }
        asm volatile("s_waitcnt lgkmcnt(0)" ::: "memory"); __builtin_amdgcn_wave_barrier();
    }
#pragma unroll
    for (int t = 0; t < 16; ++t) { ACC[(w * 16 + t) * 64 + lane] = acc[t]; if (lane == 0) { Mx[w * 16 + t] = mrun[t]; Lx[w * 16 + t] = lrun[t]; } }
    __syncthreads();
    for (int e = tid; e < 1024; e += 512) {
        const int t = e >> 6, d = e & 63; float mm = -INFINITY;
#pragma unroll
        for (int ww = 0; ww < 8; ++ww) mm = fmaxf(mm, Mx[ww * 16 + t]);
        float num = 0.f, den = 0.f;
#pragma unroll
        for (int ww = 0; ww < 8; ++ww) { const float f = __builtin_amdgcn_exp2f(Mx[ww * 16 + t] - mm); num += ACC[(ww * 16 + t) * 64 + d] * f; den += Lx[ww * 16 + t] * f; }
        const unsigned pk = cvt_pk_bf16(num / den, 0.f); FQ[(srow + t) * 512 + h * 64 + d] = (u16)(pk & 0xffffu);
    }
    __syncthreads();
}

struct Args { const float* in[25]; float* out; unsigned char* ws; };
constexpr int P4_RET = 128, P4_FS = 128, P4_FP = 2048, P4_RS = 64, P4_ITEMS = P4_RET + P4_FS + P4_FP + P4_RS;

__device__ __forceinline__ unsigned char* kern_ptr(int k) {
    const __attribute__((address_space(4))) char* p = (const __attribute__((address_space(4))) char*)__builtin_amdgcn_kernarg_segment_ptr();
    asm volatile("" : "+s"(p));
    return *(unsigned char* const __attribute__((address_space(4)))*)(p + 8 * k);
}
__global__ void __launch_bounds__(512, 2) fwd(Args a) {
    extern __shared__ __attribute__((aligned(16))) unsigned char lds_raw[];
    LAS unsigned char* lds = (LAS unsigned char*)lds_raw;
    cg::grid_group grid = cg::this_grid();
    const int tid = threadIdx.x, lane = tid & 63, wave = __builtin_amdgcn_readfirstlane(tid >> 6);
    const int G = gridDim.x, bx = blockIdx.x;
#define WSB() kern_ptr(26)
#define OUTB() ((float*)kern_ptr(25))
#define INP(k) ((const float*)kern_ptr(k))
#define P16(off) ((u16*)(WSB() + (off)))
#define PF32(off) ((float*)(WSB() + (off)))
    unsigned* ctl = (unsigned*)(WSB() + O_CTL);
    LAS unsigned* misc = (LAS unsigned*)(lds + LDS_BYTES - 128);
    if (tid < 32) misc[tid] = 0u;
    __syncthreads();
    const xb::XcdBarrier bar = xb::xcd_barrier_post(ctl + 4096, (volatile XLAS unsigned*)(misc + 8));
#ifdef PROBE_PH
    unsigned long long pr_t0 = __builtin_amdgcn_s_memrealtime(), pr_acc = 0; int pr_n = 0;
#define GSYNC() do { xb::xcd_barrier(bar); if (pr_n == PROBE_PH) pr_acc = __builtin_amdgcn_s_memrealtime() - pr_t0; ++pr_n; pr_t0 = __builtin_amdgcn_s_memrealtime(); } while (0)
#else
#define GSYNC() xb::xcd_barrier(bar)
#endif

#ifndef PHM
#define PHM 0xffff
#endif
#define PH(k) if constexpr (((PHM)>>(k))&1)
    PH(0) {
        LAS float* scr = (LAS float*)(lds + wave * 16384);
        const int gw = bx * 8 + wave, NGW = G * 8;
        constexpr int I0 = 16 * 176, I1 = 44 * 32, I2 = 16 * 216, I3 = 16 * 32, I4 = 8 * 32, I5 = 16 * 32, I8 = 4 * 32;
        constexpr int NIT = I0 + I1 + I2 + I3 + I4 + I5 + I0 + I1 + I8 + I3;
        for (int it = gw; it < NIT; it += NGW) {
            int r = it;
            if (r < I0) { transpose_item(INP(9), INP(8), 1024, 5632, 1, P16(O_W1IN), 176, scr, r, lane); continue; } r -= I0;
            if (r < I1) { transpose_item(INP(10), nullptr, 2816, 1024, 0, P16(O_W1OUT), 32, scr, r, lane); continue; } r -= I1;
            if (r < I2) { transpose_item(INP(12), INP(11), 1024, 6664, 2, P16(O_WMIX), 216, scr, r, lane); continue; } r -= I2;
            if (r < I3) { transpose_item(INP(16), nullptr, 1024, 1024, 0, P16(O_WBR), 32, scr, r, lane); continue; } r -= I3;
            if (r < I4) { transpose_item(INP(17), nullptr, 512, 1024, 0, P16(O_WBF), 32, scr, r, lane); continue; } r -= I4;
            if (r < I5) { transpose_item(INP(18), nullptr, 1024, 1024, 0, P16(O_WOUT), 32, scr, r, lane); continue; } r -= I5;
            if (r < I0) { transpose_item(INP(20), INP(19), 1024, 5632, 1, P16(O_W2IN), 176, scr, r, lane); continue; } r -= I0;
            if (r < I1) { transpose_item(INP(21), nullptr, 2816, 1024, 0, P16(O_W2OUT), 32, scr, r, lane); continue; } r -= I1;
            if (r < I8) { transpose_item(INP(23), nullptr, 256, 1024, 0, P16(O_WPLE), 32, scr, r, lane); continue; } r -= I8;
            transpose_item(INP(24), INP(22), 1024, 1024, 0, P16(O_WPG), 32, scr, r, lane);
        }
        for (int rb = gw * 4; rb < MT; rb += NGW * 4) {
            f32x4 v[4][4]; float s[4];
#pragma unroll
            for (int r = 0; r < 4; ++r) { const int row = rb + r; const f32x4* xr = (const f32x4*)(row < MP ? INP(0) + (size_t)row * 1024 : INP(1) + (size_t)(row - MP) * 1024) + lane;
#pragma unroll
                for (int j = 0; j < 4; ++j) v[r][j] = xr[64 * j]; }
#pragma unroll
            for (int r = 0; r < 4; ++r) { float q = 0.f;
#pragma unroll
                for (int j = 0; j < 4; ++j) q += (v[r][j][0] * v[r][j][0] + v[r][j][1] * v[r][j][1]) + (v[r][j][2] * v[r][j][2] + v[r][j][3] * v[r][j][3]);
                s[r] = wave_sum(q);
                u32x2* o = (u32x2*)(P16(O_XB) + (size_t)(rb + r) * 1024) + lane;
#pragma unroll
                for (int j = 0; j < 4; ++j) { u32x2 w; w.x = cvt_pk_bf16(v[r][j][0], v[r][j][1]); w.y = cvt_pk_bf16(v[r][j][2], v[r][j][3]); o[64 * j] = w; } }
            { const int r = lane >> 4, c = lane & 15; const float sv = r == 0 ? s[0] : (r == 1 ? s[1] : (r == 2 ? s[2] : s[3])); PF32(O_SS)[(size_t)(rb + r) * 16 + c] = c == 0 ? sv : 0.f; }
        }
        for (int i = bx * 512 + tid; i < NPOS * 64; i += G * 512) {
            const int pi = i >> 6, f = i & 63; const float pos = pi < SEQ ? (float)pi : (float)(PAST + pi - SEQ);
            const float freq = __builtin_amdgcn_exp2f(-(float)f * (13.287712379549449f / 64.f)); const float ang = pos * freq;
            double rev = (double)ang * 0.15915494309189535; rev -= floor(rev); const float rf = (float)rev;
            PF32(O_TABC)[i] = __builtin_amdgcn_cosf(rf); PF32(O_TABS)[i] = __builtin_amdgcn_sinf(rf);
        }
    }
    grid.sync(); GSYNC();
    PH(1) { pg8::Gemm g{P16(O_XB), P16(O_W1IN), MT, 5632, 1024}; pg8::StaticOrder S; S.init(MT, 5632, G, bx); EpiSwiglu E{P16(O_ACT1), PF32(O_SS)};
      pg8::gemm_phase<EpiSwiglu, pg8::StaticOrder, true, true>(lds, g, S, E); }
    GSYNC();
    PH(2) { const FResid f{P16(O_XB), PF32(O_SS), 0.5f};
      small_gemm<FResid>(lds, P16(O_ACT1) + (size_t)MP * DFF, P16(O_W1OUT), DFF, f, bx, G);
      pg8::Gemm g{P16(O_ACT1), P16(O_W1OUT), MP, 1024, DFF}; pg8::StaticOrder S; S.init(MP, 1024, G, bx); const EpiWrap<FResid> E{f};
      pg8::gemm_phase<EpiWrap<FResid>, pg8::StaticOrder, true, true>(lds, g, S, E); }
    GSYNC();
    PH(3) { pg8::Gemm g{P16(O_XB), P16(O_WMIX), MT, NMIX, 1024}; pg8::StaticOrder S; S.init(MT, NMIX, G, bx);
      EpiMix E{PF32(O_SS), PF32(O_TABC), PF32(O_TABS), INP(14), INP(15), INP(13), P16(O_RQK), P16(O_RV), P16(O_RG), P16(O_FQ), P16(O_FK), P16(O_FV), P16(O_ZG), OUTB(), OUTB() + OUT_YP};
      pg8::gemm_phase<EpiMix, pg8::StaticOrder, true, true>(lds, g, S, E); }
    GSYNC();
    {
        LAS unsigned* slot = misc;
        float dbound;
        { float gq_ = __builtin_fabsf(INP(14)[lane]), gk_ = __builtin_fabsf(INP(15)[lane]);
#pragma unroll
          for (int o_ = 1; o_ < 64; o_ <<= 1) { gq_ = fmaxf(gq_, __shfl_xor(gq_, o_)); gk_ = fmaxf(gk_, __shfl_xor(gk_, o_)); }
          dbound = gq_ * gk_ * (64.f * 0.125f * L2E * 1.02f) + 1.f; if (tid == 0) misc[2] = __float_as_uint(dbound); }
        for (;;) {
            __syncthreads();
            if (tid == 0) slot[0] = atomicAdd(ctl, 1u);
            __syncthreads();
            const int it = (int)slot[0];
            if (it >= P4_ITEMS) break;
#ifdef PROBE_ITEM
            const unsigned long long pi_t0 = __builtin_amdgcn_s_memrealtime();
#endif
            if (it < P4_RET) { const int b = it >> 2, h = it & 3;
                PH(10) ret_prompt_item(lds, P16(O_RQK), P16(O_RV), P16(O_RG), OUTB() + OUT_RSP + (size_t)(b * 4 + h) * 32768, (size_t)b * SEQ, h);
            } else if (it < P4_RET + P4_FS) { const int j = it - P4_RET, b = j >> 3, h = j & 7;
                PH(11) fox_sample_item2(lds, b, h, P16(O_FQ), P16(O_FK), P16(O_FV), INP(5), INP(6), INP(7), OUTB() + OUT_LS);
            } else if (it < P4_RET + P4_FS + P4_FP) { const int j = it - P4_RET - P4_FS, qb = 7 - (j >> 8), bh = j & 255;
                PH(12) attn_body::attn_unit<8>(bh >> 3, bh & 7, qb, (const attn_body::bf16*)P16(O_FQ), (const attn_body::bf16*)P16(O_FK), (const attn_body::bf16*)P16(O_FV), (attn_body::bf16*)P16(O_FQ), OUTB() + OUT_YP, __uint_as_float(misc[2]), (char*)lds_raw);
            } else { const int j = it - P4_RET - P4_FS - P4_FP, b = j >> 2, h = j & 3;
                PH(13) ret_item<16>(lds, P16(O_RQK), P16(O_RV), P16(O_RG), INP(4) + (size_t)(b * 4 + h) * 32768, OUTB() + OUT_RSS + (size_t)(b * 4 + h) * 32768, (size_t)MP + (size_t)b * 16, 1, h);
            }
#ifdef PROBE_ITEM
            { const int kind = it < P4_RET ? 0 : (it < P4_RET + P4_FS ? 1 : (it < P4_RET + P4_FS + P4_FP ? 2 : 3));
              if (kind == PROBE_ITEM && tid == 0) atomicMax(ctl + 16, (unsigned)(__builtin_amdgcn_s_memrealtime() - pi_t0)); }
#endif
        }
    }
    GSYNC();
    {
        for (size_t i = (size_t)bx * 512 + tid; i < (size_t)MT * 32; i += (size_t)G * 512) {
            const size_t e8 = i * 8; const float* src = e8 < (size_t)MP * 256 ? INP(2) + e8 : INP(3) + (e8 - (size_t)MP * 256);
            const f32x4 v0 = *(const f32x4*)src, v1 = *(const f32x4*)(src + 4);
            u32x4 w; w.x = cvt_pk_bf16(v0[0], v0[1]); w.y = cvt_pk_bf16(v0[2], v0[3]); w.z = cvt_pk_bf16(v1[0], v1[1]); w.w = cvt_pk_bf16(v1[2], v1[3]);
            *(u32x4*)(P16(O_FV) + e8) = w;
        }
        PH(5) { const FGate<false> f0{P16(O_RG), P16(O_ZG), nullptr}; const FGate<true> f1{P16(O_RG), P16(O_ZG), nullptr};
          small_gemm<FGate<false>>(lds, P16(O_RV) + (size_t)MP * 1024, P16(O_WBR), 1024, f0, bx, G);
          small_gemm<FGate<true>>(lds, P16(O_FQ) + (size_t)MP * 512, P16(O_WBF), 512, f1, bx, G);
          { pg8::Gemm g{P16(O_RV), P16(O_WBR), MP, 1024, 1024}; pg8::StaticOrder S; S.init(MP, 1024, G, bx); const EpiWrap<FGate<false>> E{f0};
            pg8::gemm_phase<EpiWrap<FGate<false>>, pg8::StaticOrder, true, true>(lds, g, S, E); }
          { pg8::Gemm g{P16(O_FQ), P16(O_WBF), MP, 1024, 512}; pg8::StaticOrder S; S.init(MP, 1024, G, bx); const EpiWrap<FGate<true>> E{f1};
            pg8::gemm_phase<EpiWrap<FGate<true>>, pg8::StaticOrder, true, true>(lds, g, S, E); } }
    }
    GSYNC();
    PH(6) { const FResid f{P16(O_XB), PF32(O_SS), 1.0f};
      small_gemm<FResid>(lds, P16(O_RG) + (size_t)MP * 1024, P16(O_WOUT), 1024, f, bx, G);
      pg8::Gemm g{P16(O_RG), P16(O_WOUT), MP, 1024, 1024}; pg8::StaticOrder S; S.init(MP, 1024, G, bx); const EpiWrap<FResid> E{f};
      pg8::gemm_phase<EpiWrap<FResid>, pg8::StaticOrder, true, true>(lds, g, S, E); }
    GSYNC();
    PH(7) { pg8::Gemm g{P16(O_XB), P16(O_W2IN), MT, 5632, 1024}; pg8::StaticOrder S; S.init(MT, 5632, G, bx); EpiSwiglu E{P16(O_ACT2), PF32(O_SS)};
      pg8::gemm_phase<EpiSwiglu, pg8::StaticOrder, true, true>(lds, g, S, E); }
    GSYNC();
    PH(8) { const FResid f{P16(O_XB), PF32(O_SS), 0.5f}; const FPlain fp{P16(O_RQK), nullptr};
      small_gemm<FResid>(lds, P16(O_ACT2) + (size_t)MP * DFF, P16(O_W2OUT), DFF, f, bx, G);
      small_gemm<FPlain>(lds, P16(O_FV) + (size_t)MP * 256, P16(O_WPLE), 256, fp, bx, G);
      { pg8::Gemm g{P16(O_ACT2), P16(O_W2OUT), MP, 1024, DFF}; pg8::StaticOrder S; S.init(MP, 1024, G, bx); const EpiWrap<FResid> E{f};
        pg8::gemm_phase<EpiWrap<FResid>, pg8::StaticOrder, true, true>(lds, g, S, E); }
      { pg8::Gemm g{P16(O_FV), P16(O_WPLE), MP, 1024, 256}; pg8::StaticOrder S; S.init(MP, 1024, G, bx); const EpiWrap<FPlain> E{fp};
        pg8::gemm_phase<EpiWrap<FPlain>, pg8::StaticOrder, true, true>(lds, g, S, E); } }
    GSYNC();
    PH(9) { const FFinal f{OUTB() + OUT_YP, OUTB() + OUT_YS, P16(O_XB), P16(O_RQK), PF32(O_SS)};
      small_gemm<FFinal>(lds, P16(O_XB) + (size_t)MP * 1024, P16(O_WPG), 1024, f, bx, G);
      pg8::Gemm g{P16(O_XB), P16(O_WPG), MP, 1024, 1024}; pg8::StaticOrder S; S.init(MP, 1024, G, bx); const EpiWrap<FFinal> E{f};
      pg8::gemm_phase<EpiWrap<FFinal>, pg8::StaticOrder, true, true>(lds, g, S, E); }
#ifdef PROBE_ITEM
    GSYNC();
    if (bx == 0) { const unsigned long long t1 = __builtin_amdgcn_s_memrealtime(); const unsigned long long dur = __hip_atomic_load(ctl + 16, __ATOMIC_RELAXED, __HIP_MEMORY_SCOPE_AGENT); while (__builtin_amdgcn_s_memrealtime() - t1 < dur) __builtin_amdgcn_s_sleep(8); }
#endif
#ifdef PROBE_PH
    if (pr_n == PROBE_PH) pr_acc = __builtin_amdgcn_s_memrealtime() - pr_t0;
    if (bx == 0) { const unsigned long long t1 = __builtin_amdgcn_s_memrealtime(); while (__builtin_amdgcn_s_memrealtime() - t1 < pr_acc) __builtin_amdgcn_s_sleep(8); }
#endif
}
}

extern "C" void kernel_launch(void* const* d_in, const int* in_sizes, int n_in, void* d_out, int out_size, void* d_ws, size_t ws_size, hipStream_t stream) {
    static int grid = 0;
    if (grid == 0) {
        if (n_in != 25 || (size_t)out_size != mk::OUT_END || ws_size < mk::WS_NEED) { fprintf(stderr, "kernel_launch: unexpected shapes (n_in %d out %d ws %zu need %zu)\n", n_in, out_size, ws_size, (size_t)mk::WS_NEED); grid = -1; return; }
        int dev = 0, cus = 0, per_cu = 0;
        hipGetDevice(&dev); hipDeviceGetAttribute(&cus, hipDeviceAttributeMultiprocessorCount, dev);
        if (hipFuncSetAttribute((const void*)mk::fwd, hipFuncAttributeMaxDynamicSharedMemorySize, mk::LDS_BYTES) != hipSuccess) { fprintf(stderr, "kernel_launch: hipFuncSetAttribute failed\n"); grid = -1; return; }
        hipOccupancyMaxActiveBlocksPerMultiprocessor(&per_cu, (const void*)mk::fwd, 512, mk::LDS_BYTES);
        if (per_cu < 1) { fprintf(stderr, "kernel_launch: occupancy query says %d blocks per CU\n", per_cu); per_cu = 1; }
        grid = cus;
    }
    if (grid < 0) return;
    if (hipMemsetAsync((char*)d_ws + mk::O_CTL, 0, 65536, stream) != hipSuccess) { fprintf(stderr, "kernel_launch: memset failed\n"); return; }
    mk::Args a{};
    for (int i = 0; i < 25; ++i) a.in[i] = (const float*)d_in[i];
    a.out = (float*)d_out; a.ws = (unsigned char*)d_ws;
    void* args[] = {&a};
    hipError_t e = hipLaunchCooperativeKernel((const void*)mk::fwd, dim3(grid), dim3(512), args, mk::LDS_BYTES, stream);
    if (e != hipSuccess) fprintf(stderr, "cooperative launch failed: %s (grid %d)\n", hipGetErrorString(e), grid);
}
```

```cpp
#include <hip/hip_runtime.h>
#include <hip/hip_cooperative_groups.h>
#include <cstdio>
#include <cstdint>
#include <hip/hip_bf16.h>
#include <cmath>
namespace cg = cooperative_groups;
namespace pg8 {
#define PG8_LAS __attribute__((address_space(3)))
typedef unsigned short bf16_t;
typedef short bf16x8 __attribute__((ext_vector_type(8)));
typedef float f32x4 __attribute__((ext_vector_type(4)));
typedef unsigned u32x4 __attribute__((ext_vector_type(4)));
constexpr int BM = 256, BK = 64, HALF = 128, HTB = HALF * BK * 2  , STAGE_BYTES = 8 * HTB, NXCD = 8, WGM = 8;

__host__ __device__ __forceinline__ int lds_byte(int r, int c) { const int st = (r >> 4) * 2 + (c >> 5), rr = r & 15, cc = c & 31, ob = rr * 64 + cc * 2; return st * 1024 + (ob ^ (((ob >> 9) & 1) << 5)); }
__host__ __device__ __forceinline__ void stage_rc(int b, int& R, int& C) { const int st = b / 1024, sb = b % 1024, swz = sb ^ (((sb >> 9) & 1) << 5); R = (st >> 1) * 16 + swz / 64; C = (st & 1) * 32 + (swz % 64) / 2; }
__host__ __device__ __forceinline__ int perm32(int rho) { const int n = rho >> 4, i = rho & 15; return 8 * (i >> 2) + 4 * n + (i & 3); }

struct Unit { int pm, pn; };
struct Gemm { const bf16_t* A; const bf16_t* Bt; int M, N, K; };

struct StaticOrder {
    int nM, nN, nwg, G, c;
    __host__ __device__ void init(int M, int N, int G_, int c_) { nM = M / BM; nN = N / BM; nwg = nM * nN; G = G_; c = c_; }
    __host__ __device__ bool next(int i, Unit& u) const {
        const long L = (long)i * G + c; if (L >= nwg) return false;
        int wgid = (int)L; { const int q = nwg / NXCD, r = nwg % NXCD, xcd = wgid % NXCD, off = wgid / NXCD; wgid = (xcd < r ? xcd * (q + 1) : r * (q + 1) + (xcd - r) * q) + off; }
        const int nig = WGM * nN, gid = wgid / nig, fm = gid * WGM, gsz = (nM - fm) < WGM ? (nM - fm) : WGM;
        u.pm = fm + ((wgid % nig) % gsz); u.pn = (wgid % nig) / gsz; return true;
    }
    __device__ __forceinline__ void a_ready(const Unit&) const {}
    __device__ __forceinline__ void done(const Unit&) const {}
};

typedef float f32x2c __attribute__((ext_vector_type(2))); typedef __bf16 bf16x2c __attribute__((ext_vector_type(2)));
__device__ __forceinline__ unsigned cvt_pk_bf16(float lo, float hi) { f32x2c v = {lo, hi}; bf16x2c b = __builtin_convertvector(v, bf16x2c); return __builtin_bit_cast(unsigned, b); }
typedef float f32x2 __attribute__((ext_vector_type(2)));
template <class Epi, class Sched, bool ALIGN_EPI = false, bool SP2 = false>
__device__ __forceinline__ void gemm_phase(PG8_LAS unsigned char* lds, const Gemm g, const Sched& S, const Epi& E) {
    int tid = threadIdx.x; asm volatile("" : "+v"(tid)); const int wid = __builtin_amdgcn_readfirstlane(tid >> 6), lane = tid & 63, wr = wid >> 2, wc = wid & 3, fr = lane & 15, fq = lane >> 4;
    const int K = g.K, nt = K / BK;
    unsigned voffA[2], voffB[2];
#pragma unroll
    for (int i = 0; i < 2; ++i) { int R, C; stage_rc(tid * 16 + i * 8192, R, C); const int Rb = Epi::PERM ? ((R & ~31) + perm32(R & 31)) : R;
        voffA[i] = (unsigned)(R * K + C) * 2u; voffB[i] = (unsigned)(Rb * K + C) * 2u; }
    const size_t kstep = (size_t)(BK * 2);
    const size_t hstep = (size_t)HALF * K * 2;
    const size_t tstep = 2 * hstep;
    const unsigned ldsw = (unsigned)wid * 1024u;
    const int aoff = lds_byte(wr * 64 + fr, fq * 8), boff = lds_byte(wc * 32 + fr, fq * 8);
#define PG8_SA(b, h) (((b) * 2 + (h)) * HTB)
#define PG8_SB(b, h) ((4 + (b) * 2 + (h)) * HTB)
#define PG8_STAGE(bufoff, gbase, voff) do { _Pragma("unroll") for (int _i = 0; _i < 2; ++_i) \
        __builtin_amdgcn_global_load_lds((const unsigned*)((const char*)(gbase) + (voff)[_i]), (PG8_LAS unsigned*)(lds + (bufoff) + ldsw + _i * 8192), 16, 0, 0); } while (0)
#define PG8_LDA(dst, b, h) do { _Pragma("unroll") for (int m = 0; m < 4; ++m) _Pragma("unroll") for (int k = 0; k < 2; ++k) dst[m][k] = *(const PG8_LAS bf16x8*)(lds + PG8_SA(b, h) + aoff + m * 2048 + k * 1024); } while (0)
#define PG8_LDB(dst, b, h) do { _Pragma("unroll") for (int n = 0; n < 2; ++n) _Pragma("unroll") for (int k = 0; k < 2; ++k) dst[n][k] = *(const PG8_LAS bf16x8*)(lds + PG8_SB(b, h) + boff + n * 2048 + k * 1024); } while (0)
#define PG8_MMA(ai, bj, At, Bt) do { __builtin_amdgcn_s_setprio(1); _Pragma("unroll") for (int m = 0; m < 4; ++m) _Pragma("unroll") for (int n = 0; n < 2; ++n) _Pragma("unroll") for (int k = 0; k < 2; ++k) \
        acc[ai][bj][m][n] = __builtin_amdgcn_mfma_f32_16x16x32_bf16(Bt[n][k], At[m][k], acc[ai][bj][m][n], 0, 0, 0); __builtin_amdgcn_s_setprio(0); } while (0)
#define PG8_WAIT_V(n) asm volatile("s_waitcnt vmcnt(" #n ")" ::: "memory")
#define PG8_WAIT_L(n) asm volatile("s_waitcnt lgkmcnt(" #n ")" ::: "memory")
#define PG8_BAR __builtin_amdgcn_s_barrier()
#define PG8_SCHED __builtin_amdgcn_sched_barrier(0)
    Unit cur, nxt; int ui = 0;
    if (!S.next(0, cur)) return;
    f32x4 acc[2][2][4][2];
#pragma unroll
    for (int a = 0; a < 2; ++a)
#pragma unroll
        for (int b = 0; b < 2; ++b)
#pragma unroll
            for (int m = 0; m < 4; ++m)
#pragma unroll
                for (int n = 0; n < 2; ++n) acc[a][b][m][n] = (f32x4){0.f, 0.f, 0.f, 0.f};
    bf16x8 At[4][2], B0[2][2], B1[2][2];
    const char* cA = (const char*)g.A + (size_t)cur.pm * tstep; const char* cB = (const char*)g.Bt + (size_t)cur.pn * tstep;
    S.a_ready(cur);
    if constexpr (SP2) {
        PG8_STAGE(PG8_SB(0, 0), cB, voffB); PG8_STAGE(PG8_SB(0, 1), cB + hstep, voffB); PG8_STAGE(PG8_SA(0, 0), cA, voffA); PG8_STAGE(PG8_SA(0, 1), cA + hstep, voffA);
        if (wr == 1) PG8_BAR;
        PG8_WAIT_V(2); PG8_BAR;
        PG8_STAGE(PG8_SB(1, 0), cB + kstep, voffB); PG8_STAGE(PG8_SA(1, 0), cA + kstep, voffA); PG8_STAGE(PG8_SB(1, 1), cB + hstep + kstep, voffB);
        PG8_WAIT_V(6); PG8_BAR;
    } else {
        PG8_STAGE(PG8_SB(0, 0), cB, voffB); PG8_STAGE(PG8_SA(0, 0), cA, voffA); PG8_STAGE(PG8_SB(0, 1), cB + hstep, voffB); PG8_STAGE(PG8_SA(0, 1), cA + hstep, voffA);
        if (wr == 1) PG8_BAR;
        PG8_WAIT_V(4); PG8_BAR;
        PG8_STAGE(PG8_SB(1, 0), cB + kstep, voffB); PG8_STAGE(PG8_SA(1, 0), cA + kstep, voffA); PG8_STAGE(PG8_SB(1, 1), cB + hstep + kstep, voffB);
        PG8_WAIT_V(6); PG8_BAR;
    }
    for (;;) {
        const bool has_next = S.next(ui + 1, nxt);
        const char* nA = has_next ? (const char*)g.A + (size_t)nxt.pm * tstep : cA; const char* nB = has_next ? (const char*)g.Bt + (size_t)nxt.pn * tstep : cB;
        for (int t = 0; t < nt; t += 2) {
            const bool last = (t == nt - 2);
            const char* a1 = cA + (size_t)(t + 1) * kstep;
            const char* a2 = last ? nA : cA + (size_t)(t + 2) * kstep; const char* b2 = last ? nB : cB + (size_t)(t + 2) * kstep;
            const char* a3 = a2 + kstep; const char* b3 = b2 + kstep;
            if (last && has_next) S.a_ready(nxt);
            if constexpr (SP2) {
            PG8_LDB(B0, 0, 0); PG8_LDB(B1, 0, 1); PG8_SCHED; PG8_LDA(At, 0, 0); PG8_STAGE(PG8_SA(1, 1), a1 + hstep, voffA);
            PG8_WAIT_V(8); PG8_WAIT_L(0); PG8_BAR; PG8_MMA(0, 0, At, B0); PG8_MMA(0, 1, At, B1); PG8_BAR; PG8_SCHED;
            PG8_LDA(At, 0, 1); PG8_STAGE(PG8_SB(0, 0), b2, voffB); PG8_STAGE(PG8_SB(0, 1), b2 + hstep, voffB); PG8_STAGE(PG8_SA(0, 0), a2, voffA);
            PG8_WAIT_V(8); PG8_WAIT_L(0); PG8_BAR; PG8_MMA(1, 0, At, B0); PG8_MMA(1, 1, At, B1); PG8_BAR; PG8_SCHED;
            PG8_LDB(B0, 1, 0); PG8_LDB(B1, 1, 1); PG8_SCHED; PG8_LDA(At, 1, 0); PG8_STAGE(PG8_SA(0, 1), a2 + hstep, voffA);
            PG8_WAIT_V(8); PG8_WAIT_L(0); PG8_BAR; PG8_MMA(0, 0, At, B0); PG8_MMA(0, 1, At, B1); PG8_BAR; PG8_SCHED;
            PG8_LDA(At, 1, 1); PG8_STAGE(PG8_SB(1, 0), b3, voffB); PG8_STAGE(PG8_SB(1, 1), b3 + hstep, voffB); PG8_STAGE(PG8_SA(1, 0), a3, voffA);
            PG8_WAIT_V(8); PG8_WAIT_L(0); PG8_BAR; PG8_MMA(1, 0, At, B0); PG8_MMA(1, 1, At, B1); PG8_BAR; PG8_SCHED;
            } else {
            PG8_LDB(B0, 0, 0); PG8_SCHED; PG8_LDA(At, 0, 0); PG8_STAGE(PG8_SA(1, 1), a1 + hstep, voffA);
            PG8_WAIT_L(8); PG8_BAR; PG8_WAIT_L(0); PG8_MMA(0, 0, At, B0); PG8_BAR; PG8_SCHED;
            PG8_LDB(B1, 0, 1); PG8_STAGE(PG8_SB(0, 0), b2, voffB);
            PG8_BAR; PG8_WAIT_L(0); PG8_MMA(0, 1, At, B1); PG8_BAR;
            PG8_LDA(At, 0, 1); PG8_STAGE(PG8_SA(0, 0), a2, voffA);
            PG8_BAR; PG8_WAIT_L(0); PG8_MMA(1, 0, At, B0); PG8_BAR; PG8_SCHED;
            PG8_STAGE(PG8_SB(0, 1), b2 + hstep, voffB);
            PG8_WAIT_V(6); PG8_BAR; PG8_MMA(1, 1, At, B1); PG8_BAR;
            PG8_LDB(B0, 1, 0); PG8_SCHED; PG8_LDA(At, 1, 0); PG8_STAGE(PG8_SA(0, 1), a2 + hstep, voffA);
            PG8_WAIT_L(8); PG8_BAR; PG8_WAIT_L(0); PG8_MMA(0, 0, At, B0); PG8_BAR; PG8_SCHED;
            PG8_LDB(B1, 1, 1); PG8_STAGE(PG8_SB(1, 0), b3, voffB);
            PG8_BAR; PG8_WAIT_L(0); PG8_MMA(0, 1, At, B1); PG8_BAR;
            PG8_LDA(At, 1, 1); PG8_STAGE(PG8_SA(1, 0), a3, voffA);
            PG8_BAR; PG8_WAIT_L(0); PG8_MMA(1, 0, At, B0); PG8_BAR; PG8_SCHED;
            PG8_STAGE(PG8_SB(1, 1), b3 + hstep, voffB);
            PG8_WAIT_V(6); PG8_BAR; PG8_MMA(1, 1, At, B1); PG8_BAR;
            }
        }
        if constexpr (ALIGN_EPI) { if (wr == 0) PG8_BAR; }
        if constexpr (!Epi::AFTER_DRAIN) { E(acc, cur, wr, wc, fr, fq); S.done(cur); }
        if (!has_next) break;
#pragma unroll
        for (int a = 0; a < 2; ++a)
#pragma unroll
            for (int b = 0; b < 2; ++b)
#pragma unroll
                for (int m = 0; m < 4; ++m)
#pragma unroll
                    for (int n = 0; n < 2; ++n) acc[a][b][m][n] = (f32x4){0.f, 0.f, 0.f, 0.f};
        cur = nxt; cA = nA; cB = nB; ++ui;
        if constexpr (ALIGN_EPI) { if (wr == 1) PG8_BAR; }
    }
    PG8_WAIT_V(0);
    if constexpr (!ALIGN_EPI) { if (wr == 0) PG8_BAR; }
    PG8_BAR;
    if constexpr (Epi::AFTER_DRAIN) { E.fused(acc, cur, wr, wc, fr, fq, lds, wid, lane); S.done(cur); }
#undef PG8_SA
#undef PG8_SB
#undef PG8_STAGE
#undef PG8_LDA
#undef PG8_LDB
#undef PG8_MMA
#undef PG8_WAIT_V
#undef PG8_WAIT_L
#undef PG8_BAR
#undef PG8_SCHED
}
}
namespace attn_body {
using bf16=__hip_bfloat16;
using bf16x8=__attribute__((ext_vector_type(8)))short;
using s16x4=__attribute__((ext_vector_type(4)))short;
using f32x16=__attribute__((ext_vector_type(16)))float;
using u32x4=__attribute__((ext_vector_type(4)))unsigned;
using f32x4v=__attribute__((ext_vector_type(4)))float;
constexpr int BATCH=32,NHEAD=8,SEQ=2048,D=64,DM=NHEAD*D;
constexpr int NW=8,QBLK=32,QB=QBLK*NW,KVBLK=64,NQB=SEQ/QB;
constexpr int ATTN_PITCH=DM, ATTN_UNIT_ROWS=QB;
__device__ __forceinline__ int crow(int r,int hi){return (r&3)+8*(r>>2)+4*hi;}
#define SBAR() __builtin_amdgcn_sched_barrier(0)
__device__ __forceinline__ void cmask(f32x16&p0,f32x16&p1,int jb,int qrel,int hi){
  const float NEG=-INFINITY; int kb=64*jb+4*hi;
  #pragma unroll
  for(int r=0;r<16;++r){int kv=kb+(r&3)+8*(r>>2); if(kv>qrel)p0[r]=NEG; if(kv+32>qrel)p1[r]=NEG;}
}

constexpr int NSLOT=3, SLOTB=8192;
constexpr int LDS_K=0, LDS_V=NSLOT*SLOTB, LDS_WS=2*NSLOT*SLOTB, LDS_OST=LDS_WS+NW*64*4, LDS_CB=LDS_OST+NW*4096, LDS_CBX=LDS_CB+2048*4, LDS_AL=LDS_CBX+256, LDS_BYTES=LDS_AL+256;
constexpr float C2=0.125f*1.4426950408889634f;
__device__ __forceinline__ void glds16(const void*gsrc,unsigned lds_dst){unsigned keep;
  asm volatile("s_mov_b32 %0, m0\n\ts_mov_b32 m0, %2\n\ts_nop 0\n\tglobal_load_lds_dwordx4 %1, off\n\ts_mov_b32 m0, %0":"=&s"(keep):"v"(gsrc),"s"(lds_dst):"memory");}
__device__ __forceinline__ float max3f(float a,float b,float c){float r;asm("v_max3_f32 %0, %1, %2, %3":"=v"(r):"v"(a),"v"(b),"v"(c));return r;}
__device__ __forceinline__ float max2f(float a,float b){float r;asm("v_max_f32_e32 %0, %1, %2":"=v"(r):"v"(a),"v"(b));return r;}
__device__ __forceinline__ float fadd_s(float a,float b){float r;asm("v_add_f32_e32 %0, %1, %2":"=v"(r):"v"(a),"v"(b));return r;}
__device__ __forceinline__ float fsub_s(float a,float b){float r;asm("v_sub_f32_e32 %0, %1, %2":"=v"(r):"v"(a),"v"(b));return r;}
typedef float f32x2_t __attribute__((ext_vector_type(2))); typedef __bf16 bf16x2_t __attribute__((ext_vector_type(2)));
__device__ __forceinline__ unsigned cvtpk_s(float lo,float hi){f32x2_t v={lo,hi};bf16x2_t b=__builtin_convertvector(v,bf16x2_t);return __builtin_bit_cast(unsigned,b);}
#define WAIT_BAR(N) asm volatile("s_waitcnt vmcnt(" #N ") lgkmcnt(0)\n\ts_barrier":::"memory")

__device__ __forceinline__ void qkt(f32x16&p0,f32x16&p1,const char*Kslot,const bf16x8*qr,int r32,int hi){ const f32x16 negm=f32x16{};
  const char*kb=Kslot+hi*1024+r32*16;
  #pragma unroll
  for(int d0=0;d0<4;++d0){
    const bf16x8 b0=*reinterpret_cast<const bf16x8*>(kb+d0*2048);
    const bf16x8 b1=*reinterpret_cast<const bf16x8*>(kb+d0*2048+512);
    if(d0==0){p0=__builtin_amdgcn_mfma_f32_32x32x16_bf16(b0,qr[0],negm,0,0,0);p1=__builtin_amdgcn_mfma_f32_32x32x16_bf16(b1,qr[0],negm,0,0,0);}
    else{p0=__builtin_amdgcn_mfma_f32_32x32x16_bf16(b0,qr[d0],p0,0,0,0);p1=__builtin_amdgcn_mfma_f32_32x32x16_bf16(b1,qr[d0],p1,0,0,0);}}
}
typedef __attribute__((address_space(3))) const char* lds_cptr;
typedef short v4i16_t __attribute__((ext_vector_type(4)));
__device__ __forceinline__ void kload8(bf16x8*kf,lds_cptr kp){
  kf[0]=*(const __attribute__((address_space(3))) bf16x8*)(kp);      kf[1]=*(const __attribute__((address_space(3))) bf16x8*)(kp+512);
  kf[2]=*(const __attribute__((address_space(3))) bf16x8*)(kp+2048); kf[3]=*(const __attribute__((address_space(3))) bf16x8*)(kp+2560);
  kf[4]=*(const __attribute__((address_space(3))) bf16x8*)(kp+4096); kf[5]=*(const __attribute__((address_space(3))) bf16x8*)(kp+4608);
  kf[6]=*(const __attribute__((address_space(3))) bf16x8*)(kp+6144); kf[7]=*(const __attribute__((address_space(3))) bf16x8*)(kp+6656);
}
__device__ __forceinline__ void kload2(bf16x8*kf,lds_cptr kp,int j){ kf[2*j]=*(const __attribute__((address_space(3))) bf16x8*)(kp+j*2048); kf[2*j+1]=*(const __attribute__((address_space(3))) bf16x8*)(kp+j*2048+512); }
__device__ __forceinline__ s16x4 vtr(lds_cptr p){ return __builtin_bit_cast(s16x4,__builtin_amdgcn_ds_read_tr16_b64_v4i16((__attribute__((address_space(3))) v4i16_t*)p)); }
__device__ __forceinline__ float rowmax(const f32x16&p0,const f32x16&p1){
  float a=max3f(p0[0],p0[1],p1[0]),b=max3f(p0[2],p0[3],p1[1]);a=max3f(a,p1[2],p1[3]);
  #pragma unroll
  for(int r=4;r<16;r+=4){a=max3f(a,p0[r],p0[r+1]);b=max3f(b,p0[r+2],p0[r+3]);a=max3f(a,p1[r],p1[r+1]);b=max3f(b,p1[r+2],p1[r+3]);}
  const float m=max2f(a,b);
  auto rr=__builtin_amdgcn_permlane32_swap(__float_as_uint(m),__float_as_uint(m),false,false);
  return max2f(__uint_as_float(rr[0]),__uint_as_float(rr[1]));
}
__device__ __forceinline__ void pv(f32x16*o,int vb,bf16x8 pa0,bf16x8 pa1,bf16x8 pa2,bf16x8 pa3){
  #pragma unroll
  for(int d0=0;d0<2;++d0){s16x4 lo[4],hi[4];
    #pragma unroll
    for(int ks=0;ks<4;++ks){
      asm volatile("ds_read_b64_tr_b16 %0,%1 offset:%c2":"=&v"(lo[ks]):"v"(vb),"i"(d0*4096+ks*1024):"memory");
      asm volatile("ds_read_b64_tr_b16 %0,%1 offset:%c2":"=&v"(hi[ks]):"v"(vb),"i"(d0*4096+ks*1024+512):"memory");}
    asm volatile("s_waitcnt lgkmcnt(0)":::"memory");SBAR();
    #define PK(k) (bf16x8){lo[k][0],lo[k][1],lo[k][2],lo[k][3],hi[k][0],hi[k][1],hi[k][2],hi[k][3]}
    o[d0]=__builtin_amdgcn_mfma_f32_32x32x16_bf16(pa0,PK(0),o[d0],0,0,0);
    o[d0]=__builtin_amdgcn_mfma_f32_32x32x16_bf16(pa1,PK(1),o[d0],0,0,0);
    o[d0]=__builtin_amdgcn_mfma_f32_32x32x16_bf16(pa2,PK(2),o[d0],0,0,0);
    o[d0]=__builtin_amdgcn_mfma_f32_32x32x16_bf16(pa3,PK(3),o[d0],0,0,0);
    #undef PK
  }
}

#ifndef ATTN_STORE16
#define ATTN_STORE16(p,v) (*(u32x4*)(p)=(v))
#endif
template<int THRL> __device__ __forceinline__ void attn_unit(int b,int h,int qb,const bf16*Q,const bf16*__restrict__ K,const bf16*__restrict__ V,bf16*O,const float*__restrict__ LFT,const float Dd,char*shm){
  int tid=threadIdx.x; asm volatile("":"+v"(tid)); const int lane=tid&63,r32=lane&31,hi=lane>>5; const int wid=__builtin_amdgcn_readfirstlane(tid>>6);
  const long rowbase=(long)b*SEQ; const int q0=qb*QB;
  const bf16*Qw=Q+(rowbase+q0+wid*QBLK)*DM+h*D;
  const bf16*Kh=K+rowbase*DM+h*D,*Vh=V+rowbase*DM+h*D;
  const unsigned lds0=(unsigned)(uintptr_t)shm;
  float*wsf=(float*)(shm+LDS_WS)+wid*64;
  const bf16*ksrc=Kh+(long)lane*DM+wid*8;
  const bf16*vsrc=Vh+(long)(16*(wid&3)+(lane>>2))*DM+(wid>>2)*32+(lane&3)*8;
  const unsigned kdst=lds0+LDS_K+wid*1024, vdst=lds0+LDS_V+wid*1024;
  #define DMA_K(t,slot) glds16(ksrc+(long)(t)*KVBLK*DM,(unsigned)__builtin_amdgcn_readfirstlane(kdst+(slot)))
  #define DMA_V(t,slot) glds16(vsrc+(long)(t)*KVBLK*DM,(unsigned)__builtin_amdgcn_readfirstlane(vdst+(slot)))
  const int vb0=(int)(lds0+LDS_V)+((lane>>4)&1)*32+(lane&3)*8+(4*hi+((lane&15)>>2))*64;
  const char*Kbase=shm+LDS_K; bf16x8 kf[8];
  const lds_cptr shm3=(lds_cptr)shm; const lds_cptr kp0=shm3+LDS_K+hi*1024+r32*16; const lds_cptr vp0=shm3+LDS_V+((lane>>4)&1)*32+(lane&3)*8+(4*hi+((lane&15)>>2))*64;
  int NT=(q0+QB)/KVBLK;
  typedef __attribute__((address_space(3))) const f32x4v* lds_f4p;
  typedef __attribute__((address_space(3))) float* lds_fp;
  bool stat; int t0;
  {
    lds_fp cbw=(lds_fp)(shm3+LDS_CB); lds_fp cbx=(lds_fp)(shm3+LDS_CBX); lds_fp alw=(lds_fp)(shm3+LDS_AL);
    const float L2E=1.4426950408889634f;
    const int nk=q0+QB; float v0=0.f,v1=0.f,v2=0.f,v3=0.f;
    if(4*tid<nk){ const f32x4v l4=*(const f32x4v*)(LFT+((long)(b*NHEAD+h))*SEQ+4*tid); v0=l4[0]; v1=l4[1]; v2=l4[2]; v3=l4[3]; }
    v1+=v0; v2+=v1; v3+=v2; float tot=v3;
    #pragma unroll
    for(int o_=1;o_<64;o_<<=1){ float u_=__shfl_up(tot,o_); if(lane>=o_)tot+=u_; }
    if(lane==63)cbx[wid]=tot;
    if(tid==0){cbx[48]=0.f;}
    asm volatile("s_waitcnt vmcnt(0) lgkmcnt(0)\n\ts_barrier":::"memory");
    float base=tot-v3;
    #pragma unroll
    for(int w_=0;w_<NW;++w_){ float x_=cbx[w_]; if(w_<wid)base+=x_; }
    v0+=base;v1+=base;v2+=base;v3+=base;
    if(4*tid<nk && ((4*tid+3)&63)==63)cbx[16+((4*tid+3)>>6)]=v3;
    if(4*tid==q0)cbx[8]=v0;
    asm volatile("s_waitcnt vmcnt(0) lgkmcnt(0)\n\ts_barrier":::"memory");
    const float cq0=cbx[8];
    if(4*tid<nk){ const float ce=cbx[16+(tid>>4)]; cbw[4*tid]=(ce-v0)*L2E-Dd; cbw[4*tid+1]=(ce-v1)*L2E-Dd; cbw[4*tid+2]=(ce-v2)*L2E-Dd; cbw[4*tid+3]=(ce-v3)*L2E-Dd; }
    bool skip_=false;
    if(tid<NT){ const float ce=cbx[16+tid], cp=(tid>0)?cbx[16+tid-1]:0.f; const float dl_=(cp-ce)*L2E;
      alw[tid]=__builtin_amdgcn_exp2f(-dl_); alw[32+tid]=dl_; if(dl_+2.f*Dd>110.f)cbx[48]=1.f;
      skip_=(tid<NT-4)&&((ce-cq0)*L2E>2.f*Dd+160.f); }
    const unsigned long long bal_=__ballot(skip_);
    if(tid==0)cbx[49]=(float)(__popcll(bal_)&~1);
    asm volatile("s_waitcnt vmcnt(0) lgkmcnt(0)\n\ts_barrier":::"memory");
    stat=(cbx[48]==0.f); t0=(int)cbx[49];
    stat=__builtin_amdgcn_readfirstlane((int)stat)!=0; t0=__builtin_amdgcn_readfirstlane(t0);
#ifdef FORCE_EXACT
    stat=false;
#endif
  }
  NT-=t0; ksrc+=(long)t0*KVBLK*DM; vsrc+=(long)t0*KVBLK*DM;
  typedef __attribute__((address_space(3))) const float* lds_cfp;
  const lds_cfp alp=(lds_cfp)(shm3+LDS_AL)+t0;
  const int tdw=NT-4+(wid>>1);
  #define ALF(t) (((t)>tdw)?1.f:alp[t])
  const lds_f4p cbp=(lds_f4p)(shm3+LDS_CB)+hi+16*t0;
  #define CBIAS(P0,P1,t) do{ const lds_f4p bp_=cbp+16*(t); _Pragma("unroll") for(int a_=0;a_<4;++a_){ const f32x4v b0_=bp_[2*a_], b1_=bp_[8+2*a_]; \
      P0[4*a_]+=b0_[0];P0[4*a_+1]+=b0_[1];P0[4*a_+2]+=b0_[2];P0[4*a_+3]+=b0_[3]; P1[4*a_]+=b1_[0];P1[4*a_+1]+=b1_[1];P1[4*a_+2]+=b1_[2];P1[4*a_+3]+=b1_[3]; } }while(0)
  DMA_K(0,0);DMA_V(0,0);DMA_K(1,SLOTB);
  bf16x8 qr[4];
  #pragma unroll
  for(int d0=0;d0<4;++d0)qr[d0]=*reinterpret_cast<const bf16x8*>(&Qw[(long)r32*DM+d0*16+hi*8]);
  float mhat=0.f,l_reg=0.f;f32x16 o[2];o[0]=f32x16{};o[1]=f32x16{};
  const int qrel=wid*QBLK+r32;
  #define CMASK(P0,P1,t) do{int jb_=(t)-(NT-4); if(jb_>=0)cmask(P0,P1,jb_,qrel,hi);}while(0)
  bool resc=false;
  #define START(P0,P1) do{ resc=false; \
    if(!stat){ const float rm=rowmax(P0,P1); const float dl=rm; mhat=fadd_s(mhat,dl); \
      _Pragma("unroll") for(int r=0;r<16;++r){P0[r]=fsub_s(P0[r],dl);P1[r]=fsub_s(P1[r],dl);} \
      } \
    _Pragma("unroll") for(int r=0;r<16;++r)P0[r]=__builtin_amdgcn_exp2f(P0[r]); }while(0)
  #define RESC(t) do{ if(stat){ const float al_=ALF(t); _Pragma("unroll") for(int d_=0;d_<2;++d_) _Pragma("unroll") for(int r=0;r<16;++r)o[d_][r]*=al_; } \
    else if(resc){ asm volatile("s_waitcnt lgkmcnt(0)":::"memory"); \
      _Pragma("unroll") for(int d_=0;d_<2;++d_) _Pragma("unroll") for(int r=0;r<16;++r)o[d_][r]*=wsf[crow(r,hi)]; } }while(0)
  f32x16 pA0,pA1,pB0,pB1;
  int sl_prev=0,sl_cur=0,sl_next=SLOTB;
  #define ROT() do{sl_prev=sl_cur;sl_cur=sl_next;sl_next=(sl_next==(NSLOT-1)*SLOTB)?0:sl_next+SLOTB;}while(0)
  DMA_K(2,2*SLOTB);
  WAIT_BAR(3);
  qkt(pA0,pA1,Kbase,qr,r32,hi);asm volatile("s_nop 15\n\ts_nop 7":"+v"(pA0),"+v"(pA1));CMASK(pA0,pA1,0);CBIAS(pA0,pA1,0);
  START(pA0,pA1);
  _Pragma("unroll") for(int r=0;r<16;++r)pA1[r]=__builtin_amdgcn_exp2f(pA1[r]);
  WAIT_BAR(0);
  DMA_K(3,0);DMA_V(1,SLOTB);
  ROT();
  kload8(kf,kp0+sl_cur);
  WAIT_BAR(2);
  s16x4 vlo[8],vhi[8]; u32x4 pw0,pw1,pw2,pw3;
  #define PKW(P,B) cvtpk_s(P[B],P[B+1])
  #define PAF(k) __builtin_bit_cast(bf16x8,pw##k)
  #define VFR(i) (bf16x8){vlo[i][0],vlo[i][1],vlo[i][2],vlo[i][3],vhi[i][0],vhi[i][1],vhi[i][2],vhi[i][3]}
  #define PIN(x) asm volatile("":"+v"(x))
  #define MX3(a,b,c) __builtin_fmaxf(__builtin_fmaxf((a),(b)),(c))
  #define GAPA(MF,A0,A1,A2,A3,W0,W1,PW) do{ MF; sacc+=A0; sacc+=A1; sacc+=A2; sacc+=A3; PIN(sacc); W0; W1; PIN(PW); SBAR(); }while(0)
  #define EX(v) __builtin_amdgcn_exp2f(v)
  #define GAPB(MF,X,B) do{ MF; X[B]=EX(X[B]); X[B+1]=EX(X[B+1]); X[B+2]=EX(X[B+2]); X[B+3]=EX(X[B+3]); PIN(X); SBAR(); }while(0)
  #define VRD(i) do{ vlo[i]=vtr(vp_+(((i)>>2)*4096+((i)&3)*1024)); vhi[i]=vtr(vp_+(((i)>>2)*4096+((i)&3)*1024+512)); }while(0)
  #define KRD(G,j) do{ if(G){ kload2(kf,kp0+sl_next,j); SBAR(); } }while(0)
  #define STEP(C0,C1,P0,P1,t,GK,GV,GL) do{ SBAR(); \
    const lds_cptr vp_=vp0+sl_prev; \
    VRD(0); SBAR(); float sacc=(P0[0]+P0[1]); \
    GAPA(C0=__builtin_amdgcn_mfma_f32_32x32x16_bf16(kf[0],qr[0],f32x16{},0,0,0), P0[2],P0[3],P0[4],P0[5],     pw0[0]=PKW(P0,0), pw0[1]=PKW(P0,2), pw0); \
    VRD(4); SBAR(); GAPA(C1=__builtin_amdgcn_mfma_f32_32x32x16_bf16(kf[1],qr[0],f32x16{},0,0,0), P0[6],P0[7],P0[8],P0[9],     pw0[2]=PKW(P0,4), pw0[3]=PKW(P0,6), pw0); \
    VRD(1); SBAR(); GAPA(C0=__builtin_amdgcn_mfma_f32_32x32x16_bf16(kf[2],qr[1],C0,0,0,0),   P0[10],P0[11],P0[12],P0[13], pw1[0]=PKW(P0,8), pw1[1]=PKW(P0,10), pw1); \
    VRD(5); SBAR(); GAPA(C1=__builtin_amdgcn_mfma_f32_32x32x16_bf16(kf[3],qr[1],C1,0,0,0),   P0[14],P0[15],P1[0],P1[1],   pw1[2]=PKW(P0,12),pw1[3]=PKW(P0,14), pw1); \
    VRD(2); SBAR(); GAPA(C0=__builtin_amdgcn_mfma_f32_32x32x16_bf16(kf[4],qr[2],C0,0,0,0),   P1[2],P1[3],P1[4],P1[5],     pw2[0]=PKW(P1,0), pw2[1]=PKW(P1,2), pw2); \
    VRD(6); SBAR(); GAPA(C1=__builtin_amdgcn_mfma_f32_32x32x16_bf16(kf[5],qr[2],C1,0,0,0),   P1[6],P1[7],P1[8],P1[9],     pw2[2]=PKW(P1,4), pw2[3]=PKW(P1,6), pw2); \
    VRD(3); SBAR(); GAPA(C0=__builtin_amdgcn_mfma_f32_32x32x16_bf16(kf[6],qr[3],C0,0,0,0),   P1[10],P1[11],P1[12],P1[13], pw3[0]=PKW(P1,8), pw3[1]=PKW(P1,10), pw3); \
    VRD(7); SBAR(); GAPA(C1=__builtin_amdgcn_mfma_f32_32x32x16_bf16(kf[7],qr[3],C1,0,0,0),   P1[14],P1[15],0.f,0.f,       pw3[2]=PKW(P1,12),pw3[3]=PKW(P1,14), pw3); \
    l_reg+=sacc; \
    if(GK){DMA_K((t)+3,sl_cur);} if(GV){DMA_V((t)+1,sl_next);} \
    CMASK(C0,C1,t); CBIAS(C0,C1,t); \
    if(stat){ l_reg*=ALF(t); resc=false; } else { mhat-=alp[32+(t)]; _Pragma("unroll") for(int r=0;r<16;++r){C0[r]-=mhat;C1[r]-=mhat;} float a=MX3(C0[0],C0[1],C1[0]),b=MX3(C0[2],C0[3],C1[1]); a=MX3(a,C1[2],C1[3]); \
      _Pragma("unroll") for(int r=4;r<16;r+=4){a=MX3(a,C0[r],C0[r+1]);b=MX3(b,C0[r+2],C0[r+3]);a=MX3(a,C1[r],C1[r+1]);b=MX3(b,C1[r+2],C1[r+3]);} \
      float rm=__builtin_fmaxf(a,b); { auto rr=__builtin_amdgcn_permlane32_swap(__float_as_uint(rm),__float_as_uint(rm),false,false); rm=__builtin_fmaxf(__uint_as_float(rr[0]),__uint_as_float(rr[1])); } \
      resc=false; \
      if(__builtin_expect(__any(rm>(float)THRL),0)){ const float dl=__builtin_fmaxf(rm,0.f); mhat+=dl; \
        _Pragma("unroll") for(int r=0;r<16;++r){C0[r]-=dl;C1[r]-=dl;} \
        const float f=__builtin_amdgcn_exp2f(-dl); l_reg*=f; if(hi==0)wsf[r32]=f; resc=true; } } \
    SBAR(); \
    GAPB(o[0]=__builtin_amdgcn_mfma_f32_32x32x16_bf16(PAF(0),VFR(0),o[0],0,0,0), C0,0); \
    GAPB(o[1]=__builtin_amdgcn_mfma_f32_32x32x16_bf16(PAF(0),VFR(4),o[1],0,0,0), C0,4); \
    KRD(GL,0); GAPB(o[0]=__builtin_amdgcn_mfma_f32_32x32x16_bf16(PAF(1),VFR(1),o[0],0,0,0), C0,8); \
    KRD(GL,1); GAPB(o[1]=__builtin_amdgcn_mfma_f32_32x32x16_bf16(PAF(1),VFR(5),o[1],0,0,0), C0,12); \
    KRD(GL,2); GAPB(o[0]=__builtin_amdgcn_mfma_f32_32x32x16_bf16(PAF(2),VFR(2),o[0],0,0,0), C1,0); \
    KRD(GL,3); GAPB(o[1]=__builtin_amdgcn_mfma_f32_32x32x16_bf16(PAF(2),VFR(6),o[1],0,0,0), C1,4); \
    GAPB(o[0]=__builtin_amdgcn_mfma_f32_32x32x16_bf16(PAF(3),VFR(3),o[0],0,0,0), C1,8); \
    GAPB(o[1]=__builtin_amdgcn_mfma_f32_32x32x16_bf16(PAF(3),VFR(7),o[1],0,0,0), C1,12); \
    }while(0)
  int t=1;
  #undef CMASK
  #define CMASK(P0,P1,t) do{}while(0)
  for(;t+5<NT;t+=2){
    STEP(pB0,pB1,pA0,pA1,t,true,true,true);     WAIT_BAR(2); RESC(t); ROT();
    STEP(pA0,pA1,pB0,pB1,t+1,true,true,true);   WAIT_BAR(2); RESC(t+1); ROT();
  }
  #undef CMASK
  #define CMASK(P0,P1,t) do{int jb_=(t)-(NT-4); if(jb_>=0)cmask(P0,P1,jb_,qrel,hi);}while(0)
  #define ENDW(tt) do{ if((tt)+3<NT){WAIT_BAR(2);} else if((tt)+2<NT){WAIT_BAR(1);} else {WAIT_BAR(0);} }while(0)
  for(;t+1<NT;t+=2){
    STEP(pB0,pB1,pA0,pA1,t,(t+3<NT),(t+1<NT),(t+1<NT));       ENDW(t);   RESC(t); ROT();
    STEP(pA0,pA1,pB0,pB1,t+1,(t+4<NT),(t+2<NT),(t+2<NT));     ENDW(t+1); RESC(t+1); ROT();
  }
  STEP(pB0,pB1,pA0,pA1,NT-1,false,false,false); RESC(NT-1);
  { float sacc=pB0[0]+pB0[1]; _Pragma("unroll") for(int r=2;r<16;++r)sacc+=pB0[r]; _Pragma("unroll") for(int r=0;r<16;++r)sacc+=pB1[r]; l_reg+=sacc;
    pw0=(u32x4){PKW(pB0,0),PKW(pB0,2),PKW(pB0,4),PKW(pB0,6)};pw1=(u32x4){PKW(pB0,8),PKW(pB0,10),PKW(pB0,12),PKW(pB0,14)};pw2=(u32x4){PKW(pB1,0),PKW(pB1,2),PKW(pB1,4),PKW(pB1,6)};pw3=(u32x4){PKW(pB1,8),PKW(pB1,10),PKW(pB1,12),PKW(pB1,14)};
    SBAR(); pv(o,vb0+sl_cur,PAF(0),PAF(1),PAF(2),PAF(3)); }
  #undef PKW
  #undef PAF
  #undef VFR
  #undef PIN
  #undef MX3
  #undef GAPA
  #undef GAPB
  #undef EX
  #undef VRD
  #undef KRD
  #undef STEP
  #undef ENDW
  {auto rr=__builtin_amdgcn_permlane32_swap(__float_as_uint(l_reg),__float_as_uint(l_reg),false,false);l_reg=__uint_as_float(rr[0])+__uint_as_float(rr[1]);}
  if(hi==0)wsf[32+r32]=l_reg;asm volatile("s_waitcnt lgkmcnt(0)":::"memory");
  float rli[16];
  #pragma unroll
  for(int r=0;r<16;++r)rli[r]=__builtin_amdgcn_rcpf(wsf[32+crow(r,hi)]);
  bf16*Ow=O+(rowbase+q0+wid*QBLK)*DM+h*D;
  { bf16*stg=(bf16*)(shm+LDS_OST)+wid*2048;
    #pragma unroll
    for(int r=0;r<16;++r){const int orow=crow(r,hi);
      #pragma unroll
      for(int d0=0;d0<2;++d0)stg[orow*64+d0*32+r32]=__float2bfloat16(o[d0][r]*rli[r]);}
    asm volatile("s_waitcnt lgkmcnt(0)":::"memory");
    #pragma unroll
    for(int i=0;i<4;++i){const int row=i*8+(lane>>3),ch=lane&7; const u32x4 v=*(const u32x4*)(stg+row*64+ch*8); ATTN_STORE16(Ow+(long)row*DM+ch*8,v);} }
  asm volatile("s_waitcnt lgkmcnt(0)\n\ts_barrier":::"memory");
  #undef DMA_K
  #undef DMA_V
  #undef CMASK
  #undef CBIAS
  #undef ALF
  #undef START
  #undef RESC
  #undef ROT
}
constexpr int ATTN_LDS_BYTES=LDS_BYTES;
#undef SBAR
#undef WAIT_BAR
}
namespace xb {
#define XLAS __attribute__((address_space(3)))
#define XB_TMO      128
#define XB_XCNT(j)  (256  + 64 * (j))
#define XB_XSUB(j)  (1280 + 64 * (j))
#define XB_XGEN(j)  (2304 + 64 * (j))
#define XB_TOP      3328
#define XB_TOPGEN   3392
#define XCD_BAR_WORDS 3456
#define XB_SPIN_CAP (1u << 18)

__device__ __forceinline__ unsigned xb_ld(unsigned* p)              { return __hip_atomic_load(p, __ATOMIC_RELAXED, __HIP_MEMORY_SCOPE_AGENT); }
__device__ __forceinline__ unsigned xb_add(unsigned* p, unsigned v) { return __hip_atomic_fetch_add(p, v, __ATOMIC_RELAXED, __HIP_MEMORY_SCOPE_AGENT); }
__device__ __forceinline__ unsigned xb_xcc_id() { return (unsigned)__builtin_amdgcn_s_getreg((3 << 11) | 20) & 0xFu; }
#define XB_SPIN(cond, bar) do { unsigned _sp = 0; while (cond) { __builtin_amdgcn_s_sleep(1); \
    if ((++_sp & 255u) == 0u) { if (xb_ld(&(bar)[XB_TMO])) break; if (_sp > XB_SPIN_CAP) { atomicAdd(&(bar)[XB_TMO], 1u); break; } } } } while (0)

struct XcdBarrier {
    unsigned* bar; unsigned x;
    volatile XLAS unsigned* st;
};

__device__ __forceinline__ XcdBarrier xcd_barrier_post(unsigned* bar, volatile XLAS unsigned* st) {
    XcdBarrier b; b.bar = bar; b.x = xb_xcc_id(); b.st = st;
    if (threadIdx.x == 0) (void)xb_add(&bar[XB_XCNT(b.x)], 1u);
    return b;
}
__device__ __forceinline__ void xcd_barrier_complete(unsigned* bar, unsigned x, unsigned& nloc, unsigned& nx) {
    const unsigned G = gridDim.x * gridDim.y * gridDim.z;
    unsigned sum, cnt, mine, sp = 0u;
    for (;;) {
        sum = 0u; cnt = 0u; mine = 0u;
#pragma unroll
        for (unsigned j = 0; j < 16; ++j) { const unsigned c = xb_ld(&bar[XB_XCNT(j)]); sum += c; cnt += (c > 0u) ? 1u : 0u; mine = (j == x) ? c : mine; }
        if (sum == G) break;
        __builtin_amdgcn_s_sleep(1);
        if ((++sp & 255u) == 0u) { if (xb_ld(&bar[XB_TMO])) break; if (sp > XB_SPIN_CAP) { atomicAdd(&bar[XB_TMO], 1u); break; } }
    }
    nloc = mine > 0u ? mine : 1u; nx = cnt > 0u ? cnt : 1u;
}

__device__ __forceinline__ void xcd_barrier(const XcdBarrier& b) {
    asm volatile("s_waitcnt vmcnt(0)" ::: "memory");
    __syncthreads();
    if (threadIdx.x == 0) {
        unsigned* bar = b.bar;
        __builtin_amdgcn_s_waitcnt(0);
        unsigned nloc = b.st[0], nx = b.st[1];
        if (nloc == 0u) { xcd_barrier_complete(bar, b.x, nloc, nx); b.st[0] = nloc; b.st[1] = nx; }
        const unsigned old = xb_add(&bar[XB_XSUB(b.x)], 1u);
        const unsigned gen = old / nloc;
        if (old + 1u == (gen + 1u) * nloc) {
            __builtin_amdgcn_fence(__ATOMIC_RELEASE, "agent");
            asm volatile("s_waitcnt vmcnt(0)" ::: "memory");
            const unsigned og = xb_add(&bar[XB_TOP], 1u);
            const unsigned tg = og / nx;
            if (og + 1u == (tg + 1u) * nx) xb_add(&bar[XB_TOPGEN], 1u);
            else XB_SPIN(xb_ld(&bar[XB_TOPGEN]) == tg, bar);
            __builtin_amdgcn_fence(__ATOMIC_ACQUIRE, "agent");
            xb_add(&bar[XB_XGEN(b.x)], 1u);
            asm volatile("s_waitcnt vmcnt(0)" ::: "memory");
        } else {
            XB_SPIN(xb_ld(&bar[XB_XGEN(b.x)]) == gen, bar);
            __builtin_amdgcn_fence(__ATOMIC_ACQUIRE, "agent");
            asm volatile("s_waitcnt vmcnt(0)" ::: "memory");
        }
    }
    __syncthreads();
}
}
namespace mk {
#define LAS __attribute__((address_space(3)))
typedef unsigned short u16;
typedef pg8::f32x4 f32x4;
typedef pg8::u32x4 u32x4;
typedef pg8::bf16x8 bf16x8;
typedef unsigned u32x2 __attribute__((ext_vector_type(2)));
using pg8::cvt_pk_bf16;

constexpr int DMODEL = 1024, SEQ = 2048, MP = 65536, MS = 256, MT = MP + MS, DFF = 2816, NMIX = 6912, PAST = 4096, NPOS = 2048 + 16;
constexpr float L2E = 1.4426950408889634f;
constexpr float QC2 = 0.125f * L2E;

constexpr size_t SZ1024 = (size_t)MT * 1024 * 2, SZ512 = (size_t)MT * 512 * 2;
constexpr size_t O_CTL = 0;
constexpr size_t O_SS = 65536;
constexpr size_t O_TABC = O_SS + (size_t)MT * 64;
constexpr size_t O_TABS = O_TABC + (size_t)NPOS * 256;
constexpr size_t O_W1IN = O_TABS + (size_t)NPOS * 256;
constexpr size_t O_W1OUT = O_W1IN + (size_t)5632 * 1024 * 2;
constexpr size_t O_WMIX = O_W1OUT + (size_t)1024 * 2816 * 2;
constexpr size_t O_WBR = O_WMIX + (size_t)NMIX * 1024 * 2;
constexpr size_t O_WBF = O_WBR + (size_t)1024 * 1024 * 2;
constexpr size_t O_WOUT = O_WBF + (size_t)1024 * 512 * 2;
constexpr size_t O_W2IN = O_WOUT + (size_t)1024 * 1024 * 2;
constexpr size_t O_W2OUT = O_W2IN + (size_t)5632 * 1024 * 2;
constexpr size_t O_WPLE = O_W2OUT + (size_t)1024 * 2816 * 2;
constexpr size_t O_WPG = O_WPLE + (size_t)1024 * 256 * 2;
constexpr size_t O_XB = O_WPG + (size_t)1024 * 1024 * 2;
constexpr size_t O_RQK = O_XB + SZ1024;
constexpr size_t O_RV = O_RQK + SZ1024;
constexpr size_t O_RG = O_RV + SZ1024;
constexpr size_t O_FQ = O_RG + SZ1024;
constexpr size_t O_FK = O_FQ + SZ512;
constexpr size_t O_FV = O_FK + SZ512;
constexpr size_t O_ZG = O_FV + SZ512;
constexpr size_t WS_NEED = O_ZG + (size_t)MT * 2048 * 2;
constexpr size_t O_ACT1 = O_RQK;
constexpr size_t O_ACT2 = O_RV;
static_assert(O_ACT1 + (size_t)MT * DFF * 2 <= O_FQ, "act1 overlay");
static_assert(O_ACT2 + (size_t)MT * DFF * 2 <= O_FV, "act2 overlay");
static_assert(WS_NEED <= 1073741824ull, "ws");
constexpr size_t OUT_YP = 0, OUT_YS = OUT_YP + (size_t)MP * 1024, OUT_RSP = OUT_YS + (size_t)MS * 1024, OUT_KP = OUT_RSP + (size_t)32 * 4 * 128 * 256,
                 OUT_VP = OUT_KP + (size_t)MP * 512, OUT_LP = OUT_VP + (size_t)MP * 512, OUT_RSS = OUT_LP + (size_t)MP * 8, OUT_KS = OUT_RSS + (size_t)16 * 4 * 128 * 256,
                 OUT_VS = OUT_KS + (size_t)MS * 512, OUT_LS = OUT_VS + (size_t)MS * 512, OUT_END = OUT_LS + (size_t)MS * 8;

constexpr int LDS_BYTES = 147456;

__device__ __forceinline__ float bf2f(unsigned h) { return __uint_as_float(h << 16); }
__device__ __forceinline__ float bflo(unsigned w) { return __uint_as_float(w << 16); }
__device__ __forceinline__ float bfhi(unsigned w) { return __uint_as_float(w & 0xffff0000u); }
__device__ __forceinline__ float fast_sigmoid(float x) { return __builtin_amdgcn_rcpf(1.f + __builtin_amdgcn_exp2f(-x * L2E)); }
__device__ __forceinline__ float wave_sum(float v) {
#pragma unroll
    for (int o = 1; o < 64; o <<= 1) v += __shfl_xor(v, o);
    return v;
}
__device__ __forceinline__ float wave_max(float v) {
#pragma unroll
    for (int o = 1; o < 64; o <<= 1) v = fmaxf(v, __shfl_xor(v, o));
    return v;
}
__device__ __forceinline__ float rstd_of(const float* ss, int row) {
    const f32x4* p = (const f32x4*)(ss + (size_t)row * 16); const f32x4 a = p[0], b = p[1], c = p[2], d = p[3];
    const float s = (((a[0] + a[1]) + (a[2] + a[3])) + ((b[0] + b[1]) + (b[2] + b[3]))) + (((c[0] + c[1]) + (c[2] + c[3])) + ((d[0] + d[1]) + (d[2] + d[3])));
    return rsqrtf(s * (1.f / 1024.f) + 1e-6f);
}
__device__ __forceinline__ int gcol(int q) { return (q & 128) + (q & 96) + ((q >> 2) & 3) * 8 + ((q >> 4) & 1) * 4 + (q & 3); }


constexpr int RS_TAB_OFF = 147456 - 128 - 1024;
__device__ __forceinline__ const LAS float* rs_table_fill(const float* ss, int pm) {
    LAS float* tab = (LAS float*)(uintptr_t)RS_TAB_OFF;
    const int t = threadIdx.x;
    if (t < 256) tab[t] = rstd_of(ss, pm * 256 + t);
    asm volatile("s_waitcnt lgkmcnt(0)" ::: "memory"); __builtin_amdgcn_s_barrier(); asm volatile("" ::: "memory");
    return tab;
}
struct EpiSwiglu {
    static constexpr bool PERM = false, AFTER_DRAIN = false;
    u16* O; const float* ss;
    __device__ __forceinline__ void operator()(const f32x4 (&acc)[2][2][4][2], const pg8::Unit& u, int wr, int wc, int fr, int fq) const {
        const int col = u.pn * 128 + wc * 32 + fq * 8; const LAS float* rst = rs_table_fill(ss, u.pm);
#pragma unroll
        for (int ai = 0; ai < 2; ++ai)
#pragma unroll
            for (int m = 0; m < 4; ++m) {
                const int row = u.pm * 256 + ai * 128 + wr * 64 + m * 16 + fr; const float rs = rst[ai * 128 + wr * 64 + m * 16 + fr];
                float a[8];
#pragma unroll
                for (int n = 0; n < 2; ++n)
#pragma unroll
                    for (int e = 0; e < 4; ++e) { const float g = acc[ai][0][m][n][e] * rs, uu = acc[ai][1][m][n][e] * rs; a[n * 4 + e] = g * uu * fast_sigmoid(g); }
                u32x4 w; w.x = cvt_pk_bf16(a[0], a[1]); w.y = cvt_pk_bf16(a[2], a[3]); w.z = cvt_pk_bf16(a[4], a[5]); w.w = cvt_pk_bf16(a[6], a[7]);
                *(u32x4*)(O + (size_t)row * DFF + col) = w;
            }
    }
};
struct EpiMix {
    static constexpr bool PERM = false, AFTER_DRAIN = false;
    const float* ss; const float* tabc; const float* tabs; const float* qg; const float* kg; const float* bfg;
    u16 *RQK, *RV, *RG, *FQ, *FK, *FV, *ZG; float* out; float* lft;
    template <int MODE> static __device__ __forceinline__ void store8(const f32x4 (&acc)[2][2][4][2], u16* base, int ld, int t, int row, float rs, int ai, int m, int wc, int fq) {
#pragma unroll
        for (int bj = 0; bj < 2; ++bj) {
            float a[8];
#pragma unroll
            for (int n = 0; n < 2; ++n)
#pragma unroll
                for (int e = 0; e < 4; ++e) { const float v = acc[ai][bj][m][n][e] * rs; a[n * 4 + e] = MODE == 0 ? v : (MODE == 1 ? v * fast_sigmoid(v) : fast_sigmoid(v)); }
            u32x4 w; w.x = cvt_pk_bf16(a[0], a[1]); w.y = cvt_pk_bf16(a[2], a[3]); w.z = cvt_pk_bf16(a[4], a[5]); w.w = cvt_pk_bf16(a[6], a[7]);
            *(u32x4*)(base + (size_t)row * ld + t * 256 + bj * 128 + wc * 32 + fq * 8) = w;
        }
    }
    template <bool ISK> static __device__ __forceinline__ void headnorm(const f32x4 (&acc)[2][2][4][2], u16* dst, const float* gn, float* o, int row, float rs, int ai, int m, int head, int fq) {
        float q = 0.f;
#pragma unroll
        for (int bj = 0; bj < 2; ++bj)
#pragma unroll
            for (int n = 0; n < 2; ++n) { const f32x4 v = acc[ai][bj][m][n] * rs; q += (v[0] * v[0] + v[1] * v[1]) + (v[2] * v[2] + v[3] * v[3]); }
        q += __shfl_xor(q, 16); q += __shfl_xor(q, 32);
        const float hr = rsqrtf(q * (1.f / 64.f) + 1e-6f) * rs * (ISK ? 1.f : QC2);
#pragma unroll
        for (int bj = 0; bj < 2; ++bj)
#pragma unroll
            for (int n = 0; n < 2; ++n) {
                const int d = 32 * bj + 16 * n + 4 * fq; const f32x4 g4 = *(const f32x4*)(gn + d); const f32x4 v = acc[ai][bj][m][n] * hr * g4;
                u32x2 w; w.x = cvt_pk_bf16(v[0], v[1]); w.y = cvt_pk_bf16(v[2], v[3]);
                *(u32x2*)(dst + (size_t)row * 512 + head * 64 + d) = w;
                if (ISK) *(f32x4*)(o + head * 64 + d) = v;
            }
    }
    __device__ __forceinline__ void operator()(const f32x4 (&acc)[2][2][4][2], const pg8::Unit& u, int wr, int wc, int fr, int fq) const {
        const int pn = u.pn; const LAS float* rst = rs_table_fill(ss, u.pm);
#pragma unroll
        for (int ai = 0; ai < 2; ++ai)
#pragma unroll
            for (int m = 0; m < 4; ++m) {
                const int row = u.pm * 256 + ai * 128 + wr * 64 + m * 16 + fr; const float rs = rst[ai * 128 + wr * 64 + m * 16 + fr];
                if (pn < 4) {
                    const int pidx = row < MP ? (row & (SEQ - 1)) : SEQ + ((row - MP) & 15);
                    const int d = 16 * wc + 4 * fq;
                    const f32x4 c = *(const f32x4*)(tabc + pidx * 64 + d), s = *(const f32x4*)(tabs + pidx * 64 + d);
                    const float sc = rs * (pn >= 2 ? 0.08838834764831845f : 1.f);
#pragma unroll
                    for (int bj = 0; bj < 2; ++bj) {
                        const f32x4 x1 = acc[ai][bj][m][0] * sc, x2 = acc[ai][bj][m][1] * sc;
                        const f32x4 o1 = x1 * c - x2 * s, o2 = x1 * s + x2 * c;
                        u16* p = RQK + (size_t)row * 1024 + (pn >> 1) * 512 + (2 * (pn & 1) + bj) * 128 + d;
                        u32x2 w1, w2; w1.x = cvt_pk_bf16(o1[0], o1[1]); w1.y = cvt_pk_bf16(o1[2], o1[3]); w2.x = cvt_pk_bf16(o2[0], o2[1]); w2.y = cvt_pk_bf16(o2[2], o2[3]);
                        *(u32x2*)p = w1; *(u32x2*)(p + 64) = w2;
                    }
                } else if (pn < 8) { store8<0>(acc, RV, 1024, pn - 4, row, rs, ai, m, wc, fq);
                } else if (pn < 12) { store8<1>(acc, RG, 1024, pn - 8, row, rs, ai, m, wc, fq);
                } else if (pn >= 19) { store8<2>(acc, ZG, 2048, pn - 19, row, rs, ai, m, wc, fq);
                } else if (pn < 14) { headnorm<false>(acc, FQ, qg, nullptr, row, rs, ai, m, 4 * (pn & 1) + wc, fq);
                } else if (pn < 16) { headnorm<true>(acc, FK, kg, row < MP ? out + OUT_KP + (size_t)row * 512 : out + OUT_KS + (size_t)(row - MP) * 512, row, rs, ai, m, 4 * (pn & 1) + wc, fq);
                } else if (pn < 18) {
                    float* o = row < MP ? out + OUT_VP + (size_t)row * 512 : out + OUT_VS + (size_t)(row - MP) * 512;
#pragma unroll
                    for (int bj = 0; bj < 2; ++bj) {
                        const int col = (pn - 16) * 256 + bj * 128 + wc * 32 + fq * 8;
                        const f32x4 v0 = acc[ai][bj][m][0] * rs, v1 = acc[ai][bj][m][1] * rs;
                        u32x4 w; w.x = cvt_pk_bf16(v0[0], v0[1]); w.y = cvt_pk_bf16(v0[2], v0[3]); w.z = cvt_pk_bf16(v1[0], v1[1]); w.w = cvt_pk_bf16(v1[2], v1[3]);
                        *(u32x4*)(FV + (size_t)row * 512 + col) = w; *(f32x4*)(o + col) = v0; *(f32x4*)(o + col + 4) = v1;
                    }
                } else {
                    if (wc == 0 && fq == 0) {
                        float* o = row < MP ? out + OUT_LP + (size_t)row * 8 : out + OUT_LS + (size_t)(row - MP) * 8;
#pragma unroll
                        for (int n = 0; n < 2; ++n) { f32x4 r;
#pragma unroll
                            for (int e = 0; e < 4; ++e) { const float x = acc[ai][0][m][n][e] * rs + bfg[n * 4 + e]; r[e] = fminf(x, 0.f) - __logf(1.f + __expf(-fabsf(x))); }
                            *(f32x4*)(o + n * 4) = r;
                            if (row < MP) { float* lt = lft + ((size_t)(row >> 11) * 8 + n * 4) * SEQ + (row & (SEQ - 1)); lt[0] = r[0]; lt[SEQ] = r[1]; lt[2 * SEQ] = r[2]; lt[3 * SEQ] = r[3]; } }
                    }
                }
            }
    }
};
struct FResid {
    static constexpr bool NEED_RS = false, WRITE_SS = true; static constexpr int BATCH = 4;
    u16* XB; float* ss; float alpha;
    struct In { u32x4 x; };
    __device__ __forceinline__ In load(int row, int col) const { In r; r.x = *(const u32x4*)(XB + (size_t)row * 1024 + col); return r; }
    __device__ __forceinline__ float finish(int row, int col, const float (&v)[8], const In& in, float) const {
        const u32x4 x = in.x;
        const float r0 = bflo(x.x) + alpha * v[0], r1 = bfhi(x.x) + alpha * v[1], r2 = bflo(x.y) + alpha * v[2], r3 = bfhi(x.y) + alpha * v[3],
                    r4 = bflo(x.z) + alpha * v[4], r5 = bfhi(x.z) + alpha * v[5], r6 = bflo(x.w) + alpha * v[6], r7 = bfhi(x.w) + alpha * v[7];
        u32x4 w; w.x = cvt_pk_bf16(r0, r1); w.y = cvt_pk_bf16(r2, r3); w.z = cvt_pk_bf16(r4, r5); w.w = cvt_pk_bf16(r6, r7); *(u32x4*)(XB + (size_t)row * 1024 + col) = w;
        return ((r0 * r0 + r1 * r1) + (r2 * r2 + r3 * r3)) + ((r4 * r4 + r5 * r5) + (r6 * r6 + r7 * r7));
    }
};
template <bool SECOND> struct FGate {
    static constexpr bool NEED_RS = false, WRITE_SS = false; static constexpr int BATCH = 4;
    u16* T; const u16* ZG; float* ss;
    struct In { u32x4 g, p; };
    __device__ __forceinline__ In load(int row, int col) const { In r; r.g = *(const u32x4*)(ZG + (size_t)row * 2048 + (SECOND ? 1024 : 0) + col); if (SECOND) r.p = *(const u32x4*)(T + (size_t)row * 1024 + col); else r.p = (u32x4){0u, 0u, 0u, 0u}; return r; }
    __device__ __forceinline__ float finish(int row, int col, const float (&a)[8], const In& in, float) const {
        const u32x4 g = in.g, p = in.p;
        float v[8] = {bflo(g.x) * a[0], bfhi(g.x) * a[1], bflo(g.y) * a[2], bfhi(g.y) * a[3], bflo(g.z) * a[4], bfhi(g.z) * a[5], bflo(g.w) * a[6], bfhi(g.w) * a[7]};
        if (SECOND) { v[0] += bflo(p.x); v[1] += bfhi(p.x); v[2] += bflo(p.y); v[3] += bfhi(p.y); v[4] += bflo(p.z); v[5] += bfhi(p.z); v[6] += bflo(p.w); v[7] += bfhi(p.w); }
        u32x4 w; w.x = cvt_pk_bf16(v[0], v[1]); w.y = cvt_pk_bf16(v[2], v[3]); w.z = cvt_pk_bf16(v[4], v[5]); w.w = cvt_pk_bf16(v[6], v[7]);
        *(u32x4*)(T + (size_t)row * 1024 + col) = w; return 0.f;
    }
};
struct FPlain {
    static constexpr bool NEED_RS = false, WRITE_SS = false; static constexpr int BATCH = 4;
    u16* O; float* ss;
    struct In { int dummy; };
    __device__ __forceinline__ In load(int, int) const { In r; r.dummy = 0; return r; }
    __device__ __forceinline__ float finish(int row, int col, const float (&a)[8], const In&, float) const {
        u32x4 w; w.x = cvt_pk_bf16(a[0], a[1]); w.y = cvt_pk_bf16(a[2], a[3]); w.z = cvt_pk_bf16(a[4], a[5]); w.w = cvt_pk_bf16(a[6], a[7]);
        *(u32x4*)(O + (size_t)row * 1024 + col) = w; return 0.f;
    }
};
struct FFinal {
    static constexpr bool NEED_RS = true, WRITE_SS = false; static constexpr int BATCH = 2;
    float* yP; float* yS; const u16* XB; const u16* PLE; float* ss;
    struct In { u32x4 x, p; };
    __device__ __forceinline__ In load(int row, int col) const { In r; r.x = *(const u32x4*)(XB + (size_t)row * 1024 + col); r.p = *(const u32x4*)(PLE + (size_t)row * 1024 + col); return r; }
    __device__ __forceinline__ float finish(int row, int col, const float (&a)[8], const In& in, float rs) const {
        float* y = (row < MP ? yP + (size_t)row * 1024 : yS + (size_t)(row - MP) * 1024) + col;
        const u32x4 x = in.x, p = in.p;
        f32x4 y0, y1;
        y0[0] = bflo(x.x) + bflo(p.x) * fast_sigmoid(a[0] * rs); y0[1] = bfhi(x.x) + bfhi(p.x) * fast_sigmoid(a[1] * rs); y0[2] = bflo(x.y) + bflo(p.y) * fast_sigmoid(a[2] * rs); y0[3] = bfhi(x.y) + bfhi(p.y) * fast_sigmoid(a[3] * rs);
        y1[0] = bflo(x.z) + bflo(p.z) * fast_sigmoid(a[4] * rs); y1[1] = bfhi(x.z) + bfhi(p.z) * fast_sigmoid(a[5] * rs); y1[2] = bflo(x.w) + bflo(p.w) * fast_sigmoid(a[6] * rs); y1[3] = bfhi(x.w) + bfhi(p.w) * fast_sigmoid(a[7] * rs);
        *(f32x4*)y = y0; *(f32x4*)(y + 4) = y1; return 0.f;
    }
};
template <class F> struct EpiWrap {
    static constexpr bool PERM = false, AFTER_DRAIN = false;
    F f;
    __device__ __forceinline__ void operator()(const f32x4 (&acc)[2][2][4][2], const pg8::Unit& u, int wr, int wc, int fr, int fq) const {
        constexpr int NB = F::BATCH; const LAS float* rst = nullptr; if (F::NEED_RS) rst = rs_table_fill(f.ss, u.pm);
#pragma unroll
        for (int ab = 0; ab < 8 / NB; ++ab) {
            const int ai = (ab * NB) / 4, m0 = (ab * NB) % 4;
            typename F::In in[NB][2];
            const int row0 = u.pm * 256 + ai * 128 + wr * 64 + fr + m0 * 16, col0 = u.pn * 256 + wc * 32 + fq * 8;
#pragma unroll
            for (int m = 0; m < NB; ++m) {
#pragma unroll
                for (int bj = 0; bj < 2; ++bj) in[m][bj] = f.load(row0 + m * 16, col0 + bj * 128);
            }
            __builtin_amdgcn_sched_barrier(0);
#pragma unroll
            for (int m = 0; m < NB; ++m) {
                const int row = row0 + m * 16; float rs = 1.f;
                if (F::NEED_RS) rs = rst[ai * 128 + wr * 64 + (m0 + m) * 16 + fr];
                float q = 0.f;
#pragma unroll
                for (int bj = 0; bj < 2; ++bj) {
                    const float v[8] = {acc[ai][bj][m0 + m][0][0], acc[ai][bj][m0 + m][0][1], acc[ai][bj][m0 + m][0][2], acc[ai][bj][m0 + m][0][3], acc[ai][bj][m0 + m][1][0], acc[ai][bj][m0 + m][1][1], acc[ai][bj][m0 + m][1][2], acc[ai][bj][m0 + m][1][3]};
                    q += f.finish(row, col0 + bj * 128, v, in[m][bj], rs);
                }
                if (F::WRITE_SS) { q += __shfl_xor(q, 16); q += __shfl_xor(q, 32); if (fq == 0) f.ss[(size_t)row * 16 + u.pn * 4 + wc] = q; }
            }
        }
    }
};
template <class F> __device__ __forceinline__ void small_gemm(LAS unsigned char* lds, const u16* A, const u16* Bt, int K, const F& f, int bx, int G) {
    int tid = threadIdx.x; asm volatile("" : "+v"(tid));
    const int lane = tid & 63, w = __builtin_amdgcn_readfirstlane(tid >> 6), g = lane >> 4, c16 = lane & 15;
    LAS float* red = (LAS float*)lds;
    const int steps = K / 256;
    for (int item = bx; item < 256; item += G) {
        const int rb = item >> 4, cb = item & 15;
        const u16* ap = A + (size_t)(16 * rb + c16) * K + (size_t)w * (K / 8) + 8 * g;
        const u16* bp = Bt + (size_t)(64 * cb + c16) * K + (size_t)w * (K / 8) + 8 * g;
        f32x4 acc[4];
#pragma unroll
        for (int nt = 0; nt < 4; ++nt) acc[nt] = (f32x4){0.f, 0.f, 0.f, 0.f};
        for (int s0 = 0; s0 < steps; s0 += 4) {
            bf16x8 a[4], b[4][4];
#pragma unroll
            for (int j = 0; j < 4; ++j) if (s0 + j < steps) { a[j] = *(const bf16x8*)(ap + 32 * (s0 + j));
#pragma unroll
                for (int nt = 0; nt < 4; ++nt) b[j][nt] = *(const bf16x8*)(bp + (size_t)16 * nt * K + 32 * (s0 + j)); }
#pragma unroll
            for (int j = 0; j < 4; ++j) if (s0 + j < steps) {
#pragma unroll
                for (int nt = 0; nt < 4; ++nt) acc[nt] = __builtin_amdgcn_mfma_f32_16x16x32_bf16(a[j], b[j][nt], acc[nt], 0, 0, 0); }
        }
        __syncthreads();
#pragma unroll
        for (int nt = 0; nt < 4; ++nt)
#pragma unroll
            for (int i = 0; i < 4; ++i) red[(w * 16 + 4 * g + i) * 64 + 16 * nt + c16] = acc[nt][i];
        __syncthreads();
        if (tid < 128) {
            const int row = tid >> 3, c8 = tid & 7, p0 = 32 * (c8 >> 2) + 4 * (c8 & 3);
            f32x4 s0 = {0.f, 0.f, 0.f, 0.f}, s1 = {0.f, 0.f, 0.f, 0.f};
#pragma unroll
            for (int ww = 0; ww < 8; ++ww) { s0 += *(const LAS f32x4*)(red + (ww * 16 + row) * 64 + p0); s1 += *(const LAS f32x4*)(red + (ww * 16 + row) * 64 + p0 + 16); }
            const float v[8] = {s0[0], s0[1], s0[2], s0[3], s1[0], s1[1], s1[2], s1[3]};
            const int grow = MP + 16 * rb + row; float rs = 1.f; if (F::NEED_RS) rs = rstd_of(f.ss, grow);
            const typename F::In in = f.load(grow, 64 * cb + 8 * c8); float q = f.finish(grow, 64 * cb + 8 * c8, v, in, rs);
            if (F::WRITE_SS) { q += __shfl_xor(q, 1); q += __shfl_xor(q, 2); q += __shfl_xor(q, 4); if (c8 == 0) f.ss[(size_t)grow * 16 + cb] = q; }
        }
    }
    __syncthreads();
}
__device__ __forceinline__ int logical_col(int kind, int pr) {
    const int t = pr >> 8, q = pr & 255, g = gcol(q);
    if (kind == 0) return t * 256 + g;
    if (kind == 1) { const int bj = q >> 7; return bj * DFF + t * 128 + (g & 127); }
    const int bj = q >> 7, wc = (q >> 5) & 3, n = (q >> 4) & 1, fq = (q >> 2) & 3, e = q & 3;
    if (t < 4) return (t >> 1) * 512 + (2 * (t & 1) + bj) * 128 + 16 * wc + 4 * fq + e + 64 * n;
    if (t < 8) return 1024 + (t - 4) * 256 + g;
    if (t < 12) return 2048 + (t - 8) * 256 + g;
    if (t < 16) return (t < 14 ? 3072 : 3584) + (4 * (t & 1) + wc) * 64 + 32 * bj + 16 * n + 4 * fq + e;
    if (t < 18) return 4096 + (t - 16) * 256 + g;
    if (t == 18) return g < 8 ? 4608 + g : -1;
    return 4616 + (t - 19) * 256 + g;
}
__device__ __forceinline__ void transpose_item(const float* W, const float* gain, int K, int Nlog, int kind, u16* WT, int nblk, LAS float* scr, int item, int lane) {
    const int kb = item / nblk, nb = item % nblk, k0 = 64 * kb, n0 = 32 * nb;
    const int lc = logical_col(kind, n0 + (lane & 31));
    float tv[32];
#pragma unroll
    for (int i = 0; i < 32; ++i) { const int kk = 2 * i + (lane >> 5); tv[i] = (lc >= 0) ? W[(size_t)(k0 + kk) * Nlog + lc] : 0.f; }
#pragma unroll
    for (int i = 0; i < 32; ++i) { const int kk = 2 * i + (lane >> 5); float v = tv[i]; if (gain) v *= gain[k0 + kk]; scr[kk * 33 + (lane & 31)] = v; }
    asm volatile("s_waitcnt lgkmcnt(0)" ::: "memory");
    const int c = lane & 7;
#pragma unroll
    for (int j = 0; j < 4; ++j) { const int n = (lane >> 3) + 8 * j; const LAS float* s = scr + (8 * c) * 33 + n;
        u32x4 o; o.x = cvt_pk_bf16(s[0 * 33], s[1 * 33]); o.y = cvt_pk_bf16(s[2 * 33], s[3 * 33]); o.z = cvt_pk_bf16(s[4 * 33], s[5 * 33]); o.w = cvt_pk_bf16(s[6 * 33], s[7 * 33]);
        *(u32x4*)(WT + (size_t)(n0 + n) * K + k0 + 8 * c) = o; }
    asm volatile("s_waitcnt lgkmcnt(0)" ::: "memory");
}

constexpr int R_QS = 0, R_KS = 17408, R_KDT = 34816, R_VT = 53248, R_AS = 90112, R_RED = 99328, R_RSTD = 101376, R_END = 101632;
template <int CH>
__device__ __forceinline__ void ret_item(LAS unsigned char* lds, const u16* RQK, u16* RV, const u16* RG, const float* s0, float* sout, size_t rowbase, int nchunks, int h) {
    constexpr int TT = CH / 16, KSN = (CH + 31) / 32;
    int tid = threadIdx.x; asm volatile("" : "+v"(tid)); const int lane = tid & 63, w = __builtin_amdgcn_readfirstlane(tid >> 6), g = lane >> 4, c16 = lane & 15;
    LAS u16* Qs = (LAS u16*)(lds + R_QS); LAS u16* Ks = (LAS u16*)(lds + R_KS); LAS u16* KdT = (LAS u16*)(lds + R_KDT); LAS u16* VT = (LAS u16*)(lds + R_VT); LAS u16* As = (LAS u16*)(lds + R_AS);
    LAS float* red = (LAS float*)(lds + R_RED); LAS float* rstdv = (LAS float*)(lds + R_RSTD);
    const float lg2 = __log2f(1.f - __builtin_amdgcn_exp2f(-5.f - (float)h));
    f32x4 S[8][2];
#pragma unroll
    for (int kt = 0; kt < 8; ++kt)
#pragma unroll
        for (int nt = 0; nt < 2; ++nt)
#pragma unroll
            for (int i = 0; i < 4; ++i) S[kt][nt][i] = s0 ? s0[(size_t)(16 * kt + 4 * g + i) * 256 + 32 * w + 16 * nt + c16] : 0.f;
    __syncthreads();
    if (CH < 32) {
        for (int i = tid; i < (R_RED - R_KDT) / 4; i += 512) ((LAS unsigned*)(lds + R_KDT))[i] = 0u;
        __syncthreads();
    }
    for (int c = 0; c < nchunks; ++c) {
        const size_t row0 = rowbase + (size_t)c * CH;
        __syncthreads();
        for (int p = tid; p < CH * 16; p += 512) {
            const int r = p >> 4, cc = p & 15;
            const u32x4 q = *(const u32x4*)(RQK + (row0 + r) * 1024 + h * 128 + cc * 8);
            const u32x4 k = *(const u32x4*)(RQK + (row0 + r) * 1024 + 512 + h * 128 + cc * 8);
            *(LAS u32x4*)(Qs + r * 136 + cc * 8) = q; *(LAS u32x4*)(Ks + r * 136 + cc * 8) = k;
            const float dec = __builtin_amdgcn_exp2f(lg2 * (float)(CH - 1 - r));
            const unsigned kw[4] = {k.x, k.y, k.z, k.w};
#pragma unroll
            for (int j = 0; j < 4; ++j) { const unsigned pk = cvt_pk_bf16(bflo(kw[j]) * dec, bfhi(kw[j]) * dec); KdT[(cc * 8 + 2 * j) * 72 + r] = (u16)(pk & 0xffffu); KdT[(cc * 8 + 2 * j + 1) * 72 + r] = (u16)(pk >> 16); }
        }
        for (int p = tid; p < CH * 32; p += 512) {
            const int r = p >> 5, cc = p & 31;
            const u32x4 v = *(const u32x4*)(RV + (row0 + r) * 1024 + h * 256 + cc * 8);
            const unsigned vw[4] = {v.x, v.y, v.z, v.w};
#pragma unroll
            for (int j = 0; j < 4; ++j) { VT[(cc * 8 + 2 * j) * 72 + r] = (u16)(vw[j] & 0xffffu); VT[(cc * 8 + 2 * j + 1) * 72 + r] = (u16)(vw[j] >> 16); }
        }
        __syncthreads();
        for (int tile = w; tile < TT * TT; tile += 8) {
            const int ti = tile / TT, tj = tile % TT; f32x4 a4 = {0.f, 0.f, 0.f, 0.f};
#pragma unroll
            for (int kk = 0; kk < 4; ++kk) {
                const bf16x8 a = *(const LAS bf16x8*)(Qs + (16 * ti + c16) * 136 + 32 * kk + 8 * g), b = *(const LAS bf16x8*)(Ks + (16 * tj + c16) * 136 + 32 * kk + 8 * g);
                a4 = __builtin_amdgcn_mfma_f32_16x16x32_bf16(a, b, a4, 0, 0, 0);
            }
#pragma unroll
            for (int i = 0; i < 4; ++i) { const int ri = 16 * ti + 4 * g + i, cj = 16 * tj + c16; const int dd = ri > cj ? ri - cj : cj - ri;
                const unsigned pk = cvt_pk_bf16(a4[i] * __builtin_amdgcn_exp2f(lg2 * (float)dd), 0.f); As[ri * 72 + cj] = (u16)(pk & 0xffffu); }
        }
        bf16x8 sb[4][2];
#pragma unroll
        for (int kk = 0; kk < 4; ++kk)
#pragma unroll
            for (int nt = 0; nt < 2; ++nt) { u32x4 t; t.x = cvt_pk_bf16(S[2 * kk][nt][0], S[2 * kk][nt][1]); t.y = cvt_pk_bf16(S[2 * kk][nt][2], S[2 * kk][nt][3]);
                t.z = cvt_pk_bf16(S[2 * kk + 1][nt][0], S[2 * kk + 1][nt][1]); t.w = cvt_pk_bf16(S[2 * kk + 1][nt][2], S[2 * kk + 1][nt][3]); sb[kk][nt] = __builtin_bit_cast(bf16x8, t); }
        f32x4 O[TT][2];
#pragma unroll
        for (int tt = 0; tt < TT; ++tt) {
            f32x4 o0 = {0.f, 0.f, 0.f, 0.f}, o1 = {0.f, 0.f, 0.f, 0.f};
#pragma unroll
            for (int kk = 0; kk < 4; ++kk) {
                const u32x2 lo = *(const LAS u32x2*)(Qs + (16 * tt + c16) * 136 + 32 * kk + 4 * g), hi = *(const LAS u32x2*)(Qs + (16 * tt + c16) * 136 + 32 * kk + 16 + 4 * g);
                u32x4 t; t.x = lo.x; t.y = lo.y; t.z = hi.x; t.w = hi.y; const bf16x8 a = __builtin_bit_cast(bf16x8, t);
                o0 = __builtin_amdgcn_mfma_f32_16x16x32_bf16(a, sb[kk][0], o0, 0, 0, 0); o1 = __builtin_amdgcn_mfma_f32_16x16x32_bf16(a, sb[kk][1], o1, 0, 0, 0);
            }
#pragma unroll
            for (int i = 0; i < 4; ++i) { const float dsc = __builtin_amdgcn_exp2f(lg2 * (float)(16 * tt + 4 * g + i + 1)); o0[i] *= dsc; o1[i] *= dsc; }
            O[tt][0] = o0; O[tt][1] = o1;
        }
        __syncthreads();
#pragma unroll
        for (int tt = 0; tt < TT; ++tt)
#pragma unroll
            for (int ks = 0; ks < KSN; ++ks) {
                const bf16x8 a = *(const LAS bf16x8*)(As + (16 * tt + c16) * 72 + 32 * ks + 8 * g);
#pragma unroll
                for (int nt = 0; nt < 2; ++nt) { const bf16x8 b = *(const LAS bf16x8*)(VT + (32 * w + 16 * nt + c16) * 72 + 32 * ks + 8 * g); O[tt][nt] = __builtin_amdgcn_mfma_f32_16x16x32_bf16(a, b, O[tt][nt], 0, 0, 0); }
            }
#pragma unroll
        for (int tt = 0; tt < TT; ++tt)
#pragma unroll
            for (int i = 0; i < 4; ++i) { float q = O[tt][0][i] * O[tt][0][i] + O[tt][1][i] * O[tt][1][i]; q += __shfl_xor(q, 1); q += __shfl_xor(q, 2); q += __shfl_xor(q, 4); q += __shfl_xor(q, 8);
                if (c16 == 0) red[w * 64 + 16 * tt + 4 * g + i] = q; }
        __syncthreads();
        if (tid < CH) { float s = 0.f;
#pragma unroll
            for (int ww = 0; ww < 8; ++ww) s += red[ww * 64 + tid];
            rstdv[tid] = rsqrtf(s * (1.f / 256.f) + 1e-6f); }
        __syncthreads();
#pragma unroll
        for (int tt = 0; tt < TT; ++tt)
#pragma unroll
            for (int i = 0; i < 4; ++i) { const int tok = 16 * tt + 4 * g + i; const float rsd = rstdv[tok];
#pragma unroll
                for (int nt = 0; nt < 2; ++nt) { const size_t off = (row0 + tok) * 1024 + h * 256 + 32 * w + 16 * nt + c16; const float gt = bf2f(RG[off]);
                    const unsigned pk = cvt_pk_bf16(O[tt][nt][i] * rsd * gt, 0.f); RV[off] = (u16)(pk & 0xffffu); } }
        const float cd = __builtin_amdgcn_exp2f(lg2 * (float)CH);
#pragma unroll
        for (int kt = 0; kt < 8; ++kt)
#pragma unroll
            for (int nt = 0; nt < 2; ++nt) S[kt][nt] = S[kt][nt] * cd;
#pragma unroll
        for (int ks = 0; ks < KSN; ++ks) {
            const bf16x8 b0 = *(const LAS bf16x8*)(VT + (32 * w + c16) * 72 + 32 * ks + 8 * g), b1 = *(const LAS bf16x8*)(VT + (32 * w + 16 + c16) * 72 + 32 * ks + 8 * g);
#pragma unroll
            for (int kt = 0; kt < 8; ++kt) { const bf16x8 a = *(const LAS bf16x8*)(KdT + (16 * kt + c16) * 72 + 32 * ks + 8 * g);
                S[kt][0] = __builtin_amdgcn_mfma_f32_16x16x32_bf16(a, b0, S[kt][0], 0, 0, 0); S[kt][1] = __builtin_amdgcn_mfma_f32_16x16x32_bf16(a, b1, S[kt][1], 0, 0, 0); }
        }
    }
#pragma unroll
    for (int kt = 0; kt < 8; ++kt)
#pragma unroll
        for (int nt = 0; nt < 2; ++nt)
#pragma unroll
            for (int i = 0; i < 4; ++i) sout[(size_t)(16 * kt + 4 * g + i) * 256 + 32 * w + 16 * nt + c16] = S[kt][nt][i];
    __syncthreads();
}
constexpr int R2_QS = 0, R2_KS = 17408, R2_KDT = 34816, R2_VT = 53248, R2_AS = 90112, R2_OS = 99328, R2_RED = 133120, R2_RSTD = 135168, R2_END = 135424;
__device__ __forceinline__ void ret_prompt_item(LAS unsigned char* lds, const u16* RQK, u16* RV, const u16* RG, float* sout, size_t rowbase, int h) {
    int tid = threadIdx.x; asm volatile("" : "+v"(tid));
    const int lane = tid & 63, w = __builtin_amdgcn_readfirstlane(tid >> 6), g = lane >> 4, c16 = lane & 15;
    LAS u16* Qs = (LAS u16*)(lds + R2_QS); LAS u16* Ks = (LAS u16*)(lds + R2_KS); LAS u16* KdT = (LAS u16*)(lds + R2_KDT); LAS u16* VT = (LAS u16*)(lds + R2_VT); LAS u16* As = (LAS u16*)(lds + R2_AS);
    LAS u16* Os = (LAS u16*)(lds + R2_OS); LAS float* red = (LAS float*)(lds + R2_RED); LAS float* rstdv = (LAS float*)(lds + R2_RSTD);
#define RBAR() asm volatile("s_waitcnt lgkmcnt(0)\n\ts_barrier" ::: "memory")
    const float lg2 = __log2f(1.f - __builtin_amdgcn_exp2f(-5.f - (float)h));
    const int rq = tid >> 4, cq = tid & 15;
    const int rv = tid >> 5, cv = tid & 31;
    const u16* gq = RQK + (rowbase + rq) * 1024 + h * 128 + cq * 8;
    const size_t voff = (rowbase + rv) * 1024 + h * 256 + cv * 8;
    u32x4 pq[2], pk[2], pv[4], pgc[4];
#define RLOAD(c) do { const size_t co_ = (size_t)(c) * 64 * 1024; \
        _Pragma("unroll") for (int i_ = 0; i_ < 2; ++i_) { pq[i_] = *(const u32x4*)(gq + co_ + (size_t)i_ * 32 * 1024); pk[i_] = *(const u32x4*)(gq + co_ + (size_t)i_ * 32 * 1024 + 512); } \
        _Pragma("unroll") for (int i_ = 0; i_ < 4; ++i_) { pv[i_] = *(const u32x4*)(RV + voff + co_ + (size_t)i_ * 16 * 1024); } } while (0)
#define GLOAD(c) do { const size_t co_ = (size_t)(c) * 64 * 1024; _Pragma("unroll") for (int i_ = 0; i_ < 4; ++i_) pgc[i_] = *(const u32x4*)(RG + voff + co_ + (size_t)i_ * 16 * 1024); } while (0)
    const int hb = c16 >> 3;
    const LAS u16* kb0 = KdT + c16 * 72 + ((g ^ hb) << 3); const LAS u16* kb2 = KdT + c16 * 72 + ((g ^ hb ^ 2) << 3);
    f32x4 S[8][2];
#pragma unroll
    for (int kt = 0; kt < 8; ++kt)
#pragma unroll
        for (int nt = 0; nt < 2; ++nt) S[kt][nt] = (f32x4){0.f, 0.f, 0.f, 0.f};
    RLOAD(0);
    asm volatile("s_waitcnt lgkmcnt(0)\n\ts_barrier" ::: "memory");
    const float cd = __builtin_amdgcn_exp2f(lg2 * 64.f);
    for (int c = 0; c < 32; ++c) {
        float lg = lg2, gf = (float)(4 * g), cf = (float)c16, rqf = (float)(63 - rq); int tw = w; asm volatile("" : "+v"(lg), "+v"(gf), "+v"(cf), "+v"(rqf), "+s"(tw));
#pragma unroll
        for (int i = 0; i < 2; ++i) {
            const int r = rq + 32 * i;
            *(LAS u32x4*)(Qs + r * 136 + cq * 8) = pq[i]; *(LAS u32x4*)(Ks + r * 136 + cq * 8) = pk[i];
            const float dec = __builtin_amdgcn_exp2f(lg * (rqf - (float)(32 * i)));
            const int pc = (((r >> 3) ^ (cq & 7)) << 3) | (r & 7);
            const unsigned kw[4] = {pk[i].x, pk[i].y, pk[i].z, pk[i].w};
#pragma unroll
            for (int j = 0; j < 4; ++j) { const unsigned pkd = cvt_pk_bf16(bflo(kw[j]) * dec, bfhi(kw[j]) * dec); KdT[(cq * 8 + 2 * j) * 72 + pc] = (u16)(pkd & 0xffffu); KdT[(cq * 8 + 2 * j + 1) * 72 + pc] = (u16)(pkd >> 16); }
        }
#pragma unroll
        for (int i = 0; i < 4; ++i) {
            const int r = rv + 16 * i; const int pc = (((r >> 3) ^ (cv & 7)) << 3) | (r & 7);
            const unsigned vw[4] = {pv[i].x, pv[i].y, pv[i].z, pv[i].w};
#pragma unroll
            for (int j = 0; j < 4; ++j) { VT[(cv * 8 + 2 * j) * 72 + pc] = (u16)(vw[j] & 0xffffu); VT[(cv * 8 + 2 * j + 1) * 72 + pc] = (u16)(vw[j] >> 16); }
        }
        __builtin_amdgcn_sched_barrier(0);
        RBAR();
#pragma unroll
        for (int t2 = 0; t2 < 2; ++t2) {
            const int tile = tw + 8 * t2, ti = tile >> 2, tj = tile & 3; f32x4 a4 = {0.f, 0.f, 0.f, 0.f}; const float dbase = (gf - cf) + (float)(16 * (ti - tj));
#pragma unroll
            for (int kk = 0; kk < 4; ++kk) {
                const bf16x8 a = *(const LAS bf16x8*)(Qs + (16 * ti + c16) * 136 + 32 * kk + 8 * g), b = *(const LAS bf16x8*)(Ks + (16 * tj + c16) * 136 + 32 * kk + 8 * g);
                a4 = __builtin_amdgcn_mfma_f32_16x16x32_bf16(a, b, a4, 0, 0, 0);
            }
#pragma unroll
            for (int i = 0; i < 4; ++i) { const int ri = 16 * ti + 4 * g + i, cj = 16 * tj + c16;
                const unsigned pkd = cvt_pk_bf16(a4[i] * __builtin_amdgcn_exp2f(lg * __builtin_fabsf(dbase + (float)i)), 0.f); As[ri * 72 + cj] = (u16)(pkd & 0xffffu); }
        }
        f32x4 O[4][2];
#pragma unroll
        for (int tt = 0; tt < 4; ++tt) { O[tt][0] = (f32x4){0.f, 0.f, 0.f, 0.f}; O[tt][1] = (f32x4){0.f, 0.f, 0.f, 0.f}; }
#pragma unroll
        for (int kk = 0; kk < 4; ++kk) {
            bf16x8 sb[2];
#pragma unroll
            for (int nt = 0; nt < 2; ++nt) { u32x4 t; t.x = cvt_pk_bf16(S[2 * kk][nt][0], S[2 * kk][nt][1]); t.y = cvt_pk_bf16(S[2 * kk][nt][2], S[2 * kk][nt][3]);
                t.z = cvt_pk_bf16(S[2 * kk + 1][nt][0], S[2 * kk + 1][nt][1]); t.w = cvt_pk_bf16(S[2 * kk + 1][nt][2], S[2 * kk + 1][nt][3]); sb[nt] = __builtin_bit_cast(bf16x8, t); }
#pragma unroll
            for (int tt = 0; tt < 4; ++tt) {
                const u32x2 lo = *(const LAS u32x2*)(Qs + (16 * tt + c16) * 136 + 32 * kk + 4 * g), hi = *(const LAS u32x2*)(Qs + (16 * tt + c16) * 136 + 32 * kk + 16 + 4 * g);
                u32x4 t; t.x = lo.x; t.y = lo.y; t.z = hi.x; t.w = hi.y; const bf16x8 a = __builtin_bit_cast(bf16x8, t);
                O[tt][0] = __builtin_amdgcn_mfma_f32_16x16x32_bf16(a, sb[0], O[tt][0], 0, 0, 0); O[tt][1] = __builtin_amdgcn_mfma_f32_16x16x32_bf16(a, sb[1], O[tt][1], 0, 0, 0);
            }
            __builtin_amdgcn_sched_barrier(0);
        }
#pragma unroll
        for (int tt = 0; tt < 4; ++tt)
#pragma unroll
            for (int i = 0; i < 4; ++i) { const float dsc = __builtin_amdgcn_exp2f(lg * (gf + (float)(16 * tt + i + 1))); O[tt][0][i] *= dsc; O[tt][1][i] *= dsc; }
        RBAR();
        if (c + 1 < 32) RLOAD(c + 1);
        const int vsw0 = (4 * w + (c16 >> 3)) & 7, vsw1 = (4 * w + 2 + (c16 >> 3)) & 7;
        bf16x8 vb[2][2];
#pragma unroll
        for (int ks = 0; ks < 2; ++ks) { vb[ks][0] = *(const LAS bf16x8*)(VT + (32 * w + c16) * 72 + (((4 * ks + g) ^ vsw0) << 3)); vb[ks][1] = *(const LAS bf16x8*)(VT + (32 * w + 16 + c16) * 72 + (((4 * ks + g) ^ vsw1) << 3)); }
#pragma unroll
        for (int tt = 0; tt < 4; ++tt)
#pragma unroll
            for (int ks = 0; ks < 2; ++ks) {
                const bf16x8 a = *(const LAS bf16x8*)(As + (16 * tt + c16) * 72 + 32 * ks + 8 * g);
                O[tt][0] = __builtin_amdgcn_mfma_f32_16x16x32_bf16(a, vb[ks][0], O[tt][0], 0, 0, 0); O[tt][1] = __builtin_amdgcn_mfma_f32_16x16x32_bf16(a, vb[ks][1], O[tt][1], 0, 0, 0); __builtin_amdgcn_sched_barrier(0);
            }
#pragma unroll
        for (int tt = 0; tt < 4; ++tt)
#pragma unroll
            for (int i = 0; i < 4; ++i) { const int tok = 16 * tt + 4 * g + i;
                float q = O[tt][0][i] * O[tt][0][i] + O[tt][1][i] * O[tt][1][i]; q += __shfl_xor(q, 1); q += __shfl_xor(q, 2); q += __shfl_xor(q, 4); q += __shfl_xor(q, 8);
                if (c16 == 0) red[tok * 8 + w] = q;
#pragma unroll
                for (int nt = 0; nt < 2; ++nt) { const unsigned pkd = cvt_pk_bf16(O[tt][nt][i], 0.f); Os[tok * 264 + 32 * w + 16 * nt + c16] = (u16)(pkd & 0xffffu); } }
        __builtin_amdgcn_sched_barrier(0);
        GLOAD(c);
#pragma unroll
        for (int kt = 0; kt < 8; ++kt) { S[kt][0] = S[kt][0] * cd; S[kt][1] = S[kt][1] * cd; }
#pragma unroll
        for (int ks = 0; ks < 2; ++ks)
#pragma unroll
            for (int kt = 0; kt < 8; ++kt) { const bf16x8 a = *(const LAS bf16x8*)(((kt & 1) ? kb2 : kb0) + 16 * kt * 72 + (((4 * ks) ^ ((kt & 2) ? 4 : 0)) << 3));
                S[kt][0] = __builtin_amdgcn_mfma_f32_16x16x32_bf16(a, vb[ks][0], S[kt][0], 0, 0, 0); S[kt][1] = __builtin_amdgcn_mfma_f32_16x16x32_bf16(a, vb[ks][1], S[kt][1], 0, 0, 0); if (kt & 1) __builtin_amdgcn_sched_barrier(0); }
        RBAR();
#pragma unroll
        for (int i = 0; i < 4; ++i) {
            const int tok = rv + 16 * i; const f32x4 p0 = *(const LAS f32x4*)(red + tok * 8), p1 = *(const LAS f32x4*)(red + tok * 8 + 4);
            const float rsd = rsqrtf((((p0[0] + p0[1]) + (p0[2] + p0[3])) + ((p1[0] + p1[1]) + (p1[2] + p1[3]))) * (1.f / 256.f) + 1e-6f);
            const u32x4 o = *(const LAS u32x4*)(Os + tok * 264 + cv * 8); const u32x4 gt = pgc[i]; u32x4 r;
            r.x = cvt_pk_bf16(bflo(o.x) * rsd * bflo(gt.x), bfhi(o.x) * rsd * bfhi(gt.x)); r.y = cvt_pk_bf16(bflo(o.y) * rsd * bflo(gt.y), bfhi(o.y) * rsd * bfhi(gt.y));
            r.z = cvt_pk_bf16(bflo(o.z) * rsd * bflo(gt.z), bfhi(o.z) * rsd * bfhi(gt.z)); r.w = cvt_pk_bf16(bflo(o.w) * rsd * bflo(gt.w), bfhi(o.w) * rsd * bfhi(gt.w));
            *(u32x4*)(RV + voff + (size_t)c * 64 * 1024 + (size_t)i * 16 * 1024) = r;
        }
    }
#pragma unroll
    for (int kt = 0; kt < 8; ++kt)
#pragma unroll
        for (int nt = 0; nt < 2; ++nt)
#pragma unroll
            for (int i = 0; i < 4; ++i) sout[(size_t)(16 * kt + 4 * g + i) * 256 + 32 * w + 16 * nt + c16] = S[kt][nt][i];
    __syncthreads();
#undef RBAR
#undef RLOAD
#undef GLOAD
}
constexpr int F2_BIAS = 0, F2_WS = 16512, F2_AW = 16640, F2_P = 17408, F2_M = 50176, F2_L = 50688, F2_ACC = 51200, F2_END = 83968;
__device__ __forceinline__ void fox_sample_item2(LAS unsigned char* lds, int b, int h, u16* FQ, const u16* FK, const u16* FV, const float* ck, const float* cv, const float* clf, const float* lfnew) {
    int tid = threadIdx.x; asm volatile("" : "+v"(tid));
    const int lane = tid & 63, w = __builtin_amdgcn_readfirstlane(tid >> 6), g = lane >> 4, c16 = lane & 15;
    LAS float* BIAS = (LAS float*)(lds + F2_BIAS); LAS float* WS = (LAS float*)(lds + F2_WS); LAS float* Aw = (LAS float*)(lds + F2_AW) + w * 16;
    LAS float* Pw = (LAS float*)(lds + F2_P) + w * 1024; LAS float* Mx = (LAS float*)(lds + F2_M); LAS float* Lx = (LAS float*)(lds + F2_L); LAS float* ACC = (LAS float*)(lds + F2_ACC);
    const size_t srow = (size_t)MP + (size_t)b * 16;
    __syncthreads();
    bf16x8 qa[2];
#pragma unroll
    for (int ks = 0; ks < 2; ++ks) qa[ks] = *(const bf16x8*)(FQ + (srow + c16) * 512 + h * 64 + 32 * ks + 8 * g);
    {
        float v[8]; float run = 0.f;
#pragma unroll
        for (int j = 0; j < 8; ++j) { run += clf[((size_t)b * PAST + 8 * tid + j) * 8 + h]; v[j] = run; }
        float tot = run;
#pragma unroll
        for (int o = 1; o < 64; o <<= 1) { const float u = __shfl_up(tot, o); if (lane >= o) tot += u; }
        if (lane == 63) WS[w] = tot;
        __syncthreads();
        float base = tot - run, all = 0.f;
#pragma unroll
        for (int ww = 0; ww < 8; ++ww) { const float x = WS[ww]; all += x; if (ww < w) base += x; }
#pragma unroll
        for (int j = 0; j < 8; ++j) BIAS[8 * tid + j] = (all - (base + v[j])) * L2E;
        if (tid == 0) { float cn = 0.f; for (int t = 0; t < 16; ++t) { cn += lfnew[((size_t)b * 16 + t) * 8 + h]; BIAS[PAST + t] = -cn * L2E; } }
    }
    __syncthreads();
    float mrun[4], lrun[4]; f32x4 acc[16];
    const int rr = lane >> 4, cc = lane & 15;
#pragma unroll
    for (int i = 0; i < 4; ++i) { mrun[i] = -INFINITY; lrun[i] = 0.f; }
#pragma unroll
    for (int t = 0; t < 16; ++t) acc[t] = (f32x4){0.f, 0.f, 0.f, 0.f};
    const int niter = (w == 0) ? 9 : 8;
    for (int it = 0; it < niter; ++it) {
        const bool isnew = it == 8;
        const int key0 = isnew ? 0 : 512 * w + 64 * it;
        f32x4 s[4]; f32x4 vv[16];
        if (!isnew) {
            f32x4 kf[4][2][2];
#pragma unroll
            for (int t = 0; t < 4; ++t) { const f32x4* kp = (const f32x4*)(ck + (((size_t)b * PAST + key0 + 16 * t + c16) * 8 + h) * 64 + 8 * g);
#pragma unroll
                for (int ks = 0; ks < 2; ++ks) { kf[t][ks][0] = kp[8 * ks]; kf[t][ks][1] = kp[8 * ks + 1]; } }
#pragma unroll
            for (int t = 0; t < 4; ++t) { f32x4 a4 = {0.f, 0.f, 0.f, 0.f};
#pragma unroll
                for (int ks = 0; ks < 2; ++ks) { u32x4 kb; kb.x = cvt_pk_bf16(kf[t][ks][0][0], kf[t][ks][0][1]); kb.y = cvt_pk_bf16(kf[t][ks][0][2], kf[t][ks][0][3]); kb.z = cvt_pk_bf16(kf[t][ks][1][0], kf[t][ks][1][1]); kb.w = cvt_pk_bf16(kf[t][ks][1][2], kf[t][ks][1][3]);
                    a4 = __builtin_amdgcn_mfma_f32_16x16x32_bf16(qa[ks], __builtin_bit_cast(bf16x8, kb), a4, 0, 0, 0); }
                const float bl = BIAS[key0 + 16 * t + c16];
                s[t] = a4 + bl; }
            { const f32x4* vp = (const f32x4*)(cv + (((size_t)b * PAST + key0 + rr) * 8 + h) * 64 + 4 * cc);
#pragma unroll
              for (int j = 0; j < 16; ++j) vv[j] = vp[(size_t)j * 4 * 128]; }
        } else {
            f32x4 a4 = {0.f, 0.f, 0.f, 0.f};
#pragma unroll
            for (int ks = 0; ks < 2; ++ks) { const bf16x8 kb = *(const bf16x8*)(FK + (srow + c16) * 512 + h * 64 + 32 * ks + 8 * g); a4 = __builtin_amdgcn_mfma_f32_16x16x32_bf16(qa[ks], kb, a4, 0, 0, 0); }
            const float bl = BIAS[PAST + c16];
#pragma unroll
            for (int i = 0; i < 4; ++i) s[0][i] = (c16 > 4 * g + i) ? -INFINITY : a4[i] + bl;
#pragma unroll
            for (int t = 1; t < 4; ++t) s[t] = (f32x4){-INFINITY, -INFINITY, -INFINITY, -INFINITY};
#pragma unroll
            for (int j = 0; j < 16; ++j) { if (j < 4) { const u32x2 x = *(const u32x2*)(FV + (srow + 4 * j + rr) * 512 + h * 64 + 4 * cc); vv[j] = (f32x4){bflo(x.x), bfhi(x.x), bflo(x.y), bfhi(x.y)}; } else vv[j] = (f32x4){0.f, 0.f, 0.f, 0.f}; }
        }
#pragma unroll
        for (int i = 0; i < 4; ++i) {
            float tm = fmaxf(fmaxf(s[0][i], s[1][i]), fmaxf(s[2][i], s[3][i]));
            tm = fmaxf(tm, __shfl_xor(tm, 1)); tm = fmaxf(tm, __shfl_xor(tm, 2)); tm = fmaxf(tm, __shfl_xor(tm, 4)); tm = fmaxf(tm, __shfl_xor(tm, 8));
            const float mn = fmaxf(mrun[i], tm), al = __builtin_amdgcn_exp2f(mrun[i] - mn);
            float ps = 0.f;
#pragma unroll
            for (int t = 0; t < 4; ++t) { const float p = __builtin_amdgcn_exp2f(s[t][i] - mn); s[t][i] = p; ps += p; }
            lrun[i] = lrun[i] * al + ps; mrun[i] = mn;
            if (c16 == 0) Aw[4 * g + i] = al;
        }
#pragma unroll
        for (int t = 0; t < 4; ++t) *(LAS f32x4*)(Pw + (16 * t + c16) * 16 + 4 * g) = s[t];
        asm volatile("s_waitcnt lgkmcnt(0)" ::: "memory"); __builtin_amdgcn_wave_barrier();
#pragma unroll
        for (int j = 0; j < 4; ++j) { const f32x4 al = *(const LAS f32x4*)(Aw + 4 * j); acc[4 * j] *= al[0]; acc[4 * j + 1] *= al[1]; acc[4 * j + 2] *= al[2]; acc[4 * j + 3] *= al[3]; }
        __builtin_amdgcn_sched_barrier(0);
#pragma unroll
        for (int j = 0; j < 16; ++j) {
            if (!isnew || j < 4) {
#pragma unroll
                for (int i = 0; i < 4; ++i) { const f32x4 p = *(const LAS f32x4*)(Pw + (4 * j + rr) * 16 + 4 * i);
                    acc[4 * i] += vv[j] * p[0]; acc[4 * i + 1] += vv[j] * p[1]; acc[4 * i + 2] += vv[j] * p[2]; acc[4 * i + 3] += vv[j] * p[3]; }
            }
            __builtin_amdgcn_sched_barrier(0);
        }
        asm volatile("s_waitcnt lgkmcnt(0)" ::: "memory"); __builtin_amdgcn_wave_barrier();
    }
#pragma unroll
    for (int i = 0; i < 4; ++i) { float l = lrun[i]; l += __shfl_xor(l, 1); l += __shfl_xor(l, 2); l += __shfl_xor(l, 4); l += __shfl_xor(l, 8); if (c16 == 0) { Mx[w * 16 + 4 * g + i] = mrun[i]; Lx[w * 16 + 4 * g + i] = l; } }
#pragma unroll
    for (int t = 0; t < 16; ++t) { f32x4 a = acc[t];
#pragma unroll
        for (int e = 0; e < 4; ++e) { a[e] += __shfl_xor(a[e], 16); a[e] += __shfl_xor(a[e], 32); }
        if (rr == 0) *(LAS f32x4*)(ACC + (w * 16 + t) * 64 + 4 * cc) = a; }
    __syncthreads();
    for (int e = tid; e < 1024; e += 512) {
        const int t = e >> 6, d = e & 63; float mm = -INFINITY;
#pragma unroll
        for (int ww = 0; ww < 8; ++ww) mm = fmaxf(mm, Mx[ww * 16 + t]);
        float num = 0.f, den = 0.f;
#pragma unroll
        for (int ww = 0; ww < 8; ++ww) { const float f = __builtin_amdgcn_exp2f(Mx[ww * 16 + t] - mm); num += ACC[(ww * 16 + t) * 64 + d] * f; den += Lx[ww * 16 + t] * f; }
        const unsigned pk = cvt_pk_bf16(num / den, 0.f); FQ[(srow + t) * 512 + h * 64 + d] = (u16)(pk & 0xffffu);
    }
    __syncthreads();
}
constexpr int F_Q = 0, F_BIAS = 4096, F_WS = 20736, F_P = 24576, F_M = 57344, F_L = 57856, F_ACC = 58368, F_END = 91136;
__device__ __forceinline__ void fox_sample_item(LAS unsigned char* lds, int b, int h, u16* FQ, const u16* FK, const u16* FV, const float* ck, const float* cv, const float* clf, const float* lfnew) {
    int tid = threadIdx.x; asm volatile("" : "+v"(tid)); const int lane = tid & 63, w = __builtin_amdgcn_readfirstlane(tid >> 6);
    LAS float* QF = (LAS float*)(lds + F_Q); LAS float* BIAS = (LAS float*)(lds + F_BIAS); LAS float* WS = (LAS float*)(lds + F_WS);
    LAS float* Pw = (LAS float*)(lds + F_P) + w * 1024; LAS float* Mx = (LAS float*)(lds + F_M); LAS float* Lx = (LAS float*)(lds + F_L); LAS float* ACC = (LAS float*)(lds + F_ACC);
    const size_t srow = (size_t)MP + (size_t)b * 16;
    __syncthreads();
    for (int e = tid; e < 1024; e += 512) QF[e] = bf2f(FQ[(srow + (e >> 6)) * 512 + h * 64 + (e & 63)]);
    {
        float v[8]; float run = 0.f;
#pragma unroll
        for (int j = 0; j < 8; ++j) { run += clf[((size_t)b * PAST + 8 * tid + j) * 8 + h]; v[j] = run; }
        float tot = run;
#pragma unroll
        for (int o = 1; o < 64; o <<= 1) { const float u = __shfl_up(tot, o); if (lane >= o) tot += u; }
        if (lane == 63) WS[w] = tot;
        __syncthreads();
        float base = tot - run, all = 0.f;
#pragma unroll
        for (int ww = 0; ww < 8; ++ww) { const float x = WS[ww]; all += x; if (ww < w) base += x; }
#pragma unroll
        for (int j = 0; j < 8; ++j) BIAS[8 * tid + j] = (all - (base + v[j])) * L2E;
        if (tid == 0) { float cn = 0.f; for (int t = 0; t < 16; ++t) { cn += lfnew[((size_t)b * 16 + t) * 8 + h]; BIAS[PAST + t] = -cn * L2E; } }
    }
    __syncthreads();
    float mrun[16], lrun[16], acc[16];
#pragma unroll
    for (int t = 0; t < 16; ++t) { mrun[t] = -INFINITY; lrun[t] = 0.f; acc[t] = 0.f; }
    const int ntile = (w == 0) ? 9 : 8;
    for (int tile = 0; tile < ntile; ++tile) {
        const bool isnew = tile == 8;
        const int key0 = isnew ? 0 : 512 * w + 64 * tile;
        float s[16];
        {
            f32x4 k[16];
            if (!isnew) { const f32x4* kp = (const f32x4*)(ck + (((size_t)b * PAST + key0 + lane) * 8 + h) * 64);
#pragma unroll
                for (int i = 0; i < 16; ++i) k[i] = kp[i];
            } else { const u32x4* kp = (const u32x4*)(FK + (srow + (lane & 15)) * 512 + h * 64);
#pragma unroll
                for (int i = 0; i < 8; ++i) { const u32x4 x = kp[i]; k[2 * i] = (f32x4){bflo(x.x), bfhi(x.x), bflo(x.y), bfhi(x.y)}; k[2 * i + 1] = (f32x4){bflo(x.z), bfhi(x.z), bflo(x.w), bfhi(x.w)}; } }
            const float bias = isnew ? BIAS[PAST + (lane & 15)] : BIAS[key0 + lane];
#pragma unroll
            for (int t = 0; t < 16; ++t) { float a = 0.f;
#pragma unroll
                for (int i = 0; i < 16; ++i) { const f32x4 q = *(const LAS f32x4*)(QF + t * 64 + 4 * i); a += (q[0] * k[i][0] + q[1] * k[i][1]) + (q[2] * k[i][2] + q[3] * k[i][3]); }
                a += bias; if (isnew && (lane > t || lane >= 16)) a = -INFINITY; s[t] = a; }
        }
#pragma unroll
        for (int t = 0; t < 16; ++t) {
            const float tm = wave_max(s[t]), mn = fmaxf(mrun[t], tm), al = __builtin_amdgcn_exp2f(mrun[t] - mn), p = __builtin_amdgcn_exp2f(s[t] - mn);
            Pw[lane * 16 + t] = p; acc[t] *= al; lrun[t] = lrun[t] * al + wave_sum(p); mrun[t] = mn;
        }
        asm volatile("s_waitcnt lgkmcnt(0)" ::: "memory"); __builtin_amdgcn_wave_barrier();
        const int nk = isnew ? 16 : 64;
        for (int kk = 0; kk < nk; ++kk) {
            const float v = isnew ? bf2f(FV[(srow + kk) * 512 + h * 64 + lane]) : cv[(((size_t)b * PAST + key0 + kk) * 8 + h) * 64 + lane];
#pragma unroll
            for (int i = 0; i < 4; ++i) { const f32x4 p = *(const LAS f32x4*)(Pw + kk * 16 + 4 * i); acc[4 * i] += p[0] * v; acc[4 * i + 1] += p[1] * v; acc[4 * i + 2] += p[2] * v; acc[4 * i + 3] += p[3] * v; }
        }
        asm volatile("s_waitcnt lgkmcnt(0)" ::: "memory"); __builtin_amdgcn_wave_barrier();
    }
#pragma unroll
    for (int t = 0; t < 16; ++t) { ACC[(w * 16 + t) * 64 + lane] = acc[t]; if (lane == 0) { Mx[w * 16 + t] = mrun[t]; Lx[w * 16 + t] = lrun[t]; } }
    __syncthreads();
    for (int e = tid; e < 1024; e += 512) {
        const int t = e >> 6, d = e & 63; float mm = -INFINITY;
#pragma unroll
        for (int ww = 0; ww < 8; ++ww) mm = fmaxf(mm, Mx[ww * 16 + t]);
        float num = 0.f, den = 0.f;
#pragma unroll
        for (int ww = 0; ww < 8; ++ww) { const float f = __builtin_amdgcn_exp2f(Mx[ww * 16 + t] - mm); num += ACC[(ww * 16 + t) * 64 + d] * f; den += Lx[ww * 16 + t] * f; }
        const unsigned pk = cvt_pk_bf16(num / den, 0.f); FQ[(srow + t) * 512 + h * 64 + d] = (u16)(pk & 0xffffu);
    }
    __syncthreads();
}

struct Args { const float* in[25]; float* out; unsigned char* ws; };
constexpr int P4_RET = 128, P4_FS = 128, P4_FP = 2048, P4_RS = 64, P4_ITEMS = P4_RET + P4_FS + P4_FP + P4_RS;

__device__ __forceinline__ unsigned char* kern_ptr(int k) {
    const __attribute__((address_space(4))) char* p = (const __attribute__((address_space(4))) char*)__builtin_amdgcn_kernarg_segment_ptr();
    asm volatile("" : "+s"(p));
    return *(unsigned char* const __attribute__((address_space(4)))*)(p + 8 * k);
}
__global__ void __launch_bounds__(512, 2) fwd(Args a) {
    extern __shared__ __attribute__((aligned(16))) unsigned char lds_raw[];
    LAS unsigned char* lds = (LAS unsigned char*)lds_raw;
    cg::grid_group grid = cg::this_grid();
    const int tid = threadIdx.x, lane = tid & 63, wave = __builtin_amdgcn_readfirstlane(tid >> 6);
    const int G = gridDim.x, bx = blockIdx.x;
#define WSB() kern_ptr(26)
#define OUTB() ((float*)kern_ptr(25))
#define INP(k) ((const float*)kern_ptr(k))
#define P16(off) ((u16*)(WSB() + (off)))
#define PF32(off) ((float*)(WSB() + (off)))
    unsigned* ctl = (unsigned*)(WSB() + O_CTL);
    LAS unsigned* misc = (LAS unsigned*)(lds + LDS_BYTES - 128);
    if (tid < 32) misc[tid] = 0u;
    __syncthreads();
    const xb::XcdBarrier bar = xb::xcd_barrier_post(ctl + 4096, (volatile XLAS unsigned*)(misc + 8));
#ifdef PROBE_PH
    unsigned long long pr_t0 = __builtin_amdgcn_s_memrealtime(), pr_acc = 0; int pr_n = 0;
#define GSYNC() do { xb::xcd_barrier(bar); if (pr_n == PROBE_PH) pr_acc = __builtin_amdgcn_s_memrealtime() - pr_t0; ++pr_n; pr_t0 = __builtin_amdgcn_s_memrealtime(); } while (0)
#else
#define GSYNC() xb::xcd_barrier(bar)
#endif

#ifndef PHM
#define PHM 0xffff
#endif
#define PH(k) if constexpr (((PHM)>>(k))&1)
    PH(0) {
        LAS float* scr = (LAS float*)(lds + wave * 16384);
        const int gw = bx * 8 + wave, NGW = G * 8;
        constexpr int I0 = 16 * 176, I1 = 44 * 32, I2 = 16 * 216, I3 = 16 * 32, I4 = 8 * 32, I5 = 16 * 32, I8 = 4 * 32;
        constexpr int NIT = I0 + I1 + I2 + I3 + I4 + I5 + I0 + I1 + I8 + I3;
        for (int it = gw; it < NIT; it += NGW) {
            int r = it;
            if (r < I0) { transpose_item(INP(9), INP(8), 1024, 5632, 1, P16(O_W1IN), 176, scr, r, lane); continue; } r -= I0;
            if (r < I1) { transpose_item(INP(10), nullptr, 2816, 1024, 0, P16(O_W1OUT), 32, scr, r, lane); continue; } r -= I1;
            if (r < I2) { transpose_item(INP(12), INP(11), 1024, 6664, 2, P16(O_WMIX), 216, scr, r, lane); continue; } r -= I2;
            if (r < I3) { transpose_item(INP(16), nullptr, 1024, 1024, 0, P16(O_WBR), 32, scr, r, lane); continue; } r -= I3;
            if (r < I4) { transpose_item(INP(17), nullptr, 512, 1024, 0, P16(O_WBF), 32, scr, r, lane); continue; } r -= I4;
            if (r < I5) { transpose_item(INP(18), nullptr, 1024, 1024, 0, P16(O_WOUT), 32, scr, r, lane); continue; } r -= I5;
            if (r < I0) { transpose_item(INP(20), INP(19), 1024, 5632, 1, P16(O_W2IN), 176, scr, r, lane); continue; } r -= I0;
            if (r < I1) { transpose_item(INP(21), nullptr, 2816, 1024, 0, P16(O_W2OUT), 32, scr, r, lane); continue; } r -= I1;
            if (r < I8) { transpose_item(INP(23), nullptr, 256, 1024, 0, P16(O_WPLE), 32, scr, r, lane); continue; } r -= I8;
            transpose_item(INP(24), INP(22), 1024, 1024, 0, P16(O_WPG), 32, scr, r, lane);
        }
        for (int rb = gw * 4; rb < MT; rb += NGW * 4) {
            f32x4 v[4][4]; float s[4];
#pragma unroll
            for (int r = 0; r < 4; ++r) { const int row = rb + r; const f32x4* xr = (const f32x4*)(row < MP ? INP(0) + (size_t)row * 1024 : INP(1) + (size_t)(row - MP) * 1024) + lane;
#pragma unroll
                for (int j = 0; j < 4; ++j) v[r][j] = xr[64 * j]; }
#pragma unroll
            for (int r = 0; r < 4; ++r) { float q = 0.f;
#pragma unroll
                for (int j = 0; j < 4; ++j) q += (v[r][j][0] * v[r][j][0] + v[r][j][1] * v[r][j][1]) + (v[r][j][2] * v[r][j][2] + v[r][j][3] * v[r][j][3]);
                s[r] = wave_sum(q);
                u32x2* o = (u32x2*)(P16(O_XB) + (size_t)(rb + r) * 1024) + lane;
#pragma unroll
                for (int j = 0; j < 4; ++j) { u32x2 w; w.x = cvt_pk_bf16(v[r][j][0], v[r][j][1]); w.y = cvt_pk_bf16(v[r][j][2], v[r][j][3]); o[64 * j] = w; } }
            { const int r = lane >> 4, c = lane & 15; const float sv = r == 0 ? s[0] : (r == 1 ? s[1] : (r == 2 ? s[2] : s[3])); PF32(O_SS)[(size_t)(rb + r) * 16 + c] = c == 0 ? sv : 0.f; }
        }
        for (int i = bx * 512 + tid; i < NPOS * 64; i += G * 512) {
            const int pi = i >> 6, f = i & 63; const float pos = pi < SEQ ? (float)pi : (float)(PAST + pi - SEQ);
            const float freq = __builtin_amdgcn_exp2f(-(float)f * (13.287712379549449f / 64.f)); const float ang = pos * freq;
            double rev = (double)ang * 0.15915494309189535; rev -= floor(rev); const float rf = (float)rev;
            PF32(O_TABC)[i] = __builtin_amdgcn_cosf(rf); PF32(O_TABS)[i] = __builtin_amdgcn_sinf(rf);
        }
    }
    if (gridDim.x == 0x7fffffffu) grid.sync();
    GSYNC();
    PH(1) { pg8::Gemm g{P16(O_XB), P16(O_W1IN), MT, 5632, 1024}; pg8::StaticOrder S; S.init(MT, 5632, G, bx); EpiSwiglu E{P16(O_ACT1), PF32(O_SS)};
      pg8::gemm_phase<EpiSwiglu, pg8::StaticOrder, true, true>(lds, g, S, E); }
    GSYNC();
    PH(2) { const FResid f{P16(O_XB), PF32(O_SS), 0.5f};
      small_gemm<FResid>(lds, P16(O_ACT1) + (size_t)MP * DFF, P16(O_W1OUT), DFF, f, bx, G);
      pg8::Gemm g{P16(O_ACT1), P16(O_W1OUT), MP, 1024, DFF}; pg8::StaticOrder S; S.init(MP, 1024, G, bx); const EpiWrap<FResid> E{f};
      pg8::gemm_phase<EpiWrap<FResid>, pg8::StaticOrder, true, true>(lds, g, S, E); }
    GSYNC();
    PH(3) { pg8::Gemm g{P16(O_XB), P16(O_WMIX), MT, NMIX, 1024}; pg8::StaticOrder S; S.init(MT, NMIX, G, bx);
      EpiMix E{PF32(O_SS), PF32(O_TABC), PF32(O_TABS), INP(14), INP(15), INP(13), P16(O_RQK), P16(O_RV), P16(O_RG), P16(O_FQ), P16(O_FK), P16(O_FV), P16(O_ZG), OUTB(), OUTB() + OUT_YP};
      pg8::gemm_phase<EpiMix, pg8::StaticOrder, true, true>(lds, g, S, E); }
    GSYNC();
    {
        LAS unsigned* slot = misc;
        float dbound;
        { float gq_ = __builtin_fabsf(INP(14)[lane]), gk_ = __builtin_fabsf(INP(15)[lane]);
#pragma unroll
          for (int o_ = 1; o_ < 64; o_ <<= 1) { gq_ = fmaxf(gq_, __shfl_xor(gq_, o_)); gk_ = fmaxf(gk_, __shfl_xor(gk_, o_)); }
          dbound = gq_ * gk_ * (64.f * 0.125f * L2E * 1.02f) + 1.f; if (tid == 0) misc[2] = __float_as_uint(dbound); }
        for (;;) {
            __syncthreads();
            if (tid == 0) slot[0] = atomicAdd(ctl, 1u);
            __syncthreads();
            const int it = (int)slot[0];
            if (it >= P4_ITEMS) break;
#ifdef PROBE_ITEM
            const unsigned long long pi_t0 = __builtin_amdgcn_s_memrealtime();
#endif
            if (it < P4_RET) { const int b = it >> 2, h = it & 3;
                PH(10) ret_prompt_item(lds, P16(O_RQK), P16(O_RV), P16(O_RG), OUTB() + OUT_RSP + (size_t)(b * 4 + h) * 32768, (size_t)b * SEQ, h);
            } else if (it < P4_RET + P4_FS) { const int j = it - P4_RET, b = j >> 3, h = j & 7;
                PH(11) fox_sample_item2(lds, b, h, P16(O_FQ), P16(O_FK), P16(O_FV), INP(5), INP(6), INP(7), OUTB() + OUT_LS);
            } else if (it < P4_RET + P4_FS + P4_FP) { const int j = it - P4_RET - P4_FS, qb = 7 - (j >> 8), bh = j & 255;
                PH(12) attn_body::attn_unit<8>(bh >> 3, bh & 7, qb, (const attn_body::bf16*)P16(O_FQ), (const attn_body::bf16*)P16(O_FK), (const attn_body::bf16*)P16(O_FV), (attn_body::bf16*)P16(O_FQ), OUTB() + OUT_YP, __uint_as_float(misc[2]), (char*)lds_raw);
            } else { const int j = it - P4_RET - P4_FS - P4_FP, b = j >> 2, h = j & 3;
                PH(13) ret_item<16>(lds, P16(O_RQK), P16(O_RV), P16(O_RG), INP(4) + (size_t)(b * 4 + h) * 32768, OUTB() + OUT_RSS + (size_t)(b * 4 + h) * 32768, (size_t)MP + (size_t)b * 16, 1, h);
            }
#ifdef PROBE_ITEM
            { const int kind = it < P4_RET ? 0 : (it < P4_RET + P4_FS ? 1 : (it < P4_RET + P4_FS + P4_FP ? 2 : 3));
              if (kind == PROBE_ITEM && tid == 0) atomicMax(ctl + 16, (unsigned)(__builtin_amdgcn_s_memrealtime() - pi_t0)); }
#endif
        }
    }
    GSYNC();
    {
        for (size_t i = (size_t)bx * 512 + tid; i < (size_t)MT * 32; i += (size_t)G * 512) {
            const size_t e8 = i * 8; const float* src = e8 < (size_t)MP * 256 ? INP(2) + e8 : INP(3) + (e8 - (size_t)MP * 256);
            const f32x4 v0 = *(const f32x4*)src, v1 = *(const f32x4*)(src + 4);
            u32x4 w; w.x = cvt_pk_bf16(v0[0], v0[1]); w.y = cvt_pk_bf16(v0[2], v0[3]); w.z = cvt_pk_bf16(v1[0], v1[1]); w.w = cvt_pk_bf16(v1[2], v1[3]);
            *(u32x4*)(P16(O_FV) + e8) = w;
        }
        PH(5) { const FGate<false> f0{P16(O_RG), P16(O_ZG), nullptr}; const FGate<true> f1{P16(O_RG), P16(O_ZG), nullptr};
          small_gemm<FGate<false>>(lds, P16(O_RV) + (size_t)MP * 1024, P16(O_WBR), 1024, f0, bx, G);
          small_gemm<FGate<true>>(lds, P16(O_FQ) + (size_t)MP * 512, P16(O_WBF), 512, f1, bx, G);
          { pg8::Gemm g{P16(O_RV), P16(O_WBR), MP, 1024, 1024}; pg8::StaticOrder S; S.init(MP, 1024, G, bx); const EpiWrap<FGate<false>> E{f0};
            pg8::gemm_phase<EpiWrap<FGate<false>>, pg8::StaticOrder, true, true>(lds, g, S, E); }
          { pg8::Gemm g{P16(O_FQ), P16(O_WBF), MP, 1024, 512}; pg8::StaticOrder S; S.init(MP, 1024, G, bx); const EpiWrap<FGate<true>> E{f1};
            pg8::gemm_phase<EpiWrap<FGate<true>>, pg8::StaticOrder, true, true>(lds, g, S, E); } }
    }
    GSYNC();
    PH(6) { const FResid f{P16(O_XB), PF32(O_SS), 1.0f};
      small_gemm<FResid>(lds, P16(O_RG) + (size_t)MP * 1024, P16(O_WOUT), 1024, f, bx, G);
      pg8::Gemm g{P16(O_RG), P16(O_WOUT), MP, 1024, 1024}; pg8::StaticOrder S; S.init(MP, 1024, G, bx); const EpiWrap<FResid> E{f};
      pg8::gemm_phase<EpiWrap<FResid>, pg8::StaticOrder, true, true>(lds, g, S, E); }
    GSYNC();
    PH(7) { pg8::Gemm g{P16(O_XB), P16(O_W2IN), MT, 5632, 1024}; pg8::StaticOrder S; S.init(MT, 5632, G, bx); EpiSwiglu E{P16(O_ACT2), PF32(O_SS)};
      pg8::gemm_phase<EpiSwiglu, pg8::StaticOrder, true, true>(lds, g, S, E); }
    GSYNC();
    PH(8) { const FResid f{P16(O_XB), PF32(O_SS), 0.5f}; const FPlain fp{P16(O_RQK), nullptr};
      small_gemm<FResid>(lds, P16(O_ACT2) + (size_t)MP * DFF, P16(O_W2OUT), DFF, f, bx, G);
      small_gemm<FPlain>(lds, P16(O_FV) + (size_t)MP * 256, P16(O_WPLE), 256, fp, bx, G);
      { pg8::Gemm g{P16(O_ACT2), P16(O_W2OUT), MP, 1024, DFF}; pg8::StaticOrder S; S.init(MP, 1024, G, bx); const EpiWrap<FResid> E{f};
        pg8::gemm_phase<EpiWrap<FResid>, pg8::StaticOrder, true, true>(lds, g, S, E); }
      { pg8::Gemm g{P16(O_FV), P16(O_WPLE), MP, 1024, 256}; pg8::StaticOrder S; S.init(MP, 1024, G, bx); const EpiWrap<FPlain> E{fp};
        pg8::gemm_phase<EpiWrap<FPlain>, pg8::StaticOrder, true, true>(lds, g, S, E); } }
    GSYNC();
    PH(9) { const FFinal f{OUTB() + OUT_YP, OUTB() + OUT_YS, P16(O_XB), P16(O_RQK), PF32(O_SS)};
      small_gemm<FFinal>(lds, P16(O_XB) + (size_t)MP * 1024, P16(O_WPG), 1024, f, bx, G);
      pg8::Gemm g{P16(O_XB), P16(O_WPG), MP, 1024, 1024}; pg8::StaticOrder S; S.init(MP, 1024, G, bx); const EpiWrap<FFinal> E{f};
      pg8::gemm_phase<EpiWrap<FFinal>, pg8::StaticOrder, true, true>(lds, g, S, E); }
#ifdef PROBE_ITEM
    GSYNC();
    if (bx == 0) { const unsigned long long t1 = __builtin_amdgcn_s_memrealtime(); const unsigned long long dur = __hip_atomic_load(ctl + 16, __ATOMIC_RELAXED, __HIP_MEMORY_SCOPE_AGENT); while (__builtin_amdgcn_s_memrealtime() - t1 < dur) __builtin_amdgcn_s_sleep(8); }
#endif
#ifdef PROBE_PH
    if (pr_n == PROBE_PH) pr_acc = __builtin_amdgcn_s_memrealtime() - pr_t0;
    if (bx == 0) { const unsigned long long t1 = __builtin_amdgcn_s_memrealtime(); while (__builtin_amdgcn_s_memrealtime() - t1 < pr_acc) __builtin_amdgcn_s_sleep(8); }
#endif
}
}

extern "C" void kernel_launch(void* const* d_in, const int* in_sizes, int n_in, void* d_out, int out_size, void* d_ws, size_t ws_size, hipStream_t stream) {
    static int grid = 0;
    if (grid == 0) {
        if (n_in != 25 || (size_t)out_size != mk::OUT_END || ws_size < mk::WS_NEED) { fprintf(stderr, "kernel_launch: unexpected shapes (n_in %d out %d ws %zu need %zu)\n", n_in, out_size, ws_size, (size_t)mk::WS_NEED); grid = -1; return; }
        int dev = 0, cus = 0, per_cu = 0;
        hipGetDevice(&dev); hipDeviceGetAttribute(&cus, hipDeviceAttributeMultiprocessorCount, dev);
        if (hipFuncSetAttribute((const void*)mk::fwd, hipFuncAttributeMaxDynamicSharedMemorySize, mk::LDS_BYTES) != hipSuccess) { fprintf(stderr, "kernel_launch: hipFuncSetAttribute failed\n"); grid = -1; return; }
        hipOccupancyMaxActiveBlocksPerMultiprocessor(&per_cu, (const void*)mk::fwd, 512, mk::LDS_BYTES);
        if (per_cu < 1) { fprintf(stderr, "kernel_launch: occupancy query says %d blocks per CU\n", per_cu); per_cu = 1; }
        grid = cus;
    }
    if (grid < 0) return;
    if (hipMemsetAsync((char*)d_ws + mk::O_CTL, 0, 65536, stream) != hipSuccess) { fprintf(stderr, "kernel_launch: memset failed\n"); return; }
    mk::Args a{};
    for (int i = 0; i < 25; ++i) a.in[i] = (const float*)d_in[i];
    a.out = (float*)d_out; a.ws = (unsigned char*)d_ws;
    void* args[] = {&a};
    hipError_t e = hipLaunchCooperativeKernel((const void*)mk::fwd, dim3(grid), dim3(512), args, mk::LDS_BYTES, stream);
    if (e != hipSuccess) fprintf(stderr, "cooperative launch failed: %s (grid %d)\n", hipGetErrorString(e), grid);
}
```

```cpp
#include <hip/hip_runtime.h>
#include <hip/hip_cooperative_groups.h>
#include <cstdio>
#include <cstdint>
#include <hip/hip_bf16.h>
#include <cmath>
namespace cg = cooperative_groups;
namespace pg8 {
#define PG8_LAS __attribute__((address_space(3)))
typedef unsigned short bf16_t;
typedef short bf16x8 __attribute__((ext_vector_type(8)));
typedef float f32x4 __attribute__((ext_vector_type(4)));
typedef unsigned u32x4 __attribute__((ext_vector_type(4)));
constexpr int BM = 256, BK = 64, HALF = 128, HTB = HALF * BK * 2  , STAGE_BYTES = 8 * HTB, NXCD = 8, WGM = 4;

__host__ __device__ __forceinline__ int lds_byte(int r, int c) { const int st = (r >> 4) * 2 + (c >> 5), rr = r & 15, cc = c & 31, ob = rr * 64 + cc * 2; return st * 1024 + (ob ^ (((ob >> 9) & 1) << 5)); }
__host__ __device__ __forceinline__ void stage_rc(int b, int& R, int& C) { const int st = b / 1024, sb = b % 1024, swz = sb ^ (((sb >> 9) & 1) << 5); R = (st >> 1) * 16 + swz / 64; C = (st & 1) * 32 + (swz % 64) / 2; }
__host__ __device__ __forceinline__ int perm32(int rho) { const int n = rho >> 4, i = rho & 15; return 8 * (i >> 2) + 4 * n + (i & 3); }

struct Unit { int pm, pn; };
struct Gemm { const bf16_t* A; const bf16_t* Bt; int M, N, K; };

struct StaticOrder {
    int nM, nN, nwg, G, c;
    __host__ __device__ void init(int M, int N, int G_, int c_) { nM = M / BM; nN = N / BM; nwg = nM * nN; G = G_; c = c_; }
    __host__ __device__ bool next(int i, Unit& u) const {
        const long L = (long)i * G + c; if (L >= nwg) return false;
        int wgid = (int)L; { const int q = nwg / NXCD, r = nwg % NXCD, xcd = wgid % NXCD, off = wgid / NXCD; wgid = (xcd < r ? xcd * (q + 1) : r * (q + 1) + (xcd - r) * q) + off; }
        const int nig = WGM * nN, gid = wgid / nig, fm = gid * WGM, gsz = (nM - fm) < WGM ? (nM - fm) : WGM;
        u.pm = fm + ((wgid % nig) % gsz); u.pn = (wgid % nig) / gsz; return true;
    }
    __device__ __forceinline__ void a_ready(const Unit&) const {}
    __device__ __forceinline__ void done(const Unit&) const {}
};

typedef float f32x2c __attribute__((ext_vector_type(2))); typedef __bf16 bf16x2c __attribute__((ext_vector_type(2)));
__device__ __forceinline__ unsigned cvt_pk_bf16(float lo, float hi) { f32x2c v = {lo, hi}; bf16x2c b = __builtin_convertvector(v, bf16x2c); return __builtin_bit_cast(unsigned, b); }
typedef float f32x2 __attribute__((ext_vector_type(2)));
template <class Epi, class Sched, bool ALIGN_EPI = false, bool SP2 = false>
__device__ __forceinline__ void gemm_phase(PG8_LAS unsigned char* lds, const Gemm g, const Sched& S, const Epi& E) {
    int tid = threadIdx.x; asm volatile("" : "+v"(tid)); const int wid = __builtin_amdgcn_readfirstlane(tid >> 6), lane = tid & 63, wr = wid >> 2, wc = wid & 3, fr = lane & 15, fq = lane >> 4;
    const int K = g.K, nt = K / BK;
    unsigned voffA[2], voffB[2];
#pragma unroll
    for (int i = 0; i < 2; ++i) { int R, C; stage_rc(tid * 16 + i * 8192, R, C); const int Rb = Epi::PERM ? ((R & ~31) + perm32(R & 31)) : R;
        voffA[i] = (unsigned)(R * K + C) * 2u; voffB[i] = (unsigned)(Rb * K + C) * 2u; }
    const size_t kstep = (size_t)(BK * 2);
    const size_t hstep = (size_t)HALF * K * 2;
    const size_t tstep = 2 * hstep;
    const unsigned ldsw = (unsigned)wid * 1024u;
    const int aoff = lds_byte(wr * 64 + fr, fq * 8), boff = lds_byte(wc * 32 + fr, fq * 8);
#define PG8_SA(b, h) (((b) * 2 + (h)) * HTB)
#define PG8_SB(b, h) ((4 + (b) * 2 + (h)) * HTB)
#define PG8_STAGE(bufoff, gbase, voff) do { _Pragma("unroll") for (int _i = 0; _i < 2; ++_i) \
        __builtin_amdgcn_global_load_lds((const unsigned*)((const char*)(gbase) + (voff)[_i]), (PG8_LAS unsigned*)(lds + (bufoff) + ldsw + _i * 8192), 16, 0, 0); } while (0)
#define PG8_LDA(dst, b, h) do { _Pragma("unroll") for (int m = 0; m < 4; ++m) _Pragma("unroll") for (int k = 0; k < 2; ++k) dst[m][k] = *(const PG8_LAS bf16x8*)(lds + PG8_SA(b, h) + aoff + m * 2048 + k * 1024); } while (0)
#define PG8_LDB(dst, b, h) do { _Pragma("unroll") for (int n = 0; n < 2; ++n) _Pragma("unroll") for (int k = 0; k < 2; ++k) dst[n][k] = *(const PG8_LAS bf16x8*)(lds + PG8_SB(b, h) + boff + n * 2048 + k * 1024); } while (0)
#define PG8_MMA(ai, bj, At, Bt) do { __builtin_amdgcn_s_setprio(1); _Pragma("unroll") for (int m = 0; m < 4; ++m) _Pragma("unroll") for (int n = 0; n < 2; ++n) _Pragma("unroll") for (int k = 0; k < 2; ++k) \
        acc[ai][bj][m][n] = __builtin_amdgcn_mfma_f32_16x16x32_bf16(Bt[n][k], At[m][k], acc[ai][bj][m][n], 0, 0, 0); __builtin_amdgcn_s_setprio(0); } while (0)
#define PG8_WAIT_V(n) asm volatile("s_waitcnt vmcnt(" #n ")" ::: "memory")
#define PG8_WAIT_L(n) asm volatile("s_waitcnt lgkmcnt(" #n ")" ::: "memory")
#define PG8_BAR __builtin_amdgcn_s_barrier()
#define PG8_SCHED __builtin_amdgcn_sched_barrier(0)
    Unit cur, nxt; int ui = 0;
    if (!S.next(0, cur)) return;
    f32x4 acc[2][2][4][2];
#pragma unroll
    for (int a = 0; a < 2; ++a)
#pragma unroll
        for (int b = 0; b < 2; ++b)
#pragma unroll
            for (int m = 0; m < 4; ++m)
#pragma unroll
                for (int n = 0; n < 2; ++n) acc[a][b][m][n] = (f32x4){0.f, 0.f, 0.f, 0.f};
    bf16x8 At[4][2], B0[2][2], B1[2][2];
    const char* cA = (const char*)g.A + (size_t)cur.pm * tstep; const char* cB = (const char*)g.Bt + (size_t)cur.pn * tstep;
    S.a_ready(cur);
    if constexpr (SP2) {
        PG8_STAGE(PG8_SB(0, 0), cB, voffB); PG8_STAGE(PG8_SB(0, 1), cB + hstep, voffB); PG8_STAGE(PG8_SA(0, 0), cA, voffA); PG8_STAGE(PG8_SA(0, 1), cA + hstep, voffA);
        if (wr == 1) PG8_BAR;
        PG8_WAIT_V(2); PG8_BAR;
        PG8_STAGE(PG8_SB(1, 0), cB + kstep, voffB); PG8_STAGE(PG8_SA(1, 0), cA + kstep, voffA); PG8_STAGE(PG8_SB(1, 1), cB + hstep + kstep, voffB);
        PG8_WAIT_V(6); PG8_BAR;
    } else {
        PG8_STAGE(PG8_SB(0, 0), cB, voffB); PG8_STAGE(PG8_SA(0, 0), cA, voffA); PG8_STAGE(PG8_SB(0, 1), cB + hstep, voffB); PG8_STAGE(PG8_SA(0, 1), cA + hstep, voffA);
        if (wr == 1) PG8_BAR;
        PG8_WAIT_V(4); PG8_BAR;
        PG8_STAGE(PG8_SB(1, 0), cB + kstep, voffB); PG8_STAGE(PG8_SA(1, 0), cA + kstep, voffA); PG8_STAGE(PG8_SB(1, 1), cB + hstep + kstep, voffB);
        PG8_WAIT_V(6); PG8_BAR;
    }
    for (;;) {
        const bool has_next = S.next(ui + 1, nxt);
        const char* nA = has_next ? (const char*)g.A + (size_t)nxt.pm * tstep : cA; const char* nB = has_next ? (const char*)g.Bt + (size_t)nxt.pn * tstep : cB;
        for (int t = 0; t < nt; t += 2) {
            const bool last = (t == nt - 2);
            const char* a1 = cA + (size_t)(t + 1) * kstep;
            const char* a2 = last ? nA : cA + (size_t)(t + 2) * kstep; const char* b2 = last ? nB : cB + (size_t)(t + 2) * kstep;
            const char* a3 = a2 + kstep; const char* b3 = b2 + kstep;
            if (last && has_next) S.a_ready(nxt);
            if constexpr (SP2) {
            PG8_LDB(B0, 0, 0); PG8_LDB(B1, 0, 1); PG8_SCHED; PG8_LDA(At, 0, 0); PG8_STAGE(PG8_SA(1, 1), a1 + hstep, voffA);
            PG8_WAIT_V(8); PG8_WAIT_L(0); PG8_BAR; PG8_MMA(0, 0, At, B0); PG8_MMA(0, 1, At, B1); PG8_BAR; PG8_SCHED;
            PG8_LDA(At, 0, 1); PG8_STAGE(PG8_SB(0, 0), b2, voffB); PG8_STAGE(PG8_SB(0, 1), b2 + hstep, voffB); PG8_STAGE(PG8_SA(0, 0), a2, voffA);
            PG8_WAIT_V(8); PG8_WAIT_L(0); PG8_BAR; PG8_MMA(1, 0, At, B0); PG8_MMA(1, 1, At, B1); PG8_BAR; PG8_SCHED;
            PG8_LDB(B0, 1, 0); PG8_LDB(B1, 1, 1); PG8_SCHED; PG8_LDA(At, 1, 0); PG8_STAGE(PG8_SA(0, 1), a2 + hstep, voffA);
            PG8_WAIT_V(8); PG8_WAIT_L(0); PG8_BAR; PG8_MMA(0, 0, At, B0); PG8_MMA(0, 1, At, B1); PG8_BAR; PG8_SCHED;
            PG8_LDA(At, 1, 1); PG8_STAGE(PG8_SB(1, 0), b3, voffB); PG8_STAGE(PG8_SB(1, 1), b3 + hstep, voffB); PG8_STAGE(PG8_SA(1, 0), a3, voffA);
            PG8_WAIT_V(8); PG8_WAIT_L(0); PG8_BAR; PG8_MMA(1, 0, At, B0); PG8_MMA(1, 1, At, B1); PG8_BAR; PG8_SCHED;
            } else {
            PG8_LDB(B0, 0, 0); PG8_SCHED; PG8_LDA(At, 0, 0); PG8_STAGE(PG8_SA(1, 1), a1 + hstep, voffA);
            PG8_WAIT_L(8); PG8_BAR; PG8_WAIT_L(0); PG8_MMA(0, 0, At, B0); PG8_BAR; PG8_SCHED;
            PG8_LDB(B1, 0, 1); PG8_STAGE(PG8_SB(0, 0), b2, voffB);
            PG8_BAR; PG8_WAIT_L(0); PG8_MMA(0, 1, At, B1); PG8_BAR;
            PG8_LDA(At, 0, 1); PG8_STAGE(PG8_SA(0, 0), a2, voffA);
            PG8_BAR; PG8_WAIT_L(0); PG8_MMA(1, 0, At, B0); PG8_BAR; PG8_SCHED;
            PG8_STAGE(PG8_SB(0, 1), b2 + hstep, voffB);
            PG8_WAIT_V(6); PG8_BAR; PG8_MMA(1, 1, At, B1); PG8_BAR;
            PG8_LDB(B0, 1, 0); PG8_SCHED; PG8_LDA(At, 1, 0); PG8_STAGE(PG8_SA(0, 1), a2 + hstep, voffA);
            PG8_WAIT_L(8); PG8_BAR; PG8_WAIT_L(0); PG8_MMA(0, 0, At, B0); PG8_BAR; PG8_SCHED;
            PG8_LDB(B1, 1, 1); PG8_STAGE(PG8_SB(1, 0), b3, voffB);
            PG8_BAR; PG8_WAIT_L(0); PG8_MMA(0, 1, At, B1); PG8_BAR;
            PG8_LDA(At, 1, 1); PG8_STAGE(PG8_SA(1, 0), a3, voffA);
            PG8_BAR; PG8_WAIT_L(0); PG8_MMA(1, 0, At, B0); PG8_BAR; PG8_SCHED;
            PG8_STAGE(PG8_SB(1, 1), b3 + hstep, voffB);
            PG8_WAIT_V(6); PG8_BAR; PG8_MMA(1, 1, At, B1); PG8_BAR;
            }
        }
        if constexpr (ALIGN_EPI) { if (wr == 0) PG8_BAR; }
        if constexpr (!Epi::AFTER_DRAIN) { E(acc, cur, wr, wc, fr, fq); S.done(cur); }
        if (!has_next) break;
#pragma unroll
        for (int a = 0; a < 2; ++a)
#pragma unroll
            for (int b = 0; b < 2; ++b)
#pragma unroll
                for (int m = 0; m < 4; ++m)
#pragma unroll
                    for (int n = 0; n < 2; ++n) acc[a][b][m][n] = (f32x4){0.f, 0.f, 0.f, 0.f};
        cur = nxt; cA = nA; cB = nB; ++ui;
        if constexpr (ALIGN_EPI) { if (wr == 1) PG8_BAR; }
    }
    PG8_WAIT_V(0);
    if constexpr (!ALIGN_EPI) { if (wr == 0) PG8_BAR; }
    PG8_BAR;
    if constexpr (Epi::AFTER_DRAIN) { E.fused(acc, cur, wr, wc, fr, fq, lds, wid, lane); S.done(cur); }
#undef PG8_SA
#undef PG8_SB
#undef PG8_STAGE
#undef PG8_LDA
#undef PG8_LDB
#undef PG8_MMA
#undef PG8_WAIT_V
#undef PG8_WAIT_L
#undef PG8_BAR
#undef PG8_SCHED
}
}
namespace attn_body {
using bf16=__hip_bfloat16;
using bf16x8=__attribute__((ext_vector_type(8)))short;
using s16x4=__attribute__((ext_vector_type(4)))short;
using f32x16=__attribute__((ext_vector_type(16)))float;
using u32x4=__attribute__((ext_vector_type(4)))unsigned;
using f32x4v=__attribute__((ext_vector_type(4)))float;
constexpr int BATCH=32,NHEAD=8,SEQ=2048,D=64,DM=NHEAD*D;
constexpr int NW=8,QBLK=32,QB=QBLK*NW,KVBLK=64,NQB=SEQ/QB;
constexpr int ATTN_PITCH=DM, ATTN_UNIT_ROWS=QB;
__device__ __forceinline__ int crow(int r,int hi){return (r&3)+8*(r>>2)+4*hi;}
#define SBAR() __builtin_amdgcn_sched_barrier(0)
__device__ __forceinline__ void cmask(f32x16&p0,f32x16&p1,int jb,int qrel,int hi){
  const float NEG=-INFINITY; int kb=64*jb+4*hi;
  #pragma unroll
  for(int r=0;r<16;++r){int kv=kb+(r&3)+8*(r>>2); if(kv>qrel)p0[r]=NEG; if(kv+32>qrel)p1[r]=NEG;}
}

constexpr int NSLOT=3, SLOTB=8192;
constexpr int LDS_K=0, LDS_V=NSLOT*SLOTB, LDS_WS=2*NSLOT*SLOTB, LDS_OST=LDS_WS+NW*64*4, LDS_CB=LDS_OST+NW*4096, LDS_CBX=LDS_CB+2048*4, LDS_AL=LDS_CBX+256, LDS_BYTES=LDS_AL+256;
constexpr float C2=0.125f*1.4426950408889634f;
__device__ __forceinline__ void glds16(const void*gsrc,unsigned lds_dst){unsigned keep;
  asm volatile("s_mov_b32 %0, m0\n\ts_mov_b32 m0, %2\n\ts_nop 0\n\tglobal_load_lds_dwordx4 %1, off\n\ts_mov_b32 m0, %0":"=&s"(keep):"v"(gsrc),"s"(lds_dst):"memory");}
__device__ __forceinline__ float max3f(float a,float b,float c){float r;asm("v_max3_f32 %0, %1, %2, %3":"=v"(r):"v"(a),"v"(b),"v"(c));return r;}
__device__ __forceinline__ float max2f(float a,float b){float r;asm("v_max_f32_e32 %0, %1, %2":"=v"(r):"v"(a),"v"(b));return r;}
__device__ __forceinline__ float fadd_s(float a,float b){float r;asm("v_add_f32_e32 %0, %1, %2":"=v"(r):"v"(a),"v"(b));return r;}
__device__ __forceinline__ float fsub_s(float a,float b){float r;asm("v_sub_f32_e32 %0, %1, %2":"=v"(r):"v"(a),"v"(b));return r;}
typedef float f32x2_t __attribute__((ext_vector_type(2))); typedef __bf16 bf16x2_t __attribute__((ext_vector_type(2)));
__device__ __forceinline__ unsigned cvtpk_s(float lo,float hi){f32x2_t v={lo,hi};bf16x2_t b=__builtin_convertvector(v,bf16x2_t);return __builtin_bit_cast(unsigned,b);}
#define WAIT_BAR(N) asm volatile("s_waitcnt vmcnt(" #N ") lgkmcnt(0)\n\ts_barrier":::"memory")

__device__ __forceinline__ void qkt(f32x16&p0,f32x16&p1,const char*Kslot,const bf16x8*qr,int r32,int hi){ const f32x16 negm=f32x16{};
  const char*kb=Kslot+hi*1024+r32*16;
  #pragma unroll
  for(int d0=0;d0<4;++d0){
    const bf16x8 b0=*reinterpret_cast<const bf16x8*>(kb+d0*2048);
    const bf16x8 b1=*reinterpret_cast<const bf16x8*>(kb+d0*2048+512);
    if(d0==0){p0=__builtin_amdgcn_mfma_f32_32x32x16_bf16(b0,qr[0],negm,0,0,0);p1=__builtin_amdgcn_mfma_f32_32x32x16_bf16(b1,qr[0],negm,0,0,0);}
    else{p0=__builtin_amdgcn_mfma_f32_32x32x16_bf16(b0,qr[d0],p0,0,0,0);p1=__builtin_amdgcn_mfma_f32_32x32x16_bf16(b1,qr[d0],p1,0,0,0);}}
}
typedef __attribute__((address_space(3))) const char* lds_cptr;
typedef short v4i16_t __attribute__((ext_vector_type(4)));
__device__ __forceinline__ void kload8(bf16x8*kf,lds_cptr kp){
  kf[0]=*(const __attribute__((address_space(3))) bf16x8*)(kp);      kf[1]=*(const __attribute__((address_space(3))) bf16x8*)(kp+512);
  kf[2]=*(const __attribute__((address_space(3))) bf16x8*)(kp+2048); kf[3]=*(const __attribute__((address_space(3))) bf16x8*)(kp+2560);
  kf[4]=*(const __attribute__((address_space(3))) bf16x8*)(kp+4096); kf[5]=*(const __attribute__((address_space(3))) bf16x8*)(kp+4608);
  kf[6]=*(const __attribute__((address_space(3))) bf16x8*)(kp+6144); kf[7]=*(const __attribute__((address_space(3))) bf16x8*)(kp+6656);
}
__device__ __forceinline__ void kload2(bf16x8*kf,lds_cptr kp,int j){ kf[2*j]=*(const __attribute__((address_space(3))) bf16x8*)(kp+j*2048); kf[2*j+1]=*(const __attribute__((address_space(3))) bf16x8*)(kp+j*2048+512); }
__device__ __forceinline__ s16x4 vtr(lds_cptr p){ return __builtin_bit_cast(s16x4,__builtin_amdgcn_ds_read_tr16_b64_v4i16((__attribute__((address_space(3))) v4i16_t*)p)); }
__device__ __forceinline__ float rowmax(const f32x16&p0,const f32x16&p1){
  float a=max3f(p0[0],p0[1],p1[0]),b=max3f(p0[2],p0[3],p1[1]);a=max3f(a,p1[2],p1[3]);
  #pragma unroll
  for(int r=4;r<16;r+=4){a=max3f(a,p0[r],p0[r+1]);b=max3f(b,p0[r+2],p0[r+3]);a=max3f(a,p1[r],p1[r+1]);b=max3f(b,p1[r+2],p1[r+3]);}
  const float m=max2f(a,b);
  auto rr=__builtin_amdgcn_permlane32_swap(__float_as_uint(m),__float_as_uint(m),false,false);
  return max2f(__uint_as_float(rr[0]),__uint_as_float(rr[1]));
}
__device__ __forceinline__ void pv(f32x16*o,int vb,bf16x8 pa0,bf16x8 pa1,bf16x8 pa2,bf16x8 pa3){
  #pragma unroll
  for(int d0=0;d0<2;++d0){s16x4 lo[4],hi[4];
    #pragma unroll
    for(int ks=0;ks<4;++ks){
      asm volatile("ds_read_b64_tr_b16 %0,%1 offset:%c2":"=&v"(lo[ks]):"v"(vb),"i"(d0*4096+ks*1024):"memory");
      asm volatile("ds_read_b64_tr_b16 %0,%1 offset:%c2":"=&v"(hi[ks]):"v"(vb),"i"(d0*4096+ks*1024+512):"memory");}
    asm volatile("s_waitcnt lgkmcnt(0)":::"memory");SBAR();
    #define PK(k) (bf16x8){lo[k][0],lo[k][1],lo[k][2],lo[k][3],hi[k][0],hi[k][1],hi[k][2],hi[k][3]}
    o[d0]=__builtin_amdgcn_mfma_f32_32x32x16_bf16(pa0,PK(0),o[d0],0,0,0);
    o[d0]=__builtin_amdgcn_mfma_f32_32x32x16_bf16(pa1,PK(1),o[d0],0,0,0);
    o[d0]=__builtin_amdgcn_mfma_f32_32x32x16_bf16(pa2,PK(2),o[d0],0,0,0);
    o[d0]=__builtin_amdgcn_mfma_f32_32x32x16_bf16(pa3,PK(3),o[d0],0,0,0);
    #undef PK
  }
}

#ifndef ATTN_STORE16
#define ATTN_STORE16(p,v) (*(u32x4*)(p)=(v))
#endif
template<int THRL> __device__ __forceinline__ void attn_unit(int b,int h,int qb,const bf16*Q,const bf16*__restrict__ K,const bf16*__restrict__ V,bf16*O,const float*__restrict__ LFT,const float Dd,char*shm){
  int tid=threadIdx.x; asm volatile("":"+v"(tid)); const int lane=tid&63,r32=lane&31,hi=lane>>5; const int wid=__builtin_amdgcn_readfirstlane(tid>>6);
  const long rowbase=(long)b*SEQ; const int q0=qb*QB;
  const bf16*Qw=Q+(rowbase+q0+wid*QBLK)*DM+h*D;
  const bf16*Kh=K+rowbase*DM+h*D,*Vh=V+rowbase*DM+h*D;
  const unsigned lds0=(unsigned)(uintptr_t)shm;
  float*wsf=(float*)(shm+LDS_WS)+wid*64;
  const bf16*ksrc=Kh+(long)lane*DM+wid*8;
  const bf16*vsrc=Vh+(long)(16*(wid&3)+(lane>>2))*DM+(wid>>2)*32+(lane&3)*8;
  const unsigned kdst=lds0+LDS_K+wid*1024, vdst=lds0+LDS_V+wid*1024;
  #define DMA_K(t,slot) glds16(ksrc+(long)(t)*KVBLK*DM,(unsigned)__builtin_amdgcn_readfirstlane(kdst+(slot)))
  #define DMA_V(t,slot) glds16(vsrc+(long)(t)*KVBLK*DM,(unsigned)__builtin_amdgcn_readfirstlane(vdst+(slot)))
  const int vb0=(int)(lds0+LDS_V)+((lane>>4)&1)*32+(lane&3)*8+(4*hi+((lane&15)>>2))*64;
  const char*Kbase=shm+LDS_K; bf16x8 kf[8];
  const lds_cptr shm3=(lds_cptr)shm; const lds_cptr kp0=shm3+LDS_K+hi*1024+r32*16; const lds_cptr vp0=shm3+LDS_V+((lane>>4)&1)*32+(lane&3)*8+(4*hi+((lane&15)>>2))*64;
  int NT=(q0+QB)/KVBLK;
  typedef __attribute__((address_space(3))) const f32x4v* lds_f4p;
  typedef __attribute__((address_space(3))) float* lds_fp;
  bool stat; int t0;
  {
    lds_fp cbw=(lds_fp)(shm3+LDS_CB); lds_fp cbx=(lds_fp)(shm3+LDS_CBX); lds_fp alw=(lds_fp)(shm3+LDS_AL);
    const float L2E=1.4426950408889634f;
    const int nk=q0+QB; float v0=0.f,v1=0.f,v2=0.f,v3=0.f;
    if(4*tid<nk){ const f32x4v l4=*(const f32x4v*)(LFT+((long)(b*NHEAD+h))*SEQ+4*tid); v0=l4[0]; v1=l4[1]; v2=l4[2]; v3=l4[3]; }
    v1+=v0; v2+=v1; v3+=v2; float tot=v3;
    #pragma unroll
    for(int o_=1;o_<64;o_<<=1){ float u_=__shfl_up(tot,o_); if(lane>=o_)tot+=u_; }
    if(lane==63)cbx[wid]=tot;
    if(tid==0){cbx[48]=0.f;}
    asm volatile("s_waitcnt vmcnt(0) lgkmcnt(0)\n\ts_barrier":::"memory");
    float base=tot-v3;
    #pragma unroll
    for(int w_=0;w_<NW;++w_){ float x_=cbx[w_]; if(w_<wid)base+=x_; }
    v0+=base;v1+=base;v2+=base;v3+=base;
    if(4*tid<nk && ((4*tid+3)&63)==63)cbx[16+((4*tid+3)>>6)]=v3;
    if(4*tid==q0)cbx[8]=v0;
    asm volatile("s_waitcnt vmcnt(0) lgkmcnt(0)\n\ts_barrier":::"memory");
    const float cq0=cbx[8];
    if(4*tid<nk){ const float ce=cbx[16+(tid>>4)]; cbw[4*tid]=(ce-v0)*L2E-Dd; cbw[4*tid+1]=(ce-v1)*L2E-Dd; cbw[4*tid+2]=(ce-v2)*L2E-Dd; cbw[4*tid+3]=(ce-v3)*L2E-Dd; }
    bool skip_=false;
    if(tid<NT){ const float ce=cbx[16+tid], cp=(tid>0)?cbx[16+tid-1]:0.f; const float dl_=(cp-ce)*L2E;
      alw[tid]=__builtin_amdgcn_exp2f(-dl_); alw[32+tid]=dl_; if(dl_+2.f*Dd>110.f)cbx[48]=1.f;
      skip_=(tid<NT-4)&&((ce-cq0)*L2E>2.f*Dd+160.f); }
    const unsigned long long bal_=__ballot(skip_);
    if(tid==0)cbx[49]=(float)(__popcll(bal_)&~1);
    asm volatile("s_waitcnt vmcnt(0) lgkmcnt(0)\n\ts_barrier":::"memory");
    stat=(cbx[48]==0.f); t0=(int)cbx[49];
    stat=__builtin_amdgcn_readfirstlane((int)stat)!=0; t0=__builtin_amdgcn_readfirstlane(t0);
#ifdef FORCE_EXACT
    stat=false;
#endif
  }
  NT-=t0; ksrc+=(long)t0*KVBLK*DM; vsrc+=(long)t0*KVBLK*DM;
  typedef __attribute__((address_space(3))) const float* lds_cfp;
  const lds_cfp alp=(lds_cfp)(shm3+LDS_AL)+t0;
  const int tdw=NT-4+(wid>>1);
  #define ALF(t) (((t)>tdw)?1.f:alp[t])
  const lds_f4p cbp=(lds_f4p)(shm3+LDS_CB)+hi+16*t0;
  #define CBIAS(P0,P1,t) do{ const lds_f4p bp_=cbp+16*(t); _Pragma("unroll") for(int a_=0;a_<4;++a_){ const f32x4v b0_=bp_[2*a_], b1_=bp_[8+2*a_]; \
      P0[4*a_]+=b0_[0];P0[4*a_+1]+=b0_[1];P0[4*a_+2]+=b0_[2];P0[4*a_+3]+=b0_[3]; P1[4*a_]+=b1_[0];P1[4*a_+1]+=b1_[1];P1[4*a_+2]+=b1_[2];P1[4*a_+3]+=b1_[3]; } }while(0)
  DMA_K(0,0);DMA_V(0,0);DMA_K(1,SLOTB);
  bf16x8 qr[4];
  #pragma unroll
  for(int d0=0;d0<4;++d0)qr[d0]=*reinterpret_cast<const bf16x8*>(&Qw[(long)r32*DM+d0*16+hi*8]);
  float mhat=0.f,l_reg=0.f;f32x16 o[2];o[0]=f32x16{};o[1]=f32x16{};
  const int qrel=wid*QBLK+r32;
  #define CMASK(P0,P1,t) do{int jb_=(t)-(NT-4); if(jb_>=0)cmask(P0,P1,jb_,qrel,hi);}while(0)
  bool resc=false;
  #define START(P0,P1) do{ resc=false; \
    if(!stat){ const float rm=rowmax(P0,P1); const float dl=rm; mhat=fadd_s(mhat,dl); \
      _Pragma("unroll") for(int r=0;r<16;++r){P0[r]=fsub_s(P0[r],dl);P1[r]=fsub_s(P1[r],dl);} \
      } \
    _Pragma("unroll") for(int r=0;r<16;++r)P0[r]=__builtin_amdgcn_exp2f(P0[r]); }while(0)
  #define RESC(t) do{ if(stat){ const float al_=ALF(t); _Pragma("unroll") for(int d_=0;d_<2;++d_) _Pragma("unroll") for(int r=0;r<16;++r)o[d_][r]*=al_; } \
    else if(resc){ asm volatile("s_waitcnt lgkmcnt(0)":::"memory"); \
      _Pragma("unroll") for(int d_=0;d_<2;++d_) _Pragma("unroll") for(int r=0;r<16;++r)o[d_][r]*=wsf[crow(r,hi)]; } }while(0)
  f32x16 pA0,pA1,pB0,pB1;
  int sl_prev=0,sl_cur=0,sl_next=SLOTB;
  #define ROT() do{sl_prev=sl_cur;sl_cur=sl_next;sl_next=(sl_next==(NSLOT-1)*SLOTB)?0:sl_next+SLOTB;}while(0)
  DMA_K(2,2*SLOTB);
  WAIT_BAR(3);
  qkt(pA0,pA1,Kbase,qr,r32,hi);asm volatile("s_nop 15\n\ts_nop 7":"+v"(pA0),"+v"(pA1));CMASK(pA0,pA1,0);CBIAS(pA0,pA1,0);
  START(pA0,pA1);
  _Pragma("unroll") for(int r=0;r<16;++r)pA1[r]=__builtin_amdgcn_exp2f(pA1[r]);
  WAIT_BAR(0);
  DMA_K(3,0);DMA_V(1,SLOTB);
  ROT();
  kload8(kf,kp0+sl_cur);
  WAIT_BAR(2);
  s16x4 vlo[8],vhi[8]; u32x4 pw0,pw1,pw2,pw3;
  #define PKW(P,B) cvtpk_s(P[B],P[B+1])
  #define PAF(k) __builtin_bit_cast(bf16x8,pw##k)
  #define VFR(i) (bf16x8){vlo[i][0],vlo[i][1],vlo[i][2],vlo[i][3],vhi[i][0],vhi[i][1],vhi[i][2],vhi[i][3]}
  #define PIN(x) asm volatile("":"+v"(x))
  #define MX3(a,b,c) __builtin_fmaxf(__builtin_fmaxf((a),(b)),(c))
  #define GAPA(MF,A0,A1,A2,A3,W0,W1,PW) do{ MF; sacc+=A0; sacc+=A1; sacc+=A2; sacc+=A3; PIN(sacc); W0; W1; PIN(PW); SBAR(); }while(0)
  #define EX(v) __builtin_amdgcn_exp2f(v)
  #define GAPB(MF,X,B) do{ MF; X[B]=EX(X[B]); X[B+1]=EX(X[B+1]); X[B+2]=EX(X[B+2]); X[B+3]=EX(X[B+3]); PIN(X); SBAR(); }while(0)
  #define VRD(i) do{ vlo[i]=vtr(vp_+(((i)>>2)*4096+((i)&3)*1024)); vhi[i]=vtr(vp_+(((i)>>2)*4096+((i)&3)*1024+512)); }while(0)
  #define KRD(G,j) do{ if(G){ kload2(kf,kp0+sl_next,j); SBAR(); } }while(0)
  #define STEP(C0,C1,P0,P1,t,GK,GV,GL) do{ SBAR(); \
    const lds_cptr vp_=vp0+sl_prev; \
    VRD(0); SBAR(); float sacc=(P0[0]+P0[1]); \
    GAPA(C0=__builtin_amdgcn_mfma_f32_32x32x16_bf16(kf[0],qr[0],f32x16{},0,0,0), P0[2],P0[3],P0[4],P0[5],     pw0[0]=PKW(P0,0), pw0[1]=PKW(P0,2), pw0); \
    VRD(4); SBAR(); GAPA(C1=__builtin_amdgcn_mfma_f32_32x32x16_bf16(kf[1],qr[0],f32x16{},0,0,0), P0[6],P0[7],P0[8],P0[9],     pw0[2]=PKW(P0,4), pw0[3]=PKW(P0,6), pw0); \
    VRD(1); SBAR(); GAPA(C0=__builtin_amdgcn_mfma_f32_32x32x16_bf16(kf[2],qr[1],C0,0,0,0),   P0[10],P0[11],P0[12],P0[13], pw1[0]=PKW(P0,8), pw1[1]=PKW(P0,10), pw1); \
    VRD(5); SBAR(); GAPA(C1=__builtin_amdgcn_mfma_f32_32x32x16_bf16(kf[3],qr[1],C1,0,0,0),   P0[14],P0[15],P1[0],P1[1],   pw1[2]=PKW(P0,12),pw1[3]=PKW(P0,14), pw1); \
    VRD(2); SBAR(); GAPA(C0=__builtin_amdgcn_mfma_f32_32x32x16_bf16(kf[4],qr[2],C0,0,0,0),   P1[2],P1[3],P1[4],P1[5],     pw2[0]=PKW(P1,0), pw2[1]=PKW(P1,2), pw2); \
    VRD(6); SBAR(); GAPA(C1=__builtin_amdgcn_mfma_f32_32x32x16_bf16(kf[5],qr[2],C1,0,0,0),   P1[6],P1[7],P1[8],P1[9],     pw2[2]=PKW(P1,4), pw2[3]=PKW(P1,6), pw2); \
    VRD(3); SBAR(); GAPA(C0=__builtin_amdgcn_mfma_f32_32x32x16_bf16(kf[6],qr[3],C0,0,0,0),   P1[10],P1[11],P1[12],P1[13], pw3[0]=PKW(P1,8), pw3[1]=PKW(P1,10), pw3); \
    VRD(7); SBAR(); GAPA(C1=__builtin_amdgcn_mfma_f32_32x32x16_bf16(kf[7],qr[3],C1,0,0,0),   P1[14],P1[15],0.f,0.f,       pw3[2]=PKW(P1,12),pw3[3]=PKW(P1,14), pw3); \
    l_reg+=sacc; \
    if(GK){DMA_K((t)+3,sl_cur);} if(GV){DMA_V((t)+1,sl_next);} \
    CMASK(C0,C1,t); CBIAS(C0,C1,t); \
    if(stat){ l_reg*=ALF(t); resc=false; } else { mhat-=alp[32+(t)]; _Pragma("unroll") for(int r=0;r<16;++r){C0[r]-=mhat;C1[r]-=mhat;} float a=MX3(C0[0],C0[1],C1[0]),b=MX3(C0[2],C0[3],C1[1]); a=MX3(a,C1[2],C1[3]); \
      _Pragma("unroll") for(int r=4;r<16;r+=4){a=MX3(a,C0[r],C0[r+1]);b=MX3(b,C0[r+2],C0[r+3]);a=MX3(a,C1[r],C1[r+1]);b=MX3(b,C1[r+2],C1[r+3]);} \
      float rm=__builtin_fmaxf(a,b); { auto rr=__builtin_amdgcn_permlane32_swap(__float_as_uint(rm),__float_as_uint(rm),false,false); rm=__builtin_fmaxf(__uint_as_float(rr[0]),__uint_as_float(rr[1])); } \
      resc=false; \
      if(__builtin_expect(__any(rm>(float)THRL),0)){ const float dl=__builtin_fmaxf(rm,0.f); mhat+=dl; \
        _Pragma("unroll") for(int r=0;r<16;++r){C0[r]-=dl;C1[r]-=dl;} \
        const float f=__builtin_amdgcn_exp2f(-dl); l_reg*=f; if(hi==0)wsf[r32]=f; resc=true; } } \
    SBAR(); \
    GAPB(o[0]=__builtin_amdgcn_mfma_f32_32x32x16_bf16(PAF(0),VFR(0),o[0],0,0,0), C0,0); \
    GAPB(o[1]=__builtin_amdgcn_mfma_f32_32x32x16_bf16(PAF(0),VFR(4),o[1],0,0,0), C0,4); \
    KRD(GL,0); GAPB(o[0]=__builtin_amdgcn_mfma_f32_32x32x16_bf16(PAF(1),VFR(1),o[0],0,0,0), C0,8); \
    KRD(GL,1); GAPB(o[1]=__builtin_amdgcn_mfma_f32_32x32x16_bf16(PAF(1),VFR(5),o[1],0,0,0), C0,12); \
    KRD(GL,2); GAPB(o[0]=__builtin_amdgcn_mfma_f32_32x32x16_bf16(PAF(2),VFR(2),o[0],0,0,0), C1,0); \
    KRD(GL,3); GAPB(o[1]=__builtin_amdgcn_mfma_f32_32x32x16_bf16(PAF(2),VFR(6),o[1],0,0,0), C1,4); \
    GAPB(o[0]=__builtin_amdgcn_mfma_f32_32x32x16_bf16(PAF(3),VFR(3),o[0],0,0,0), C1,8); \
    GAPB(o[1]=__builtin_amdgcn_mfma_f32_32x32x16_bf16(PAF(3),VFR(7),o[1],0,0,0), C1,12); \
    }while(0)
  int t=1;
  #undef CMASK
  #define CMASK(P0,P1,t) do{}while(0)
  for(;t+5<NT;t+=2){
    STEP(pB0,pB1,pA0,pA1,t,true,true,true);     WAIT_BAR(2); RESC(t); ROT();
    STEP(pA0,pA1,pB0,pB1,t+1,true,true,true);   WAIT_BAR(2); RESC(t+1); ROT();
  }
  #undef CMASK
  #define CMASK(P0,P1,t) do{int jb_=(t)-(NT-4); if(jb_>=0)cmask(P0,P1,jb_,qrel,hi);}while(0)
  #define ENDW(tt) do{ if((tt)+3<NT){WAIT_BAR(2);} else if((tt)+2<NT){WAIT_BAR(1);} else {WAIT_BAR(0);} }while(0)
  for(;t+1<NT;t+=2){
    STEP(pB0,pB1,pA0,pA1,t,(t+3<NT),(t+1<NT),(t+1<NT));       ENDW(t);   RESC(t); ROT();
    STEP(pA0,pA1,pB0,pB1,t+1,(t+4<NT),(t+2<NT),(t+2<NT));     ENDW(t+1); RESC(t+1); ROT();
  }
  STEP(pB0,pB1,pA0,pA1,NT-1,false,false,false); RESC(NT-1);
  { float sacc=pB0[0]+pB0[1]; _Pragma("unroll") for(int r=2;r<16;++r)sacc+=pB0[r]; _Pragma("unroll") for(int r=0;r<16;++r)sacc+=pB1[r]; l_reg+=sacc;
    pw0=(u32x4){PKW(pB0,0),PKW(pB0,2),PKW(pB0,4),PKW(pB0,6)};pw1=(u32x4){PKW(pB0,8),PKW(pB0,10),PKW(pB0,12),PKW(pB0,14)};pw2=(u32x4){PKW(pB1,0),PKW(pB1,2),PKW(pB1,4),PKW(pB1,6)};pw3=(u32x4){PKW(pB1,8),PKW(pB1,10),PKW(pB1,12),PKW(pB1,14)};
    SBAR(); pv(o,vb0+sl_cur,PAF(0),PAF(1),PAF(2),PAF(3)); }
  #undef PKW
  #undef PAF
  #undef VFR
  #undef PIN
  #undef MX3
  #undef GAPA
  #undef GAPB
  #undef EX
  #undef VRD
  #undef KRD
  #undef STEP
  #undef ENDW
  {auto rr=__builtin_amdgcn_permlane32_swap(__float_as_uint(l_reg),__float_as_uint(l_reg),false,false);l_reg=__uint_as_float(rr[0])+__uint_as_float(rr[1]);}
  if(hi==0)wsf[32+r32]=l_reg;asm volatile("s_waitcnt lgkmcnt(0)":::"memory");
  float rli[16];
  #pragma unroll
  for(int r=0;r<16;++r)rli[r]=__builtin_amdgcn_rcpf(wsf[32+crow(r,hi)]);
  bf16*Ow=O+(rowbase+q0+wid*QBLK)*DM+h*D;
  { bf16*stg=(bf16*)(shm+LDS_OST)+wid*2048;
    #pragma unroll
    for(int r=0;r<16;++r){const int orow=crow(r,hi);
      #pragma unroll
      for(int d0=0;d0<2;++d0)stg[orow*64+d0*32+r32]=__float2bfloat16(o[d0][r]*rli[r]);}
    asm volatile("s_waitcnt lgkmcnt(0)":::"memory");
    #pragma unroll
    for(int i=0;i<4;++i){const int row=i*8+(lane>>3),ch=lane&7; const u32x4 v=*(const u32x4*)(stg+row*64+ch*8); ATTN_STORE16(Ow+(long)row*DM+ch*8,v);} }
  asm volatile("s_waitcnt lgkmcnt(0)\n\ts_barrier":::"memory");
  #undef DMA_K
  #undef DMA_V
  #undef CMASK
  #undef CBIAS
  #undef ALF
  #undef START
  #undef RESC
  #undef ROT
}
constexpr int ATTN_LDS_BYTES=LDS_BYTES;
#undef SBAR
#undef WAIT_BAR
}
namespace xb {
#define XLAS __attribute__((address_space(3)))
#define XB_TMO      128
#define XB_XCNT(j)  (256  + 64 * (j))
#define XB_XSUB(j)  (1280 + 64 * (j))
#define XB_XGEN(j)  (2304 + 64 * (j))
#define XB_TOP      3328
#define XB_TOPGEN   3392
#define XCD_BAR_WORDS 3456
#define XB_SPIN_CAP (1u << 18)

__device__ __forceinline__ unsigned xb_ld(unsigned* p)              { return __hip_atomic_load(p, __ATOMIC_RELAXED, __HIP_MEMORY_SCOPE_AGENT); }
__device__ __forceinline__ unsigned xb_add(unsigned* p, unsigned v) { return __hip_atomic_fetch_add(p, v, __ATOMIC_RELAXED, __HIP_MEMORY_SCOPE_AGENT); }
__device__ __forceinline__ unsigned xb_xcc_id() { return (unsigned)__builtin_amdgcn_s_getreg((3 << 11) | 20) & 0xFu; }
#define XB_SPIN(cond, bar) do { unsigned _sp = 0; while (cond) { __builtin_amdgcn_s_sleep(1); \
    if ((++_sp & 255u) == 0u) { if (xb_ld(&(bar)[XB_TMO])) break; if (_sp > XB_SPIN_CAP) { atomicAdd(&(bar)[XB_TMO], 1u); break; } } } } while (0)

struct XcdBarrier {
    unsigned* bar; unsigned x;
    volatile XLAS unsigned* st;
};

__device__ __forceinline__ XcdBarrier xcd_barrier_post(unsigned* bar, volatile XLAS unsigned* st) {
    XcdBarrier b; b.bar = bar; b.x = xb_xcc_id(); b.st = st;
    if (threadIdx.x == 0) (void)xb_add(&bar[XB_XCNT(b.x)], 1u);
    return b;
}
__device__ __forceinline__ void xcd_barrier_complete(unsigned* bar, unsigned x, unsigned& nloc, unsigned& nx) {
    const unsigned G = gridDim.x * gridDim.y * gridDim.z;
    unsigned sum, cnt, mine, sp = 0u;
    for (;;) {
        sum = 0u; cnt = 0u; mine = 0u;
#pragma unroll
        for (unsigned j = 0; j < 16; ++j) { const unsigned c = xb_ld(&bar[XB_XCNT(j)]); sum += c; cnt += (c > 0u) ? 1u : 0u; mine = (j == x) ? c : mine; }
        if (sum == G) break;
        __builtin_amdgcn_s_sleep(1);
        if ((++sp & 255u) == 0u) { if (xb_ld(&bar[XB_TMO])) break; if (sp > XB_SPIN_CAP) { atomicAdd(&bar[XB_TMO], 1u); break; } }
    }
    nloc = mine > 0u ? mine : 1u; nx = cnt > 0u ? cnt : 1u;
}

__device__ __forceinline__ void xcd_barrier(const XcdBarrier& b) {
    asm volatile("s_waitcnt vmcnt(0)" ::: "memory");
    __syncthreads();
    if (threadIdx.x == 0) {
        unsigned* bar = b.bar;
        __builtin_amdgcn_s_waitcnt(0);
        unsigned nloc = b.st[0], nx = b.st[1];
        if (nloc == 0u) { xcd_barrier_complete(bar, b.x, nloc, nx); b.st[0] = nloc; b.st[1] = nx; }
        const unsigned old = xb_add(&bar[XB_XSUB(b.x)], 1u);
        const unsigned gen = old / nloc;
        if (old + 1u == (gen + 1u) * nloc) {
            __builtin_amdgcn_fence(__ATOMIC_RELEASE, "agent");
            asm volatile("s_waitcnt vmcnt(0)" ::: "memory");
            const unsigned og = xb_add(&bar[XB_TOP], 1u);
            const unsigned tg = og / nx;
            if (og + 1u == (tg + 1u) * nx) xb_add(&bar[XB_TOPGEN], 1u);
            else XB_SPIN(xb_ld(&bar[XB_TOPGEN]) == tg, bar);
            __builtin_amdgcn_fence(__ATOMIC_ACQUIRE, "agent");
            xb_add(&bar[XB_XGEN(b.x)], 1u);
            asm volatile("s_waitcnt vmcnt(0)" ::: "memory");
        } else {
            XB_SPIN(xb_ld(&bar[XB_XGEN(b.x)]) == gen, bar);
            __builtin_amdgcn_fence(__ATOMIC_ACQUIRE, "agent");
            asm volatile("s_waitcnt vmcnt(0)" ::: "memory");
        }
    }
    __syncthreads();
}
}
namespace mk {
#define LAS __attribute__((address_space(3)))
typedef unsigned short u16;
typedef pg8::f32x4 f32x4;
typedef pg8::u32x4 u32x4;
typedef pg8::bf16x8 bf16x8;
typedef unsigned u32x2 __attribute__((ext_vector_type(2)));
using pg8::cvt_pk_bf16;

constexpr int DMODEL = 1024, SEQ = 2048, MP = 65536, MS = 256, MT = MP + MS, DFF = 2816, NMIX = 6912, PAST = 4096, NPOS = 2048 + 16;
constexpr float L2E = 1.4426950408889634f;
constexpr float QC2 = 0.125f * L2E;

constexpr size_t SZ1024 = (size_t)MT * 1024 * 2, SZ512 = (size_t)MT * 512 * 2;
constexpr size_t O_CTL = 0;
constexpr size_t O_SS = 65536;
constexpr size_t O_TABC = O_SS + (size_t)MT * 64;
constexpr size_t O_TABS = O_TABC + (size_t)NPOS * 256;
constexpr size_t O_W1IN = O_TABS + (size_t)NPOS * 256;
constexpr size_t O_W1OUT = O_W1IN + (size_t)5632 * 1024 * 2;
constexpr size_t O_WMIX = O_W1OUT + (size_t)1024 * 2816 * 2;
constexpr size_t O_WBR = O_WMIX + (size_t)NMIX * 1024 * 2;
constexpr size_t O_WBF = O_WBR + (size_t)1024 * 1024 * 2;
constexpr size_t O_WOUT = O_WBF + (size_t)1024 * 512 * 2;
constexpr size_t O_W2IN = O_WOUT + (size_t)1024 * 1024 * 2;
constexpr size_t O_W2OUT = O_W2IN + (size_t)5632 * 1024 * 2;
constexpr size_t O_WPLE = O_W2OUT + (size_t)1024 * 2816 * 2;
constexpr size_t O_WPG = O_WPLE + (size_t)1024 * 256 * 2;
constexpr size_t O_XB = O_WPG + (size_t)1024 * 1024 * 2;
constexpr size_t O_RQK = O_XB + SZ1024;
constexpr size_t O_RV = O_RQK + SZ1024;
constexpr size_t O_RG = O_RV + SZ1024;
constexpr size_t O_FQ = O_RG + SZ1024;
constexpr size_t O_FK = O_FQ + SZ512;
constexpr size_t O_FV = O_FK + SZ512;
constexpr size_t O_ZG = O_FV + SZ512;
constexpr size_t WS_NEED = O_ZG + (size_t)MT * 2048 * 2;
constexpr size_t O_ACT1 = O_RQK;
constexpr size_t O_ACT2 = O_RV;
static_assert(O_ACT1 + (size_t)MT * DFF * 2 <= O_FQ, "act1 overlay");
static_assert(O_ACT2 + (size_t)MT * DFF * 2 <= O_FV, "act2 overlay");
static_assert(WS_NEED <= 1073741824ull, "ws");
constexpr size_t OUT_YP = 0, OUT_YS = OUT_YP + (size_t)MP * 1024, OUT_RSP = OUT_YS + (size_t)MS * 1024, OUT_KP = OUT_RSP + (size_t)32 * 4 * 128 * 256,
                 OUT_VP = OUT_KP + (size_t)MP * 512, OUT_LP = OUT_VP + (size_t)MP * 512, OUT_RSS = OUT_LP + (size_t)MP * 8, OUT_KS = OUT_RSS + (size_t)16 * 4 * 128 * 256,
                 OUT_VS = OUT_KS + (size_t)MS * 512, OUT_LS = OUT_VS + (size_t)MS * 512, OUT_END = OUT_LS + (size_t)MS * 8;

constexpr int LDS_BYTES = 147456;

__device__ __forceinline__ float bf2f(unsigned h) { return __uint_as_float(h << 16); }
__device__ __forceinline__ float bflo(unsigned w) { return __uint_as_float(w << 16); }
__device__ __forceinline__ float bfhi(unsigned w) { return __uint_as_float(w & 0xffff0000u); }
__device__ __forceinline__ float fast_sigmoid(float x) { return __builtin_amdgcn_rcpf(1.f + __builtin_amdgcn_exp2f(-x * L2E)); }
__device__ __forceinline__ float wave_sum(float v) {
#pragma unroll
    for (int o = 1; o < 64; o <<= 1) v += __shfl_xor(v, o);
    return v;
}
__device__ __forceinline__ float wave_max(float v) {
#pragma unroll
    for (int o = 1; o < 64; o <<= 1) v = fmaxf(v, __shfl_xor(v, o));
    return v;
}
__device__ __forceinline__ float rstd_of(const float* ss, int row) {
    const f32x4* p = (const f32x4*)(ss + (size_t)row * 16); const f32x4 a = p[0], b = p[1], c = p[2], d = p[3];
    const float s = (((a[0] + a[1]) + (a[2] + a[3])) + ((b[0] + b[1]) + (b[2] + b[3]))) + (((c[0] + c[1]) + (c[2] + c[3])) + ((d[0] + d[1]) + (d[2] + d[3])));
    return rsqrtf(s * (1.f / 1024.f) + 1e-6f);
}
__device__ __forceinline__ int gcol(int q) { return (q & 128) + (q & 96) + ((q >> 2) & 3) * 8 + ((q >> 4) & 1) * 4 + (q & 3); }


constexpr int RS_TAB_OFF = 147456 - 128 - 1024;
__device__ __forceinline__ const LAS float* rs_table_fill(const float* ss, int pm) {
    LAS float* tab = (LAS float*)(uintptr_t)RS_TAB_OFF;
    const int t = threadIdx.x;
    if (t < 256) tab[t] = rstd_of(ss, pm * 256 + t);
    asm volatile("s_waitcnt lgkmcnt(0)" ::: "memory"); __builtin_amdgcn_s_barrier(); asm volatile("" ::: "memory");
    return tab;
}
struct EpiSwiglu {
    static constexpr bool PERM = false, AFTER_DRAIN = false;
    u16* O; const float* ss;
    __device__ __forceinline__ void operator()(const f32x4 (&acc)[2][2][4][2], const pg8::Unit& u, int wr, int wc, int fr, int fq) const {
        const int col = u.pn * 128 + wc * 32 + fq * 8; const LAS float* rst = rs_table_fill(ss, u.pm);
#pragma unroll
        for (int ai = 0; ai < 2; ++ai)
#pragma unroll
            for (int m = 0; m < 4; ++m) {
                const int row = u.pm * 256 + ai * 128 + wr * 64 + m * 16 + fr; const float rs = rst[ai * 128 + wr * 64 + m * 16 + fr];
                float a[8];
#pragma unroll
                for (int n = 0; n < 2; ++n)
#pragma unroll
                    for (int e = 0; e < 4; ++e) { const float g = acc[ai][0][m][n][e] * rs, uu = acc[ai][1][m][n][e] * rs; a[n * 4 + e] = g * uu * fast_sigmoid(g); }
                u32x4 w; w.x = cvt_pk_bf16(a[0], a[1]); w.y = cvt_pk_bf16(a[2], a[3]); w.z = cvt_pk_bf16(a[4], a[5]); w.w = cvt_pk_bf16(a[6], a[7]);
                *(u32x4*)(O + (size_t)row * DFF + col) = w;
            }
    }
};
struct EpiMix {
    static constexpr bool PERM = false, AFTER_DRAIN = false;
    const float* ss; const float* tabc; const float* tabs; const float* qg; const float* kg; const float* bfg;
    u16 *RQK, *RV, *RG, *FQ, *FK, *FV, *ZG; float* out; float* lft;
    template <int MODE> static __device__ __forceinline__ void store8(const f32x4 (&acc)[2][2][4][2], u16* base, int ld, int t, int row, float rs, int ai, int m, int wc, int fq) {
#pragma unroll
        for (int bj = 0; bj < 2; ++bj) {
            float a[8];
#pragma unroll
            for (int n = 0; n < 2; ++n)
#pragma unroll
                for (int e = 0; e < 4; ++e) { const float v = acc[ai][bj][m][n][e] * rs; a[n * 4 + e] = MODE == 0 ? v : (MODE == 1 ? v * fast_sigmoid(v) : fast_sigmoid(v)); }
            u32x4 w; w.x = cvt_pk_bf16(a[0], a[1]); w.y = cvt_pk_bf16(a[2], a[3]); w.z = cvt_pk_bf16(a[4], a[5]); w.w = cvt_pk_bf16(a[6], a[7]);
            *(u32x4*)(base + (size_t)row * ld + t * 256 + bj * 128 + wc * 32 + fq * 8) = w;
        }
    }
    template <bool ISK> static __device__ __forceinline__ void headnorm(const f32x4 (&acc)[2][2][4][2], u16* dst, const float* gn, float* o, int row, float rs, int ai, int m, int head, int fq) {
        float q = 0.f;
#pragma unroll
        for (int bj = 0; bj < 2; ++bj)
#pragma unroll
            for (int n = 0; n < 2; ++n) { const f32x4 v = acc[ai][bj][m][n] * rs; q += (v[0] * v[0] + v[1] * v[1]) + (v[2] * v[2] + v[3] * v[3]); }
        q += __shfl_xor(q, 16); q += __shfl_xor(q, 32);
        const float hr = rsqrtf(q * (1.f / 64.f) + 1e-6f) * rs * (ISK ? 1.f : QC2);
#pragma unroll
        for (int bj = 0; bj < 2; ++bj)
#pragma unroll
            for (int n = 0; n < 2; ++n) {
                const int d = 32 * bj + 16 * n + 4 * fq; const f32x4 g4 = *(const f32x4*)(gn + d); const f32x4 v = acc[ai][bj][m][n] * hr * g4;
                u32x2 w; w.x = cvt_pk_bf16(v[0], v[1]); w.y = cvt_pk_bf16(v[2], v[3]);
                *(u32x2*)(dst + (size_t)row * 512 + head * 64 + d) = w;
                if (ISK) *(f32x4*)(o + head * 64 + d) = v;
            }
    }
    __device__ __forceinline__ void operator()(const f32x4 (&acc)[2][2][4][2], const pg8::Unit& u, int wr, int wc, int fr, int fq) const {
        const int pn = u.pn; const LAS float* rst = rs_table_fill(ss, u.pm);
#pragma unroll
        for (int ai = 0; ai < 2; ++ai)
#pragma unroll
            for (int m = 0; m < 4; ++m) {
                const int row = u.pm * 256 + ai * 128 + wr * 64 + m * 16 + fr; const float rs = rst[ai * 128 + wr * 64 + m * 16 + fr];
                if (pn < 4) {
                    const int pidx = row < MP ? (row & (SEQ - 1)) : SEQ + ((row - MP) & 15);
                    const int d = 16 * wc + 4 * fq;
                    const f32x4 c = *(const f32x4*)(tabc + pidx * 64 + d), s = *(const f32x4*)(tabs + pidx * 64 + d);
                    const float sc = rs * (pn >= 2 ? 0.08838834764831845f : 1.f);
#pragma unroll
                    for (int bj = 0; bj < 2; ++bj) {
                        const f32x4 x1 = acc[ai][bj][m][0] * sc, x2 = acc[ai][bj][m][1] * sc;
                        const f32x4 o1 = x1 * c - x2 * s, o2 = x1 * s + x2 * c;
                        u16* p = RQK + (size_t)row * 1024 + (pn >> 1) * 512 + (2 * (pn & 1) + bj) * 128 + d;
                        u32x2 w1, w2; w1.x = cvt_pk_bf16(o1[0], o1[1]); w1.y = cvt_pk_bf16(o1[2], o1[3]); w2.x = cvt_pk_bf16(o2[0], o2[1]); w2.y = cvt_pk_bf16(o2[2], o2[3]);
                        *(u32x2*)p = w1; *(u32x2*)(p + 64) = w2;
                    }
                } else if (pn < 8) { store8<0>(acc, RV, 1024, pn - 4, row, rs, ai, m, wc, fq);
                } else if (pn < 12) { store8<1>(acc, RG, 1024, pn - 8, row, rs, ai, m, wc, fq);
                } else if (pn >= 19) { store8<2>(acc, ZG, 2048, pn - 19, row, rs, ai, m, wc, fq);
                } else if (pn < 14) { headnorm<false>(acc, FQ, qg, nullptr, row, rs, ai, m, 4 * (pn & 1) + wc, fq);
                } else if (pn < 16) { headnorm<true>(acc, FK, kg, row < MP ? out + OUT_KP + (size_t)row * 512 : out + OUT_KS + (size_t)(row - MP) * 512, row, rs, ai, m, 4 * (pn & 1) + wc, fq);
                } else if (pn < 18) {
                    float* o = row < MP ? out + OUT_VP + (size_t)row * 512 : out + OUT_VS + (size_t)(row - MP) * 512;
#pragma unroll
                    for (int bj = 0; bj < 2; ++bj) {
                        const int col = (pn - 16) * 256 + bj * 128 + wc * 32 + fq * 8;
                        const f32x4 v0 = acc[ai][bj][m][0] * rs, v1 = acc[ai][bj][m][1] * rs;
                        u32x4 w; w.x = cvt_pk_bf16(v0[0], v0[1]); w.y = cvt_pk_bf16(v0[2], v0[3]); w.z = cvt_pk_bf16(v1[0], v1[1]); w.w = cvt_pk_bf16(v1[2], v1[3]);
                        *(u32x4*)(FV + (size_t)row * 512 + col) = w; *(f32x4*)(o + col) = v0; *(f32x4*)(o + col + 4) = v1;
                    }
                } else {
                    if (wc == 0 && fq == 0) {
                        float* o = row < MP ? out + OUT_LP + (size_t)row * 8 : out + OUT_LS + (size_t)(row - MP) * 8;
#pragma unroll
                        for (int n = 0; n < 2; ++n) { f32x4 r;
#pragma unroll
                            for (int e = 0; e < 4; ++e) { const float x = acc[ai][0][m][n][e] * rs + bfg[n * 4 + e]; r[e] = fminf(x, 0.f) - __logf(1.f + __expf(-fabsf(x))); }
                            *(f32x4*)(o + n * 4) = r;
                            if (row < MP) { float* lt = lft + ((size_t)(row >> 11) * 8 + n * 4) * SEQ + (row & (SEQ - 1)); lt[0] = r[0]; lt[SEQ] = r[1]; lt[2 * SEQ] = r[2]; lt[3 * SEQ] = r[3]; } }
                    }
                }
            }
    }
};
struct FResid {
    static constexpr bool NEED_RS = false, WRITE_SS = true; static constexpr int BATCH = 4;
    u16* XB; float* ss; float alpha;
    struct In { u32x4 x; };
    __device__ __forceinline__ In load(int row, int col) const { In r; r.x = *(const u32x4*)(XB + (size_t)row * 1024 + col); return r; }
    __device__ __forceinline__ float finish(int row, int col, const float (&v)[8], const In& in, float) const {
        const u32x4 x = in.x;
        const float r0 = bflo(x.x) + alpha * v[0], r1 = bfhi(x.x) + alpha * v[1], r2 = bflo(x.y) + alpha * v[2], r3 = bfhi(x.y) + alpha * v[3],
                    r4 = bflo(x.z) + alpha * v[4], r5 = bfhi(x.z) + alpha * v[5], r6 = bflo(x.w) + alpha * v[6], r7 = bfhi(x.w) + alpha * v[7];
        u32x4 w; w.x = cvt_pk_bf16(r0, r1); w.y = cvt_pk_bf16(r2, r3); w.z = cvt_pk_bf16(r4, r5); w.w = cvt_pk_bf16(r6, r7); *(u32x4*)(XB + (size_t)row * 1024 + col) = w;
        return ((r0 * r0 + r1 * r1) + (r2 * r2 + r3 * r3)) + ((r4 * r4 + r5 * r5) + (r6 * r6 + r7 * r7));
    }
};
template <bool SECOND> struct FGate {
    static constexpr bool NEED_RS = false, WRITE_SS = false; static constexpr int BATCH = 4;
    u16* T; const u16* ZG; float* ss;
    struct In { u32x4 g, p; };
    __device__ __forceinline__ In load(int row, int col) const { In r; r.g = *(const u32x4*)(ZG + (size_t)row * 2048 + (SECOND ? 1024 : 0) + col); if (SECOND) r.p = *(const u32x4*)(T + (size_t)row * 1024 + col); else r.p = (u32x4){0u, 0u, 0u, 0u}; return r; }
    __device__ __forceinline__ float finish(int row, int col, const float (&a)[8], const In& in, float) const {
        const u32x4 g = in.g, p = in.p;
        float v[8] = {bflo(g.x) * a[0], bfhi(g.x) * a[1], bflo(g.y) * a[2], bfhi(g.y) * a[3], bflo(g.z) * a[4], bfhi(g.z) * a[5], bflo(g.w) * a[6], bfhi(g.w) * a[7]};
        if (SECOND) { v[0] += bflo(p.x); v[1] += bfhi(p.x); v[2] += bflo(p.y); v[3] += bfhi(p.y); v[4] += bflo(p.z); v[5] += bfhi(p.z); v[6] += bflo(p.w); v[7] += bfhi(p.w); }
        u32x4 w; w.x = cvt_pk_bf16(v[0], v[1]); w.y = cvt_pk_bf16(v[2], v[3]); w.z = cvt_pk_bf16(v[4], v[5]); w.w = cvt_pk_bf16(v[6], v[7]);
        *(u32x4*)(T + (size_t)row * 1024 + col) = w; return 0.f;
    }
};
struct FPlain {
    static constexpr bool NEED_RS = false, WRITE_SS = false; static constexpr int BATCH = 4;
    u16* O; float* ss;
    struct In { int dummy; };
    __device__ __forceinline__ In load(int, int) const { In r; r.dummy = 0; return r; }
    __device__ __forceinline__ float finish(int row, int col, const float (&a)[8], const In&, float) const {
        u32x4 w; w.x = cvt_pk_bf16(a[0], a[1]); w.y = cvt_pk_bf16(a[2], a[3]); w.z = cvt_pk_bf16(a[4], a[5]); w.w = cvt_pk_bf16(a[6], a[7]);
        *(u32x4*)(O + (size_t)row * 1024 + col) = w; return 0.f;
    }
};
struct FFinal {
    static constexpr bool NEED_RS = true, WRITE_SS = false; static constexpr int BATCH = 2;
    float* yP; float* yS; const u16* XB; const u16* PLE; float* ss;
    struct In { u32x4 x, p; };
    __device__ __forceinline__ In load(int row, int col) const { In r; r.x = *(const u32x4*)(XB + (size_t)row * 1024 + col); r.p = *(const u32x4*)(PLE + (size_t)row * 1024 + col); return r; }
    __device__ __forceinline__ float finish(int row, int col, const float (&a)[8], const In& in, float rs) const {
        float* y = (row < MP ? yP + (size_t)row * 1024 : yS + (size_t)(row - MP) * 1024) + col;
        const u32x4 x = in.x, p = in.p;
        f32x4 y0, y1;
        y0[0] = bflo(x.x) + bflo(p.x) * fast_sigmoid(a[0] * rs); y0[1] = bfhi(x.x) + bfhi(p.x) * fast_sigmoid(a[1] * rs); y0[2] = bflo(x.y) + bflo(p.y) * fast_sigmoid(a[2] * rs); y0[3] = bfhi(x.y) + bfhi(p.y) * fast_sigmoid(a[3] * rs);
        y1[0] = bflo(x.z) + bflo(p.z) * fast_sigmoid(a[4] * rs); y1[1] = bfhi(x.z) + bfhi(p.z) * fast_sigmoid(a[5] * rs); y1[2] = bflo(x.w) + bflo(p.w) * fast_sigmoid(a[6] * rs); y1[3] = bfhi(x.w) + bfhi(p.w) * fast_sigmoid(a[7] * rs);
        *(f32x4*)y = y0; *(f32x4*)(y + 4) = y1; return 0.f;
    }
};
template <class F> struct EpiWrap {
    static constexpr bool PERM = false, AFTER_DRAIN = false;
    F f;
    __device__ __forceinline__ void operator()(const f32x4 (&acc)[2][2][4][2], const pg8::Unit& u, int wr, int wc, int fr, int fq) const {
        constexpr int NB = F::BATCH; const LAS float* rst = nullptr; if (F::NEED_RS) rst = rs_table_fill(f.ss, u.pm);
#pragma unroll
        for (int ab = 0; ab < 8 / NB; ++ab) {
            const int ai = (ab * NB) / 4, m0 = (ab * NB) % 4;
            typename F::In in[NB][2];
            const int row0 = u.pm * 256 + ai * 128 + wr * 64 + fr + m0 * 16, col0 = u.pn * 256 + wc * 32 + fq * 8;
#pragma unroll
            for (int m = 0; m < NB; ++m) {
#pragma unroll
                for (int bj = 0; bj < 2; ++bj) in[m][bj] = f.load(row0 + m * 16, col0 + bj * 128);
            }
            __builtin_amdgcn_sched_barrier(0);
#pragma unroll
            for (int m = 0; m < NB; ++m) {
                const int row = row0 + m * 16; float rs = 1.f;
                if (F::NEED_RS) rs = rst[ai * 128 + wr * 64 + (m0 + m) * 16 + fr];
                float q = 0.f;
#pragma unroll
                for (int bj = 0; bj < 2; ++bj) {
                    const float v[8] = {acc[ai][bj][m0 + m][0][0], acc[ai][bj][m0 + m][0][1], acc[ai][bj][m0 + m][0][2], acc[ai][bj][m0 + m][0][3], acc[ai][bj][m0 + m][1][0], acc[ai][bj][m0 + m][1][1], acc[ai][bj][m0 + m][1][2], acc[ai][bj][m0 + m][1][3]};
                    q += f.finish(row, col0 + bj * 128, v, in[m][bj], rs);
                }
                if (F::WRITE_SS) { q += __shfl_xor(q, 16); q += __shfl_xor(q, 32); if (fq == 0) f.ss[(size_t)row * 16 + u.pn * 4 + wc] = q; }
            }
        }
    }
};
template <class F> __device__ __forceinline__ void small_gemm(LAS unsigned char* lds, const u16* A, const u16* Bt, int K, const F& f, int bx, int G) {
    int tid = threadIdx.x; asm volatile("" : "+v"(tid));
    const int lane = tid & 63, w = __builtin_amdgcn_readfirstlane(tid >> 6), g = lane >> 4, c16 = lane & 15;
    LAS float* red = (LAS float*)lds;
    const int steps = K / 256;
    for (int item = bx; item < 256; item += G) {
        const int rb = item >> 4, cb = item & 15;
        const u16* ap = A + (size_t)(16 * rb + c16) * K + (size_t)w * (K / 8) + 8 * g;
        const u16* bp = Bt + (size_t)(64 * cb + c16) * K + (size_t)w * (K / 8) + 8 * g;
        f32x4 acc[4];
#pragma unroll
        for (int nt = 0; nt < 4; ++nt) acc[nt] = (f32x4){0.f, 0.f, 0.f, 0.f};
        for (int s0 = 0; s0 < steps; s0 += 4) {
            bf16x8 a[4], b[4][4];
#pragma unroll
            for (int j = 0; j < 4; ++j) if (s0 + j < steps) { a[j] = *(const bf16x8*)(ap + 32 * (s0 + j));
#pragma unroll
                for (int nt = 0; nt < 4; ++nt) b[j][nt] = *(const bf16x8*)(bp + (size_t)16 * nt * K + 32 * (s0 + j)); }
#pragma unroll
            for (int j = 0; j < 4; ++j) if (s0 + j < steps) {
#pragma unroll
                for (int nt = 0; nt < 4; ++nt) acc[nt] = __builtin_amdgcn_mfma_f32_16x16x32_bf16(a[j], b[j][nt], acc[nt], 0, 0, 0); }
        }
        __syncthreads();
#pragma unroll
        for (int nt = 0; nt < 4; ++nt)
#pragma unroll
            for (int i = 0; i < 4; ++i) red[(w * 16 + 4 * g + i) * 64 + 16 * nt + c16] = acc[nt][i];
        __syncthreads();
        if (tid < 128) {
            const int row = tid >> 3, c8 = tid & 7, p0 = 32 * (c8 >> 2) + 4 * (c8 & 3);
            f32x4 s0 = {0.f, 0.f, 0.f, 0.f}, s1 = {0.f, 0.f, 0.f, 0.f};
#pragma unroll
            for (int ww = 0; ww < 8; ++ww) { s0 += *(const LAS f32x4*)(red + (ww * 16 + row) * 64 + p0); s1 += *(const LAS f32x4*)(red + (ww * 16 + row) * 64 + p0 + 16); }
            const float v[8] = {s0[0], s0[1], s0[2], s0[3], s1[0], s1[1], s1[2], s1[3]};
            const int grow = MP + 16 * rb + row; float rs = 1.f; if (F::NEED_RS) rs = rstd_of(f.ss, grow);
            const typename F::In in = f.load(grow, 64 * cb + 8 * c8); float q = f.finish(grow, 64 * cb + 8 * c8, v, in, rs);
            if (F::WRITE_SS) { q += __shfl_xor(q, 1); q += __shfl_xor(q, 2); q += __shfl_xor(q, 4); if (c8 == 0) f.ss[(size_t)grow * 16 + cb] = q; }
        }
    }
    __syncthreads();
}
__device__ __forceinline__ int logical_col(int kind, int pr) {
    const int t = pr >> 8, q = pr & 255, g = gcol(q);
    if (kind == 0) return t * 256 + g;
    if (kind == 1) { const int bj = q >> 7; return bj * DFF + t * 128 + (g & 127); }
    const int bj = q >> 7, wc = (q >> 5) & 3, n = (q >> 4) & 1, fq = (q >> 2) & 3, e = q & 3;
    if (t < 4) return (t >> 1) * 512 + (2 * (t & 1) + bj) * 128 + 16 * wc + 4 * fq + e + 64 * n;
    if (t < 8) return 1024 + (t - 4) * 256 + g;
    if (t < 12) return 2048 + (t - 8) * 256 + g;
    if (t < 16) return (t < 14 ? 3072 : 3584) + (4 * (t & 1) + wc) * 64 + 32 * bj + 16 * n + 4 * fq + e;
    if (t < 18) return 4096 + (t - 16) * 256 + g;
    if (t == 18) return g < 8 ? 4608 + g : -1;
    return 4616 + (t - 19) * 256 + g;
}
__device__ __forceinline__ void transpose_item(const float* W, const float* gain, int K, int Nlog, int kind, u16* WT, int nblk, LAS float* scr, int item, int lane) {
    const int kb = item / nblk, nb = item % nblk, k0 = 64 * kb, n0 = 32 * nb;
    const int lc = logical_col(kind, n0 + (lane & 31));
    float tv[32];
#pragma unroll
    for (int i = 0; i < 32; ++i) { const int kk = 2 * i + (lane >> 5); tv[i] = (lc >= 0) ? W[(size_t)(k0 + kk) * Nlog + lc] : 0.f; }
#pragma unroll
    for (int i = 0; i < 32; ++i) { const int kk = 2 * i + (lane >> 5); float v = tv[i]; if (gain) v *= gain[k0 + kk]; scr[kk * 33 + (lane & 31)] = v; }
    asm volatile("s_waitcnt lgkmcnt(0)" ::: "memory");
    const int c = lane & 7;
#pragma unroll
    for (int j = 0; j < 4; ++j) { const int n = (lane >> 3) + 8 * j; const LAS float* s = scr + (8 * c) * 33 + n;
        u32x4 o; o.x = cvt_pk_bf16(s[0 * 33], s[1 * 33]); o.y = cvt_pk_bf16(s[2 * 33], s[3 * 33]); o.z = cvt_pk_bf16(s[4 * 33], s[5 * 33]); o.w = cvt_pk_bf16(s[6 * 33], s[7 * 33]);
        *(u32x4*)(WT + (size_t)(n0 + n) * K + k0 + 8 * c) = o; }
    asm volatile("s_waitcnt lgkmcnt(0)" ::: "memory");
}

constexpr int R_QS = 0, R_KS = 17408, R_KDT = 34816, R_VT = 53248, R_AS = 90112, R_RED = 99328, R_RSTD = 101376, R_END = 101632;
template <int CH>
__device__ __forceinline__ void ret_item(LAS unsigned char* lds, const u16* RQK, u16* RV, const u16* RG, const float* s0, float* sout, size_t rowbase, int nchunks, int h) {
    constexpr int TT = CH / 16, KSN = (CH + 31) / 32;
    int tid = threadIdx.x; asm volatile("" : "+v"(tid)); const int lane = tid & 63, w = __builtin_amdgcn_readfirstlane(tid >> 6), g = lane >> 4, c16 = lane & 15;
    LAS u16* Qs = (LAS u16*)(lds + R_QS); LAS u16* Ks = (LAS u16*)(lds + R_KS); LAS u16* KdT = (LAS u16*)(lds + R_KDT); LAS u16* VT = (LAS u16*)(lds + R_VT); LAS u16* As = (LAS u16*)(lds + R_AS);
    LAS float* red = (LAS float*)(lds + R_RED); LAS float* rstdv = (LAS float*)(lds + R_RSTD);
    const float lg2 = __log2f(1.f - __builtin_amdgcn_exp2f(-5.f - (float)h));
    f32x4 S[8][2];
#pragma unroll
    for (int kt = 0; kt < 8; ++kt)
#pragma unroll
        for (int nt = 0; nt < 2; ++nt)
#pragma unroll
            for (int i = 0; i < 4; ++i) S[kt][nt][i] = s0 ? s0[(size_t)(16 * kt + 4 * g + i) * 256 + 32 * w + 16 * nt + c16] : 0.f;
    __syncthreads();
    if (CH < 32) {
        for (int i = tid; i < (R_RED - R_KDT) / 4; i += 512) ((LAS unsigned*)(lds + R_KDT))[i] = 0u;
        __syncthreads();
    }
    for (int c = 0; c < nchunks; ++c) {
        const size_t row0 = rowbase + (size_t)c * CH;
        __syncthreads();
        for (int p = tid; p < CH * 16; p += 512) {
            const int r = p >> 4, cc = p & 15;
            const u32x4 q = *(const u32x4*)(RQK + (row0 + r) * 1024 + h * 128 + cc * 8);
            const u32x4 k = *(const u32x4*)(RQK + (row0 + r) * 1024 + 512 + h * 128 + cc * 8);
            *(LAS u32x4*)(Qs + r * 136 + cc * 8) = q; *(LAS u32x4*)(Ks + r * 136 + cc * 8) = k;
            const float dec = __builtin_amdgcn_exp2f(lg2 * (float)(CH - 1 - r));
            const unsigned kw[4] = {k.x, k.y, k.z, k.w};
#pragma unroll
            for (int j = 0; j < 4; ++j) { const unsigned pk = cvt_pk_bf16(bflo(kw[j]) * dec, bfhi(kw[j]) * dec); KdT[(cc * 8 + 2 * j) * 72 + r] = (u16)(pk & 0xffffu); KdT[(cc * 8 + 2 * j + 1) * 72 + r] = (u16)(pk >> 16); }
        }
        for (int p = tid; p < CH * 32; p += 512) {
            const int r = p >> 5, cc = p & 31;
            const u32x4 v = *(const u32x4*)(RV + (row0 + r) * 1024 + h * 256 + cc * 8);
            const unsigned vw[4] = {v.x, v.y, v.z, v.w};
#pragma unroll
            for (int j = 0; j < 4; ++j) { VT[(cc * 8 + 2 * j) * 72 + r] = (u16)(vw[j] & 0xffffu); VT[(cc * 8 + 2 * j + 1) * 72 + r] = (u16)(vw[j] >> 16); }
        }
        __syncthreads();
        for (int tile = w; tile < TT * TT; tile += 8) {
            const int ti = tile / TT, tj = tile % TT; f32x4 a4 = {0.f, 0.f, 0.f, 0.f};
#pragma unroll
            for (int kk = 0; kk < 4; ++kk) {
                const bf16x8 a = *(const LAS bf16x8*)(Qs + (16 * ti + c16) * 136 + 32 * kk + 8 * g), b = *(const LAS bf16x8*)(Ks + (16 * tj + c16) * 136 + 32 * kk + 8 * g);
                a4 = __builtin_amdgcn_mfma_f32_16x16x32_bf16(a, b, a4, 0, 0, 0);
            }
#pragma unroll
            for (int i = 0; i < 4; ++i) { const int ri = 16 * ti + 4 * g + i, cj = 16 * tj + c16; const int dd = ri > cj ? ri - cj : cj - ri;
                const unsigned pk = cvt_pk_bf16(a4[i] * __builtin_amdgcn_exp2f(lg2 * (float)dd), 0.f); As[ri * 72 + cj] = (u16)(pk & 0xffffu); }
        }
        bf16x8 sb[4][2];
#pragma unroll
        for (int kk = 0; kk < 4; ++kk)
#pragma unroll
            for (int nt = 0; nt < 2; ++nt) { u32x4 t; t.x = cvt_pk_bf16(S[2 * kk][nt][0], S[2 * kk][nt][1]); t.y = cvt_pk_bf16(S[2 * kk][nt][2], S[2 * kk][nt][3]);
                t.z = cvt_pk_bf16(S[2 * kk + 1][nt][0], S[2 * kk + 1][nt][1]); t.w = cvt_pk_bf16(S[2 * kk + 1][nt][2], S[2 * kk + 1][nt][3]); sb[kk][nt] = __builtin_bit_cast(bf16x8, t); }
        f32x4 O[TT][2];
#pragma unroll
        for (int tt = 0; tt < TT; ++tt) {
            f32x4 o0 = {0.f, 0.f, 0.f, 0.f}, o1 = {0.f, 0.f, 0.f, 0.f};
#pragma unroll
            for (int kk = 0; kk < 4; ++kk) {
                const u32x2 lo = *(const LAS u32x2*)(Qs + (16 * tt + c16) * 136 + 32 * kk + 4 * g), hi = *(const LAS u32x2*)(Qs + (16 * tt + c16) * 136 + 32 * kk + 16 + 4 * g);
                u32x4 t; t.x = lo.x; t.y = lo.y; t.z = hi.x; t.w = hi.y; const bf16x8 a = __builtin_bit_cast(bf16x8, t);
                o0 = __builtin_amdgcn_mfma_f32_16x16x32_bf16(a, sb[kk][0], o0, 0, 0, 0); o1 = __builtin_amdgcn_mfma_f32_16x16x32_bf16(a, sb[kk][1], o1, 0, 0, 0);
            }
#pragma unroll
            for (int i = 0; i < 4; ++i) { const float dsc = __builtin_amdgcn_exp2f(lg2 * (float)(16 * tt + 4 * g + i + 1)); o0[i] *= dsc; o1[i] *= dsc; }
            O[tt][0] = o0; O[tt][1] = o1;
        }
        __syncthreads();
#pragma unroll
        for (int tt = 0; tt < TT; ++tt)
#pragma unroll
            for (int ks = 0; ks < KSN; ++ks) {
                const bf16x8 a = *(const LAS bf16x8*)(As + (16 * tt + c16) * 72 + 32 * ks + 8 * g);
#pragma unroll
                for (int nt = 0; nt < 2; ++nt) { const bf16x8 b = *(const LAS bf16x8*)(VT + (32 * w + 16 * nt + c16) * 72 + 32 * ks + 8 * g); O[tt][nt] = __builtin_amdgcn_mfma_f32_16x16x32_bf16(a, b, O[tt][nt], 0, 0, 0); }
            }
#pragma unroll
        for (int tt = 0; tt < TT; ++tt)
#pragma unroll
            for (int i = 0; i < 4; ++i) { float q = O[tt][0][i] * O[tt][0][i] + O[tt][1][i] * O[tt][1][i]; q += __shfl_xor(q, 1); q += __shfl_xor(q, 2); q += __shfl_xor(q, 4); q += __shfl_xor(q, 8);
                if (c16 == 0) red[w * 64 + 16 * tt + 4 * g + i] = q; }
        __syncthreads();
        if (tid < CH) { float s = 0.f;
#pragma unroll
            for (int ww = 0; ww < 8; ++ww) s += red[ww * 64 + tid];
            rstdv[tid] = rsqrtf(s * (1.f / 256.f) + 1e-6f); }
        __syncthreads();
#pragma unroll
        for (int tt = 0; tt < TT; ++tt)
#pragma unroll
            for (int i = 0; i < 4; ++i) { const int tok = 16 * tt + 4 * g + i; const float rsd = rstdv[tok];
#pragma unroll
                for (int nt = 0; nt < 2; ++nt) { const size_t off = (row0 + tok) * 1024 + h * 256 + 32 * w + 16 * nt + c16; const float gt = bf2f(RG[off]);
                    const unsigned pk = cvt_pk_bf16(O[tt][nt][i] * rsd * gt, 0.f); RV[off] = (u16)(pk & 0xffffu); } }
        const float cd = __builtin_amdgcn_exp2f(lg2 * (float)CH);
#pragma unroll
        for (int kt = 0; kt < 8; ++kt)
#pragma unroll
            for (int nt = 0; nt < 2; ++nt) S[kt][nt] = S[kt][nt] * cd;
#pragma unroll
        for (int ks = 0; ks < KSN; ++ks) {
            const bf16x8 b0 = *(const LAS bf16x8*)(VT + (32 * w + c16) * 72 + 32 * ks + 8 * g), b1 = *(const LAS bf16x8*)(VT + (32 * w + 16 + c16) * 72 + 32 * ks + 8 * g);
#pragma unroll
            for (int kt = 0; kt < 8; ++kt) { const bf16x8 a = *(const LAS bf16x8*)(KdT + (16 * kt + c16) * 72 + 32 * ks + 8 * g);
                S[kt][0] = __builtin_amdgcn_mfma_f32_16x16x32_bf16(a, b0, S[kt][0], 0, 0, 0); S[kt][1] = __builtin_amdgcn_mfma_f32_16x16x32_bf16(a, b1, S[kt][1], 0, 0, 0); }
        }
    }
#pragma unroll
    for (int kt = 0; kt < 8; ++kt)
#pragma unroll
        for (int nt = 0; nt < 2; ++nt)
#pragma unroll
            for (int i = 0; i < 4; ++i) sout[(size_t)(16 * kt + 4 * g + i) * 256 + 32 * w + 16 * nt + c16] = S[kt][nt][i];
    __syncthreads();
}
constexpr int R2_QS = 0, R2_KS = 17408, R2_KDT = 34816, R2_VT = 53248, R2_AS = 90112, R2_OS = 99328, R2_RED = 133120, R2_RSTD = 135168, R2_END = 135424;
__device__ __forceinline__ void ret_prompt_item(LAS unsigned char* lds, const u16* RQK, u16* RV, const u16* RG, float* sout, size_t rowbase, int h) {
    int tid = threadIdx.x; asm volatile("" : "+v"(tid));
    const int lane = tid & 63, w = __builtin_amdgcn_readfirstlane(tid >> 6), g = lane >> 4, c16 = lane & 15;
    LAS u16* Qs = (LAS u16*)(lds + R2_QS); LAS u16* Ks = (LAS u16*)(lds + R2_KS); LAS u16* KdT = (LAS u16*)(lds + R2_KDT); LAS u16* VT = (LAS u16*)(lds + R2_VT); LAS u16* As = (LAS u16*)(lds + R2_AS);
    LAS u16* Os = (LAS u16*)(lds + R2_OS); LAS float* red = (LAS float*)(lds + R2_RED); LAS float* rstdv = (LAS float*)(lds + R2_RSTD);
#define RBAR() asm volatile("s_waitcnt lgkmcnt(0)\n\ts_barrier" ::: "memory")
    const float lg2 = __log2f(1.f - __builtin_amdgcn_exp2f(-5.f - (float)h));
    const int rq = tid >> 4, cq = tid & 15;
    const int rv = tid >> 5, cv = tid & 31;
    const u16* gq = RQK + (rowbase + rq) * 1024 + h * 128 + cq * 8;
    const size_t voff = (rowbase + rv) * 1024 + h * 256 + cv * 8;
    u32x4 pq[2], pk[2], pv[4], pgc[4];
#define RLOAD(c) do { const size_t co_ = (size_t)(c) * 64 * 1024; \
        _Pragma("unroll") for (int i_ = 0; i_ < 2; ++i_) { pq[i_] = *(const u32x4*)(gq + co_ + (size_t)i_ * 32 * 1024); pk[i_] = *(const u32x4*)(gq + co_ + (size_t)i_ * 32 * 1024 + 512); } \
        _Pragma("unroll") for (int i_ = 0; i_ < 4; ++i_) { pv[i_] = *(const u32x4*)(RV + voff + co_ + (size_t)i_ * 16 * 1024); } } while (0)
#define GLOAD(c) do { const size_t co_ = (size_t)(c) * 64 * 1024; _Pragma("unroll") for (int i_ = 0; i_ < 4; ++i_) pgc[i_] = *(const u32x4*)(RG + voff + co_ + (size_t)i_ * 16 * 1024); } while (0)
    const int hb = c16 >> 3;
    const LAS u16* kb0 = KdT + c16 * 72 + ((g ^ hb) << 3); const LAS u16* kb2 = KdT + c16 * 72 + ((g ^ hb ^ 2) << 3);
    f32x4 S[8][2];
#pragma unroll
    for (int kt = 0; kt < 8; ++kt)
#pragma unroll
        for (int nt = 0; nt < 2; ++nt) S[kt][nt] = (f32x4){0.f, 0.f, 0.f, 0.f};
    RLOAD(0);
    asm volatile("s_waitcnt lgkmcnt(0)\n\ts_barrier" ::: "memory");
    const float cd = __builtin_amdgcn_exp2f(lg2 * 64.f);
    for (int c = 0; c < 32; ++c) {
        float lg = lg2, gf = (float)(4 * g), cf = (float)c16, rqf = (float)(63 - rq); int tw = w; asm volatile("" : "+v"(lg), "+v"(gf), "+v"(cf), "+v"(rqf), "+s"(tw));
#pragma unroll
        for (int i = 0; i < 2; ++i) {
            const int r = rq + 32 * i;
            *(LAS u32x4*)(Qs + r * 136 + cq * 8) = pq[i]; *(LAS u32x4*)(Ks + r * 136 + cq * 8) = pk[i];
            const float dec = __builtin_amdgcn_exp2f(lg * (rqf - (float)(32 * i)));
            const int pc = (((r >> 3) ^ (cq & 7)) << 3) | (r & 7);
            const unsigned kw[4] = {pk[i].x, pk[i].y, pk[i].z, pk[i].w};
#pragma unroll
            for (int j = 0; j < 4; ++j) { const unsigned pkd = cvt_pk_bf16(bflo(kw[j]) * dec, bfhi(kw[j]) * dec); KdT[(cq * 8 + 2 * j) * 72 + pc] = (u16)(pkd & 0xffffu); KdT[(cq * 8 + 2 * j + 1) * 72 + pc] = (u16)(pkd >> 16); }
        }
#pragma unroll
        for (int i = 0; i < 4; ++i) {
            const int r = rv + 16 * i; const int pc = (((r >> 3) ^ (cv & 7)) << 3) | (r & 7);
            const unsigned vw[4] = {pv[i].x, pv[i].y, pv[i].z, pv[i].w};
#pragma unroll
            for (int j = 0; j < 4; ++j) { VT[(cv * 8 + 2 * j) * 72 + pc] = (u16)(vw[j] & 0xffffu); VT[(cv * 8 + 2 * j + 1) * 72 + pc] = (u16)(vw[j] >> 16); }
        }
        __builtin_amdgcn_sched_barrier(0);
        RBAR();
#pragma unroll
        for (int t2 = 0; t2 < 2; ++t2) {
            const int tile = tw + 8 * t2, ti = tile >> 2, tj = tile & 3; f32x4 a4 = {0.f, 0.f, 0.f, 0.f}; const float dbase = (gf - cf) + (float)(16 * (ti - tj));
#pragma unroll
            for (int kk = 0; kk < 4; ++kk) {
                const bf16x8 a = *(const LAS bf16x8*)(Qs + (16 * ti + c16) * 136 + 32 * kk + 8 * g), b = *(const LAS bf16x8*)(Ks + (16 * tj + c16) * 136 + 32 * kk + 8 * g);
                a4 = __builtin_amdgcn_mfma_f32_16x16x32_bf16(a, b, a4, 0, 0, 0);
            }
#pragma unroll
            for (int i = 0; i < 4; ++i) { const int ri = 16 * ti + 4 * g + i, cj = 16 * tj + c16;
                const unsigned pkd = cvt_pk_bf16(a4[i] * __builtin_amdgcn_exp2f(lg * __builtin_fabsf(dbase + (float)i)), 0.f); As[ri * 72 + cj] = (u16)(pkd & 0xffffu); }
        }
        f32x4 O[4][2];
#pragma unroll
        for (int tt = 0; tt < 4; ++tt) { O[tt][0] = (f32x4){0.f, 0.f, 0.f, 0.f}; O[tt][1] = (f32x4){0.f, 0.f, 0.f, 0.f}; }
#pragma unroll
        for (int kk = 0; kk < 4; ++kk) {
            bf16x8 sb[2];
#pragma unroll
            for (int nt = 0; nt < 2; ++nt) { u32x4 t; t.x = cvt_pk_bf16(S[2 * kk][nt][0], S[2 * kk][nt][1]); t.y = cvt_pk_bf16(S[2 * kk][nt][2], S[2 * kk][nt][3]);
                t.z = cvt_pk_bf16(S[2 * kk + 1][nt][0], S[2 * kk + 1][nt][1]); t.w = cvt_pk_bf16(S[2 * kk + 1][nt][2], S[2 * kk + 1][nt][3]); sb[nt] = __builtin_bit_cast(bf16x8, t); }
#pragma unroll
            for (int tt = 0; tt < 4; ++tt) {
                const u32x2 lo = *(const LAS u32x2*)(Qs + (16 * tt + c16) * 136 + 32 * kk + 4 * g), hi = *(const LAS u32x2*)(Qs + (16 * tt + c16) * 136 + 32 * kk + 16 + 4 * g);
                u32x4 t; t.x = lo.x; t.y = lo.y; t.z = hi.x; t.w = hi.y; const bf16x8 a = __builtin_bit_cast(bf16x8, t);
                O[tt][0] = __builtin_amdgcn_mfma_f32_16x16x32_bf16(a, sb[0], O[tt][0], 0, 0, 0); O[tt][1] = __builtin_amdgcn_mfma_f32_16x16x32_bf16(a, sb[1], O[tt][1], 0, 0, 0);
            }
            __builtin_amdgcn_sched_barrier(0);
        }
#pragma unroll
        for (int tt = 0; tt < 4; ++tt)
#pragma unroll
            for (int i = 0; i < 4; ++i) { const float dsc = __builtin_amdgcn_exp2f(lg * (gf + (float)(16 * tt + i + 1))); O[tt][0][i] *= dsc; O[tt][1][i] *= dsc; }
        RBAR();
        if (c + 1 < 32) RLOAD(c + 1);
        const int vsw0 = (4 * w + (c16 >> 3)) & 7, vsw1 = (4 * w + 2 + (c16 >> 3)) & 7;
        bf16x8 vb[2][2];
#pragma unroll
        for (int ks = 0; ks < 2; ++ks) { vb[ks][0] = *(const LAS bf16x8*)(VT + (32 * w + c16) * 72 + (((4 * ks + g) ^ vsw0) << 3)); vb[ks][1] = *(const LAS bf16x8*)(VT + (32 * w + 16 + c16) * 72 + (((4 * ks + g) ^ vsw1) << 3)); }
#pragma unroll
        for (int tt = 0; tt < 4; ++tt)
#pragma unroll
            for (int ks = 0; ks < 2; ++ks) {
                const bf16x8 a = *(const LAS bf16x8*)(As + (16 * tt + c16) * 72 + 32 * ks + 8 * g);
                O[tt][0] = __builtin_amdgcn_mfma_f32_16x16x32_bf16(a, vb[ks][0], O[tt][0], 0, 0, 0); O[tt][1] = __builtin_amdgcn_mfma_f32_16x16x32_bf16(a, vb[ks][1], O[tt][1], 0, 0, 0); __builtin_amdgcn_sched_barrier(0);
            }
#pragma unroll
        for (int tt = 0; tt < 4; ++tt)
#pragma unroll
            for (int i = 0; i < 4; ++i) { const int tok = 16 * tt + 4 * g + i;
                float q = O[tt][0][i] * O[tt][0][i] + O[tt][1][i] * O[tt][1][i]; q += __shfl_xor(q, 1); q += __shfl_xor(q, 2); q += __shfl_xor(q, 4); q += __shfl_xor(q, 8);
                if (c16 == 0) red[tok * 8 + w] = q;
#pragma unroll
                for (int nt = 0; nt < 2; ++nt) { const unsigned pkd = cvt_pk_bf16(O[tt][nt][i], 0.f); Os[tok * 264 + 32 * w + 16 * nt + c16] = (u16)(pkd & 0xffffu); } }
        __builtin_amdgcn_sched_barrier(0);
        GLOAD(c);
#pragma unroll
        for (int kt = 0; kt < 8; ++kt) { S[kt][0] = S[kt][0] * cd; S[kt][1] = S[kt][1] * cd; }
#pragma unroll
        for (int ks = 0; ks < 2; ++ks)
#pragma unroll
            for (int kt = 0; kt < 8; ++kt) { const bf16x8 a = *(const LAS bf16x8*)(((kt & 1) ? kb2 : kb0) + 16 * kt * 72 + (((4 * ks) ^ ((kt & 2) ? 4 : 0)) << 3));
                S[kt][0] = __builtin_amdgcn_mfma_f32_16x16x32_bf16(a, vb[ks][0], S[kt][0], 0, 0, 0); S[kt][1] = __builtin_amdgcn_mfma_f32_16x16x32_bf16(a, vb[ks][1], S[kt][1], 0, 0, 0); if (kt & 1) __builtin_amdgcn_sched_barrier(0); }
        RBAR();
#pragma unroll
        for (int i = 0; i < 4; ++i) {
            const int tok = rv + 16 * i; const f32x4 p0 = *(const LAS f32x4*)(red + tok * 8), p1 = *(const LAS f32x4*)(red + tok * 8 + 4);
            const float rsd = rsqrtf((((p0[0] + p0[1]) + (p0[2] + p0[3])) + ((p1[0] + p1[1]) + (p1[2] + p1[3]))) * (1.f / 256.f) + 1e-6f);
            const u32x4 o = *(const LAS u32x4*)(Os + tok * 264 + cv * 8); const u32x4 gt = pgc[i]; u32x4 r;
            r.x = cvt_pk_bf16(bflo(o.x) * rsd * bflo(gt.x), bfhi(o.x) * rsd * bfhi(gt.x)); r.y = cvt_pk_bf16(bflo(o.y) * rsd * bflo(gt.y), bfhi(o.y) * rsd * bfhi(gt.y));
            r.z = cvt_pk_bf16(bflo(o.z) * rsd * bflo(gt.z), bfhi(o.z) * rsd * bfhi(gt.z)); r.w = cvt_pk_bf16(bflo(o.w) * rsd * bflo(gt.w), bfhi(o.w) * rsd * bfhi(gt.w));
            *(u32x4*)(RV + voff + (size_t)c * 64 * 1024 + (size_t)i * 16 * 1024) = r;
        }
    }
#pragma unroll
    for (int kt = 0; kt < 8; ++kt)
#pragma unroll
        for (int nt = 0; nt < 2; ++nt)
#pragma unroll
            for (int i = 0; i < 4; ++i) sout[(size_t)(16 * kt + 4 * g + i) * 256 + 32 * w + 16 * nt + c16] = S[kt][nt][i];
    __syncthreads();
#undef RBAR
#undef RLOAD
#undef GLOAD
}
constexpr int F2_BIAS = 0, F2_WS = 16512, F2_AW = 16640, F2_P = 17408, F2_M = 50176, F2_L = 50688, F2_ACC = 51200, F2_END = 83968;
__device__ __forceinline__ void fox_sample_item2(LAS unsigned char* lds, int b, int h, u16* FQ, const u16* FK, const u16* FV, const float* ck, const float* cv, const float* clf, const float* lfnew) {
    int tid = threadIdx.x; asm volatile("" : "+v"(tid));
    const int lane = tid & 63, w = __builtin_amdgcn_readfirstlane(tid >> 6), g = lane >> 4, c16 = lane & 15;
    LAS float* BIAS = (LAS float*)(lds + F2_BIAS); LAS float* WS = (LAS float*)(lds + F2_WS); LAS float* Aw = (LAS float*)(lds + F2_AW) + w * 16;
    LAS float* Pw = (LAS float*)(lds + F2_P) + w * 1024; LAS float* Mx = (LAS float*)(lds + F2_M); LAS float* Lx = (LAS float*)(lds + F2_L); LAS float* ACC = (LAS float*)(lds + F2_ACC);
    const size_t srow = (size_t)MP + (size_t)b * 16;
    __syncthreads();
    bf16x8 qa[2];
#pragma unroll
    for (int ks = 0; ks < 2; ++ks) qa[ks] = *(const bf16x8*)(FQ + (srow + c16) * 512 + h * 64 + 32 * ks + 8 * g);
    {
        float v[8]; float run = 0.f;
#pragma unroll
        for (int j = 0; j < 8; ++j) { run += clf[((size_t)b * PAST + 8 * tid + j) * 8 + h]; v[j] = run; }
        float tot = run;
#pragma unroll
        for (int o = 1; o < 64; o <<= 1) { const float u = __shfl_up(tot, o); if (lane >= o) tot += u; }
        if (lane == 63) WS[w] = tot;
        __syncthreads();
        float base = tot - run, all = 0.f;
#pragma unroll
        for (int ww = 0; ww < 8; ++ww) { const float x = WS[ww]; all += x; if (ww < w) base += x; }
#pragma unroll
        for (int j = 0; j < 8; ++j) BIAS[8 * tid + j] = (all - (base + v[j])) * L2E;
        if (tid == 0) { float cn = 0.f; for (int t = 0; t < 16; ++t) { cn += lfnew[((size_t)b * 16 + t) * 8 + h]; BIAS[PAST + t] = -cn * L2E; } }
    }
    __syncthreads();
    float mrun[4], lrun[4]; f32x4 acc[16];
    const int rr = lane >> 4, cc = lane & 15;
#pragma unroll
    for (int i = 0; i < 4; ++i) { mrun[i] = -INFINITY; lrun[i] = 0.f; }
#pragma unroll
    for (int t = 0; t < 16; ++t) acc[t] = (f32x4){0.f, 0.f, 0.f, 0.f};
    const int niter = (w == 0) ? 9 : 8;
    for (int it = 0; it < niter; ++it) {
        const bool isnew = it == 8;
        const int key0 = isnew ? 0 : 512 * w + 64 * it;
        f32x4 s[4]; f32x4 vv[16];
        if (!isnew) {
            f32x4 kf[4][2][2];
#pragma unroll
            for (int t = 0; t < 4; ++t) { const f32x4* kp = (const f32x4*)(ck + (((size_t)b * PAST + key0 + 16 * t + c16) * 8 + h) * 64 + 8 * g);
#pragma unroll
                for (int ks = 0; ks < 2; ++ks) { kf[t][ks][0] = kp[8 * ks]; kf[t][ks][1] = kp[8 * ks + 1]; } }
#pragma unroll
            for (int t = 0; t < 4; ++t) { f32x4 a4 = {0.f, 0.f, 0.f, 0.f};
#pragma unroll
                for (int ks = 0; ks < 2; ++ks) { u32x4 kb; kb.x = cvt_pk_bf16(kf[t][ks][0][0], kf[t][ks][0][1]); kb.y = cvt_pk_bf16(kf[t][ks][0][2], kf[t][ks][0][3]); kb.z = cvt_pk_bf16(kf[t][ks][1][0], kf[t][ks][1][1]); kb.w = cvt_pk_bf16(kf[t][ks][1][2], kf[t][ks][1][3]);
                    a4 = __builtin_amdgcn_mfma_f32_16x16x32_bf16(qa[ks], __builtin_bit_cast(bf16x8, kb), a4, 0, 0, 0); }
                const float bl = BIAS[key0 + 16 * t + c16];
                s[t] = a4 + bl; }
            { const f32x4* vp = (const f32x4*)(cv + (((size_t)b * PAST + key0 + rr) * 8 + h) * 64 + 4 * cc);
#pragma unroll
              for (int j = 0; j < 16; ++j) vv[j] = vp[(size_t)j * 4 * 128]; }
        } else {
            f32x4 a4 = {0.f, 0.f, 0.f, 0.f};
#pragma unroll
            for (int ks = 0; ks < 2; ++ks) { const bf16x8 kb = *(const bf16x8*)(FK + (srow + c16) * 512 + h * 64 + 32 * ks + 8 * g); a4 = __builtin_amdgcn_mfma_f32_16x16x32_bf16(qa[ks], kb, a4, 0, 0, 0); }
            const float bl = BIAS[PAST + c16];
#pragma unroll
            for (int i = 0; i < 4; ++i) s[0][i] = (c16 > 4 * g + i) ? -INFINITY : a4[i] + bl;
#pragma unroll
            for (int t = 1; t < 4; ++t) s[t] = (f32x4){-INFINITY, -INFINITY, -INFINITY, -INFINITY};
#pragma unroll
            for (int j = 0; j < 16; ++j) { if (j < 4) { const u32x2 x = *(const u32x2*)(FV + (srow + 4 * j + rr) * 512 + h * 64 + 4 * cc); vv[j] = (f32x4){bflo(x.x), bfhi(x.x), bflo(x.y), bfhi(x.y)}; } else vv[j] = (f32x4){0.f, 0.f, 0.f, 0.f}; }
        }
#pragma unroll
        for (int i = 0; i < 4; ++i) {
            float tm = fmaxf(fmaxf(s[0][i], s[1][i]), fmaxf(s[2][i], s[3][i]));
            tm = fmaxf(tm, __shfl_xor(tm, 1)); tm = fmaxf(tm, __shfl_xor(tm, 2)); tm = fmaxf(tm, __shfl_xor(tm, 4)); tm = fmaxf(tm, __shfl_xor(tm, 8));
            const float mn = fmaxf(mrun[i], tm), al = __builtin_amdgcn_exp2f(mrun[i] - mn);
            float ps = 0.f;
#pragma unroll
            for (int t = 0; t < 4; ++t) { const float p = __builtin_amdgcn_exp2f(s[t][i] - mn); s[t][i] = p; ps += p; }
            lrun[i] = lrun[i] * al + ps; mrun[i] = mn;
            if (c16 == 0) Aw[4 * g + i] = al;
        }
#pragma unroll
        for (int t = 0; t < 4; ++t) *(LAS f32x4*)(Pw + (16 * t + c16) * 16 + 4 * g) = s[t];
        asm volatile("s_waitcnt lgkmcnt(0)" ::: "memory"); __builtin_amdgcn_wave_barrier();
#pragma unroll
        for (int j = 0; j < 4; ++j) { const f32x4 al = *(const LAS f32x4*)(Aw + 4 * j); acc[4 * j] *= al[0]; acc[4 * j + 1] *= al[1]; acc[4 * j + 2] *= al[2]; acc[4 * j + 3] *= al[3]; }
        __builtin_amdgcn_sched_barrier(0);
#pragma unroll
        for (int j = 0; j < 16; ++j) {
            if (!isnew || j < 4) {
#pragma unroll
                for (int i = 0; i < 4; ++i) { const f32x4 p = *(const LAS f32x4*)(Pw + (4 * j + rr) * 16 + 4 * i);
                    acc[4 * i] += vv[j] * p[0]; acc[4 * i + 1] += vv[j] * p[1]; acc[4 * i + 2] += vv[j] * p[2]; acc[4 * i + 3] += vv[j] * p[3]; }
            }
            __builtin_amdgcn_sched_barrier(0);
        }
        asm volatile("s_waitcnt lgkmcnt(0)" ::: "memory"); __builtin_amdgcn_wave_barrier();
    }
#pragma unroll
    for (int i = 0; i < 4; ++i) { float l = lrun[i]; l += __shfl_xor(l, 1); l += __shfl_xor(l, 2); l += __shfl_xor(l, 4); l += __shfl_xor(l, 8); if (c16 == 0) { Mx[w * 16 + 4 * g + i] = mrun[i]; Lx[w * 16 + 4 * g + i] = l; } }
#pragma unroll
    for (int t = 0; t < 16; ++t) { f32x4 a = acc[t];
#pragma unroll
        for (int e = 0; e < 4; ++e) { a[e] += __shfl_xor(a[e], 16); a[e] += __shfl_xor(a[e], 32); }
        if (rr == 0) *(LAS f32x4*)(ACC + (w * 16 + t) * 64 + 4 * cc) = a; }
    __syncthreads();
    for (int e = tid; e < 1024; e += 512) {
        const int t = e >> 6, d = e & 63; float mm = -INFINITY;
#pragma unroll
        for (int ww = 0; ww < 8; ++ww) mm = fmaxf(mm, Mx[ww * 16 + t]);
        float num = 0.f, den = 0.f;
#pragma unroll
        for (int ww = 0; ww < 8; ++ww) { const float f = __builtin_amdgcn_exp2f(Mx[ww * 16 + t] - mm); num += ACC[(ww * 16 + t) * 64 + d] * f; den += Lx[ww * 16 + t] * f; }
        const unsigned pk = cvt_pk_bf16(num / den, 0.f); FQ[(srow + t) * 512 + h * 64 + d] = (u16)(pk & 0xffffu);
    }
    __syncthreads();
}
constexpr int F_Q = 0, F_BIAS = 4096, F_WS = 20736, F_P = 24576, F_M = 57344, F_L = 57856, F_ACC = 58368, F_END = 91136;
__device__ __forceinline__ void fox_sample_item(LAS unsigned char* lds, int b, int h, u16* FQ, const u16* FK, const u16* FV, const float* ck, const float* cv, const float* clf, const float* lfnew) {
    int tid = threadIdx.x; asm volatile("" : "+v"(tid)); const int lane = tid & 63, w = __builtin_amdgcn_readfirstlane(tid >> 6);
    LAS float* QF = (LAS float*)(lds + F_Q); LAS float* BIAS = (LAS float*)(lds + F_BIAS); LAS float* WS = (LAS float*)(lds + F_WS);
    LAS float* Pw = (LAS float*)(lds + F_P) + w * 1024; LAS float* Mx = (LAS float*)(lds + F_M); LAS float* Lx = (LAS float*)(lds + F_L); LAS float* ACC = (LAS float*)(lds + F_ACC);
    const size_t srow = (size_t)MP + (size_t)b * 16;
    __syncthreads();
    for (int e = tid; e < 1024; e += 512) QF[e] = bf2f(FQ[(srow + (e >> 6)) * 512 + h * 64 + (e & 63)]);
    {
        float v[8]; float run = 0.f;
#pragma unroll
        for (int j = 0; j < 8; ++j) { run += clf[((size_t)b * PAST + 8 * tid + j) * 8 + h]; v[j] = run; }
        float tot = run;
#pragma unroll
        for (int o = 1; o < 64; o <<= 1) { const float u = __shfl_up(tot, o); if (lane >= o) tot += u; }
        if (lane == 63) WS[w] = tot;
        __syncthreads();
        float base = tot - run, all = 0.f;
#pragma unroll
        for (int ww = 0; ww < 8; ++ww) { const float x = WS[ww]; all += x; if (ww < w) base += x; }
#pragma unroll
        for (int j = 0; j < 8; ++j) BIAS[8 * tid + j] = (all - (base + v[j])) * L2E;
        if (tid == 0) { float cn = 0.f; for (int t = 0; t < 16; ++t) { cn += lfnew[((size_t)b * 16 + t) * 8 + h]; BIAS[PAST + t] = -cn * L2E; } }
    }
    __syncthreads();
    float mrun[16], lrun[16], acc[16];
#pragma unroll
    for (int t = 0; t < 16; ++t) { mrun[t] = -INFINITY; lrun[t] = 0.f; acc[t] = 0.f; }
    const int ntile = (w == 0) ? 9 : 8;
    for (int tile = 0; tile < ntile; ++tile) {
        const bool isnew = tile == 8;
        const int key0 = isnew ? 0 : 512 * w + 64 * tile;
        float s[16];
        {
            f32x4 k[16];
            if (!isnew) { const f32x4* kp = (const f32x4*)(ck + (((size_t)b * PAST + key0 + lane) * 8 + h) * 64);
#pragma unroll
                for (int i = 0; i < 16; ++i) k[i] = kp[i];
            } else { const u32x4* kp = (const u32x4*)(FK + (srow + (lane & 15)) * 512 + h * 64);
#pragma unroll
                for (int i = 0; i < 8; ++i) { const u32x4 x = kp[i]; k[2 * i] = (f32x4){bflo(x.x), bfhi(x.x), bflo(x.y), bfhi(x.y)}; k[2 * i + 1] = (f32x4){bflo(x.z), bfhi(x.z), bflo(x.w), bfhi(x.w)}; } }
            const float bias = isnew ? BIAS[PAST + (lane & 15)] : BIAS[key0 + lane];
#pragma unroll
            for (int t = 0; t < 16; ++t) { float a = 0.f;
#pragma unroll
                for (int i = 0; i < 16; ++i) { const f32x4 q = *(const LAS f32x4*)(QF + t * 64 + 4 * i); a += (q[0] * k[i][0] + q[1] * k[i][1]) + (q[2] * k[i][2] + q[3] * k[i][3]); }
                a += bias; if (isnew && (lane > t || lane >= 16)) a = -INFINITY; s[t] = a; }
        }
#pragma unroll
        for (int t = 0; t < 16; ++t) {
            const float tm = wave_max(s[t]), mn = fmaxf(mrun[t], tm), al = __builtin_amdgcn_exp2f(mrun[t] - mn), p = __builtin_amdgcn_exp2f(s[t] - mn);
            Pw[lane * 16 + t] = p; acc[t] *= al; lrun[t] = lrun[t] * al + wave_sum(p); mrun[t] = mn;
        }
        asm volatile("s_waitcnt lgkmcnt(0)" ::: "memory"); __builtin_amdgcn_wave_barrier();
        const int nk = isnew ? 16 : 64;
        for (int kk = 0; kk < nk; ++kk) {
            const float v = isnew ? bf2f(FV[(srow + kk) * 512 + h * 64 + lane]) : cv[(((size_t)b * PAST + key0 + kk) * 8 + h) * 64 + lane];
#pragma unroll
            for (int i = 0; i < 4; ++i) { const f32x4 p = *(const LAS f32x4*)(Pw + kk * 16 + 4 * i); acc[4 * i] += p[0] * v; acc[4 * i + 1] += p[1] * v; acc[4 * i + 2] += p[2] * v; acc[4 * i + 3] += p[3] * v; }
        }
        asm volatile("s_waitcnt lgkmcnt(0)" ::: "memory"); __builtin_amdgcn_wave_barrier();
    }
#pragma unroll
    for (int t = 0; t < 16; ++t) { ACC[(w * 16 + t) * 64 + lane] = acc[t]; if (lane == 0) { Mx[w * 16 + t] = mrun[t]; Lx[w * 16 + t] = lrun[t]; } }
    __syncthreads();
    for (int e = tid; e < 1024; e += 512) {
        const int t = e >> 6, d = e & 63; float mm = -INFINITY;
#pragma unroll
        for (int ww = 0; ww < 8; ++ww) mm = fmaxf(mm, Mx[ww * 16 + t]);
        float num = 0.f, den = 0.f;
#pragma unroll
        for (int ww = 0; ww < 8; ++ww) { const float f = __builtin_amdgcn_exp2f(Mx[ww * 16 + t] - mm); num += ACC[(ww * 16 + t) * 64 + d] * f; den += Lx[ww * 16 + t] * f; }
        const unsigned pk = cvt_pk_bf16(num / den, 0.f); FQ[(srow + t) * 512 + h * 64 + d] = (u16)(pk & 0xffffu);
    }
    __syncthreads();
}

struct Args { const float* in[25]; float* out; unsigned char* ws; };
constexpr int P4_RET = 128, P4_FS = 128, P4_FP = 2048, P4_RS = 64, P4_ITEMS = P4_RET + P4_FS + P4_FP + P4_RS;

__device__ __forceinline__ unsigned char* kern_ptr(int k) {
    const __attribute__((address_space(4))) char* p = (const __attribute__((address_space(4))) char*)__builtin_amdgcn_kernarg_segment_ptr();
    asm volatile("" : "+s"(p));
    return *(unsigned char* const __attribute__((address_space(4)))*)(p + 8 * k);
}
__global__ void __launch_bounds__(512, 2) fwd(Args a) {
    extern __shared__ __attribute__((aligned(16))) unsigned char lds_raw[];
    LAS unsigned char* lds = (LAS unsigned char*)lds_raw;
    cg::grid_group grid = cg::this_grid();
    const int tid = threadIdx.x, lane = tid & 63, wave = __builtin_amdgcn_readfirstlane(tid >> 6);
    const int G = gridDim.x, bx = blockIdx.x;
#define WSB() kern_ptr(26)
#define OUTB() ((float*)kern_ptr(25))
#define INP(k) ((const float*)kern_ptr(k))
#define P16(off) ((u16*)(WSB() + (off)))
#define PF32(off) ((float*)(WSB() + (off)))
    unsigned* ctl = (unsigned*)(WSB() + O_CTL);
    LAS unsigned* misc = (LAS unsigned*)(lds + LDS_BYTES - 128);
    if (tid < 32) misc[tid] = 0u;
    __syncthreads();
    const xb::XcdBarrier bar = xb::xcd_barrier_post(ctl + 4096, (volatile XLAS unsigned*)(misc + 8));
#ifdef PROBE_PH
    unsigned long long pr_t0 = __builtin_amdgcn_s_memrealtime(), pr_acc = 0; int pr_n = 0;
#define GSYNC() do { xb::xcd_barrier(bar); if (pr_n == PROBE_PH) pr_acc = __builtin_amdgcn_s_memrealtime() - pr_t0; ++pr_n; pr_t0 = __builtin_amdgcn_s_memrealtime(); } while (0)
#else
#define GSYNC() xb::xcd_barrier(bar)
#endif

#ifndef PHM
#define PHM 0xffff
#endif
#define PH(k) if constexpr (((PHM)>>(k))&1)
    PH(0) {
        LAS float* scr = (LAS float*)(lds + wave * 16384);
        const int gw = bx * 8 + wave, NGW = G * 8;
        constexpr int I0 = 16 * 176, I1 = 44 * 32, I2 = 16 * 216, I3 = 16 * 32, I4 = 8 * 32, I5 = 16 * 32, I8 = 4 * 32;
        constexpr int NIT = I0 + I1 + I2 + I3 + I4 + I5 + I0 + I1 + I8 + I3;
        for (int it = gw; it < NIT; it += NGW) {
            int r = it;
            if (r < I0) { transpose_item(INP(9), INP(8), 1024, 5632, 1, P16(O_W1IN), 176, scr, r, lane); continue; } r -= I0;
            if (r < I1) { transpose_item(INP(10), nullptr, 2816, 1024, 0, P16(O_W1OUT), 32, scr, r, lane); continue; } r -= I1;
            if (r < I2) { transpose_item(INP(12), INP(11), 1024, 6664, 2, P16(O_WMIX), 216, scr, r, lane); continue; } r -= I2;
            if (r < I3) { transpose_item(INP(16), nullptr, 1024, 1024, 0, P16(O_WBR), 32, scr, r, lane); continue; } r -= I3;
            if (r < I4) { transpose_item(INP(17), nullptr, 512, 1024, 0, P16(O_WBF), 32, scr, r, lane); continue; } r -= I4;
            if (r < I5) { transpose_item(INP(18), nullptr, 1024, 1024, 0, P16(O_WOUT), 32, scr, r, lane); continue; } r -= I5;
            if (r < I0) { transpose_item(INP(20), INP(19), 1024, 5632, 1, P16(O_W2IN), 176, scr, r, lane); continue; } r -= I0;
            if (r < I1) { transpose_item(INP(21), nullptr, 2816, 1024, 0, P16(O_W2OUT), 32, scr, r, lane); continue; } r -= I1;
            if (r < I8) { transpose_item(INP(23), nullptr, 256, 1024, 0, P16(O_WPLE), 32, scr, r, lane); continue; } r -= I8;
            transpose_item(INP(24), INP(22), 1024, 1024, 0, P16(O_WPG), 32, scr, r, lane);
        }
        for (int rb = gw * 4; rb < MT; rb += NGW * 4) {
            f32x4 v[4][4]; float s[4];
#pragma unroll
            for (int r = 0; r < 4; ++r) { const int row = rb + r; const f32x4* xr = (const f32x4*)(row < MP ? INP(0) + (size_t)row * 1024 : INP(1) + (size_t)(row - MP) * 1024) + lane;
#pragma unroll
                for (int j = 0; j < 4; ++j) v[r][j] = xr[64 * j]; }
#pragma unroll
            for (int r = 0; r < 4; ++r) { float q = 0.f;
#pragma unroll
                for (int j = 0; j < 4; ++j) q += (v[r][j][0] * v[r][j][0] + v[r][j][1] * v[r][j][1]) + (v[r][j][2] * v[r][j][2] + v[r][j][3] * v[r][j][3]);
                s[r] = wave_sum(q);
                u32x2* o = (u32x2*)(P16(O_XB) + (size_t)(rb + r) * 1024) + lane;
#pragma unroll
                for (int j = 0; j < 4; ++j) { u32x2 w; w.x = cvt_pk_bf16(v[r][j][0], v[r][j][1]); w.y = cvt_pk_bf16(v[r][j][2], v[r][j][3]); o[64 * j] = w; } }
            { const int r = lane >> 4, c = lane & 15; const float sv = r == 0 ? s[0] : (r == 1 ? s[1] : (r == 2 ? s[2] : s[3])); PF32(O_SS)[(size_t)(rb + r) * 16 + c] = c == 0 ? sv : 0.f; }
        }
        for (int i = bx * 512 + tid; i < NPOS * 64; i += G * 512) {
            const int pi = i >> 6, f = i & 63; const float pos = pi < SEQ ? (float)pi : (float)(PAST + pi - SEQ);
            const float freq = __builtin_amdgcn_exp2f(-(float)f * (13.287712379549449f / 64.f)); const float ang = pos * freq;
            double rev = (double)ang * 0.15915494309189535; rev -= floor(rev); const float rf = (float)rev;
            PF32(O_TABC)[i] = __builtin_amdgcn_cosf(rf); PF32(O_TABS)[i] = __builtin_amdgcn_sinf(rf);
        }
    }
    if (gridDim.x == 0x7fffffffu) grid.sync();
    GSYNC();
    PH(1) { pg8::Gemm g{P16(O_XB), P16(O_W1IN), MT, 5632, 1024}; pg8::StaticOrder S; S.init(MT, 5632, G, bx); EpiSwiglu E{P16(O_ACT1), PF32(O_SS)};
      pg8::gemm_phase<EpiSwiglu, pg8::StaticOrder, true, true>(lds, g, S, E); }
    GSYNC();
    PH(2) { const FResid f{P16(O_XB), PF32(O_SS), 0.5f};
      small_gemm<FResid>(lds, P16(O_ACT1) + (size_t)MP * DFF, P16(O_W1OUT), DFF, f, bx, G);
      pg8::Gemm g{P16(O_ACT1), P16(O_W1OUT), MP, 1024, DFF}; pg8::StaticOrder S; S.init(MP, 1024, G, bx); const EpiWrap<FResid> E{f};
      pg8::gemm_phase<EpiWrap<FResid>, pg8::StaticOrder, true, true>(lds, g, S, E); }
    GSYNC();
    PH(3) { pg8::Gemm g{P16(O_XB), P16(O_WMIX), MT, NMIX, 1024}; pg8::StaticOrder S; S.init(MT, NMIX, G, bx);
      EpiMix E{PF32(O_SS), PF32(O_TABC), PF32(O_TABS), INP(14), INP(15), INP(13), P16(O_RQK), P16(O_RV), P16(O_RG), P16(O_FQ), P16(O_FK), P16(O_FV), P16(O_ZG), OUTB(), OUTB() + OUT_YP};
      pg8::gemm_phase<EpiMix, pg8::StaticOrder, true, true>(lds, g, S, E); }
    GSYNC();
    {
        LAS unsigned* slot = misc;
        float dbound;
        { float gq_ = __builtin_fabsf(INP(14)[lane]), gk_ = __builtin_fabsf(INP(15)[lane]);
#pragma unroll
          for (int o_ = 1; o_ < 64; o_ <<= 1) { gq_ = fmaxf(gq_, __shfl_xor(gq_, o_)); gk_ = fmaxf(gk_, __shfl_xor(gk_, o_)); }
          dbound = gq_ * gk_ * (64.f * 0.125f * L2E * 1.02f) + 1.f; if (tid == 0) misc[2] = __float_as_uint(dbound); }
        for (;;) {
            __syncthreads();
            if (tid == 0) slot[0] = atomicAdd(ctl, 1u);
            __syncthreads();
            const int it = (int)slot[0];
            if (it >= P4_ITEMS) break;
#ifdef PROBE_ITEM
            const unsigned long long pi_t0 = __builtin_amdgcn_s_memrealtime();
#endif
            if (it < P4_RET) { const int b = it >> 2, h = it & 3;
                PH(10) ret_prompt_item(lds, P16(O_RQK), P16(O_RV), P16(O_RG), OUTB() + OUT_RSP + (size_t)(b * 4 + h) * 32768, (size_t)b * SEQ, h);
            } else if (it < P4_RET + P4_FS) { const int j = it - P4_RET, b = j >> 3, h = j & 7;
                PH(11) fox_sample_item2(lds, b, h, P16(O_FQ), P16(O_FK), P16(O_FV), INP(5), INP(6), INP(7), OUTB() + OUT_LS);
            } else if (it < P4_RET + P4_FS + P4_FP) { const int j = it - P4_RET - P4_FS, qb = 7 - (j >> 8), bh = j & 255;
                PH(12) attn_body::attn_unit<8>(bh >> 3, bh & 7, qb, (const attn_body::bf16*)P16(O_FQ), (const attn_body::bf16*)P16(O_FK), (const attn_body::bf16*)P16(O_FV), (attn_body::bf16*)P16(O_FQ), OUTB() + OUT_YP, __uint_as_float(misc[2]), (char*)lds_raw);
            } else { const int j = it - P4_RET - P4_FS - P4_FP, b = j >> 2, h = j & 3;
                PH(13) ret_item<16>(lds, P16(O_RQK), P16(O_RV), P16(O_RG), INP(4) + (size_t)(b * 4 + h) * 32768, OUTB() + OUT_RSS + (size_t)(b * 4 + h) * 32768, (size_t)MP + (size_t)b * 16, 1, h);
            }
#ifdef PROBE_ITEM
            { const int kind = it < P4_RET ? 0 : (it < P4_RET + P4_FS ? 1 : (it < P4_RET + P4_FS + P4_FP ? 2 : 3));
              if (kind == PROBE_ITEM && tid == 0) atomicMax(ctl + 16, (unsigned)(__builtin_amdgcn_s_memrealtime() - pi_t0)); }
#endif
        }
    }
    GSYNC();
    {
        for (size_t i = (size_t)bx * 512 + tid; i < (size_t)MT * 32; i += (size_t)G * 512) {
            const size_t e8 = i * 8; const float* src = e8 < (size_t)MP * 256 ? INP(2) + e8 : INP(3) + (e8 - (size_t)MP * 256);
            const f32x4 v0 = *(const f32x4*)src, v1 = *(const f32x4*)(src + 4);
            u32x4 w; w.x = cvt_pk_bf16(v0[0], v0[1]); w.y = cvt_pk_bf16(v0[2], v0[3]); w.z = cvt_pk_bf16(v1[0], v1[1]); w.w = cvt_pk_bf16(v1[2], v1[3]);
            *(u32x4*)(P16(O_FV) + e8) = w;
        }
        PH(5) { const FGate<false> f0{P16(O_RG), P16(O_ZG), nullptr}; const FGate<true> f1{P16(O_RG), P16(O_ZG), nullptr};
          small_gemm<FGate<false>>(lds, P16(O_RV) + (size_t)MP * 1024, P16(O_WBR), 1024, f0, bx, G);
          small_gemm<FGate<true>>(lds, P16(O_FQ) + (size_t)MP * 512, P16(O_WBF), 512, f1, bx, G);
          { pg8::Gemm g{P16(O_RV), P16(O_WBR), MP, 1024, 1024}; pg8::StaticOrder S; S.init(MP, 1024, G, bx); const EpiWrap<FGate<false>> E{f0};
            pg8::gemm_phase<EpiWrap<FGate<false>>, pg8::StaticOrder, true, true>(lds, g, S, E); }
          { pg8::Gemm g{P16(O_FQ), P16(O_WBF), MP, 1024, 512}; pg8::StaticOrder S; S.init(MP, 1024, G, bx); const EpiWrap<FGate<true>> E{f1};
            pg8::gemm_phase<EpiWrap<FGate<true>>, pg8::StaticOrder, true, true>(lds, g, S, E); } }
    }
    GSYNC();
    PH(6) { const FResid f{P16(O_XB), PF32(O_SS), 1.0f};
      small_gemm<FResid>(lds, P16(O_RG) + (size_t)MP * 1024, P16(O_WOUT), 1024, f, bx, G);
      pg8::Gemm g{P16(O_RG), P16(O_WOUT), MP, 1024, 1024}; pg8::StaticOrder S; S.init(MP, 1024, G, bx); const EpiWrap<FResid> E{f};
      pg8::gemm_phase<EpiWrap<FResid>, pg8::StaticOrder, true, true>(lds, g, S, E); }
    GSYNC();
    PH(7) { pg8::Gemm g{P16(O_XB), P16(O_W2IN), MT, 5632, 1024}; pg8::StaticOrder S; S.init(MT, 5632, G, bx); EpiSwiglu E{P16(O_ACT2), PF32(O_SS)};
      pg8::gemm_phase<EpiSwiglu, pg8::StaticOrder, true, true>(lds, g, S, E); }
    GSYNC();
    PH(8) { const FResid f{P16(O_XB), PF32(O_SS), 0.5f}; const FPlain fp{P16(O_RQK), nullptr};
      small_gemm<FResid>(lds, P16(O_ACT2) + (size_t)MP * DFF, P16(O_W2OUT), DFF, f, bx, G);
      small_gemm<FPlain>(lds, P16(O_FV) + (size_t)MP * 256, P16(O_WPLE), 256, fp, bx, G);
      { pg8::Gemm g{P16(O_ACT2), P16(O_W2OUT), MP, 1024, DFF}; pg8::StaticOrder S; S.init(MP, 1024, G, bx); const EpiWrap<FResid> E{f};
        pg8::gemm_phase<EpiWrap<FResid>, pg8::StaticOrder, true, true>(lds, g, S, E); }
      { pg8::Gemm g{P16(O_FV), P16(O_WPLE), MP, 1024, 256}; pg8::StaticOrder S; S.init(MP, 1024, G, bx); const EpiWrap<FPlain> E{fp};
        pg8::gemm_phase<EpiWrap<FPlain>, pg8::StaticOrder, true, true>(lds, g, S, E); } }
    GSYNC();
    PH(9) { const FFinal f{OUTB() + OUT_YP, OUTB() + OUT_YS, P16(O_XB), P16(O_RQK), PF32(O_SS)};
      small_gemm<FFinal>(lds, P16(O_XB) + (size_t)MP * 1024, P16(O_WPG), 1024, f, bx, G);
      pg8::Gemm g{P16(O_XB), P16(O_WPG), MP, 1024, 1024}; pg8::StaticOrder S; S.init(MP, 1024, G, bx); const EpiWrap<FFinal> E{f};
      pg8::gemm_phase<EpiWrap<FFinal>, pg8::StaticOrder, true, true>(lds, g, S, E); }
#ifdef PROBE_ITEM
    GSYNC();
    if (bx == 0) { const unsigned long long t1 = __builtin_amdgcn_s_memrealtime(); const unsigned long long dur = __hip_atomic_load(ctl + 16, __ATOMIC_RELAXED, __HIP_MEMORY_SCOPE_AGENT); while (__builtin_amdgcn_s_memrealtime() - t1 < dur) __builtin_amdgcn_s_sleep(8); }
#endif
#ifdef PROBE_PH
    if (pr_n == PROBE_PH) pr_acc = __builtin_amdgcn_s_memrealtime() - pr_t0;
    if (bx == 0) { const unsigned long long t1 = __builtin_amdgcn_s_memrealtime(); while (__builtin_amdgcn_s_memrealtime() - t1 < pr_acc) __builtin_amdgcn_s_sleep(8); }
#endif
}
}

extern "C" void kernel_launch(void* const* d_in, const int* in_sizes, int n_in, void* d_out, int out_size, void* d_ws, size_t ws_size, hipStream_t stream) {
    static int grid = 0;
    if (grid == 0) {
        if (n_in != 25 || (size_t)out_size != mk::OUT_END || ws_size < mk::WS_NEED) { fprintf(stderr, "kernel_launch: unexpected shapes (n_in %d out %d ws %zu need %zu)\n", n_in, out_size, ws_size, (size_t)mk::WS_NEED); grid = -1; return; }
        int dev = 0, cus = 0, per_cu = 0;
        hipGetDevice(&dev); hipDeviceGetAttribute(&cus, hipDeviceAttributeMultiprocessorCount, dev);
        if (hipFuncSetAttribute((const void*)mk::fwd, hipFuncAttributeMaxDynamicSharedMemorySize, mk::LDS_BYTES) != hipSuccess) { fprintf(stderr, "kernel_launch: hipFuncSetAttribute failed\n"); grid = -1; return; }
        hipOccupancyMaxActiveBlocksPerMultiprocessor(&per_cu, (const void*)mk::fwd, 512, mk::LDS_BYTES);
        if (per_cu < 1) { fprintf(stderr, "kernel_launch: occupancy query says %d blocks per CU\n", per_cu); per_cu = 1; }
        grid = cus;
    }
    if (grid < 0) return;
    if (hipMemsetAsync((char*)d_ws + mk::O_CTL, 0, 65536, stream) != hipSuccess) { fprintf(stderr, "kernel_launch: memset failed\n"); return; }
    mk::Args a{};
    for (int i = 0; i < 25; ++i) a.in[i] = (const float*)d_in[i];
    a.out = (float*)d_out; a.ws = (unsigned char*)d_ws;
    void* args[] = {&a};
    hipError_t e = hipLaunchCooperativeKernel((const void*)mk::fwd, dim3(grid), dim3(512), args, mk::LDS_BYTES, stream);
    if (e != hipSuccess) fprintf(stderr, "cooperative launch failed: %s (grid %d)\n", hipGetErrorString(e), grid);
}
```

```cpp
#include <hip/hip_runtime.h>
#include <hip/hip_cooperative_groups.h>
#include <cstdio>
#include <cstdint>
#include <hip/hip_bf16.h>
#include <cmath>
namespace cg = cooperative_groups;
namespace pg8 {
#define PG8_LAS __attribute__((address_space(3)))
typedef unsigned short bf16_t;
typedef short bf16x8 __attribute__((ext_vector_type(8)));
typedef float f32x4 __attribute__((ext_vector_type(4)));
typedef unsigned u32x4 __attribute__((ext_vector_type(4)));
constexpr int BM = 256, BK = 64, HALF = 128, HTB = HALF * BK * 2  , STAGE_BYTES = 8 * HTB, NXCD = 8, WGM = 4;

__host__ __device__ __forceinline__ int lds_byte(int r, int c) { const int st = (r >> 4) * 2 + (c >> 5), rr = r & 15, cc = c & 31, ob = rr * 64 + cc * 2; return st * 1024 + (ob ^ (((ob >> 9) & 1) << 5)); }
__host__ __device__ __forceinline__ void stage_rc(int b, int& R, int& C) { const int st = b / 1024, sb = b % 1024, swz = sb ^ (((sb >> 9) & 1) << 5); R = (st >> 1) * 16 + swz / 64; C = (st & 1) * 32 + (swz % 64) / 2; }
__host__ __device__ __forceinline__ int perm32(int rho) { const int n = rho >> 4, i = rho & 15; return 8 * (i >> 2) + 4 * n + (i & 3); }

struct Unit { int pm, pn; };
struct Gemm { const bf16_t* A; const bf16_t* Bt; int M, N, K; };

struct StaticOrder {
    int nM, nN, nwg, G, c;
    __host__ __device__ void init(int M, int N, int G_, int c_) { nM = M / BM; nN = N / BM; nwg = nM * nN; G = G_; c = c_; }
    __host__ __device__ bool next(int i, Unit& u) const {
        const long L = (long)i * G + c; if (L >= nwg) return false;
        int wgid = (int)L; { const int q = nwg / NXCD, r = nwg % NXCD, xcd = wgid % NXCD, off = wgid / NXCD; wgid = (xcd < r ? xcd * (q + 1) : r * (q + 1) + (xcd - r) * q) + off; }
        const int nig = WGM * nN, gid = wgid / nig, fm = gid * WGM, gsz = (nM - fm) < WGM ? (nM - fm) : WGM;
        u.pm = fm + ((wgid % nig) % gsz); u.pn = (wgid % nig) / gsz; return true;
    }
    __device__ __forceinline__ void a_ready(const Unit&) const {}
    __device__ __forceinline__ void done(const Unit&) const {}
};

typedef float f32x2c __attribute__((ext_vector_type(2))); typedef __bf16 bf16x2c __attribute__((ext_vector_type(2)));
__device__ __forceinline__ unsigned cvt_pk_bf16(float lo, float hi) { f32x2c v = {lo, hi}; bf16x2c b = __builtin_convertvector(v, bf16x2c); return __builtin_bit_cast(unsigned, b); }
typedef float f32x2 __attribute__((ext_vector_type(2)));
template <class Epi, class Sched, bool ALIGN_EPI = false, bool SP2 = false>
__device__ __forceinline__ void gemm_phase(PG8_LAS unsigned char* lds, const Gemm g, const Sched& S, const Epi& E) {
    int tid = threadIdx.x; asm volatile("" : "+v"(tid)); const int wid = __builtin_amdgcn_readfirstlane(tid >> 6), lane = tid & 63, wr = wid >> 2, wc = wid & 3, fr = lane & 15, fq = lane >> 4;
    const int K = g.K, nt = K / BK;
    unsigned voffA[2], voffB[2];
#pragma unroll
    for (int i = 0; i < 2; ++i) { int R, C; stage_rc(tid * 16 + i * 8192, R, C); const int Rb = Epi::PERM ? ((R & ~31) + perm32(R & 31)) : R;
        voffA[i] = (unsigned)(R * K + C) * 2u; voffB[i] = (unsigned)(Rb * K + C) * 2u; }
    const size_t kstep = (size_t)(BK * 2);
    const size_t hstep = (size_t)HALF * K * 2;
    const size_t tstep = 2 * hstep;
    const unsigned ldsw = (unsigned)wid * 1024u;
    const int aoff = lds_byte(wr * 64 + fr, fq * 8), boff = lds_byte(wc * 32 + fr, fq * 8);
#define PG8_SA(b, h) (((b) * 2 + (h)) * HTB)
#define PG8_SB(b, h) ((4 + (b) * 2 + (h)) * HTB)
#define PG8_STAGE(bufoff, gbase, voff) do { _Pragma("unroll") for (int _i = 0; _i < 2; ++_i) \
        __builtin_amdgcn_global_load_lds((const unsigned*)((const char*)(gbase) + (voff)[_i]), (PG8_LAS unsigned*)(lds + (bufoff) + ldsw + _i * 8192), 16, 0, 0); } while (0)
#define PG8_LDA(dst, b, h) do { _Pragma("unroll") for (int m = 0; m < 4; ++m) _Pragma("unroll") for (int k = 0; k < 2; ++k) dst[m][k] = *(const PG8_LAS bf16x8*)(lds + PG8_SA(b, h) + aoff + m * 2048 + k * 1024); } while (0)
#define PG8_LDB(dst, b, h) do { _Pragma("unroll") for (int n = 0; n < 2; ++n) _Pragma("unroll") for (int k = 0; k < 2; ++k) dst[n][k] = *(const PG8_LAS bf16x8*)(lds + PG8_SB(b, h) + boff + n * 2048 + k * 1024); } while (0)
#define PG8_MMA(ai, bj, At, Bt) do { __builtin_amdgcn_s_setprio(1); _Pragma("unroll") for (int m = 0; m < 4; ++m) _Pragma("unroll") for (int n = 0; n < 2; ++n) _Pragma("unroll") for (int k = 0; k < 2; ++k) \
        acc[ai][bj][m][n] = __builtin_amdgcn_mfma_f32_16x16x32_bf16(Bt[n][k], At[m][k], acc[ai][bj][m][n], 0, 0, 0); __builtin_amdgcn_s_setprio(0); } while (0)
#define PG8_WAIT_V(n) asm volatile("s_waitcnt vmcnt(" #n ")" ::: "memory")
#define PG8_WAIT_L(n) asm volatile("s_waitcnt lgkmcnt(" #n ")" ::: "memory")
#define PG8_BAR __builtin_amdgcn_s_barrier()
#define PG8_SCHED __builtin_amdgcn_sched_barrier(0)
    Unit cur, nxt; int ui = 0;
    if (!S.next(0, cur)) return;
    f32x4 acc[2][2][4][2];
#pragma unroll
    for (int a = 0; a < 2; ++a)
#pragma unroll
        for (int b = 0; b < 2; ++b)
#pragma unroll
            for (int m = 0; m < 4; ++m)
#pragma unroll
                for (int n = 0; n < 2; ++n) acc[a][b][m][n] = (f32x4){0.f, 0.f, 0.f, 0.f};
    bf16x8 At[4][2], B0[2][2], B1[2][2];
    const char* cA = (const char*)g.A + (size_t)cur.pm * tstep; const char* cB = (const char*)g.Bt + (size_t)cur.pn * tstep;
    S.a_ready(cur);
    if constexpr (SP2) {
        PG8_STAGE(PG8_SB(0, 0), cB, voffB); PG8_STAGE(PG8_SB(0, 1), cB + hstep, voffB); PG8_STAGE(PG8_SA(0, 0), cA, voffA); PG8_STAGE(PG8_SA(0, 1), cA + hstep, voffA);
        if (wr == 1) PG8_BAR;
        PG8_WAIT_V(2); PG8_BAR;
        PG8_STAGE(PG8_SB(1, 0), cB + kstep, voffB); PG8_STAGE(PG8_SA(1, 0), cA + kstep, voffA); PG8_STAGE(PG8_SB(1, 1), cB + hstep + kstep, voffB);
        PG8_WAIT_V(6); PG8_BAR;
    } else {
        PG8_STAGE(PG8_SB(0, 0), cB, voffB); PG8_STAGE(PG8_SA(0, 0), cA, voffA); PG8_STAGE(PG8_SB(0, 1), cB + hstep, voffB); PG8_STAGE(PG8_SA(0, 1), cA + hstep, voffA);
        if (wr == 1) PG8_BAR;
        PG8_WAIT_V(4); PG8_BAR;
        PG8_STAGE(PG8_SB(1, 0), cB + kstep, voffB); PG8_STAGE(PG8_SA(1, 0), cA + kstep, voffA); PG8_STAGE(PG8_SB(1, 1), cB + hstep + kstep, voffB);
        PG8_WAIT_V(6); PG8_BAR;
    }
    for (;;) {
        const bool has_next = S.next(ui + 1, nxt);
        const char* nA = has_next ? (const char*)g.A + (size_t)nxt.pm * tstep : cA; const char* nB = has_next ? (const char*)g.Bt + (size_t)nxt.pn * tstep : cB;
        for (int t = 0; t < nt; t += 2) {
            const bool last = (t == nt - 2);
            const char* a1 = cA + (size_t)(t + 1) * kstep;
            const char* a2 = last ? nA : cA + (size_t)(t + 2) * kstep; const char* b2 = last ? nB : cB + (size_t)(t + 2) * kstep;
            const char* a3 = a2 + kstep; const char* b3 = b2 + kstep;
            if (last && has_next) S.a_ready(nxt);
            if constexpr (SP2) {
            PG8_LDB(B0, 0, 0); PG8_LDB(B1, 0, 1); PG8_SCHED; PG8_LDA(At, 0, 0); PG8_STAGE(PG8_SA(1, 1), a1 + hstep, voffA);
            PG8_WAIT_V(8); PG8_WAIT_L(0); PG8_BAR; PG8_MMA(0, 0, At, B0); PG8_MMA(0, 1, At, B1); PG8_BAR; PG8_SCHED;
            PG8_LDA(At, 0, 1); PG8_STAGE(PG8_SB(0, 0), b2, voffB); PG8_STAGE(PG8_SB(0, 1), b2 + hstep, voffB); PG8_STAGE(PG8_SA(0, 0), a2, voffA);
            PG8_WAIT_V(8); PG8_WAIT_L(0); PG8_BAR; PG8_MMA(1, 0, At, B0); PG8_MMA(1, 1, At, B1); PG8_BAR; PG8_SCHED;
            PG8_LDB(B0, 1, 0); PG8_LDB(B1, 1, 1); PG8_SCHED; PG8_LDA(At, 1, 0); PG8_STAGE(PG8_SA(0, 1), a2 + hstep, voffA);
            PG8_WAIT_V(8); PG8_WAIT_L(0); PG8_BAR; PG8_MMA(0, 0, At, B0); PG8_MMA(0, 1, At, B1); PG8_BAR; PG8_SCHED;
            PG8_LDA(At, 1, 1); PG8_STAGE(PG8_SB(1, 0), b3, voffB); PG8_STAGE(PG8_SB(1, 1), b3 + hstep, voffB); PG8_STAGE(PG8_SA(1, 0), a3, voffA);
            PG8_WAIT_V(8); PG8_WAIT_L(0); PG8_BAR; PG8_MMA(1, 0, At, B0); PG8_MMA(1, 1, At, B1); PG8_BAR; PG8_SCHED;
            } else {
            PG8_LDB(B0, 0, 0); PG8_SCHED; PG8_LDA(At, 0, 0); PG8_STAGE(PG8_SA(1, 1), a1 + hstep, voffA);
            PG8_WAIT_L(8); PG8_BAR; PG8_WAIT_L(0); PG8_MMA(0, 0, At, B0); PG8_BAR; PG8_SCHED;
            PG8_LDB(B1, 0, 1); PG8_STAGE(PG8_SB(0, 0), b2, voffB);
            PG8_BAR; PG8_WAIT_L(0); PG8_MMA(0, 1, At, B1); PG8_BAR;
            PG8_LDA(At, 0, 1); PG8_STAGE(PG8_SA(0, 0), a2, voffA);
            PG8_BAR; PG8_WAIT_L(0); PG8_MMA(1, 0, At, B0); PG8_BAR; PG8_SCHED;
            PG8_STAGE(PG8_SB(0, 1), b2 + hstep, voffB);
            PG8_WAIT_V(6); PG8_BAR; PG8_MMA(1, 1, At, B1); PG8_BAR;
            PG8_LDB(B0, 1, 0); PG8_SCHED; PG8_LDA(At, 1, 0); PG8_STAGE(PG8_SA(0, 1), a2 + hstep, voffA);
            PG8_WAIT_L(8); PG8_BAR; PG8_WAIT_L(0); PG8_MMA(0, 0, At, B0); PG8_BAR; PG8_SCHED;
            PG8_LDB(B1, 1, 1); PG8_STAGE(PG8_SB(1, 0), b3, voffB);
            PG8_BAR; PG8_WAIT_L(0); PG8_MMA(0, 1, At, B1); PG8_BAR;
            PG8_LDA(At, 1, 1); PG8_STAGE(PG8_SA(1, 0), a3, voffA);
            PG8_BAR; PG8_WAIT_L(0); PG8_MMA(1, 0, At, B0); PG8_BAR; PG8_SCHED;
            PG8_STAGE(PG8_SB(1, 1), b3 + hstep, voffB);
            PG8_WAIT_V(6); PG8_BAR; PG8_MMA(1, 1, At, B1); PG8_BAR;
            }
        }
        if constexpr (ALIGN_EPI) { if (wr == 0) PG8_BAR; }
        if constexpr (!Epi::AFTER_DRAIN) { E(acc, cur, wr, wc, fr, fq); S.done(cur); }
        if (!has_next) break;
#pragma unroll
        for (int a = 0; a < 2; ++a)
#pragma unroll
            for (int b = 0; b < 2; ++b)
#pragma unroll
                for (int m = 0; m < 4; ++m)
#pragma unroll
                    for (int n = 0; n < 2; ++n) acc[a][b][m][n] = (f32x4){0.f, 0.f, 0.f, 0.f};
        cur = nxt; cA = nA; cB = nB; ++ui;
        if constexpr (ALIGN_EPI) { if (wr == 1) PG8_BAR; }
    }
    PG8_WAIT_V(0);
    if constexpr (!ALIGN_EPI) { if (wr == 0) PG8_BAR; }
    PG8_BAR;
    if constexpr (Epi::AFTER_DRAIN) { E.fused(acc, cur, wr, wc, fr, fq, lds, wid, lane); S.done(cur); }
#undef PG8_SA
#undef PG8_SB
#undef PG8_STAGE
#undef PG8_LDA
#undef PG8_LDB
#undef PG8_MMA
#undef PG8_WAIT_V
#undef PG8_WAIT_L
#undef PG8_BAR
#undef PG8_SCHED
}
}
namespace attn_body {
using bf16=__hip_bfloat16;
using bf16x8=__attribute__((ext_vector_type(8)))short;
using s16x4=__attribute__((ext_vector_type(4)))short;
using f32x16=__attribute__((ext_vector_type(16)))float;
using u32x4=__attribute__((ext_vector_type(4)))unsigned;
using f32x4v=__attribute__((ext_vector_type(4)))float;
constexpr int BATCH=32,NHEAD=8,SEQ=2048,D=64,DM=NHEAD*D;
constexpr int NW=8,QBLK=32,QB=QBLK*NW,KVBLK=64,NQB=SEQ/QB;
constexpr int ATTN_PITCH=DM, ATTN_UNIT_ROWS=QB;
__device__ __forceinline__ int crow(int r,int hi){return (r&3)+8*(r>>2)+4*hi;}
#define SBAR() __builtin_amdgcn_sched_barrier(0)
__device__ __forceinline__ void cmask(f32x16&p0,f32x16&p1,int jb,int qrel,int hi){
  const float NEG=-INFINITY; int kb=64*jb+4*hi;
  #pragma unroll
  for(int r=0;r<16;++r){int kv=kb+(r&3)+8*(r>>2); if(kv>qrel)p0[r]=NEG; if(kv+32>qrel)p1[r]=NEG;}
}

constexpr int NSLOT=3, SLOTB=8192;
constexpr int LDS_K=0, LDS_V=NSLOT*SLOTB, LDS_WS=2*NSLOT*SLOTB, LDS_OST=LDS_WS+NW*64*4, LDS_CB=LDS_OST+NW*4096, LDS_CBX=LDS_CB+2048*4, LDS_AL=LDS_CBX+256, LDS_BYTES=LDS_AL+256;
constexpr float C2=0.125f*1.4426950408889634f;
__device__ __forceinline__ void glds16(const void*gsrc,unsigned lds_dst){unsigned keep;
  asm volatile("s_mov_b32 %0, m0\n\ts_mov_b32 m0, %2\n\ts_nop 0\n\tglobal_load_lds_dwordx4 %1, off\n\ts_mov_b32 m0, %0":"=&s"(keep):"v"(gsrc),"s"(lds_dst):"memory");}
__device__ __forceinline__ float max3f(float a,float b,float c){float r;asm("v_max3_f32 %0, %1, %2, %3":"=v"(r):"v"(a),"v"(b),"v"(c));return r;}
__device__ __forceinline__ float max2f(float a,float b){float r;asm("v_max_f32_e32 %0, %1, %2":"=v"(r):"v"(a),"v"(b));return r;}
__device__ __forceinline__ float fadd_s(float a,float b){float r;asm("v_add_f32_e32 %0, %1, %2":"=v"(r):"v"(a),"v"(b));return r;}
__device__ __forceinline__ float fsub_s(float a,float b){float r;asm("v_sub_f32_e32 %0, %1, %2":"=v"(r):"v"(a),"v"(b));return r;}
typedef float f32x2_t __attribute__((ext_vector_type(2))); typedef __bf16 bf16x2_t __attribute__((ext_vector_type(2)));
__device__ __forceinline__ unsigned cvtpk_s(float lo,float hi){f32x2_t v={lo,hi};bf16x2_t b=__builtin_convertvector(v,bf16x2_t);return __builtin_bit_cast(unsigned,b);}
#define WAIT_BAR(N) asm volatile("s_waitcnt vmcnt(" #N ") lgkmcnt(0)\n\ts_barrier":::"memory")

__device__ __forceinline__ void qkt(f32x16&p0,f32x16&p1,const char*Kslot,const bf16x8*qr,int r32,int hi){ const f32x16 negm=f32x16{};
  const char*kb=Kslot+hi*1024+r32*16;
  #pragma unroll
  for(int d0=0;d0<4;++d0){
    const bf16x8 b0=*reinterpret_cast<const bf16x8*>(kb+d0*2048);
    const bf16x8 b1=*reinterpret_cast<const bf16x8*>(kb+d0*2048+512);
    if(d0==0){p0=__builtin_amdgcn_mfma_f32_32x32x16_bf16(b0,qr[0],negm,0,0,0);p1=__builtin_amdgcn_mfma_f32_32x32x16_bf16(b1,qr[0],negm,0,0,0);}
    else{p0=__builtin_amdgcn_mfma_f32_32x32x16_bf16(b0,qr[d0],p0,0,0,0);p1=__builtin_amdgcn_mfma_f32_32x32x16_bf16(b1,qr[d0],p1,0,0,0);}}
}
typedef __attribute__((address_space(3))) const char* lds_cptr;
typedef short v4i16_t __attribute__((ext_vector_type(4)));
__device__ __forceinline__ void kload8(bf16x8*kf,lds_cptr kp){
  kf[0]=*(const __attribute__((address_space(3))) bf16x8*)(kp);      kf[1]=*(const __attribute__((address_space(3))) bf16x8*)(kp+512);
  kf[2]=*(const __attribute__((address_space(3))) bf16x8*)(kp+2048); kf[3]=*(const __attribute__((address_space(3))) bf16x8*)(kp+2560);
  kf[4]=*(const __attribute__((address_space(3))) bf16x8*)(kp+4096); kf[5]=*(const __attribute__((address_space(3))) bf16x8*)(kp+4608);
  kf[6]=*(const __attribute__((address_space(3))) bf16x8*)(kp+6144); kf[7]=*(const __attribute__((address_space(3))) bf16x8*)(kp+6656);
}
__device__ __forceinline__ void kload2(bf16x8*kf,lds_cptr kp,int j){ kf[2*j]=*(const __attribute__((address_space(3))) bf16x8*)(kp+j*2048); kf[2*j+1]=*(const __attribute__((address_space(3))) bf16x8*)(kp+j*2048+512); }
__device__ __forceinline__ s16x4 vtr(lds_cptr p){ return __builtin_bit_cast(s16x4,__builtin_amdgcn_ds_read_tr16_b64_v4i16((__attribute__((address_space(3))) v4i16_t*)p)); }
__device__ __forceinline__ float rowmax(const f32x16&p0,const f32x16&p1){
  float a=max3f(p0[0],p0[1],p1[0]),b=max3f(p0[2],p0[3],p1[1]);a=max3f(a,p1[2],p1[3]);
  #pragma unroll
  for(int r=4;r<16;r+=4){a=max3f(a,p0[r],p0[r+1]);b=max3f(b,p0[r+2],p0[r+3]);a=max3f(a,p1[r],p1[r+1]);b=max3f(b,p1[r+2],p1[r+3]);}
  const float m=max2f(a,b);
  auto rr=__builtin_amdgcn_permlane32_swap(__float_as_uint(m),__float_as_uint(m),false,false);
  return max2f(__uint_as_float(rr[0]),__uint_as_float(rr[1]));
}
__device__ __forceinline__ void pv(f32x16*o,int vb,bf16x8 pa0,bf16x8 pa1,bf16x8 pa2,bf16x8 pa3){
  #pragma unroll
  for(int d0=0;d0<2;++d0){s16x4 lo[4],hi[4];
    #pragma unroll
    for(int ks=0;ks<4;++ks){
      asm volatile("ds_read_b64_tr_b16 %0,%1 offset:%c2":"=&v"(lo[ks]):"v"(vb),"i"(d0*4096+ks*1024):"memory");
      asm volatile("ds_read_b64_tr_b16 %0,%1 offset:%c2":"=&v"(hi[ks]):"v"(vb),"i"(d0*4096+ks*1024+512):"memory");}
    asm volatile("s_waitcnt lgkmcnt(0)":::"memory");SBAR();
    #define PK(k) (bf16x8){lo[k][0],lo[k][1],lo[k][2],lo[k][3],hi[k][0],hi[k][1],hi[k][2],hi[k][3]}
    o[d0]=__builtin_amdgcn_mfma_f32_32x32x16_bf16(pa0,PK(0),o[d0],0,0,0);
    o[d0]=__builtin_amdgcn_mfma_f32_32x32x16_bf16(pa1,PK(1),o[d0],0,0,0);
    o[d0]=__builtin_amdgcn_mfma_f32_32x32x16_bf16(pa2,PK(2),o[d0],0,0,0);
    o[d0]=__builtin_amdgcn_mfma_f32_32x32x16_bf16(pa3,PK(3),o[d0],0,0,0);
    #undef PK
  }
}

#ifndef ATTN_STORE16
#define ATTN_STORE16(p,v) (*(u32x4*)(p)=(v))
#endif
template<int THRL> __device__ __forceinline__ void attn_unit(int b,int h,int qb,const bf16*Q,const bf16*__restrict__ K,const bf16*__restrict__ V,bf16*O,const float*__restrict__ LFT,const float Dd,char*shm){
  int tid=threadIdx.x; asm volatile("":"+v"(tid)); const int lane=tid&63,r32=lane&31,hi=lane>>5; const int wid=__builtin_amdgcn_readfirstlane(tid>>6);
  const long rowbase=(long)b*SEQ; const int q0=qb*QB;
  const bf16*Qw=Q+(rowbase+q0+wid*QBLK)*DM+h*D;
  const bf16*Kh=K+rowbase*DM+h*D,*Vh=V+rowbase*DM+h*D;
  const unsigned lds0=(unsigned)(uintptr_t)shm;
  float*wsf=(float*)(shm+LDS_WS)+wid*64;
  const bf16*ksrc=Kh+(long)lane*DM+wid*8;
  const bf16*vsrc=Vh+(long)(16*(wid&3)+(lane>>2))*DM+(wid>>2)*32+(lane&3)*8;
  const unsigned kdst=lds0+LDS_K+wid*1024, vdst=lds0+LDS_V+wid*1024;
  #define DMA_K(t,slot) glds16(ksrc+(long)(t)*KVBLK*DM,(unsigned)__builtin_amdgcn_readfirstlane(kdst+(slot)))
  #define DMA_V(t,slot) glds16(vsrc+(long)(t)*KVBLK*DM,(unsigned)__builtin_amdgcn_readfirstlane(vdst+(slot)))
  const int vb0=(int)(lds0+LDS_V)+((lane>>4)&1)*32+(lane&3)*8+(4*hi+((lane&15)>>2))*64;
  const char*Kbase=shm+LDS_K; bf16x8 kf[8];
  const lds_cptr shm3=(lds_cptr)shm; const lds_cptr kp0=shm3+LDS_K+hi*1024+r32*16; const lds_cptr vp0=shm3+LDS_V+((lane>>4)&1)*32+(lane&3)*8+(4*hi+((lane&15)>>2))*64;
  int NT=(q0+QB)/KVBLK;
  typedef __attribute__((address_space(3))) const f32x4v* lds_f4p;
  typedef __attribute__((address_space(3))) float* lds_fp;
  bool stat; int t0;
  {
    lds_fp cbw=(lds_fp)(shm3+LDS_CB); lds_fp cbx=(lds_fp)(shm3+LDS_CBX); lds_fp alw=(lds_fp)(shm3+LDS_AL);
    const float L2E=1.4426950408889634f;
    const int nk=q0+QB; float v0=0.f,v1=0.f,v2=0.f,v3=0.f;
    if(4*tid<nk){ const f32x4v l4=*(const f32x4v*)(LFT+((long)(b*NHEAD+h))*SEQ+4*tid); v0=l4[0]; v1=l4[1]; v2=l4[2]; v3=l4[3]; }
    v1+=v0; v2+=v1; v3+=v2; float tot=v3;
    #pragma unroll
    for(int o_=1;o_<64;o_<<=1){ float u_=__shfl_up(tot,o_); if(lane>=o_)tot+=u_; }
    if(lane==63)cbx[wid]=tot;
    if(tid==0){cbx[48]=0.f;}
    asm volatile("s_waitcnt vmcnt(0) lgkmcnt(0)\n\ts_barrier":::"memory");
    float base=tot-v3;
    #pragma unroll
    for(int w_=0;w_<NW;++w_){ float x_=cbx[w_]; if(w_<wid)base+=x_; }
    v0+=base;v1+=base;v2+=base;v3+=base;
    if(4*tid<nk && ((4*tid+3)&63)==63)cbx[16+((4*tid+3)>>6)]=v3;
    if(4*tid==q0)cbx[8]=v0;
    asm volatile("s_waitcnt vmcnt(0) lgkmcnt(0)\n\ts_barrier":::"memory");
    const float cq0=cbx[8];
    if(4*tid<nk){ const float ce=cbx[16+(tid>>4)]; cbw[4*tid]=(ce-v0)*L2E-Dd; cbw[4*tid+1]=(ce-v1)*L2E-Dd; cbw[4*tid+2]=(ce-v2)*L2E-Dd; cbw[4*tid+3]=(ce-v3)*L2E-Dd; }
    bool skip_=false;
    if(tid<NT){ const float ce=cbx[16+tid], cp=(tid>0)?cbx[16+tid-1]:0.f; const float dl_=(cp-ce)*L2E;
      alw[tid]=__builtin_amdgcn_exp2f(-dl_); alw[32+tid]=dl_; if(dl_+2.f*Dd>110.f)cbx[48]=1.f;
      skip_=(tid<NT-4)&&((ce-cq0)*L2E>2.f*Dd+160.f); }
    const unsigned long long bal_=__ballot(skip_);
    if(tid==0)cbx[49]=(float)(__popcll(bal_)&~1);
    asm volatile("s_waitcnt vmcnt(0) lgkmcnt(0)\n\ts_barrier":::"memory");
    stat=(cbx[48]==0.f); t0=(int)cbx[49];
    stat=__builtin_amdgcn_readfirstlane((int)stat)!=0; t0=__builtin_amdgcn_readfirstlane(t0);
#ifdef FORCE_EXACT
    stat=false;
#endif
  }
  NT-=t0; ksrc+=(long)t0*KVBLK*DM; vsrc+=(long)t0*KVBLK*DM;
  typedef __attribute__((address_space(3))) const float* lds_cfp;
  const lds_cfp alp=(lds_cfp)(shm3+LDS_AL)+t0;
  const int tdw=NT-4+(wid>>1);
  #define ALF(t) (((t)>tdw)?1.f:alp[t])
  const lds_f4p cbp=(lds_f4p)(shm3+LDS_CB)+hi+16*t0;
  #define CBIAS(P0,P1,t) do{ const lds_f4p bp_=cbp+16*(t); _Pragma("unroll") for(int a_=0;a_<4;++a_){ const f32x4v b0_=bp_[2*a_], b1_=bp_[8+2*a_]; \
      P0[4*a_]+=b0_[0];P0[4*a_+1]+=b0_[1];P0[4*a_+2]+=b0_[2];P0[4*a_+3]+=b0_[3]; P1[4*a_]+=b1_[0];P1[4*a_+1]+=b1_[1];P1[4*a_+2]+=b1_[2];P1[4*a_+3]+=b1_[3]; } }while(0)
  DMA_K(0,0);DMA_V(0,0);DMA_K(1,SLOTB);
  bf16x8 qr[4];
  #pragma unroll
  for(int d0=0;d0<4;++d0)qr[d0]=*reinterpret_cast<const bf16x8*>(&Qw[(long)r32*DM+d0*16+hi*8]);
  float mhat=0.f,l_reg=0.f;f32x16 o[2];o[0]=f32x16{};o[1]=f32x16{};
  const int qrel=wid*QBLK+r32;
  #define CMASK(P0,P1,t) do{int jb_=(t)-(NT-4); if(jb_>=0)cmask(P0,P1,jb_,qrel,hi);}while(0)
  bool resc=false;
  #define START(P0,P1) do{ resc=false; \
    if(!stat){ const float rm=rowmax(P0,P1); const float dl=rm; mhat=fadd_s(mhat,dl); \
      _Pragma("unroll") for(int r=0;r<16;++r){P0[r]=fsub_s(P0[r],dl);P1[r]=fsub_s(P1[r],dl);} \
      } \
    _Pragma("unroll") for(int r=0;r<16;++r)P0[r]=__builtin_amdgcn_exp2f(P0[r]); }while(0)
  #define RESC(t) do{ if(stat){ const float al_=ALF(t); _Pragma("unroll") for(int d_=0;d_<2;++d_) _Pragma("unroll") for(int r=0;r<16;++r)o[d_][r]*=al_; } \
    else if(resc){ asm volatile("s_waitcnt lgkmcnt(0)":::"memory"); \
      _Pragma("unroll") for(int d_=0;d_<2;++d_) _Pragma("unroll") for(int r=0;r<16;++r)o[d_][r]*=wsf[crow(r,hi)]; } }while(0)
  f32x16 pA0,pA1,pB0,pB1;
  int sl_prev=0,sl_cur=0,sl_next=SLOTB;
  #define ROT() do{sl_prev=sl_cur;sl_cur=sl_next;sl_next=(sl_next==(NSLOT-1)*SLOTB)?0:sl_next+SLOTB;}while(0)
  DMA_K(2,2*SLOTB);
  WAIT_BAR(3);
  qkt(pA0,pA1,Kbase,qr,r32,hi);asm volatile("s_nop 15\n\ts_nop 7":"+v"(pA0),"+v"(pA1));CMASK(pA0,pA1,0);CBIAS(pA0,pA1,0);
  START(pA0,pA1);
  _Pragma("unroll") for(int r=0;r<16;++r)pA1[r]=__builtin_amdgcn_exp2f(pA1[r]);
  WAIT_BAR(0);
  DMA_K(3,0);DMA_V(1,SLOTB);
  ROT();
  kload8(kf,kp0+sl_cur);
  WAIT_BAR(2);
  s16x4 vlo[8],vhi[8]; u32x4 pw0,pw1,pw2,pw3;
  #define PKW(P,B) cvtpk_s(P[B],P[B+1])
  #define PAF(k) __builtin_bit_cast(bf16x8,pw##k)
  #define VFR(i) (bf16x8){vlo[i][0],vlo[i][1],vlo[i][2],vlo[i][3],vhi[i][0],vhi[i][1],vhi[i][2],vhi[i][3]}
  #define PIN(x) asm volatile("":"+v"(x))
  #define MX3(a,b,c) __builtin_fmaxf(__builtin_fmaxf((a),(b)),(c))
  #define GAPA(MF,A0,A1,A2,A3,W0,W1,PW) do{ MF; sacc+=A0; sacc+=A1; sacc+=A2; sacc+=A3; PIN(sacc); W0; W1; PIN(PW); SBAR(); }while(0)
  #define EX(v) __builtin_amdgcn_exp2f(v)
  #define GAPB(MF,X,B) do{ MF; X[B]=EX(X[B]); X[B+1]=EX(X[B+1]); X[B+2]=EX(X[B+2]); X[B+3]=EX(X[B+3]); PIN(X); SBAR(); }while(0)
  #define VRD(i) do{ vlo[i]=vtr(vp_+(((i)>>2)*4096+((i)&3)*1024)); vhi[i]=vtr(vp_+(((i)>>2)*4096+((i)&3)*1024+512)); }while(0)
  #define KRD(G,j) do{ if(G){ kload2(kf,kp0+sl_next,j); SBAR(); } }while(0)
  #define STEP(C0,C1,P0,P1,t,GK,GV,GL) do{ SBAR(); \
    const lds_cptr vp_=vp0+sl_prev; \
    VRD(0); SBAR(); float sacc=(P0[0]+P0[1]); \
    GAPA(C0=__builtin_amdgcn_mfma_f32_32x32x16_bf16(kf[0],qr[0],f32x16{},0,0,0), P0[2],P0[3],P0[4],P0[5],     pw0[0]=PKW(P0,0), pw0[1]=PKW(P0,2), pw0); \
    VRD(4); SBAR(); GAPA(C1=__builtin_amdgcn_mfma_f32_32x32x16_bf16(kf[1],qr[0],f32x16{},0,0,0), P0[6],P0[7],P0[8],P0[9],     pw0[2]=PKW(P0,4), pw0[3]=PKW(P0,6), pw0); \
    VRD(1); SBAR(); GAPA(C0=__builtin_amdgcn_mfma_f32_32x32x16_bf16(kf[2],qr[1],C0,0,0,0),   P0[10],P0[11],P0[12],P0[13], pw1[0]=PKW(P0,8), pw1[1]=PKW(P0,10), pw1); \
    VRD(5); SBAR(); GAPA(C1=__builtin_amdgcn_mfma_f32_32x32x16_bf16(kf[3],qr[1],C1,0,0,0),   P0[14],P0[15],P1[0],P1[1],   pw1[2]=PKW(P0,12),pw1[3]=PKW(P0,14), pw1); \
    VRD(2); SBAR(); GAPA(C0=__builtin_amdgcn_mfma_f32_32x32x16_bf16(kf[4],qr[2],C0,0,0,0),   P1[2],P1[3],P1[4],P1[5],     pw2[0]=PKW(P1,0), pw2[1]=PKW(P1,2), pw2); \
    VRD(6); SBAR(); GAPA(C1=__builtin_amdgcn_mfma_f32_32x32x16_bf16(kf[5],qr[2],C1,0,0,0),   P1[6],P1[7],P1[8],P1[9],     pw2[2]=PKW(P1,4), pw2[3]=PKW(P1,6), pw2); \
    VRD(3); SBAR(); GAPA(C0=__builtin_amdgcn_mfma_f32_32x32x16_bf16(kf[6],qr[3],C0,0,0,0),   P1[10],P1[11],P1[12],P1[13], pw3[0]=PKW(P1,8), pw3[1]=PKW(P1,10), pw3); \
    VRD(7); SBAR(); GAPA(C1=__builtin_amdgcn_mfma_f32_32x32x16_bf16(kf[7],qr[3],C1,0,0,0),   P1[14],P1[15],0.f,0.f,       pw3[2]=PKW(P1,12),pw3[3]=PKW(P1,14), pw3); \
    l_reg+=sacc; \
    if(GK){DMA_K((t)+3,sl_cur);} if(GV){DMA_V((t)+1,sl_next);} \
    CMASK(C0,C1,t); CBIAS(C0,C1,t); \
    if(stat){ l_reg*=ALF(t); resc=false; } else { mhat-=alp[32+(t)]; _Pragma("unroll") for(int r=0;r<16;++r){C0[r]-=mhat;C1[r]-=mhat;} float a=MX3(C0[0],C0[1],C1[0]),b=MX3(C0[2],C0[3],C1[1]); a=MX3(a,C1[2],C1[3]); \
      _Pragma("unroll") for(int r=4;r<16;r+=4){a=MX3(a,C0[r],C0[r+1]);b=MX3(b,C0[r+2],C0[r+3]);a=MX3(a,C1[r],C1[r+1]);b=MX3(b,C1[r+2],C1[r+3]);} \
      float rm=__builtin_fmaxf(a,b); { auto rr=__builtin_amdgcn_permlane32_swap(__float_as_uint(rm),__float_as_uint(rm),false,false); rm=__builtin_fmaxf(__uint_as_float(rr[0]),__uint_as_float(rr[1])); } \
      resc=false; \
      if(__builtin_expect(__any(rm>(float)THRL),0)){ const float dl=__builtin_fmaxf(rm,0.f); mhat+=dl; \
        _Pragma("unroll") for(int r=0;r<16;++r){C0[r]-=dl;C1[r]-=dl;} \
        const float f=__builtin_amdgcn_exp2f(-dl); l_reg*=f; if(hi==0)wsf[r32]=f; resc=true; } } \
    SBAR(); \
    GAPB(o[0]=__builtin_amdgcn_mfma_f32_32x32x16_bf16(PAF(0),VFR(0),o[0],0,0,0), C0,0); \
    GAPB(o[1]=__builtin_amdgcn_mfma_f32_32x32x16_bf16(PAF(0),VFR(4),o[1],0,0,0), C0,4); \
    KRD(GL,0); GAPB(o[0]=__builtin_amdgcn_mfma_f32_32x32x16_bf16(PAF(1),VFR(1),o[0],0,0,0), C0,8); \
    KRD(GL,1); GAPB(o[1]=__builtin_amdgcn_mfma_f32_32x32x16_bf16(PAF(1),VFR(5),o[1],0,0,0), C0,12); \
    KRD(GL,2); GAPB(o[0]=__builtin_amdgcn_mfma_f32_32x32x16_bf16(PAF(2),VFR(2),o[0],0,0,0), C1,0); \
    KRD(GL,3); GAPB(o[1]=__builtin_amdgcn_mfma_f32_32x32x16_bf16(PAF(2),VFR(6),o[1],0,0,0), C1,4); \
    GAPB(o[0]=__builtin_amdgcn_mfma_f32_32x32x16_bf16(PAF(3),VFR(3),o[0],0,0,0), C1,8); \
    GAPB(o[1]=__builtin_amdgcn_mfma_f32_32x32x16_bf16(PAF(3),VFR(7),o[1],0,0,0), C1,12); \
    }while(0)
  int t=1;
  #undef CMASK
  #define CMASK(P0,P1,t) do{}while(0)
  for(;t+5<NT;t+=2){
    STEP(pB0,pB1,pA0,pA1,t,true,true,true);     WAIT_BAR(2); RESC(t); ROT();
    STEP(pA0,pA1,pB0,pB1,t+1,true,true,true);   WAIT_BAR(2); RESC(t+1); ROT();
  }
  #undef CMASK
  #define CMASK(P0,P1,t) do{int jb_=(t)-(NT-4); if(jb_>=0)cmask(P0,P1,jb_,qrel,hi);}while(0)
  #define ENDW(tt) do{ if((tt)+3<NT){WAIT_BAR(2);} else if((tt)+2<NT){WAIT_BAR(1);} else {WAIT_BAR(0);} }while(0)
  for(;t+1<NT;t+=2){
    STEP(pB0,pB1,pA0,pA1,t,(t+3<NT),(t+1<NT),(t+1<NT));       ENDW(t);   RESC(t); ROT();
    STEP(pA0,pA1,pB0,pB1,t+1,(t+4<NT),(t+2<NT),(t+2<NT));     ENDW(t+1); RESC(t+1); ROT();
  }
  STEP(pB0,pB1,pA0,pA1,NT-1,false,false,false); RESC(NT-1);
  { float sacc=pB0[0]+pB0[1]; _Pragma("unroll") for(int r=2;r<16;++r)sacc+=pB0[r]; _Pragma("unroll") for(int r=0;r<16;++r)sacc+=pB1[r]; l_reg+=sacc;
    pw0=(u32x4){PKW(pB0,0),PKW(pB0,2),PKW(pB0,4),PKW(pB0,6)};pw1=(u32x4){PKW(pB0,8),PKW(pB0,10),PKW(pB0,12),PKW(pB0,14)};pw2=(u32x4){PKW(pB1,0),PKW(pB1,2),PKW(pB1,4),PKW(pB1,6)};pw3=(u32x4){PKW(pB1,8),PKW(pB1,10),PKW(pB1,12),PKW(pB1,14)};
    SBAR(); pv(o,vb0+sl_cur,PAF(0),PAF(1),PAF(2),PAF(3)); }
  #undef PKW
  #undef PAF
  #undef VFR
  #undef PIN
  #undef MX3
  #undef GAPA
  #undef GAPB
  #undef EX
  #undef VRD
  #undef KRD
  #undef STEP
  #undef ENDW
  {auto rr=__builtin_amdgcn_permlane32_swap(__float_as_uint(l_reg),__float_as_uint(l_reg),false,false);l_reg=__uint_as_float(rr[0])+__uint_as_float(rr[1]);}
  if(hi==0)wsf[32+r32]=l_reg;asm volatile("s_waitcnt lgkmcnt(0)":::"memory");
  float rli[16];
  #pragma unroll
  for(int r=0;r<16;++r)rli[r]=__builtin_amdgcn_rcpf(wsf[32+crow(r,hi)]);
  bf16*Ow=O+(rowbase+q0+wid*QBLK)*DM+h*D;
  { bf16*stg=(bf16*)(shm+LDS_OST)+wid*2048;
    #pragma unroll
    for(int r=0;r<16;++r){const int orow=crow(r,hi);
      #pragma unroll
      for(int d0=0;d0<2;++d0)stg[orow*64+d0*32+r32]=__float2bfloat16(o[d0][r]*rli[r]);}
    asm volatile("s_waitcnt lgkmcnt(0)":::"memory");
    #pragma unroll
    for(int i=0;i<4;++i){const int row=i*8+(lane>>3),ch=lane&7; const u32x4 v=*(const u32x4*)(stg+row*64+ch*8); ATTN_STORE16(Ow+(long)row*DM+ch*8,v);} }
  asm volatile("s_waitcnt lgkmcnt(0)\n\ts_barrier":::"memory");
  #undef DMA_K
  #undef DMA_V
  #undef CMASK
  #undef CBIAS
  #undef ALF
  #undef START
  #undef RESC
  #undef ROT
}
constexpr int ATTN_LDS_BYTES=LDS_BYTES;
#undef SBAR
#undef WAIT_BAR
}
namespace xb {
#define XLAS __attribute__((address_space(3)))
#define XB_TMO      128
#define XB_XCNT(j)  (256  + 64 * (j))
#define XB_XSUB(j)  (1280 + 64 * (j))
#define XB_XGEN(j)  (2304 + 64 * (j))
#define XB_TOP      3328
#define XB_TOPGEN   3392
#define XCD_BAR_WORDS 3456
#define XB_SPIN_CAP (1u << 18)

__device__ __forceinline__ unsigned xb_ld(unsigned* p)              { return __hip_atomic_load(p, __ATOMIC_RELAXED, __HIP_MEMORY_SCOPE_AGENT); }
__device__ __forceinline__ unsigned xb_add(unsigned* p, unsigned v) { return __hip_atomic_fetch_add(p, v, __ATOMIC_RELAXED, __HIP_MEMORY_SCOPE_AGENT); }
__device__ __forceinline__ unsigned xb_xcc_id() { return (unsigned)__builtin_amdgcn_s_getreg((3 << 11) | 20) & 0xFu; }
#define XB_SPIN(cond, bar) do { unsigned _sp = 0; while (cond) { __builtin_amdgcn_s_sleep(1); \
    if ((++_sp & 255u) == 0u) { if (xb_ld(&(bar)[XB_TMO])) break; if (_sp > XB_SPIN_CAP) { atomicAdd(&(bar)[XB_TMO], 1u); break; } } } } while (0)

struct XcdBarrier {
    unsigned* bar; unsigned x;
    volatile XLAS unsigned* st;
};

__device__ __forceinline__ XcdBarrier xcd_barrier_post(unsigned* bar, volatile XLAS unsigned* st) {
    XcdBarrier b; b.bar = bar; b.x = xb_xcc_id(); b.st = st;
    if (threadIdx.x == 0) (void)xb_add(&bar[XB_XCNT(b.x)], 1u);
    return b;
}
__device__ __forceinline__ void xcd_barrier_complete(unsigned* bar, unsigned x, unsigned& nloc, unsigned& nx) {
    const unsigned G = gridDim.x * gridDim.y * gridDim.z;
    unsigned sum, cnt, mine, sp = 0u;
    for (;;) {
        sum = 0u; cnt = 0u; mine = 0u;
#pragma unroll
        for (unsigned j = 0; j < 16; ++j) { const unsigned c = xb_ld(&bar[XB_XCNT(j)]); sum += c; cnt += (c > 0u) ? 1u : 0u; mine = (j == x) ? c : mine; }
        if (sum == G) break;
        __builtin_amdgcn_s_sleep(1);
        if ((++sp & 255u) == 0u) { if (xb_ld(&bar[XB_TMO])) break; if (sp > XB_SPIN_CAP) { atomicAdd(&bar[XB_TMO], 1u); break; } }
    }
    nloc = mine > 0u ? mine : 1u; nx = cnt > 0u ? cnt : 1u;
}

__device__ __forceinline__ void xcd_barrier(const XcdBarrier& b) {
    asm volatile("s_waitcnt vmcnt(0)" ::: "memory");
    __syncthreads();
    if (threadIdx.x == 0) {
        unsigned* bar = b.bar;
        __builtin_amdgcn_s_waitcnt(0);
        unsigned nloc = b.st[0], nx = b.st[1];
        if (nloc == 0u) { xcd_barrier_complete(bar, b.x, nloc, nx); b.st[0] = nloc; b.st[1] = nx; }
        const unsigned old = xb_add(&bar[XB_XSUB(b.x)], 1u);
        const unsigned gen = old / nloc;
        if (old + 1u == (gen + 1u) * nloc) {
            __builtin_amdgcn_fence(__ATOMIC_RELEASE, "agent");
            asm volatile("s_waitcnt vmcnt(0)" ::: "memory");
            const unsigned og = xb_add(&bar[XB_TOP], 1u);
            const unsigned tg = og / nx;
            if (og + 1u == (tg + 1u) * nx) xb_add(&bar[XB_TOPGEN], 1u);
            else XB_SPIN(xb_ld(&bar[XB_TOPGEN]) == tg, bar);
            __builtin_amdgcn_fence(__ATOMIC_ACQUIRE, "agent");
            xb_add(&bar[XB_XGEN(b.x)], 1u);
            asm volatile("s_waitcnt vmcnt(0)" ::: "memory");
        } else {
            XB_SPIN(xb_ld(&bar[XB_XGEN(b.x)]) == gen, bar);
            __builtin_amdgcn_fence(__ATOMIC_ACQUIRE, "agent");
            asm volatile("s_waitcnt vmcnt(0)" ::: "memory");
        }
    }
    __syncthreads();
}
}
namespace mk {
#define LAS __attribute__((address_space(3)))
typedef unsigned short u16;
typedef pg8::f32x4 f32x4;
typedef pg8::u32x4 u32x4;
typedef pg8::bf16x8 bf16x8;
typedef unsigned u32x2 __attribute__((ext_vector_type(2)));
using pg8::cvt_pk_bf16;

constexpr int DMODEL = 1024, SEQ = 2048, MP = 65536, MS = 256, MT = MP + MS, DFF = 2816, NMIX = 6912, PAST = 4096, NPOS = 2048 + 16;
constexpr float L2E = 1.4426950408889634f;
constexpr float QC2 = 0.125f * L2E;

constexpr size_t SZ1024 = (size_t)MT * 1024 * 2, SZ512 = (size_t)MT * 512 * 2;
constexpr size_t O_CTL = 0;
constexpr size_t O_SS = 65536;
constexpr size_t O_TABC = O_SS + (size_t)MT * 64;
constexpr size_t O_TABS = O_TABC + (size_t)NPOS * 256;
constexpr size_t O_W1IN = O_TABS + (size_t)NPOS * 256;
constexpr size_t O_W1OUT = O_W1IN + (size_t)5632 * 1024 * 2;
constexpr size_t O_WMIX = O_W1OUT + (size_t)1024 * 2816 * 2;
constexpr size_t O_WBR = O_WMIX + (size_t)NMIX * 1024 * 2;
constexpr size_t O_WBF = O_WBR + (size_t)1024 * 1024 * 2;
constexpr size_t O_WOUT = O_WBF + (size_t)1024 * 512 * 2;
constexpr size_t O_W2IN = O_WOUT + (size_t)1024 * 1024 * 2;
constexpr size_t O_W2OUT = O_W2IN + (size_t)5632 * 1024 * 2;
constexpr size_t O_WPLE = O_W2OUT + (size_t)1024 * 2816 * 2;
constexpr size_t O_WPG = O_WPLE + (size_t)1024 * 256 * 2;
constexpr size_t O_XB = O_WPG + (size_t)1024 * 1024 * 2;
constexpr size_t O_RQK = O_XB + SZ1024;
constexpr size_t O_RV = O_RQK + SZ1024;
constexpr size_t O_RG = O_RV + SZ1024;
constexpr size_t O_FQ = O_RG + SZ1024;
constexpr size_t O_FK = O_FQ + SZ512;
constexpr size_t O_FV = O_FK + SZ512;
constexpr size_t O_ZG = O_FV + SZ512;
constexpr size_t WS_NEED = O_ZG + (size_t)MT * 2048 * 2;
constexpr size_t O_ACT1 = O_RQK;
constexpr size_t O_ACT2 = O_RV;
static_assert(O_ACT1 + (size_t)MT * DFF * 2 <= O_FQ, "act1 overlay");
static_assert(O_ACT2 + (size_t)MT * DFF * 2 <= O_FV, "act2 overlay");
static_assert(WS_NEED <= 1073741824ull, "ws");
constexpr size_t OUT_YP = 0, OUT_YS = OUT_YP + (size_t)MP * 1024, OUT_RSP = OUT_YS + (size_t)MS * 1024, OUT_KP = OUT_RSP + (size_t)32 * 4 * 128 * 256,
                 OUT_VP = OUT_KP + (size_t)MP * 512, OUT_LP = OUT_VP + (size_t)MP * 512, OUT_RSS = OUT_LP + (size_t)MP * 8, OUT_KS = OUT_RSS + (size_t)16 * 4 * 128 * 256,
                 OUT_VS = OUT_KS + (size_t)MS * 512, OUT_LS = OUT_VS + (size_t)MS * 512, OUT_END = OUT_LS + (size_t)MS * 8;

constexpr int LDS_BYTES = 147456;

__device__ __forceinline__ float bf2f(unsigned h) { return __uint_as_float(h << 16); }
__device__ __forceinline__ float bflo(unsigned w) { return __uint_as_float(w << 16); }
__device__ __forceinline__ float bfhi(unsigned w) { return __uint_as_float(w & 0xffff0000u); }
__device__ __forceinline__ float fast_sigmoid(float x) { return __builtin_amdgcn_rcpf(1.f + __builtin_amdgcn_exp2f(-x * L2E)); }
__device__ __forceinline__ float wave_sum(float v) {
#pragma unroll
    for (int o = 1; o < 64; o <<= 1) v += __shfl_xor(v, o);
    return v;
}
__device__ __forceinline__ float wave_max(float v) {
#pragma unroll
    for (int o = 1; o < 64; o <<= 1) v = fmaxf(v, __shfl_xor(v, o));
    return v;
}
__device__ __forceinline__ float rstd_of(const float* ss, int row) {
    const f32x4* p = (const f32x4*)(ss + (size_t)row * 16); const f32x4 a = p[0], b = p[1], c = p[2], d = p[3];
    const float s = (((a[0] + a[1]) + (a[2] + a[3])) + ((b[0] + b[1]) + (b[2] + b[3]))) + (((c[0] + c[1]) + (c[2] + c[3])) + ((d[0] + d[1]) + (d[2] + d[3])));
    return rsqrtf(s * (1.f / 1024.f) + 1e-6f);
}
__device__ __forceinline__ int gcol(int q) { return (q & 128) + (q & 96) + ((q >> 2) & 3) * 8 + ((q >> 4) & 1) * 4 + (q & 3); }


constexpr int RS_TAB_OFF = 147456 - 128 - 1024;
__device__ __forceinline__ const LAS float* rs_table_fill(const float* ss, int pm) {
    LAS float* tab = (LAS float*)(uintptr_t)RS_TAB_OFF;
    const int t = threadIdx.x;
    if (t < 256) tab[t] = rstd_of(ss, pm * 256 + t);
    asm volatile("s_waitcnt lgkmcnt(0)" ::: "memory"); __builtin_amdgcn_s_barrier(); asm volatile("" ::: "memory");
    return tab;
}
struct EpiSwiglu {
    static constexpr bool PERM = false, AFTER_DRAIN = false;
    u16* O; const float* ss;
    __device__ __forceinline__ void operator()(const f32x4 (&acc)[2][2][4][2], const pg8::Unit& u, int wr, int wc, int fr, int fq) const {
        const int col = u.pn * 128 + wc * 32 + fq * 8; const LAS float* rst = rs_table_fill(ss, u.pm);
#pragma unroll
        for (int ai = 0; ai < 2; ++ai)
#pragma unroll
            for (int m = 0; m < 4; ++m) {
                const int row = u.pm * 256 + ai * 128 + wr * 64 + m * 16 + fr; const float rs = rst[ai * 128 + wr * 64 + m * 16 + fr];
                typedef float f32x2 __attribute__((ext_vector_type(2)));
                const float nrs = -rs * L2E, rs2 = rs * rs; unsigned wv[4];
#pragma unroll
                for (int n = 0; n < 2; ++n)
#pragma unroll
                    for (int e = 0; e < 4; e += 2) {
                        const f32x2 g2 = {acc[ai][0][m][n][e], acc[ai][0][m][n][e + 1]}, u2 = {acc[ai][1][m][n][e], acc[ai][1][m][n][e + 1]};
                        const f32x2 t2 = g2 * nrs; f32x2 d2 = {__builtin_amdgcn_exp2f(t2.x), __builtin_amdgcn_exp2f(t2.y)}; d2 = d2 + 1.0f;
                        const f32x2 r2 = {__builtin_amdgcn_rcpf(d2.x), __builtin_amdgcn_rcpf(d2.y)};
                        const f32x2 a2 = ((g2 * u2) * rs2) * r2;
                        wv[n * 2 + (e >> 1)] = cvt_pk_bf16(a2.x, a2.y);
                    }
                u32x4 w; w.x = wv[0]; w.y = wv[1]; w.z = wv[2]; w.w = wv[3];
                *(u32x4*)(O + (size_t)row * DFF + col) = w;
            }
    }
};
struct EpiMix {
    static constexpr bool PERM = false, AFTER_DRAIN = false;
    const float* ss; const float* tabc; const float* tabs; const float* qg; const float* kg; const float* bfg;
    u16 *RQK, *RV, *RG, *FQ, *FK, *FV, *ZG; float* out; float* lft;
    template <int MODE> static __device__ __forceinline__ void store8(const f32x4 (&acc)[2][2][4][2], u16* base, int ld, int t, int row, float rs, int ai, int m, int wc, int fq) {
#pragma unroll
        for (int bj = 0; bj < 2; ++bj) {
            float a[8];
#pragma unroll
            for (int n = 0; n < 2; ++n)
#pragma unroll
                for (int e = 0; e < 4; ++e) { const float v = acc[ai][bj][m][n][e] * rs; a[n * 4 + e] = MODE == 0 ? v : (MODE == 1 ? v * fast_sigmoid(v) : fast_sigmoid(v)); }
            u32x4 w; w.x = cvt_pk_bf16(a[0], a[1]); w.y = cvt_pk_bf16(a[2], a[3]); w.z = cvt_pk_bf16(a[4], a[5]); w.w = cvt_pk_bf16(a[6], a[7]);
            *(u32x4*)(base + (size_t)row * ld + t * 256 + bj * 128 + wc * 32 + fq * 8) = w;
        }
    }
    template <bool ISK> static __device__ __forceinline__ void headnorm(const f32x4 (&acc)[2][2][4][2], u16* dst, const float* gn, float* o, int row, float rs, int ai, int m, int head, int fq) {
        float q = 0.f;
#pragma unroll
        for (int bj = 0; bj < 2; ++bj)
#pragma unroll
            for (int n = 0; n < 2; ++n) { const f32x4 v = acc[ai][bj][m][n] * rs; q += (v[0] * v[0] + v[1] * v[1]) + (v[2] * v[2] + v[3] * v[3]); }
        q += __shfl_xor(q, 16); q += __shfl_xor(q, 32);
        const float hr = rsqrtf(q * (1.f / 64.f) + 1e-6f) * rs * (ISK ? 1.f : QC2);
#pragma unroll
        for (int bj = 0; bj < 2; ++bj)
#pragma unroll
            for (int n = 0; n < 2; ++n) {
                const int d = 32 * bj + 16 * n + 4 * fq; const f32x4 g4 = *(const f32x4*)(gn + d); const f32x4 v = acc[ai][bj][m][n] * hr * g4;
                u32x2 w; w.x = cvt_pk_bf16(v[0], v[1]); w.y = cvt_pk_bf16(v[2], v[3]);
                *(u32x2*)(dst + (size_t)row * 512 + head * 64 + d) = w;
                if (ISK) *(f32x4*)(o + head * 64 + d) = v;
            }
    }
    __device__ __forceinline__ void operator()(const f32x4 (&acc)[2][2][4][2], const pg8::Unit& u, int wr, int wc, int fr, int fq) const {
        const int pn = u.pn; const LAS float* rst = rs_table_fill(ss, u.pm);
#pragma unroll
        for (int ai = 0; ai < 2; ++ai)
#pragma unroll
            for (int m = 0; m < 4; ++m) {
                const int row = u.pm * 256 + ai * 128 + wr * 64 + m * 16 + fr; const float rs = rst[ai * 128 + wr * 64 + m * 16 + fr];
                if (pn < 4) {
                    const int pidx = row < MP ? (row & (SEQ - 1)) : SEQ + ((row - MP) & 15);
                    const int d = 16 * wc + 4 * fq;
                    const f32x4 c = *(const f32x4*)(tabc + pidx * 64 + d), s = *(const f32x4*)(tabs + pidx * 64 + d);
                    const float sc = rs * (pn >= 2 ? 0.08838834764831845f : 1.f);
#pragma unroll
                    for (int bj = 0; bj < 2; ++bj) {
                        const f32x4 x1 = acc[ai][bj][m][0] * sc, x2 = acc[ai][bj][m][1] * sc;
                        const f32x4 o1 = x1 * c - x2 * s, o2 = x1 * s + x2 * c;
                        u16* p = RQK + (size_t)row * 1024 + (pn >> 1) * 512 + (2 * (pn & 1) + bj) * 128 + d;
                        u32x2 w1, w2; w1.x = cvt_pk_bf16(o1[0], o1[1]); w1.y = cvt_pk_bf16(o1[2], o1[3]); w2.x = cvt_pk_bf16(o2[0], o2[1]); w2.y = cvt_pk_bf16(o2[2], o2[3]);
                        *(u32x2*)p = w1; *(u32x2*)(p + 64) = w2;
                    }
                } else if (pn < 8) { store8<0>(acc, RV, 1024, pn - 4, row, rs, ai, m, wc, fq);
                } else if (pn < 12) { store8<1>(acc, RG, 1024, pn - 8, row, rs, ai, m, wc, fq);
                } else if (pn >= 19) { store8<2>(acc, ZG, 2048, pn - 19, row, rs, ai, m, wc, fq);
                } else if (pn < 14) { headnorm<false>(acc, FQ, qg, nullptr, row, rs, ai, m, 4 * (pn & 1) + wc, fq);
                } else if (pn < 16) { headnorm<true>(acc, FK, kg, row < MP ? out + OUT_KP + (size_t)row * 512 : out + OUT_KS + (size_t)(row - MP) * 512, row, rs, ai, m, 4 * (pn & 1) + wc, fq);
                } else if (pn < 18) {
                    float* o = row < MP ? out + OUT_VP + (size_t)row * 512 : out + OUT_VS + (size_t)(row - MP) * 512;
#pragma unroll
                    for (int bj = 0; bj < 2; ++bj) {
                        const int col = (pn - 16) * 256 + bj * 128 + wc * 32 + fq * 8;
                        const f32x4 v0 = acc[ai][bj][m][0] * rs, v1 = acc[ai][bj][m][1] * rs;
                        u32x4 w; w.x = cvt_pk_bf16(v0[0], v0[1]); w.y = cvt_pk_bf16(v0[2], v0[3]); w.z = cvt_pk_bf16(v1[0], v1[1]); w.w = cvt_pk_bf16(v1[2], v1[3]);
                        *(u32x4*)(FV + (size_t)row * 512 + col) = w; *(f32x4*)(o + col) = v0; *(f32x4*)(o + col + 4) = v1;
                    }
                } else {
                    if (wc == 0 && fq == 0) {
                        float* o = row < MP ? out + OUT_LP + (size_t)row * 8 : out + OUT_LS + (size_t)(row - MP) * 8;
#pragma unroll
                        for (int n = 0; n < 2; ++n) { f32x4 r;
#pragma unroll
                            for (int e = 0; e < 4; ++e) { const float x = acc[ai][0][m][n][e] * rs + bfg[n * 4 + e]; r[e] = fminf(x, 0.f) - __logf(1.f + __expf(-fabsf(x))); }
                            *(f32x4*)(o + n * 4) = r;
                            if (row < MP) { float* lt = lft + ((size_t)(row >> 11) * 8 + n * 4) * SEQ + (row & (SEQ - 1)); lt[0] = r[0]; lt[SEQ] = r[1]; lt[2 * SEQ] = r[2]; lt[3 * SEQ] = r[3]; } }
                    }
                }
            }
    }
};
struct FResid {
    static constexpr bool NEED_RS = false, WRITE_SS = true; static constexpr int BATCH = 4;
    u16* XB; float* ss; float alpha;
    struct In { u32x4 x; };
    __device__ __forceinline__ In load(int row, int col) const { In r; r.x = *(const u32x4*)(XB + (size_t)row * 1024 + col); return r; }
    __device__ __forceinline__ float finish(int row, int col, const float (&v)[8], const In& in, float) const {
        const u32x4 x = in.x;
        const float r0 = bflo(x.x) + alpha * v[0], r1 = bfhi(x.x) + alpha * v[1], r2 = bflo(x.y) + alpha * v[2], r3 = bfhi(x.y) + alpha * v[3],
                    r4 = bflo(x.z) + alpha * v[4], r5 = bfhi(x.z) + alpha * v[5], r6 = bflo(x.w) + alpha * v[6], r7 = bfhi(x.w) + alpha * v[7];
        u32x4 w; w.x = cvt_pk_bf16(r0, r1); w.y = cvt_pk_bf16(r2, r3); w.z = cvt_pk_bf16(r4, r5); w.w = cvt_pk_bf16(r6, r7); *(u32x4*)(XB + (size_t)row * 1024 + col) = w;
        return ((r0 * r0 + r1 * r1) + (r2 * r2 + r3 * r3)) + ((r4 * r4 + r5 * r5) + (r6 * r6 + r7 * r7));
    }
};
template <bool SECOND> struct FGate {
    static constexpr bool NEED_RS = false, WRITE_SS = false; static constexpr int BATCH = 4;
    u16* T; const u16* ZG; float* ss;
    struct In { u32x4 g, p; };
    __device__ __forceinline__ In load(int row, int col) const { In r; r.g = *(const u32x4*)(ZG + (size_t)row * 2048 + (SECOND ? 1024 : 0) + col); if (SECOND) r.p = *(const u32x4*)(T + (size_t)row * 1024 + col); else r.p = (u32x4){0u, 0u, 0u, 0u}; return r; }
    __device__ __forceinline__ float finish(int row, int col, const float (&a)[8], const In& in, float) const {
        const u32x4 g = in.g, p = in.p;
        float v[8] = {bflo(g.x) * a[0], bfhi(g.x) * a[1], bflo(g.y) * a[2], bfhi(g.y) * a[3], bflo(g.z) * a[4], bfhi(g.z) * a[5], bflo(g.w) * a[6], bfhi(g.w) * a[7]};
        if (SECOND) { v[0] += bflo(p.x); v[1] += bfhi(p.x); v[2] += bflo(p.y); v[3] += bfhi(p.y); v[4] += bflo(p.z); v[5] += bfhi(p.z); v[6] += bflo(p.w); v[7] += bfhi(p.w); }
        u32x4 w; w.x = cvt_pk_bf16(v[0], v[1]); w.y = cvt_pk_bf16(v[2], v[3]); w.z = cvt_pk_bf16(v[4], v[5]); w.w = cvt_pk_bf16(v[6], v[7]);
        *(u32x4*)(T + (size_t)row * 1024 + col) = w; return 0.f;
    }
};
struct FPlain {
    static constexpr bool NEED_RS = false, WRITE_SS = false; static constexpr int BATCH = 4;
    u16* O; float* ss;
    struct In { int dummy; };
    __device__ __forceinline__ In load(int, int) const { In r; r.dummy = 0; return r; }
    __device__ __forceinline__ float finish(int row, int col, const float (&a)[8], const In&, float) const {
        u32x4 w; w.x = cvt_pk_bf16(a[0], a[1]); w.y = cvt_pk_bf16(a[2], a[3]); w.z = cvt_pk_bf16(a[4], a[5]); w.w = cvt_pk_bf16(a[6], a[7]);
        *(u32x4*)(O + (size_t)row * 1024 + col) = w; return 0.f;
    }
};
struct FFinal {
    static constexpr bool NEED_RS = true, WRITE_SS = false; static constexpr int BATCH = 2;
    float* yP; float* yS; const u16* XB; const u16* PLE; float* ss;
    struct In { u32x4 x, p; };
    __device__ __forceinline__ In load(int row, int col) const { In r; r.x = *(const u32x4*)(XB + (size_t)row * 1024 + col); r.p = *(const u32x4*)(PLE + (size_t)row * 1024 + col); return r; }
    __device__ __forceinline__ float finish(int row, int col, const float (&a)[8], const In& in, float rs) const {
        float* y = (row < MP ? yP + (size_t)row * 1024 : yS + (size_t)(row - MP) * 1024) + col;
        const u32x4 x = in.x, p = in.p;
        f32x4 y0, y1;
        y0[0] = bflo(x.x) + bflo(p.x) * fast_sigmoid(a[0] * rs); y0[1] = bfhi(x.x) + bfhi(p.x) * fast_sigmoid(a[1] * rs); y0[2] = bflo(x.y) + bflo(p.y) * fast_sigmoid(a[2] * rs); y0[3] = bfhi(x.y) + bfhi(p.y) * fast_sigmoid(a[3] * rs);
        y1[0] = bflo(x.z) + bflo(p.z) * fast_sigmoid(a[4] * rs); y1[1] = bfhi(x.z) + bfhi(p.z) * fast_sigmoid(a[5] * rs); y1[2] = bflo(x.w) + bflo(p.w) * fast_sigmoid(a[6] * rs); y1[3] = bfhi(x.w) + bfhi(p.w) * fast_sigmoid(a[7] * rs);
        *(f32x4*)y = y0; *(f32x4*)(y + 4) = y1; return 0.f;
    }
};
template <class F> struct EpiWrap {
    static constexpr bool PERM = false, AFTER_DRAIN = false;
    F f;
    __device__ __forceinline__ void operator()(const f32x4 (&acc)[2][2][4][2], const pg8::Unit& u, int wr, int wc, int fr, int fq) const {
        constexpr int NB = F::BATCH; const LAS float* rst = nullptr; if (F::NEED_RS) rst = rs_table_fill(f.ss, u.pm);
#pragma unroll
        for (int ab = 0; ab < 8 / NB; ++ab) {
            const int ai = (ab * NB) / 4, m0 = (ab * NB) % 4;
            typename F::In in[NB][2];
            const int row0 = u.pm * 256 + ai * 128 + wr * 64 + fr + m0 * 16, col0 = u.pn * 256 + wc * 32 + fq * 8;
#pragma unroll
            for (int m = 0; m < NB; ++m) {
#pragma unroll
                for (int bj = 0; bj < 2; ++bj) in[m][bj] = f.load(row0 + m * 16, col0 + bj * 128);
            }
            __builtin_amdgcn_sched_barrier(0);
#pragma unroll
            for (int m = 0; m < NB; ++m) {
                const int row = row0 + m * 16; float rs = 1.f;
                if (F::NEED_RS) rs = rst[ai * 128 + wr * 64 + (m0 + m) * 16 + fr];
                float q = 0.f;
#pragma unroll
                for (int bj = 0; bj < 2; ++bj) {
                    const float v[8] = {acc[ai][bj][m0 + m][0][0], acc[ai][bj][m0 + m][0][1], acc[ai][bj][m0 + m][0][2], acc[ai][bj][m0 + m][0][3], acc[ai][bj][m0 + m][1][0], acc[ai][bj][m0 + m][1][1], acc[ai][bj][m0 + m][1][2], acc[ai][bj][m0 + m][1][3]};
                    q += f.finish(row, col0 + bj * 128, v, in[m][bj], rs);
                }
                if (F::WRITE_SS) { q += __shfl_xor(q, 16); q += __shfl_xor(q, 32); if (fq == 0) f.ss[(size_t)row * 16 + u.pn * 4 + wc] = q; }
            }
        }
    }
};
template <class F> __device__ __forceinline__ void small_gemm(LAS unsigned char* lds, const u16* A, const u16* Bt, int K, const F& f, int bx, int G) {
    int tid = threadIdx.x; asm volatile("" : "+v"(tid));
    const int lane = tid & 63, w = __builtin_amdgcn_readfirstlane(tid >> 6), g = lane >> 4, c16 = lane & 15;
    LAS float* red = (LAS float*)lds;
    const int steps = K / 256;
    for (int item = bx; item < 256; item += G) {
        const int rb = item >> 4, cb = item & 15;
        const u16* ap = A + (size_t)(16 * rb + c16) * K + (size_t)w * (K / 8) + 8 * g;
        const u16* bp = Bt + (size_t)(64 * cb + c16) * K + (size_t)w * (K / 8) + 8 * g;
        f32x4 acc[4];
#pragma unroll
        for (int nt = 0; nt < 4; ++nt) acc[nt] = (f32x4){0.f, 0.f, 0.f, 0.f};
        for (int s0 = 0; s0 < steps; s0 += 4) {
            bf16x8 a[4], b[4][4];
#pragma unroll
            for (int j = 0; j < 4; ++j) if (s0 + j < steps) { a[j] = *(const bf16x8*)(ap + 32 * (s0 + j));
#pragma unroll
                for (int nt = 0; nt < 4; ++nt) b[j][nt] = *(const bf16x8*)(bp + (size_t)16 * nt * K + 32 * (s0 + j)); }
#pragma unroll
            for (int j = 0; j < 4; ++j) if (s0 + j < steps) {
#pragma unroll
                for (int nt = 0; nt < 4; ++nt) acc[nt] = __builtin_amdgcn_mfma_f32_16x16x32_bf16(a[j], b[j][nt], acc[nt], 0, 0, 0); }
        }
        __syncthreads();
#pragma unroll
        for (int nt = 0; nt < 4; ++nt)
#pragma unroll
            for (int i = 0; i < 4; ++i) red[(w * 16 + 4 * g + i) * 64 + 16 * nt + c16] = acc[nt][i];
        __syncthreads();
        if (tid < 128) {
            const int row = tid >> 3, c8 = tid & 7, p0 = 32 * (c8 >> 2) + 4 * (c8 & 3);
            f32x4 s0 = {0.f, 0.f, 0.f, 0.f}, s1 = {0.f, 0.f, 0.f, 0.f};
#pragma unroll
            for (int ww = 0; ww < 8; ++ww) { s0 += *(const LAS f32x4*)(red + (ww * 16 + row) * 64 + p0); s1 += *(const LAS f32x4*)(red + (ww * 16 + row) * 64 + p0 + 16); }
            const float v[8] = {s0[0], s0[1], s0[2], s0[3], s1[0], s1[1], s1[2], s1[3]};
            const int grow = MP + 16 * rb + row; float rs = 1.f; if (F::NEED_RS) rs = rstd_of(f.ss, grow);
            const typename F::In in = f.load(grow, 64 * cb + 8 * c8); float q = f.finish(grow, 64 * cb + 8 * c8, v, in, rs);
            if (F::WRITE_SS) { q += __shfl_xor(q, 1); q += __shfl_xor(q, 2); q += __shfl_xor(q, 4); if (c8 == 0) f.ss[(size_t)grow * 16 + cb] = q; }
        }
    }
    __syncthreads();
}
__device__ __forceinline__ int logical_col(int kind, int pr) {
    const int t = pr >> 8, q = pr & 255, g = gcol(q);
    if (kind == 0) return t * 256 + g;
    if (kind == 1) { const int bj = q >> 7; return bj * DFF + t * 128 + (g & 127); }
    const int bj = q >> 7, wc = (q >> 5) & 3, n = (q >> 4) & 1, fq = (q >> 2) & 3, e = q & 3;
    if (t < 4) return (t >> 1) * 512 + (2 * (t & 1) + bj) * 128 + 16 * wc + 4 * fq + e + 64 * n;
    if (t < 8) return 1024 + (t - 4) * 256 + g;
    if (t < 12) return 2048 + (t - 8) * 256 + g;
    if (t < 16) return (t < 14 ? 3072 : 3584) + (4 * (t & 1) + wc) * 64 + 32 * bj + 16 * n + 4 * fq + e;
    if (t < 18) return 4096 + (t - 16) * 256 + g;
    if (t == 18) return g < 8 ? 4608 + g : -1;
    return 4616 + (t - 19) * 256 + g;
}
__device__ __forceinline__ void transpose_item(const float* W, const float* gain, int K, int Nlog, int kind, u16* WT, int nblk, LAS float* scr, int item, int lane) {
    const int kb = item / nblk, nb = item % nblk, k0 = 64 * kb, n0 = 32 * nb;
    const int lc = logical_col(kind, n0 + (lane & 31));
    float tv[32];
#pragma unroll
    for (int i = 0; i < 32; ++i) { const int kk = 2 * i + (lane >> 5); tv[i] = (lc >= 0) ? W[(size_t)(k0 + kk) * Nlog + lc] : 0.f; }
#pragma unroll
    for (int i = 0; i < 32; ++i) { const int kk = 2 * i + (lane >> 5); float v = tv[i]; if (gain) v *= gain[k0 + kk]; scr[kk * 33 + (lane & 31)] = v; }
    asm volatile("s_waitcnt lgkmcnt(0)" ::: "memory");
    const int c = lane & 7;
#pragma unroll
    for (int j = 0; j < 4; ++j) { const int n = (lane >> 3) + 8 * j; const LAS float* s = scr + (8 * c) * 33 + n;
        u32x4 o; o.x = cvt_pk_bf16(s[0 * 33], s[1 * 33]); o.y = cvt_pk_bf16(s[2 * 33], s[3 * 33]); o.z = cvt_pk_bf16(s[4 * 33], s[5 * 33]); o.w = cvt_pk_bf16(s[6 * 33], s[7 * 33]);
        *(u32x4*)(WT + (size_t)(n0 + n) * K + k0 + 8 * c) = o; }
    asm volatile("s_waitcnt lgkmcnt(0)" ::: "memory");
}

constexpr int R_QS = 0, R_KS = 17408, R_KDT = 34816, R_VT = 53248, R_AS = 90112, R_RED = 99328, R_RSTD = 101376, R_END = 101632;
template <int CH>
__device__ __forceinline__ void ret_item(LAS unsigned char* lds, const u16* RQK, u16* RV, const u16* RG, const float* s0, float* sout, size_t rowbase, int nchunks, int h) {
    constexpr int TT = CH / 16, KSN = (CH + 31) / 32;
    int tid = threadIdx.x; asm volatile("" : "+v"(tid)); const int lane = tid & 63, w = __builtin_amdgcn_readfirstlane(tid >> 6), g = lane >> 4, c16 = lane & 15;
    LAS u16* Qs = (LAS u16*)(lds + R_QS); LAS u16* Ks = (LAS u16*)(lds + R_KS); LAS u16* KdT = (LAS u16*)(lds + R_KDT); LAS u16* VT = (LAS u16*)(lds + R_VT); LAS u16* As = (LAS u16*)(lds + R_AS);
    LAS float* red = (LAS float*)(lds + R_RED); LAS float* rstdv = (LAS float*)(lds + R_RSTD);
    const float lg2 = __log2f(1.f - __builtin_amdgcn_exp2f(-5.f - (float)h));
    f32x4 S[8][2];
#pragma unroll
    for (int kt = 0; kt < 8; ++kt)
#pragma unroll
        for (int nt = 0; nt < 2; ++nt)
#pragma unroll
            for (int i = 0; i < 4; ++i) S[kt][nt][i] = s0 ? s0[(size_t)(16 * kt + 4 * g + i) * 256 + 32 * w + 16 * nt + c16] : 0.f;
    __syncthreads();
    if (CH < 32) {
        for (int i = tid; i < (R_RED - R_KDT) / 4; i += 512) ((LAS unsigned*)(lds + R_KDT))[i] = 0u;
        __syncthreads();
    }
    for (int c = 0; c < nchunks; ++c) {
        const size_t row0 = rowbase + (size_t)c * CH;
        __syncthreads();
        for (int p = tid; p < CH * 16; p += 512) {
            const int r = p >> 4, cc = p & 15;
            const u32x4 q = *(const u32x4*)(RQK + (row0 + r) * 1024 + h * 128 + cc * 8);
            const u32x4 k = *(const u32x4*)(RQK + (row0 + r) * 1024 + 512 + h * 128 + cc * 8);
            *(LAS u32x4*)(Qs + r * 136 + cc * 8) = q; *(LAS u32x4*)(Ks + r * 136 + cc * 8) = k;
            const float dec = __builtin_amdgcn_exp2f(lg2 * (float)(CH - 1 - r));
            const unsigned kw[4] = {k.x, k.y, k.z, k.w};
#pragma unroll
            for (int j = 0; j < 4; ++j) { const unsigned pk = cvt_pk_bf16(bflo(kw[j]) * dec, bfhi(kw[j]) * dec); KdT[(cc * 8 + 2 * j) * 72 + r] = (u16)(pk & 0xffffu); KdT[(cc * 8 + 2 * j + 1) * 72 + r] = (u16)(pk >> 16); }
        }
        for (int p = tid; p < CH * 32; p += 512) {
            const int r = p >> 5, cc = p & 31;
            const u32x4 v = *(const u32x4*)(RV + (row0 + r) * 1024 + h * 256 + cc * 8);
            const unsigned vw[4] = {v.x, v.y, v.z, v.w};
#pragma unroll
            for (int j = 0; j < 4; ++j) { VT[(cc * 8 + 2 * j) * 72 + r] = (u16)(vw[j] & 0xffffu); VT[(cc * 8 + 2 * j + 1) * 72 + r] = (u16)(vw[j] >> 16); }
        }
        __syncthreads();
        for (int tile = w; tile < TT * TT; tile += 8) {
            const int ti = tile / TT, tj = tile % TT; f32x4 a4 = {0.f, 0.f, 0.f, 0.f};
#pragma unroll
            for (int kk = 0; kk < 4; ++kk) {
                const bf16x8 a = *(const LAS bf16x8*)(Qs + (16 * ti + c16) * 136 + 32 * kk + 8 * g), b = *(const LAS bf16x8*)(Ks + (16 * tj + c16) * 136 + 32 * kk + 8 * g);
                a4 = __builtin_amdgcn_mfma_f32_16x16x32_bf16(a, b, a4, 0, 0, 0);
            }
#pragma unroll
            for (int i = 0; i < 4; ++i) { const int ri = 16 * ti + 4 * g + i, cj = 16 * tj + c16; const int dd = ri > cj ? ri - cj : cj - ri;
                const unsigned pk = cvt_pk_bf16(a4[i] * __builtin_amdgcn_exp2f(lg2 * (float)dd), 0.f); As[ri * 72 + cj] = (u16)(pk & 0xffffu); }
        }
        bf16x8 sb[4][2];
#pragma unroll
        for (int kk = 0; kk < 4; ++kk)
#pragma unroll
            for (int nt = 0; nt < 2; ++nt) { u32x4 t; t.x = cvt_pk_bf16(S[2 * kk][nt][0], S[2 * kk][nt][1]); t.y = cvt_pk_bf16(S[2 * kk][nt][2], S[2 * kk][nt][3]);
                t.z = cvt_pk_bf16(S[2 * kk + 1][nt][0], S[2 * kk + 1][nt][1]); t.w = cvt_pk_bf16(S[2 * kk + 1][nt][2], S[2 * kk + 1][nt][3]); sb[kk][nt] = __builtin_bit_cast(bf16x8, t); }
        f32x4 O[TT][2];
#pragma unroll
        for (int tt = 0; tt < TT; ++tt) {
            f32x4 o0 = {0.f, 0.f, 0.f, 0.f}, o1 = {0.f, 0.f, 0.f, 0.f};
#pragma unroll
            for (int kk = 0; kk < 4; ++kk) {
                const u32x2 lo = *(const LAS u32x2*)(Qs + (16 * tt + c16) * 136 + 32 * kk + 4 * g), hi = *(const LAS u32x2*)(Qs + (16 * tt + c16) * 136 + 32 * kk + 16 + 4 * g);
                u32x4 t; t.x = lo.x; t.y = lo.y; t.z = hi.x; t.w = hi.y; const bf16x8 a = __builtin_bit_cast(bf16x8, t);
                o0 = __builtin_amdgcn_mfma_f32_16x16x32_bf16(a, sb[kk][0], o0, 0, 0, 0); o1 = __builtin_amdgcn_mfma_f32_16x16x32_bf16(a, sb[kk][1], o1, 0, 0, 0);
            }
#pragma unroll
            for (int i = 0; i < 4; ++i) { const float dsc = __builtin_amdgcn_exp2f(lg2 * (float)(16 * tt + 4 * g + i + 1)); o0[i] *= dsc; o1[i] *= dsc; }
            O[tt][0] = o0; O[tt][1] = o1;
        }
        __syncthreads();
#pragma unroll
        for (int tt = 0; tt < TT; ++tt)
#pragma unroll
            for (int ks = 0; ks < KSN; ++ks) {
                const bf16x8 a = *(const LAS bf16x8*)(As + (16 * tt + c16) * 72 + 32 * ks + 8 * g);
#pragma unroll
                for (int nt = 0; nt < 2; ++nt) { const bf16x8 b = *(const LAS bf16x8*)(VT + (32 * w + 16 * nt + c16) * 72 + 32 * ks + 8 * g); O[tt][nt] = __builtin_amdgcn_mfma_f32_16x16x32_bf16(a, b, O[tt][nt], 0, 0, 0); }
            }
#pragma unroll
        for (int tt = 0; tt < TT; ++tt)
#pragma unroll
            for (int i = 0; i < 4; ++i) { float q = O[tt][0][i] * O[tt][0][i] + O[tt][1][i] * O[tt][1][i]; q += __shfl_xor(q, 1); q += __shfl_xor(q, 2); q += __shfl_xor(q, 4); q += __shfl_xor(q, 8);
                if (c16 == 0) red[w * 64 + 16 * tt + 4 * g + i] = q; }
        __syncthreads();
        if (tid < CH) { float s = 0.f;
#pragma unroll
            for (int ww = 0; ww < 8; ++ww) s += red[ww * 64 + tid];
            rstdv[tid] = rsqrtf(s * (1.f / 256.f) + 1e-6f); }
        __syncthreads();
#pragma unroll
        for (int tt = 0; tt < TT; ++tt)
#pragma unroll
            for (int i = 0; i < 4; ++i) { const int tok = 16 * tt + 4 * g + i; const float rsd = rstdv[tok];
#pragma unroll
                for (int nt = 0; nt < 2; ++nt) { const size_t off = (row0 + tok) * 1024 + h * 256 + 32 * w + 16 * nt + c16; const float gt = bf2f(RG[off]);
                    const unsigned pk = cvt_pk_bf16(O[tt][nt][i] * rsd * gt, 0.f); RV[off] = (u16)(pk & 0xffffu); } }
        const float cd = __builtin_amdgcn_exp2f(lg2 * (float)CH);
#pragma unroll
        for (int kt = 0; kt < 8; ++kt)
#pragma unroll
            for (int nt = 0; nt < 2; ++nt) S[kt][nt] = S[kt][nt] * cd;
#pragma unroll
        for (int ks = 0; ks < KSN; ++ks) {
            const bf16x8 b0 = *(const LAS bf16x8*)(VT + (32 * w + c16) * 72 + 32 * ks + 8 * g), b1 = *(const LAS bf16x8*)(VT + (32 * w + 16 + c16) * 72 + 32 * ks + 8 * g);
#pragma unroll
            for (int kt = 0; kt < 8; ++kt) { const bf16x8 a = *(const LAS bf16x8*)(KdT + (16 * kt + c16) * 72 + 32 * ks + 8 * g);
                S[kt][0] = __builtin_amdgcn_mfma_f32_16x16x32_bf16(a, b0, S[kt][0], 0, 0, 0); S[kt][1] = __builtin_amdgcn_mfma_f32_16x16x32_bf16(a, b1, S[kt][1], 0, 0, 0); }
        }
    }
#pragma unroll
    for (int kt = 0; kt < 8; ++kt)
#pragma unroll
        for (int nt = 0; nt < 2; ++nt)
#pragma unroll
            for (int i = 0; i < 4; ++i) sout[(size_t)(16 * kt + 4 * g + i) * 256 + 32 * w + 16 * nt + c16] = S[kt][nt][i];
    __syncthreads();
}
constexpr int R2_QS = 0, R2_KS = 17408, R2_KDT = 34816, R2_VT = 53248, R2_AS = 90112, R2_OS = 99328, R2_RED = 133120, R2_RSTD = 135168, R2_END = 135424;
__device__ __forceinline__ void ret_prompt_item(LAS unsigned char* lds, const u16* RQK, u16* RV, const u16* RG, float* sout, size_t rowbase, int h) {
    int tid = threadIdx.x; asm volatile("" : "+v"(tid));
    const int lane = tid & 63, w = __builtin_amdgcn_readfirstlane(tid >> 6), g = lane >> 4, c16 = lane & 15;
    LAS u16* Qs = (LAS u16*)(lds + R2_QS); LAS u16* Ks = (LAS u16*)(lds + R2_KS); LAS u16* KdT = (LAS u16*)(lds + R2_KDT); LAS u16* VT = (LAS u16*)(lds + R2_VT); LAS u16* As = (LAS u16*)(lds + R2_AS);
    LAS u16* Os = (LAS u16*)(lds + R2_OS); LAS float* red = (LAS float*)(lds + R2_RED); LAS float* rstdv = (LAS float*)(lds + R2_RSTD);
#define RBAR() asm volatile("s_waitcnt lgkmcnt(0)\n\ts_barrier" ::: "memory")
    const float lg2 = __log2f(1.f - __builtin_amdgcn_exp2f(-5.f - (float)h));
    const int rq = tid >> 4, cq = tid & 15;
    const int rv = tid >> 5, cv = tid & 31;
    const u16* gq = RQK + (rowbase + rq) * 1024 + h * 128 + cq * 8;
    const size_t voff = (rowbase + rv) * 1024 + h * 256 + cv * 8;
    u32x4 pq[2], pk[2], pv[4], pgc[4];
#define RLOAD(c) do { const size_t co_ = (size_t)(c) * 64 * 1024; \
        _Pragma("unroll") for (int i_ = 0; i_ < 2; ++i_) { pq[i_] = *(const u32x4*)(gq + co_ + (size_t)i_ * 32 * 1024); pk[i_] = *(const u32x4*)(gq + co_ + (size_t)i_ * 32 * 1024 + 512); } \
        _Pragma("unroll") for (int i_ = 0; i_ < 4; ++i_) { pv[i_] = *(const u32x4*)(RV + voff + co_ + (size_t)i_ * 16 * 1024); } } while (0)
#define GLOAD(c) do { const size_t co_ = (size_t)(c) * 64 * 1024; _Pragma("unroll") for (int i_ = 0; i_ < 4; ++i_) pgc[i_] = *(const u32x4*)(RG + voff + co_ + (size_t)i_ * 16 * 1024); } while (0)
    const int hb = c16 >> 3;
    const LAS u16* kb0 = KdT + c16 * 72 + ((g ^ hb) << 3); const LAS u16* kb2 = KdT + c16 * 72 + ((g ^ hb ^ 2) << 3);
    f32x4 S[8][2];
#pragma unroll
    for (int kt = 0; kt < 8; ++kt)
#pragma unroll
        for (int nt = 0; nt < 2; ++nt) S[kt][nt] = (f32x4){0.f, 0.f, 0.f, 0.f};
    RLOAD(0);
    asm volatile("s_waitcnt lgkmcnt(0)\n\ts_barrier" ::: "memory");
    const float cd = __builtin_amdgcn_exp2f(lg2 * 64.f);
    for (int c = 0; c < 32; ++c) {
        float lg = lg2, gf = (float)(4 * g), cf = (float)c16, rqf = (float)(63 - rq); int tw = w; asm volatile("" : "+v"(lg), "+v"(gf), "+v"(cf), "+v"(rqf), "+s"(tw));
#pragma unroll
        for (int i = 0; i < 2; ++i) {
            const int r = rq + 32 * i;
            *(LAS u32x4*)(Qs + r * 136 + cq * 8) = pq[i]; *(LAS u32x4*)(Ks + r * 136 + cq * 8) = pk[i];
            const float dec = __builtin_amdgcn_exp2f(lg * (rqf - (float)(32 * i)));
            const int pc = (((r >> 3) ^ (cq & 7)) << 3) | (r & 7);
            const unsigned kw[4] = {pk[i].x, pk[i].y, pk[i].z, pk[i].w};
#pragma unroll
            for (int j = 0; j < 4; ++j) { const unsigned pkd = cvt_pk_bf16(bflo(kw[j]) * dec, bfhi(kw[j]) * dec); KdT[(cq * 8 + 2 * j) * 72 + pc] = (u16)(pkd & 0xffffu); KdT[(cq * 8 + 2 * j + 1) * 72 + pc] = (u16)(pkd >> 16); }
        }
#pragma unroll
        for (int i = 0; i < 4; ++i) {
            const int r = rv + 16 * i; const int pc = (((r >> 3) ^ (cv & 7)) << 3) | (r & 7);
            const unsigned vw[4] = {pv[i].x, pv[i].y, pv[i].z, pv[i].w};
#pragma unroll
            for (int j = 0; j < 4; ++j) { VT[(cv * 8 + 2 * j) * 72 + pc] = (u16)(vw[j] & 0xffffu); VT[(cv * 8 + 2 * j + 1) * 72 + pc] = (u16)(vw[j] >> 16); }
        }
        __builtin_amdgcn_sched_barrier(0);
        RBAR();
#pragma unroll
        for (int t2 = 0; t2 < 2; ++t2) {
            const int tile = tw + 8 * t2, ti = tile >> 2, tj = tile & 3; f32x4 a4 = {0.f, 0.f, 0.f, 0.f}; const float dbase = (gf - cf) + (float)(16 * (ti - tj));
#pragma unroll
            for (int kk = 0; kk < 4; ++kk) {
                const bf16x8 a = *(const LAS bf16x8*)(Qs + (16 * ti + c16) * 136 + 32 * kk + 8 * g), b = *(const LAS bf16x8*)(Ks + (16 * tj + c16) * 136 + 32 * kk + 8 * g);
                a4 = __builtin_amdgcn_mfma_f32_16x16x32_bf16(a, b, a4, 0, 0, 0);
            }
#pragma unroll
            for (int i = 0; i < 4; ++i) { const int ri = 16 * ti + 4 * g + i, cj = 16 * tj + c16;
                const unsigned pkd = cvt_pk_bf16(a4[i] * __builtin_amdgcn_exp2f(lg * __builtin_fabsf(dbase + (float)i)), 0.f); As[ri * 72 + cj] = (u16)(pkd & 0xffffu); }
        }
        f32x4 O[4][2];
#pragma unroll
        for (int tt = 0; tt < 4; ++tt) { O[tt][0] = (f32x4){0.f, 0.f, 0.f, 0.f}; O[tt][1] = (f32x4){0.f, 0.f, 0.f, 0.f}; }
#pragma unroll
        for (int kk = 0; kk < 4; ++kk) {
            bf16x8 sb[2];
#pragma unroll
            for (int nt = 0; nt < 2; ++nt) { u32x4 t; t.x = cvt_pk_bf16(S[2 * kk][nt][0], S[2 * kk][nt][1]); t.y = cvt_pk_bf16(S[2 * kk][nt][2], S[2 * kk][nt][3]);
                t.z = cvt_pk_bf16(S[2 * kk + 1][nt][0], S[2 * kk + 1][nt][1]); t.w = cvt_pk_bf16(S[2 * kk + 1][nt][2], S[2 * kk + 1][nt][3]); sb[nt] = __builtin_bit_cast(bf16x8, t); }
#pragma unroll
            for (int tt = 0; tt < 4; ++tt) {
                const u32x2 lo = *(const LAS u32x2*)(Qs + (16 * tt + c16) * 136 + 32 * kk + 4 * g), hi = *(const LAS u32x2*)(Qs + (16 * tt + c16) * 136 + 32 * kk + 16 + 4 * g);
                u32x4 t; t.x = lo.x; t.y = lo.y; t.z = hi.x; t.w = hi.y; const bf16x8 a = __builtin_bit_cast(bf16x8, t);
                O[tt][0] = __builtin_amdgcn_mfma_f32_16x16x32_bf16(a, sb[0], O[tt][0], 0, 0, 0); O[tt][1] = __builtin_amdgcn_mfma_f32_16x16x32_bf16(a, sb[1], O[tt][1], 0, 0, 0);
            }
            __builtin_amdgcn_sched_barrier(0);
        }
#pragma unroll
        for (int tt = 0; tt < 4; ++tt)
#pragma unroll
            for (int i = 0; i < 4; ++i) { const float dsc = __builtin_amdgcn_exp2f(lg * (gf + (float)(16 * tt + i + 1))); O[tt][0][i] *= dsc; O[tt][1][i] *= dsc; }
        RBAR();
        if (c + 1 < 32) RLOAD(c + 1);
        const int vsw0 = (4 * w + (c16 >> 3)) & 7, vsw1 = (4 * w + 2 + (c16 >> 3)) & 7;
        bf16x8 vb[2][2];
#pragma unroll
        for (int ks = 0; ks < 2; ++ks) { vb[ks][0] = *(const LAS bf16x8*)(VT + (32 * w + c16) * 72 + (((4 * ks + g) ^ vsw0) << 3)); vb[ks][1] = *(const LAS bf16x8*)(VT + (32 * w + 16 + c16) * 72 + (((4 * ks + g) ^ vsw1) << 3)); }
#pragma unroll
        for (int tt = 0; tt < 4; ++tt)
#pragma unroll
            for (int ks = 0; ks < 2; ++ks) {
                const bf16x8 a = *(const LAS bf16x8*)(As + (16 * tt + c16) * 72 + 32 * ks + 8 * g);
                O[tt][0] = __builtin_amdgcn_mfma_f32_16x16x32_bf16(a, vb[ks][0], O[tt][0], 0, 0, 0); O[tt][1] = __builtin_amdgcn_mfma_f32_16x16x32_bf16(a, vb[ks][1], O[tt][1], 0, 0, 0); __builtin_amdgcn_sched_barrier(0);
            }
#pragma unroll
        for (int tt = 0; tt < 4; ++tt)
#pragma unroll
            for (int i = 0; i < 4; ++i) { const int tok = 16 * tt + 4 * g + i;
                float q = O[tt][0][i] * O[tt][0][i] + O[tt][1][i] * O[tt][1][i]; q += __shfl_xor(q, 1); q += __shfl_xor(q, 2); q += __shfl_xor(q, 4); q += __shfl_xor(q, 8);
                if (c16 == 0) red[tok * 8 + w] = q;
#pragma unroll
                for (int nt = 0; nt < 2; ++nt) { const unsigned pkd = cvt_pk_bf16(O[tt][nt][i], 0.f); Os[tok * 264 + 32 * w + 16 * nt + c16] = (u16)(pkd & 0xffffu); } }
        __builtin_amdgcn_sched_barrier(0);
        GLOAD(c);
#pragma unroll
        for (int kt = 0; kt < 8; ++kt) { S[kt][0] = S[kt][0] * cd; S[kt][1] = S[kt][1] * cd; }
#pragma unroll
        for (int ks = 0; ks < 2; ++ks)
#pragma unroll
            for (int kt = 0; kt < 8; ++kt) { const bf16x8 a = *(const LAS bf16x8*)(((kt & 1) ? kb2 : kb0) + 16 * kt * 72 + (((4 * ks) ^ ((kt & 2) ? 4 : 0)) << 3));
                S[kt][0] = __builtin_amdgcn_mfma_f32_16x16x32_bf16(a, vb[ks][0], S[kt][0], 0, 0, 0); S[kt][1] = __builtin_amdgcn_mfma_f32_16x16x32_bf16(a, vb[ks][1], S[kt][1], 0, 0, 0); if (kt & 1) __builtin_amdgcn_sched_barrier(0); }
        RBAR();
#pragma unroll
        for (int i = 0; i < 4; ++i) {
            const int tok = rv + 16 * i; const f32x4 p0 = *(const LAS f32x4*)(red + tok * 8), p1 = *(const LAS f32x4*)(red + tok * 8 + 4);
            const float rsd = rsqrtf((((p0[0] + p0[1]) + (p0[2] + p0[3])) + ((p1[0] + p1[1]) + (p1[2] + p1[3]))) * (1.f / 256.f) + 1e-6f);
            const u32x4 o = *(const LAS u32x4*)(Os + tok * 264 + cv * 8); const u32x4 gt = pgc[i]; u32x4 r;
            r.x = cvt_pk_bf16(bflo(o.x) * rsd * bflo(gt.x), bfhi(o.x) * rsd * bfhi(gt.x)); r.y = cvt_pk_bf16(bflo(o.y) * rsd * bflo(gt.y), bfhi(o.y) * rsd * bfhi(gt.y));
            r.z = cvt_pk_bf16(bflo(o.z) * rsd * bflo(gt.z), bfhi(o.z) * rsd * bfhi(gt.z)); r.w = cvt_pk_bf16(bflo(o.w) * rsd * bflo(gt.w), bfhi(o.w) * rsd * bfhi(gt.w));
            *(u32x4*)(RV + voff + (size_t)c * 64 * 1024 + (size_t)i * 16 * 1024) = r;
        }
    }
#pragma unroll
    for (int kt = 0; kt < 8; ++kt)
#pragma unroll
        for (int nt = 0; nt < 2; ++nt)
#pragma unroll
            for (int i = 0; i < 4; ++i) sout[(size_t)(16 * kt + 4 * g + i) * 256 + 32 * w + 16 * nt + c16] = S[kt][nt][i];
    __syncthreads();
#undef RBAR
#undef RLOAD
#undef GLOAD
}
constexpr int F2_BIAS = 0, F2_WS = 16512, F2_AW = 16640, F2_P = 17408, F2_M = 50176, F2_L = 50688, F2_ACC = 51200, F2_END = 83968;
__device__ __forceinline__ void fox_sample_item2(LAS unsigned char* lds, int b, int h, u16* FQ, const u16* FK, const u16* FV, const float* ck, const float* cv, const float* clf, const float* lfnew) {
    int tid = threadIdx.x; asm volatile("" : "+v"(tid));
    const int lane = tid & 63, w = __builtin_amdgcn_readfirstlane(tid >> 6), g = lane >> 4, c16 = lane & 15;
    LAS float* BIAS = (LAS float*)(lds + F2_BIAS); LAS float* WS = (LAS float*)(lds + F2_WS); LAS float* Aw = (LAS float*)(lds + F2_AW) + w * 16;
    LAS float* Pw = (LAS float*)(lds + F2_P) + w * 1024; LAS float* Mx = (LAS float*)(lds + F2_M); LAS float* Lx = (LAS float*)(lds + F2_L); LAS float* ACC = (LAS float*)(lds + F2_ACC);
    const size_t srow = (size_t)MP + (size_t)b * 16;
    __syncthreads();
    bf16x8 qa[2];
#pragma unroll
    for (int ks = 0; ks < 2; ++ks) qa[ks] = *(const bf16x8*)(FQ + (srow + c16) * 512 + h * 64 + 32 * ks + 8 * g);
    {
        float v[8]; float run = 0.f;
#pragma unroll
        for (int j = 0; j < 8; ++j) { run += clf[((size_t)b * PAST + 8 * tid + j) * 8 + h]; v[j] = run; }
        float tot = run;
#pragma unroll
        for (int o = 1; o < 64; o <<= 1) { const float u = __shfl_up(tot, o); if (lane >= o) tot += u; }
        if (lane == 63) WS[w] = tot;
        __syncthreads();
        float base = tot - run, all = 0.f;
#pragma unroll
        for (int ww = 0; ww < 8; ++ww) { const float x = WS[ww]; all += x; if (ww < w) base += x; }
#pragma unroll
        for (int j = 0; j < 8; ++j) BIAS[8 * tid + j] = (all - (base + v[j])) * L2E;
        if (tid == 0) { float cn = 0.f; for (int t = 0; t < 16; ++t) { cn += lfnew[((size_t)b * 16 + t) * 8 + h]; BIAS[PAST + t] = -cn * L2E; } }
    }
    __syncthreads();
    float mrun[4], lrun[4]; f32x4 acc[16];
    const int rr = lane >> 4, cc = lane & 15;
#pragma unroll
    for (int i = 0; i < 4; ++i) { mrun[i] = -INFINITY; lrun[i] = 0.f; }
#pragma unroll
    for (int t = 0; t < 16; ++t) acc[t] = (f32x4){0.f, 0.f, 0.f, 0.f};
    const int niter = (w == 0) ? 9 : 8;
    for (int it = 0; it < niter; ++it) {
        const bool isnew = it == 8;
        const int key0 = isnew ? 0 : 512 * w + 64 * it;
        f32x4 s[4]; f32x4 vv[16];
        if (!isnew) {
            f32x4 kf[4][2][2];
#pragma unroll
            for (int t = 0; t < 4; ++t) { const f32x4* kp = (const f32x4*)(ck + (((size_t)b * PAST + key0 + 16 * t + c16) * 8 + h) * 64 + 8 * g);
#pragma unroll
                for (int ks = 0; ks < 2; ++ks) { kf[t][ks][0] = kp[8 * ks]; kf[t][ks][1] = kp[8 * ks + 1]; } }
#pragma unroll
            for (int t = 0; t < 4; ++t) { f32x4 a4 = {0.f, 0.f, 0.f, 0.f};
#pragma unroll
                for (int ks = 0; ks < 2; ++ks) { u32x4 kb; kb.x = cvt_pk_bf16(kf[t][ks][0][0], kf[t][ks][0][1]); kb.y = cvt_pk_bf16(kf[t][ks][0][2], kf[t][ks][0][3]); kb.z = cvt_pk_bf16(kf[t][ks][1][0], kf[t][ks][1][1]); kb.w = cvt_pk_bf16(kf[t][ks][1][2], kf[t][ks][1][3]);
                    a4 = __builtin_amdgcn_mfma_f32_16x16x32_bf16(qa[ks], __builtin_bit_cast(bf16x8, kb), a4, 0, 0, 0); }
                const float bl = BIAS[key0 + 16 * t + c16];
                s[t] = a4 + bl; }
            { const f32x4* vp = (const f32x4*)(cv + (((size_t)b * PAST + key0 + rr) * 8 + h) * 64 + 4 * cc);
#pragma unroll
              for (int j = 0; j < 16; ++j) vv[j] = vp[(size_t)j * 4 * 128]; }
        } else {
            f32x4 a4 = {0.f, 0.f, 0.f, 0.f};
#pragma unroll
            for (int ks = 0; ks < 2; ++ks) { const bf16x8 kb = *(const bf16x8*)(FK + (srow + c16) * 512 + h * 64 + 32 * ks + 8 * g); a4 = __builtin_amdgcn_mfma_f32_16x16x32_bf16(qa[ks], kb, a4, 0, 0, 0); }
            const float bl = BIAS[PAST + c16];
#pragma unroll
            for (int i = 0; i < 4; ++i) s[0][i] = (c16 > 4 * g + i) ? -INFINITY : a4[i] + bl;
#pragma unroll
            for (int t = 1; t < 4; ++t) s[t] = (f32x4){-INFINITY, -INFINITY, -INFINITY, -INFINITY};
#pragma unroll
            for (int j = 0; j < 16; ++j) { if (j < 4) { const u32x2 x = *(const u32x2*)(FV + (srow + 4 * j + rr) * 512 + h * 64 + 4 * cc); vv[j] = (f32x4){bflo(x.x), bfhi(x.x), bflo(x.y), bfhi(x.y)}; } else vv[j] = (f32x4){0.f, 0.f, 0.f, 0.f}; }
        }
#pragma unroll
        for (int i = 0; i < 4; ++i) {
            float tm = fmaxf(fmaxf(s[0][i], s[1][i]), fmaxf(s[2][i], s[3][i]));
            tm = fmaxf(tm, __shfl_xor(tm, 1)); tm = fmaxf(tm, __shfl_xor(tm, 2)); tm = fmaxf(tm, __shfl_xor(tm, 4)); tm = fmaxf(tm, __shfl_xor(tm, 8));
            const float mn = fmaxf(mrun[i], tm), al = __builtin_amdgcn_exp2f(mrun[i] - mn);
            float ps = 0.f;
#pragma unroll
            for (int t = 0; t < 4; ++t) { const float p = __builtin_amdgcn_exp2f(s[t][i] - mn); s[t][i] = p; ps += p; }
            lrun[i] = lrun[i] * al + ps; mrun[i] = mn;
            if (c16 == 0) Aw[4 * g + i] = al;
        }
#pragma unroll
        for (int t = 0; t < 4; ++t) *(LAS f32x4*)(Pw + (16 * t + c16) * 16 + 4 * g) = s[t];
        asm volatile("s_waitcnt lgkmcnt(0)" ::: "memory"); __builtin_amdgcn_wave_barrier();
#pragma unroll
        for (int j = 0; j < 4; ++j) { const f32x4 al = *(const LAS f32x4*)(Aw + 4 * j); acc[4 * j] *= al[0]; acc[4 * j + 1] *= al[1]; acc[4 * j + 2] *= al[2]; acc[4 * j + 3] *= al[3]; }
        __builtin_amdgcn_sched_barrier(0);
#pragma unroll
        for (int j = 0; j < 16; ++j) {
            if (!isnew || j < 4) {
#pragma unroll
                for (int i = 0; i < 4; ++i) { const f32x4 p = *(const LAS f32x4*)(Pw + (4 * j + rr) * 16 + 4 * i);
                    acc[4 * i] += vv[j] * p[0]; acc[4 * i + 1] += vv[j] * p[1]; acc[4 * i + 2] += vv[j] * p[2]; acc[4 * i + 3] += vv[j] * p[3]; }
            }
            __builtin_amdgcn_sched_barrier(0);
        }
        asm volatile("s_waitcnt lgkmcnt(0)" ::: "memory"); __builtin_amdgcn_wave_barrier();
    }
#pragma unroll
    for (int i = 0; i < 4; ++i) { float l = lrun[i]; l += __shfl_xor(l, 1); l += __shfl_xor(l, 2); l += __shfl_xor(l, 4); l += __shfl_xor(l, 8); if (c16 == 0) { Mx[w * 16 + 4 * g + i] = mrun[i]; Lx[w * 16 + 4 * g + i] = l; } }
#pragma unroll
    for (int t = 0; t < 16; ++t) { f32x4 a = acc[t];
#pragma unroll
        for (int e = 0; e < 4; ++e) { a[e] += __shfl_xor(a[e], 16); a[e] += __shfl_xor(a[e], 32); }
        if (rr == 0) *(LAS f32x4*)(ACC + (w * 16 + t) * 64 + 4 * cc) = a; }
    __syncthreads();
    for (int e = tid; e < 1024; e += 512) {
        const int t = e >> 6, d = e & 63; float mm = -INFINITY;
#pragma unroll
        for (int ww = 0; ww < 8; ++ww) mm = fmaxf(mm, Mx[ww * 16 + t]);
        float num = 0.f, den = 0.f;
#pragma unroll
        for (int ww = 0; ww < 8; ++ww) { const float f = __builtin_amdgcn_exp2f(Mx[ww * 16 + t] - mm); num += ACC[(ww * 16 + t) * 64 + d] * f; den += Lx[ww * 16 + t] * f; }
        const unsigned pk = cvt_pk_bf16(num / den, 0.f); FQ[(srow + t) * 512 + h * 64 + d] = (u16)(pk & 0xffffu);
    }
    __syncthreads();
}
constexpr int F_Q = 0, F_BIAS = 4096, F_WS = 20736, F_P = 24576, F_M = 57344, F_L = 57856, F_ACC = 58368, F_END = 91136;
__device__ __forceinline__ void fox_sample_item(LAS unsigned char* lds, int b, int h, u16* FQ, const u16* FK, const u16* FV, const float* ck, const float* cv, const float* clf, const float* lfnew) {
    int tid = threadIdx.x; asm volatile("" : "+v"(tid)); const int lane = tid & 63, w = __builtin_amdgcn_readfirstlane(tid >> 6);
    LAS float* QF = (LAS float*)(lds + F_Q); LAS float* BIAS = (LAS float*)(lds + F_BIAS); LAS float* WS = (LAS float*)(lds + F_WS);
    LAS float* Pw = (LAS float*)(lds + F_P) + w * 1024; LAS float* Mx = (LAS float*)(lds + F_M); LAS float* Lx = (LAS float*)(lds + F_L); LAS float* ACC = (LAS float*)(lds + F_ACC);
    const size_t srow = (size_t)MP + (size_t)b * 16;
    __syncthreads();
    for (int e = tid; e < 1024; e += 512) QF[e] = bf2f(FQ[(srow + (e >> 6)) * 512 + h * 64 + (e & 63)]);
    {
        float v[8]; float run = 0.f;
#pragma unroll
        for (int j = 0; j < 8; ++j) { run += clf[((size_t)b * PAST + 8 * tid + j) * 8 + h]; v[j] = run; }
        float tot = run;
#pragma unroll
        for (int o = 1; o < 64; o <<= 1) { const float u = __shfl_up(tot, o); if (lane >= o) tot += u; }
        if (lane == 63) WS[w] = tot;
        __syncthreads();
        float base = tot - run, all = 0.f;
#pragma unroll
        for (int ww = 0; ww < 8; ++ww) { const float x = WS[ww]; all += x; if (ww < w) base += x; }
#pragma unroll
        for (int j = 0; j < 8; ++j) BIAS[8 * tid + j] = (all - (base + v[j])) * L2E;
        if (tid == 0) { float cn = 0.f; for (int t = 0; t < 16; ++t) { cn += lfnew[((size_t)b * 16 + t) * 8 + h]; BIAS[PAST + t] = -cn * L2E; } }
    }
    __syncthreads();
    float mrun[16], lrun[16], acc[16];
#pragma unroll
    for (int t = 0; t < 16; ++t) { mrun[t] = -INFINITY; lrun[t] = 0.f; acc[t] = 0.f; }
    const int ntile = (w == 0) ? 9 : 8;
    for (int tile = 0; tile < ntile; ++tile) {
        const bool isnew = tile == 8;
        const int key0 = isnew ? 0 : 512 * w + 64 * tile;
        float s[16];
        {
            f32x4 k[16];
            if (!isnew) { const f32x4* kp = (const f32x4*)(ck + (((size_t)b * PAST + key0 + lane) * 8 + h) * 64);
#pragma unroll
                for (int i = 0; i < 16; ++i) k[i] = kp[i];
            } else { const u32x4* kp = (const u32x4*)(FK + (srow + (lane & 15)) * 512 + h * 64);
#pragma unroll
                for (int i = 0; i < 8; ++i) { const u32x4 x = kp[i]; k[2 * i] = (f32x4){bflo(x.x), bfhi(x.x), bflo(x.y), bfhi(x.y)}; k[2 * i + 1] = (f32x4){bflo(x.z), bfhi(x.z), bflo(x.w), bfhi(x.w)}; } }
            const float bias = isnew ? BIAS[PAST + (lane & 15)] : BIAS[key0 + lane];
#pragma unroll
            for (int t = 0; t < 16; ++t) { float a = 0.f;
#pragma unroll
                for (int i = 0; i < 16; ++i) { const f32x4 q = *(const LAS f32x4*)(QF + t * 64 + 4 * i); a += (q[0] * k[i][0] + q[1] * k[i][1]) + (q[2] * k[i][2] + q[3] * k[i][3]); }
                a += bias; if (isnew && (lane > t || lane >= 16)) a = -INFINITY; s[t] = a; }
        }
#pragma unroll
        for (int t = 0; t < 16; ++t) {
            const float tm = wave_max(s[t]), mn = fmaxf(mrun[t], tm), al = __builtin_amdgcn_exp2f(mrun[t] - mn), p = __builtin_amdgcn_exp2f(s[t] - mn);
            Pw[lane * 16 + t] = p; acc[t] *= al; lrun[t] = lrun[t] * al + wave_sum(p); mrun[t] = mn;
        }
        asm volatile("s_waitcnt lgkmcnt(0)" ::: "memory"); __builtin_amdgcn_wave_barrier();
        const int nk = isnew ? 16 : 64;
        for (int kk = 0; kk < nk; ++kk) {
            const float v = isnew ? bf2f(FV[(srow + kk) * 512 + h * 64 + lane]) : cv[(((size_t)b * PAST + key0 + kk) * 8 + h) * 64 + lane];
#pragma unroll
            for (int i = 0; i < 4; ++i) { const f32x4 p = *(const LAS f32x4*)(Pw + kk * 16 + 4 * i); acc[4 * i] += p[0] * v; acc[4 * i + 1] += p[1] * v; acc[4 * i + 2] += p[2] * v; acc[4 * i + 3] += p[3] * v; }
        }
        asm volatile("s_waitcnt lgkmcnt(0)" ::: "memory"); __builtin_amdgcn_wave_barrier();
    }
#pragma unroll
    for (int t = 0; t < 16; ++t) { ACC[(w * 16 + t) * 64 + lane] = acc[t]; if (lane == 0) { Mx[w * 16 + t] = mrun[t]; Lx[w * 16 + t] = lrun[t]; } }
    __syncthreads();
    for (int e = tid; e < 1024; e += 512) {
        const int t = e >> 6, d = e & 63; float mm = -INFINITY;
#pragma unroll
        for (int ww = 0; ww < 8; ++ww) mm = fmaxf(mm, Mx[ww * 16 + t]);
        float num = 0.f, den = 0.f;
#pragma unroll
        for (int ww = 0; ww < 8; ++ww) { const float f = __builtin_amdgcn_exp2f(Mx[ww * 16 + t] - mm); num += ACC[(ww * 16 + t) * 64 + d] * f; den += Lx[ww * 16 + t] * f; }
        const unsigned pk = cvt_pk_bf16(num / den, 0.f); FQ[(srow + t) * 512 + h * 64 + d] = (u16)(pk & 0xffffu);
    }
    __syncthreads();
}

struct Args { const float* in[25]; float* out; unsigned char* ws; };
constexpr int P4_RET = 128, P4_FS = 128, P4_FP = 2048, P4_RS = 64, P4_ITEMS = P4_RET + P4_FS + P4_FP + P4_RS;

__device__ __forceinline__ unsigned char* kern_ptr(int k) {
    const __attribute__((address_space(4))) char* p = (const __attribute__((address_space(4))) char*)__builtin_amdgcn_kernarg_segment_ptr();
    asm volatile("" : "+s"(p));
    return *(unsigned char* const __attribute__((address_space(4)))*)(p + 8 * k);
}
__global__ void __launch_bounds__(512, 2) fwd(Args a) {
    extern __shared__ __attribute__((aligned(16))) unsigned char lds_raw[];
    LAS unsigned char* lds = (LAS unsigned char*)lds_raw;
    cg::grid_group grid = cg::this_grid();
    const int tid = threadIdx.x, lane = tid & 63, wave = __builtin_amdgcn_readfirstlane(tid >> 6);
    const int G = gridDim.x, bx = blockIdx.x;
#define WSB() kern_ptr(26)
#define OUTB() ((float*)kern_ptr(25))
#define INP(k) ((const float*)kern_ptr(k))
#define P16(off) ((u16*)(WSB() + (off)))
#define PF32(off) ((float*)(WSB() + (off)))
    unsigned* ctl = (unsigned*)(WSB() + O_CTL);
    LAS unsigned* misc = (LAS unsigned*)(lds + LDS_BYTES - 128);
    if (tid < 32) misc[tid] = 0u;
    __syncthreads();
    const xb::XcdBarrier bar = xb::xcd_barrier_post(ctl + 4096, (volatile XLAS unsigned*)(misc + 8));
#ifdef PROBE_PH
    unsigned long long pr_t0 = __builtin_amdgcn_s_memrealtime(), pr_acc = 0; int pr_n = 0;
#define GSYNC() do { xb::xcd_barrier(bar); if (pr_n == PROBE_PH) pr_acc = __builtin_amdgcn_s_memrealtime() - pr_t0; ++pr_n; pr_t0 = __builtin_amdgcn_s_memrealtime(); } while (0)
#else
#define GSYNC() xb::xcd_barrier(bar)
#endif

#ifndef PHM
#define PHM 0xffff
#endif
#define PH(k) if constexpr (((PHM)>>(k))&1)
    PH(0) {
        LAS float* scr = (LAS float*)(lds + wave * 16384);
        const int gw = bx * 8 + wave, NGW = G * 8;
        constexpr int I0 = 16 * 176, I1 = 44 * 32, I2 = 16 * 216, I3 = 16 * 32, I4 = 8 * 32, I5 = 16 * 32, I8 = 4 * 32;
        constexpr int NIT = I0 + I1 + I2 + I3 + I4 + I5 + I0 + I1 + I8 + I3;
        for (int it = gw; it < NIT; it += NGW) {
            int r = it;
            if (r < I0) { transpose_item(INP(9), INP(8), 1024, 5632, 1, P16(O_W1IN), 176, scr, r, lane); continue; } r -= I0;
            if (r < I1) { transpose_item(INP(10), nullptr, 2816, 1024, 0, P16(O_W1OUT), 32, scr, r, lane); continue; } r -= I1;
            if (r < I2) { transpose_item(INP(12), INP(11), 1024, 6664, 2, P16(O_WMIX), 216, scr, r, lane); continue; } r -= I2;
            if (r < I3) { transpose_item(INP(16), nullptr, 1024, 1024, 0, P16(O_WBR), 32, scr, r, lane); continue; } r -= I3;
            if (r < I4) { transpose_item(INP(17), nullptr, 512, 1024, 0, P16(O_WBF), 32, scr, r, lane); continue; } r -= I4;
            if (r < I5) { transpose_item(INP(18), nullptr, 1024, 1024, 0, P16(O_WOUT), 32, scr, r, lane); continue; } r -= I5;
            if (r < I0) { transpose_item(INP(20), INP(19), 1024, 5632, 1, P16(O_W2IN), 176, scr, r, lane); continue; } r -= I0;
            if (r < I1) { transpose_item(INP(21), nullptr, 2816, 1024, 0, P16(O_W2OUT), 32, scr, r, lane); continue; } r -= I1;
            if (r < I8) { transpose_item(INP(23), nullptr, 256, 1024, 0, P16(O_WPLE), 32, scr, r, lane); continue; } r -= I8;
            transpose_item(INP(24), INP(22), 1024, 1024, 0, P16(O_WPG), 32, scr, r, lane);
        }
        for (int rb = gw * 4; rb < MT; rb += NGW * 4) {
            f32x4 v[4][4]; float s[4];
#pragma unroll
            for (int r = 0; r < 4; ++r) { const int row = rb + r; const f32x4* xr = (const f32x4*)(row < MP ? INP(0) + (size_t)row * 1024 : INP(1) + (size_t)(row - MP) * 1024) + lane;
#pragma unroll
                for (int j = 0; j < 4; ++j) v[r][j] = xr[64 * j]; }
#pragma unroll
            for (int r = 0; r < 4; ++r) { float q = 0.f;
#pragma unroll
                for (int j = 0; j < 4; ++j) q += (v[r][j][0] * v[r][j][0] + v[r][j][1] * v[r][j][1]) + (v[r][j][2] * v[r][j][2] + v[r][j][3] * v[r][j][3]);
                s[r] = wave_sum(q);
                u32x2* o = (u32x2*)(P16(O_XB) + (size_t)(rb + r) * 1024) + lane;
#pragma unroll
                for (int j = 0; j < 4; ++j) { u32x2 w; w.x = cvt_pk_bf16(v[r][j][0], v[r][j][1]); w.y = cvt_pk_bf16(v[r][j][2], v[r][j][3]); o[64 * j] = w; } }
            { const int r = lane >> 4, c = lane & 15; const float sv = r == 0 ? s[0] : (r == 1 ? s[1] : (r == 2 ? s[2] : s[3])); PF32(O_SS)[(size_t)(rb + r) * 16 + c] = c == 0 ? sv : 0.f; }
        }
        for (int i = bx * 512 + tid; i < NPOS * 64; i += G * 512) {
            const int pi = i >> 6, f = i & 63; const float pos = pi < SEQ ? (float)pi : (float)(PAST + pi - SEQ);
            const float freq = __builtin_amdgcn_exp2f(-(float)f * (13.287712379549449f / 64.f)); const float ang = pos * freq;
            double rev = (double)ang * 0.15915494309189535; rev -= floor(rev); const float rf = (float)rev;
            PF32(O_TABC)[i] = __builtin_amdgcn_cosf(rf); PF32(O_TABS)[i] = __builtin_amdgcn_sinf(rf);
        }
    }
    if (gridDim.x == 0x7fffffffu) grid.sync();
    GSYNC();
    PH(1) { pg8::Gemm g{P16(O_XB), P16(O_W1IN), MT, 5632, 1024}; pg8::StaticOrder S; S.init(MT, 5632, G, bx); EpiSwiglu E{P16(O_ACT1), PF32(O_SS)};
      pg8::gemm_phase<EpiSwiglu, pg8::StaticOrder, true, true>(lds, g, S, E); }
    GSYNC();
    PH(2) { const FResid f{P16(O_XB), PF32(O_SS), 0.5f};
      small_gemm<FResid>(lds, P16(O_ACT1) + (size_t)MP * DFF, P16(O_W1OUT), DFF, f, bx, G);
      pg8::Gemm g{P16(O_ACT1), P16(O_W1OUT), MP, 1024, DFF}; pg8::StaticOrder S; S.init(MP, 1024, G, bx); const EpiWrap<FResid> E{f};
      pg8::gemm_phase<EpiWrap<FResid>, pg8::StaticOrder, true, true>(lds, g, S, E); }
    GSYNC();
    PH(3) { pg8::Gemm g{P16(O_XB), P16(O_WMIX), MT, NMIX, 1024}; pg8::StaticOrder S; S.init(MT, NMIX, G, bx);
      EpiMix E{PF32(O_SS), PF32(O_TABC), PF32(O_TABS), INP(14), INP(15), INP(13), P16(O_RQK), P16(O_RV), P16(O_RG), P16(O_FQ), P16(O_FK), P16(O_FV), P16(O_ZG), OUTB(), OUTB() + OUT_YP};
      pg8::gemm_phase<EpiMix, pg8::StaticOrder, true, true>(lds, g, S, E); }
    GSYNC();
    {
        LAS unsigned* slot = misc;
        float dbound;
        { float gq_ = __builtin_fabsf(INP(14)[lane]), gk_ = __builtin_fabsf(INP(15)[lane]);
#pragma unroll
          for (int o_ = 1; o_ < 64; o_ <<= 1) { gq_ = fmaxf(gq_, __shfl_xor(gq_, o_)); gk_ = fmaxf(gk_, __shfl_xor(gk_, o_)); }
          dbound = gq_ * gk_ * (64.f * 0.125f * L2E * 1.02f) + 1.f; if (tid == 0) misc[2] = __float_as_uint(dbound); }
        for (;;) {
            __syncthreads();
            if (tid == 0) slot[0] = atomicAdd(ctl, 1u);
            __syncthreads();
            const int it = (int)slot[0];
            if (it >= P4_ITEMS) break;
#ifdef PROBE_ITEM
            const unsigned long long pi_t0 = __builtin_amdgcn_s_memrealtime();
#endif
            if (it < P4_RET) { const int b = it >> 2, h = it & 3;
                PH(10) ret_prompt_item(lds, P16(O_RQK), P16(O_RV), P16(O_RG), OUTB() + OUT_RSP + (size_t)(b * 4 + h) * 32768, (size_t)b * SEQ, h);
            } else if (it < P4_RET + P4_FS) { const int j = it - P4_RET, b = j >> 3, h = j & 7;
                PH(11) fox_sample_item2(lds, b, h, P16(O_FQ), P16(O_FK), P16(O_FV), INP(5), INP(6), INP(7), OUTB() + OUT_LS);
            } else if (it < P4_RET + P4_FS + P4_FP) { const int j = it - P4_RET - P4_FS, qb = 7 - (j >> 8), bh = j & 255;
                PH(12) attn_body::attn_unit<8>(bh >> 3, bh & 7, qb, (const attn_body::bf16*)P16(O_FQ), (const attn_body::bf16*)P16(O_FK), (const attn_body::bf16*)P16(O_FV), (attn_body::bf16*)P16(O_FQ), OUTB() + OUT_YP, __uint_as_float(misc[2]), (char*)lds_raw);
            } else { const int j = it - P4_RET - P4_FS - P4_FP, b = j >> 2, h = j & 3;
                PH(13) ret_item<16>(lds, P16(O_RQK), P16(O_RV), P16(O_RG), INP(4) + (size_t)(b * 4 + h) * 32768, OUTB() + OUT_RSS + (size_t)(b * 4 + h) * 32768, (size_t)MP + (size_t)b * 16, 1, h);
            }
#ifdef PROBE_ITEM
            { const int kind = it < P4_RET ? 0 : (it < P4_RET + P4_FS ? 1 : (it < P4_RET + P4_FS + P4_FP ? 2 : 3));
              if (kind == PROBE_ITEM && tid == 0) atomicMax(ctl + 16, (unsigned)(__builtin_amdgcn_s_memrealtime() - pi_t0)); }
#endif
        }
    }
    GSYNC();
    {
        for (size_t i = (size_t)bx * 512 + tid; i < (size_t)MT * 32; i += (size_t)G * 512) {
            const size_t e8 = i * 8; const float* src = e8 < (size_t)MP * 256 ? INP(2) + e8 : INP(3) + (e8 - (size_t)MP * 256);
            const f32x4 v0 = *(const f32x4*)src, v1 = *(const f32x4*)(src + 4);
            u32x4 w; w.x = cvt_pk_bf16(v0[0], v0[1]); w.y = cvt_pk_bf16(v0[2], v0[3]); w.z = cvt_pk_bf16(v1[0], v1[1]); w.w = cvt_pk_bf16(v1[2], v1[3]);
            *(u32x4*)(P16(O_FV) + e8) = w;
        }
        PH(5) { const FGate<false> f0{P16(O_RG), P16(O_ZG), nullptr}; const FGate<true> f1{P16(O_RG), P16(O_ZG), nullptr};
          small_gemm<FGate<false>>(lds, P16(O_RV) + (size_t)MP * 1024, P16(O_WBR), 1024, f0, bx, G);
          small_gemm<FGate<true>>(lds, P16(O_FQ) + (size_t)MP * 512, P16(O_WBF), 512, f1, bx, G);
          { pg8::Gemm g{P16(O_RV), P16(O_WBR), MP, 1024, 1024}; pg8::StaticOrder S; S.init(MP, 1024, G, bx); const EpiWrap<FGate<false>> E{f0};
            pg8::gemm_phase<EpiWrap<FGate<false>>, pg8::StaticOrder, true, true>(lds, g, S, E); }
          { pg8::Gemm g{P16(O_FQ), P16(O_WBF), MP, 1024, 512}; pg8::StaticOrder S; S.init(MP, 1024, G, bx); const EpiWrap<FGate<true>> E{f1};
            pg8::gemm_phase<EpiWrap<FGate<true>>, pg8::StaticOrder, true, true>(lds, g, S, E); } }
    }
    GSYNC();
    PH(6) { const FResid f{P16(O_XB), PF32(O_SS), 1.0f};
      small_gemm<FResid>(lds, P16(O_RG) + (size_t)MP * 1024, P16(O_WOUT), 1024, f, bx, G);
      pg8::Gemm g{P16(O_RG), P16(O_WOUT), MP, 1024, 1024}; pg8::StaticOrder S; S.init(MP, 1024, G, bx); const EpiWrap<FResid> E{f};
      pg8::gemm_phase<EpiWrap<FResid>, pg8::StaticOrder, true, true>(lds, g, S, E); }
    GSYNC();
    PH(7) { pg8::Gemm g{P16(O_XB), P16(O_W2IN), MT, 5632, 1024}; pg8::StaticOrder S; S.init(MT, 5632, G, bx); EpiSwiglu E{P16(O_ACT2), PF32(O_SS)};
      pg8::gemm_phase<EpiSwiglu, pg8::StaticOrder, true, true>(lds, g, S, E); }
    GSYNC();
    PH(8) { const FResid f{P16(O_XB), PF32(O_SS), 0.5f}; const FPlain fp{P16(O_RQK), nullptr};
      small_gemm<FResid>(lds, P16(O_ACT2) + (size_t)MP * DFF, P16(O_W2OUT), DFF, f, bx, G);
      small_gemm<FPlain>(lds, P16(O_FV) + (size_t)MP * 256, P16(O_WPLE), 256, fp, bx, G);
      { pg8::Gemm g{P16(O_ACT2), P16(O_W2OUT), MP, 1024, DFF}; pg8::StaticOrder S; S.init(MP, 1024, G, bx); const EpiWrap<FResid> E{f};
        pg8::gemm_phase<EpiWrap<FResid>, pg8::StaticOrder, true, true>(lds, g, S, E); }
      { pg8::Gemm g{P16(O_FV), P16(O_WPLE), MP, 1024, 256}; pg8::StaticOrder S; S.init(MP, 1024, G, bx); const EpiWrap<FPlain> E{fp};
        pg8::gemm_phase<EpiWrap<FPlain>, pg8::StaticOrder, true, true>(lds, g, S, E); } }
    GSYNC();
    PH(9) { const FFinal f{OUTB() + OUT_YP, OUTB() + OUT_YS, P16(O_XB), P16(O_RQK), PF32(O_SS)};
      small_gemm<FFinal>(lds, P16(O_XB) + (size_t)MP * 1024, P16(O_WPG), 1024, f, bx, G);
      pg8::Gemm g{P16(O_XB), P16(O_WPG), MP, 1024, 1024}; pg8::StaticOrder S; S.init(MP, 1024, G, bx); const EpiWrap<FFinal> E{f};
      pg8::gemm_phase<EpiWrap<FFinal>, pg8::StaticOrder, true, true>(lds, g, S, E); }
#ifdef PROBE_ITEM
    GSYNC();
    if (bx == 0) { const unsigned long long t1 = __builtin_amdgcn_s_memrealtime(); const unsigned long long dur = __hip_atomic_load(ctl + 16, __ATOMIC_RELAXED, __HIP_MEMORY_SCOPE_AGENT); while (__builtin_amdgcn_s_memrealtime() - t1 < dur) __builtin_amdgcn_s_sleep(8); }
#endif
#ifdef PROBE_PH
    if (pr_n == PROBE_PH) pr_acc = __builtin_amdgcn_s_memrealtime() - pr_t0;
    if (bx == 0) { const unsigned long long t1 = __builtin_amdgcn_s_memrealtime(); while (__builtin_amdgcn_s_memrealtime() - t1 < pr_acc) __builtin_amdgcn_s_sleep(8); }
#endif
}
}

extern "C" void kernel_launch(void* const* d_in, const int* in_sizes, int n_in, void* d_out, int out_size, void* d_ws, size_t ws_size, hipStream_t stream) {
    static int grid = 0;
    if (grid == 0) {
        if (n_in != 25 || (size_t)out_size != mk::OUT_END || ws_size < mk::WS_NEED) { fprintf(stderr, "kernel_launch: unexpected shapes (n_in %d out %d ws %zu need %zu)\n", n_in, out_size, ws_size, (size_t)mk::WS_NEED); grid = -1; return; }
        int dev = 0, cus = 0, per_cu = 0;
        hipGetDevice(&dev); hipDeviceGetAttribute(&cus, hipDeviceAttributeMultiprocessorCount, dev);
        if (hipFuncSetAttribute((const void*)mk::fwd, hipFuncAttributeMaxDynamicSharedMemorySize, mk::LDS_BYTES) != hipSuccess) { fprintf(stderr, "kernel_launch: hipFuncSetAttribute failed\n"); grid = -1; return; }
        hipOccupancyMaxActiveBlocksPerMultiprocessor(&per_cu, (const void*)mk::fwd, 512, mk::LDS_BYTES);
        if (per_cu < 1) { fprintf(stderr, "kernel_launch: occupancy query says %d blocks per CU\n", per_cu); per_cu = 1; }
        grid = cus;
    }
    if (grid < 0) return;
    if (hipMemsetAsync((char*)d_ws + mk::O_CTL, 0, 65536, stream) != hipSuccess) { fprintf(stderr, "kernel_launch: memset failed\n"); return; }
    mk::Args a{};
    for (int i = 0; i < 25; ++i) a.in[i] = (const float*)d_in[i];
    a.out = (float*)d_out; a.ws = (unsigned char*)d_ws;
    void* args[] = {&a};
    hipError_t e = hipLaunchCooperativeKernel((const void*)mk::fwd, dim3(grid), dim3(512), args, mk::LDS_BYTES, stream);
    if (e != hipSuccess) fprintf(stderr, "cooperative launch failed: %s (grid %d)\n", hipGetErrorString(e), grid);
}
```

```cpp
#include <hip/hip_runtime.h>
#include <hip/hip_cooperative_groups.h>
#include <cstdio>
#include <cstdint>
#include <hip/hip_bf16.h>
#include <cmath>
namespace cg = cooperative_groups;
namespace pg8 {
#define PG8_LAS __attribute__((address_space(3)))
typedef unsigned short bf16_t;
typedef short bf16x8 __attribute__((ext_vector_type(8)));
typedef float f32x4 __attribute__((ext_vector_type(4)));
typedef unsigned u32x4 __attribute__((ext_vector_type(4)));
constexpr int BM = 256, BK = 64, HALF = 128, HTB = HALF * BK * 2  , STAGE_BYTES = 8 * HTB, NXCD = 8, WGM = 4;

__host__ __device__ __forceinline__ int lds_byte(int r, int c) { const int st = (r >> 4) * 2 + (c >> 5), rr = r & 15, cc = c & 31, ob = rr * 64 + cc * 2; return st * 1024 + (ob ^ (((ob >> 9) & 1) << 5)); }
__host__ __device__ __forceinline__ void stage_rc(int b, int& R, int& C) { const int st = b / 1024, sb = b % 1024, swz = sb ^ (((sb >> 9) & 1) << 5); R = (st >> 1) * 16 + swz / 64; C = (st & 1) * 32 + (swz % 64) / 2; }
__host__ __device__ __forceinline__ int perm32(int rho) { const int n = rho >> 4, i = rho & 15; return 8 * (i >> 2) + 4 * n + (i & 3); }

struct Unit { int pm, pn; };
struct Gemm { const bf16_t* A; const bf16_t* Bt; int M, N, K; };

struct StaticOrder {
    int nM, nN, nwg, G, c;
    __host__ __device__ void init(int M, int N, int G_, int c_) { nM = M / BM; nN = N / BM; nwg = nM * nN; G = G_; c = c_; }
    __host__ __device__ bool next(int i, Unit& u) const {
        const long L = (long)i * G + c; if (L >= nwg) return false;
        int wgid = (int)L; { const int q = nwg / NXCD, r = nwg % NXCD, xcd = wgid % NXCD, off = wgid / NXCD; wgid = (xcd < r ? xcd * (q + 1) : r * (q + 1) + (xcd - r) * q) + off; }
        const int nig = WGM * nN, gid = wgid / nig, fm = gid * WGM, gsz = (nM - fm) < WGM ? (nM - fm) : WGM;
        u.pm = fm + ((wgid % nig) % gsz); u.pn = (wgid % nig) / gsz; return true;
    }
    __device__ __forceinline__ void a_ready(const Unit&) const {}
    __device__ __forceinline__ void done(const Unit&) const {}
};

typedef float f32x2c __attribute__((ext_vector_type(2))); typedef __bf16 bf16x2c __attribute__((ext_vector_type(2)));
__device__ __forceinline__ unsigned cvt_pk_bf16(float lo, float hi) { f32x2c v = {lo, hi}; bf16x2c b = __builtin_convertvector(v, bf16x2c); return __builtin_bit_cast(unsigned, b); }
typedef float f32x2 __attribute__((ext_vector_type(2)));
template <class Epi, class Sched, bool ALIGN_EPI = false, bool SP2 = false>
__device__ __forceinline__ void gemm_phase(PG8_LAS unsigned char* lds, const Gemm g, const Sched& S, const Epi& E) {
    int tid = threadIdx.x; asm volatile("" : "+v"(tid)); const int wid = __builtin_amdgcn_readfirstlane(tid >> 6), lane = tid & 63, wr = wid >> 2, wc = wid & 3, fr = lane & 15, fq = lane >> 4;
    const int K = g.K, nt = K / BK;
    unsigned voffA[2], voffB[2];
#pragma unroll
    for (int i = 0; i < 2; ++i) { int R, C; stage_rc(tid * 16 + i * 8192, R, C); const int Rb = Epi::PERM ? ((R & ~31) + perm32(R & 31)) : R;
        voffA[i] = (unsigned)(R * K + C) * 2u; voffB[i] = (unsigned)(Rb * K + C) * 2u; }
    const size_t kstep = (size_t)(BK * 2);
    const size_t hstep = (size_t)HALF * K * 2;
    const size_t tstep = 2 * hstep;
    const unsigned ldsw = (unsigned)wid * 1024u;
    const int aoff = lds_byte(wr * 64 + fr, fq * 8), boff = lds_byte(wc * 32 + fr, fq * 8);
#define PG8_SA(b, h) (((b) * 2 + (h)) * HTB)
#define PG8_SB(b, h) ((4 + (b) * 2 + (h)) * HTB)
#define PG8_STAGE(bufoff, gbase, voff) do { _Pragma("unroll") for (int _i = 0; _i < 2; ++_i) \
        __builtin_amdgcn_global_load_lds((const unsigned*)((const char*)(gbase) + (voff)[_i]), (PG8_LAS unsigned*)(lds + (bufoff) + ldsw + _i * 8192), 16, 0, 0); } while (0)
#define PG8_LDA(dst, b, h) do { _Pragma("unroll") for (int m = 0; m < 4; ++m) _Pragma("unroll") for (int k = 0; k < 2; ++k) dst[m][k] = *(const PG8_LAS bf16x8*)(lds + PG8_SA(b, h) + aoff + m * 2048 + k * 1024); } while (0)
#define PG8_LDB(dst, b, h) do { _Pragma("unroll") for (int n = 0; n < 2; ++n) _Pragma("unroll") for (int k = 0; k < 2; ++k) dst[n][k] = *(const PG8_LAS bf16x8*)(lds + PG8_SB(b, h) + boff + n * 2048 + k * 1024); } while (0)
#define PG8_MMA(ai, bj, At, Bt) do { __builtin_amdgcn_s_setprio(1); _Pragma("unroll") for (int m = 0; m < 4; ++m) _Pragma("unroll") for (int n = 0; n < 2; ++n) _Pragma("unroll") for (int k = 0; k < 2; ++k) \
        acc[ai][bj][m][n] = __builtin_amdgcn_mfma_f32_16x16x32_bf16(Bt[n][k], At[m][k], acc[ai][bj][m][n], 0, 0, 0); __builtin_amdgcn_s_setprio(0); } while (0)
#define PG8_WAIT_V(n) asm volatile("s_waitcnt vmcnt(" #n ")" ::: "memory")
#define PG8_WAIT_L(n) asm volatile("s_waitcnt lgkmcnt(" #n ")" ::: "memory")
#define PG8_BAR __builtin_amdgcn_s_barrier()
#define PG8_SCHED __builtin_amdgcn_sched_barrier(0)
    Unit cur, nxt; int ui = 0;
    if (!S.next(0, cur)) return;
    f32x4 acc[2][2][4][2];
#pragma unroll
    for (int a = 0; a < 2; ++a)
#pragma unroll
        for (int b = 0; b < 2; ++b)
#pragma unroll
            for (int m = 0; m < 4; ++m)
#pragma unroll
                for (int n = 0; n < 2; ++n) acc[a][b][m][n] = (f32x4){0.f, 0.f, 0.f, 0.f};
    bf16x8 At[4][2], B0[2][2], B1[2][2];
    const char* cA = (const char*)g.A + (size_t)cur.pm * tstep; const char* cB = (const char*)g.Bt + (size_t)cur.pn * tstep;
    S.a_ready(cur);
    if constexpr (SP2) {
        PG8_STAGE(PG8_SB(0, 0), cB, voffB); PG8_STAGE(PG8_SB(0, 1), cB + hstep, voffB); PG8_STAGE(PG8_SA(0, 0), cA, voffA); PG8_STAGE(PG8_SA(0, 1), cA + hstep, voffA);
        if (wr == 1) PG8_BAR;
        PG8_WAIT_V(2); PG8_BAR;
        PG8_STAGE(PG8_SB(1, 0), cB + kstep, voffB); PG8_STAGE(PG8_SA(1, 0), cA + kstep, voffA); PG8_STAGE(PG8_SB(1, 1), cB + hstep + kstep, voffB);
        PG8_WAIT_V(6); PG8_BAR;
    } else {
        PG8_STAGE(PG8_SB(0, 0), cB, voffB); PG8_STAGE(PG8_SA(0, 0), cA, voffA); PG8_STAGE(PG8_SB(0, 1), cB + hstep, voffB); PG8_STAGE(PG8_SA(0, 1), cA + hstep, voffA);
        if (wr == 1) PG8_BAR;
        PG8_WAIT_V(4); PG8_BAR;
        PG8_STAGE(PG8_SB(1, 0), cB + kstep, voffB); PG8_STAGE(PG8_SA(1, 0), cA + kstep, voffA); PG8_STAGE(PG8_SB(1, 1), cB + hstep + kstep, voffB);
        PG8_WAIT_V(6); PG8_BAR;
    }
    for (;;) {
        const bool has_next = S.next(ui + 1, nxt);
        const char* nA = has_next ? (const char*)g.A + (size_t)nxt.pm * tstep : cA; const char* nB = has_next ? (const char*)g.Bt + (size_t)nxt.pn * tstep : cB;
        for (int t = 0; t < nt; t += 2) {
            const bool last = (t == nt - 2);
            const char* a1 = cA + (size_t)(t + 1) * kstep;
            const char* a2 = last ? nA : cA + (size_t)(t + 2) * kstep; const char* b2 = last ? nB : cB + (size_t)(t + 2) * kstep;
            const char* a3 = a2 + kstep; const char* b3 = b2 + kstep;
            if (last && has_next) S.a_ready(nxt);
            if constexpr (SP2) {
            PG8_LDB(B0, 0, 0); PG8_LDB(B1, 0, 1); PG8_SCHED; PG8_LDA(At, 0, 0); PG8_STAGE(PG8_SA(1, 1), a1 + hstep, voffA);
            PG8_WAIT_V(8); PG8_WAIT_L(0); PG8_BAR; PG8_MMA(0, 0, At, B0); PG8_MMA(0, 1, At, B1); PG8_BAR; PG8_SCHED;
            PG8_LDA(At, 0, 1); PG8_STAGE(PG8_SB(0, 0), b2, voffB); PG8_STAGE(PG8_SB(0, 1), b2 + hstep, voffB); PG8_STAGE(PG8_SA(0, 0), a2, voffA);
            PG8_WAIT_V(8); PG8_WAIT_L(0); PG8_BAR; PG8_MMA(1, 0, At, B0); PG8_MMA(1, 1, At, B1); PG8_BAR; PG8_SCHED;
            PG8_LDB(B0, 1, 0); PG8_LDB(B1, 1, 1); PG8_SCHED; PG8_LDA(At, 1, 0); PG8_STAGE(PG8_SA(0, 1), a2 + hstep, voffA);
            PG8_WAIT_V(8); PG8_WAIT_L(0); PG8_BAR; PG8_MMA(0, 0, At, B0); PG8_MMA(0, 1, At, B1); PG8_BAR; PG8_SCHED;
            PG8_LDA(At, 1, 1); PG8_STAGE(PG8_SB(1, 0), b3, voffB); PG8_STAGE(PG8_SB(1, 1), b3 + hstep, voffB); PG8_STAGE(PG8_SA(1, 0), a3, voffA);
            PG8_WAIT_V(8); PG8_WAIT_L(0); PG8_BAR; PG8_MMA(1, 0, At, B0); PG8_MMA(1, 1, At, B1); PG8_BAR; PG8_SCHED;
            } else {
            PG8_LDB(B0, 0, 0); PG8_SCHED; PG8_LDA(At, 0, 0); PG8_STAGE(PG8_SA(1, 1), a1 + hstep, voffA);
            PG8_WAIT_L(8); PG8_BAR; PG8_WAIT_L(0); PG8_MMA(0, 0, At, B0); PG8_BAR; PG8_SCHED;
            PG8_LDB(B1, 0, 1); PG8_STAGE(PG8_SB(0, 0), b2, voffB);
            PG8_BAR; PG8_WAIT_L(0); PG8_MMA(0, 1, At, B1); PG8_BAR;
            PG8_LDA(At, 0, 1); PG8_STAGE(PG8_SA(0, 0), a2, voffA);
            PG8_BAR; PG8_WAIT_L(0); PG8_MMA(1, 0, At, B0); PG8_BAR; PG8_SCHED;
            PG8_STAGE(PG8_SB(0, 1), b2 + hstep, voffB);
            PG8_WAIT_V(6); PG8_BAR; PG8_MMA(1, 1, At, B1); PG8_BAR;
            PG8_LDB(B0, 1, 0); PG8_SCHED; PG8_LDA(At, 1, 0); PG8_STAGE(PG8_SA(0, 1), a2 + hstep, voffA);
            PG8_WAIT_L(8); PG8_BAR; PG8_WAIT_L(0); PG8_MMA(0, 0, At, B0); PG8_BAR; PG8_SCHED;
            PG8_LDB(B1, 1, 1); PG8_STAGE(PG8_SB(1, 0), b3, voffB);
            PG8_BAR; PG8_WAIT_L(0); PG8_MMA(0, 1, At, B1); PG8_BAR;
            PG8_LDA(At, 1, 1); PG8_STAGE(PG8_SA(1, 0), a3, voffA);
            PG8_BAR; PG8_WAIT_L(0); PG8_MMA(1, 0, At, B0); PG8_BAR; PG8_SCHED;
            PG8_STAGE(PG8_SB(1, 1), b3 + hstep, voffB);
            PG8_WAIT_V(6); PG8_BAR; PG8_MMA(1, 1, At, B1); PG8_BAR;
            }
        }
        if constexpr (ALIGN_EPI) { if (wr == 0) PG8_BAR; }
        if constexpr (!Epi::AFTER_DRAIN) { E(acc, cur, wr, wc, fr, fq); S.done(cur); }
        if (!has_next) break;
#pragma unroll
        for (int a = 0; a < 2; ++a)
#pragma unroll
            for (int b = 0; b < 2; ++b)
#pragma unroll
                for (int m = 0; m < 4; ++m)
#pragma unroll
                    for (int n = 0; n < 2; ++n) acc[a][b][m][n] = (f32x4){0.f, 0.f, 0.f, 0.f};
        cur = nxt; cA = nA; cB = nB; ++ui;
        if constexpr (ALIGN_EPI) { if (wr == 1) PG8_BAR; }
    }
    PG8_WAIT_V(0);
    if constexpr (!ALIGN_EPI) { if (wr == 0) PG8_BAR; }
    PG8_BAR;
    if constexpr (Epi::AFTER_DRAIN) { E.fused(acc, cur, wr, wc, fr, fq, lds, wid, lane); S.done(cur); }
#undef PG8_SA
#undef PG8_SB
#undef PG8_STAGE
#undef PG8_LDA
#undef PG8_LDB
#undef PG8_MMA
#undef PG8_WAIT_V
#undef PG8_WAIT_L
#undef PG8_BAR
#undef PG8_SCHED
}
}
namespace attn_body {
using bf16=__hip_bfloat16;
using bf16x8=__attribute__((ext_vector_type(8)))short;
using s16x4=__attribute__((ext_vector_type(4)))short;
using f32x16=__attribute__((ext_vector_type(16)))float;
using u32x4=__attribute__((ext_vector_type(4)))unsigned;
using f32x4v=__attribute__((ext_vector_type(4)))float;
constexpr int BATCH=32,NHEAD=8,SEQ=2048,D=64,DM=NHEAD*D;
constexpr int NW=8,QBLK=32,QB=QBLK*NW,KVBLK=64,NQB=SEQ/QB;
constexpr int ATTN_PITCH=DM, ATTN_UNIT_ROWS=QB;
__device__ __forceinline__ int crow(int r,int hi){return (r&3)+8*(r>>2)+4*hi;}
#define SBAR() __builtin_amdgcn_sched_barrier(0)
__device__ __forceinline__ void cmask(f32x16&p0,f32x16&p1,int jb,int qrel,int hi){
  const float NEG=-INFINITY; int kb=64*jb+4*hi;
  #pragma unroll
  for(int r=0;r<16;++r){int kv=kb+(r&3)+8*(r>>2); if(kv>qrel)p0[r]=NEG; if(kv+32>qrel)p1[r]=NEG;}
}

constexpr int NSLOT=3, SLOTB=8192;
constexpr int LDS_K=0, LDS_V=NSLOT*SLOTB, LDS_WS=2*NSLOT*SLOTB, LDS_OST=LDS_WS+NW*64*4, LDS_CB=LDS_OST+NW*4096, LDS_CBX=LDS_CB+2048*4, LDS_AL=LDS_CBX+256, LDS_BYTES=LDS_AL+256;
constexpr float C2=0.125f*1.4426950408889634f;
__device__ __forceinline__ void glds16(const void*gsrc,unsigned lds_dst){unsigned keep;
  asm volatile("s_mov_b32 %0, m0\n\ts_mov_b32 m0, %2\n\ts_nop 0\n\tglobal_load_lds_dwordx4 %1, off\n\ts_mov_b32 m0, %0":"=&s"(keep):"v"(gsrc),"s"(lds_dst):"memory");}
__device__ __forceinline__ float max3f(float a,float b,float c){float r;asm("v_max3_f32 %0, %1, %2, %3":"=v"(r):"v"(a),"v"(b),"v"(c));return r;}
__device__ __forceinline__ float max2f(float a,float b){float r;asm("v_max_f32_e32 %0, %1, %2":"=v"(r):"v"(a),"v"(b));return r;}
__device__ __forceinline__ float fadd_s(float a,float b){float r;asm("v_add_f32_e32 %0, %1, %2":"=v"(r):"v"(a),"v"(b));return r;}
__device__ __forceinline__ float fsub_s(float a,float b){float r;asm("v_sub_f32_e32 %0, %1, %2":"=v"(r):"v"(a),"v"(b));return r;}
typedef float f32x2_t __attribute__((ext_vector_type(2))); typedef __bf16 bf16x2_t __attribute__((ext_vector_type(2)));
__device__ __forceinline__ unsigned cvtpk_s(float lo,float hi){f32x2_t v={lo,hi};bf16x2_t b=__builtin_convertvector(v,bf16x2_t);return __builtin_bit_cast(unsigned,b);}
#define WAIT_BAR(N) asm volatile("s_waitcnt vmcnt(" #N ") lgkmcnt(0)\n\ts_barrier":::"memory")

__device__ __forceinline__ void qkt(f32x16&p0,f32x16&p1,const char*Kslot,const bf16x8*qr,int r32,int hi){ const f32x16 negm=f32x16{};
  const char*kb=Kslot+hi*1024+r32*16;
  #pragma unroll
  for(int d0=0;d0<4;++d0){
    const bf16x8 b0=*reinterpret_cast<const bf16x8*>(kb+d0*2048);
    const bf16x8 b1=*reinterpret_cast<const bf16x8*>(kb+d0*2048+512);
    if(d0==0){p0=__builtin_amdgcn_mfma_f32_32x32x16_bf16(b0,qr[0],negm,0,0,0);p1=__builtin_amdgcn_mfma_f32_32x32x16_bf16(b1,qr[0],negm,0,0,0);}
    else{p0=__builtin_amdgcn_mfma_f32_32x32x16_bf16(b0,qr[d0],p0,0,0,0);p1=__builtin_amdgcn_mfma_f32_32x32x16_bf16(b1,qr[d0],p1,0,0,0);}}
}
typedef __attribute__((address_space(3))) const char* lds_cptr;
typedef short v4i16_t __attribute__((ext_vector_type(4)));
__device__ __forceinline__ void kload8(bf16x8*kf,lds_cptr kp){
  kf[0]=*(const __attribute__((address_space(3))) bf16x8*)(kp);      kf[1]=*(const __attribute__((address_space(3))) bf16x8*)(kp+512);
  kf[2]=*(const __attribute__((address_space(3))) bf16x8*)(kp+2048); kf[3]=*(const __attribute__((address_space(3))) bf16x8*)(kp+2560);
  kf[4]=*(const __attribute__((address_space(3))) bf16x8*)(kp+4096); kf[5]=*(const __attribute__((address_space(3))) bf16x8*)(kp+4608);
  kf[6]=*(const __attribute__((address_space(3))) bf16x8*)(kp+6144); kf[7]=*(const __attribute__((address_space(3))) bf16x8*)(kp+6656);
}
__device__ __forceinline__ void kload2(bf16x8*kf,lds_cptr kp,int j){ kf[2*j]=*(const __attribute__((address_space(3))) bf16x8*)(kp+j*2048); kf[2*j+1]=*(const __attribute__((address_space(3))) bf16x8*)(kp+j*2048+512); }
__device__ __forceinline__ s16x4 vtr(lds_cptr p){ return __builtin_bit_cast(s16x4,__builtin_amdgcn_ds_read_tr16_b64_v4i16((__attribute__((address_space(3))) v4i16_t*)p)); }
__device__ __forceinline__ float rowmax(const f32x16&p0,const f32x16&p1){
  float a=max3f(p0[0],p0[1],p1[0]),b=max3f(p0[2],p0[3],p1[1]);a=max3f(a,p1[2],p1[3]);
  #pragma unroll
  for(int r=4;r<16;r+=4){a=max3f(a,p0[r],p0[r+1]);b=max3f(b,p0[r+2],p0[r+3]);a=max3f(a,p1[r],p1[r+1]);b=max3f(b,p1[r+2],p1[r+3]);}
  const float m=max2f(a,b);
  auto rr=__builtin_amdgcn_permlane32_swap(__float_as_uint(m),__float_as_uint(m),false,false);
  return max2f(__uint_as_float(rr[0]),__uint_as_float(rr[1]));
}
__device__ __forceinline__ void pv(f32x16*o,int vb,bf16x8 pa0,bf16x8 pa1,bf16x8 pa2,bf16x8 pa3){
  #pragma unroll
  for(int d0=0;d0<2;++d0){s16x4 lo[4],hi[4];
    #pragma unroll
    for(int ks=0;ks<4;++ks){
      asm volatile("ds_read_b64_tr_b16 %0,%1 offset:%c2":"=&v"(lo[ks]):"v"(vb),"i"(d0*4096+ks*1024):"memory");
      asm volatile("ds_read_b64_tr_b16 %0,%1 offset:%c2":"=&v"(hi[ks]):"v"(vb),"i"(d0*4096+ks*1024+512):"memory");}
    asm volatile("s_waitcnt lgkmcnt(0)":::"memory");SBAR();
    #define PK(k) (bf16x8){lo[k][0],lo[k][1],lo[k][2],lo[k][3],hi[k][0],hi[k][1],hi[k][2],hi[k][3]}
    o[d0]=__builtin_amdgcn_mfma_f32_32x32x16_bf16(pa0,PK(0),o[d0],0,0,0);
    o[d0]=__builtin_amdgcn_mfma_f32_32x32x16_bf16(pa1,PK(1),o[d0],0,0,0);
    o[d0]=__builtin_amdgcn_mfma_f32_32x32x16_bf16(pa2,PK(2),o[d0],0,0,0);
    o[d0]=__builtin_amdgcn_mfma_f32_32x32x16_bf16(pa3,PK(3),o[d0],0,0,0);
    #undef PK
  }
}

#ifndef ATTN_STORE16
#define ATTN_STORE16(p,v) (*(u32x4*)(p)=(v))
#endif
template<int THRL> __device__ __forceinline__ void attn_unit(int b,int h,int qb,const bf16*Q,const bf16*__restrict__ K,const bf16*__restrict__ V,bf16*O,const float*__restrict__ LFT,const float Dd,char*shm){
  int tid=threadIdx.x; asm volatile("":"+v"(tid)); const int lane=tid&63,r32=lane&31,hi=lane>>5; const int wid=__builtin_amdgcn_readfirstlane(tid>>6);
  const long rowbase=(long)b*SEQ; const int q0=qb*QB;
  const bf16*Qw=Q+(rowbase+q0+wid*QBLK)*DM+h*D;
  const bf16*Kh=K+rowbase*DM+h*D,*Vh=V+rowbase*DM+h*D;
  const unsigned lds0=(unsigned)(uintptr_t)shm;
  float*wsf=(float*)(shm+LDS_WS)+wid*64;
  const bf16*ksrc=Kh+(long)lane*DM+wid*8;
  const bf16*vsrc=Vh+(long)(16*(wid&3)+(lane>>2))*DM+(wid>>2)*32+(lane&3)*8;
  const unsigned kdst=lds0+LDS_K+wid*1024, vdst=lds0+LDS_V+wid*1024;
  #define DMA_K(t,slot) glds16(ksrc+(long)(t)*KVBLK*DM,(unsigned)__builtin_amdgcn_readfirstlane(kdst+(slot)))
  #define DMA_V(t,slot) glds16(vsrc+(long)(t)*KVBLK*DM,(unsigned)__builtin_amdgcn_readfirstlane(vdst+(slot)))
  const int vb0=(int)(lds0+LDS_V)+((lane>>4)&1)*32+(lane&3)*8+(4*hi+((lane&15)>>2))*64;
  const char*Kbase=shm+LDS_K; bf16x8 kf[8];
  const lds_cptr shm3=(lds_cptr)shm; const lds_cptr kp0=shm3+LDS_K+hi*1024+r32*16; const lds_cptr vp0=shm3+LDS_V+((lane>>4)&1)*32+(lane&3)*8+(4*hi+((lane&15)>>2))*64;
  int NT=(q0+QB)/KVBLK;
  typedef __attribute__((address_space(3))) const f32x4v* lds_f4p;
  typedef __attribute__((address_space(3))) float* lds_fp;
  bool stat; int t0;
  {
    lds_fp cbw=(lds_fp)(shm3+LDS_CB); lds_fp cbx=(lds_fp)(shm3+LDS_CBX); lds_fp alw=(lds_fp)(shm3+LDS_AL);
    const float L2E=1.4426950408889634f;
    const int nk=q0+QB; float v0=0.f,v1=0.f,v2=0.f,v3=0.f;
    if(4*tid<nk){ const f32x4v l4=*(const f32x4v*)(LFT+((long)(b*NHEAD+h))*SEQ+4*tid); v0=l4[0]; v1=l4[1]; v2=l4[2]; v3=l4[3]; }
    v1+=v0; v2+=v1; v3+=v2; float tot=v3;
    #pragma unroll
    for(int o_=1;o_<64;o_<<=1){ float u_=__shfl_up(tot,o_); if(lane>=o_)tot+=u_; }
    if(lane==63)cbx[wid]=tot;
    if(tid==0){cbx[48]=0.f;}
    asm volatile("s_waitcnt vmcnt(0) lgkmcnt(0)\n\ts_barrier":::"memory");
    float base=tot-v3;
    #pragma unroll
    for(int w_=0;w_<NW;++w_){ float x_=cbx[w_]; if(w_<wid)base+=x_; }
    v0+=base;v1+=base;v2+=base;v3+=base;
    if(4*tid<nk && ((4*tid+3)&63)==63)cbx[16+((4*tid+3)>>6)]=v3;
    if(4*tid==q0)cbx[8]=v0;
    asm volatile("s_waitcnt vmcnt(0) lgkmcnt(0)\n\ts_barrier":::"memory");
    const float cq0=cbx[8];
    if(4*tid<nk){ const float ce=cbx[16+(tid>>4)]; cbw[4*tid]=(ce-v0)*L2E-Dd; cbw[4*tid+1]=(ce-v1)*L2E-Dd; cbw[4*tid+2]=(ce-v2)*L2E-Dd; cbw[4*tid+3]=(ce-v3)*L2E-Dd; }
    bool skip_=false;
    if(tid<NT){ const float ce=cbx[16+tid], cp=(tid>0)?cbx[16+tid-1]:0.f; const float dl_=(cp-ce)*L2E;
      alw[tid]=__builtin_amdgcn_exp2f(-dl_); alw[32+tid]=dl_; if(dl_+2.f*Dd>110.f)cbx[48]=1.f;
      skip_=(tid<NT-4)&&((ce-cq0)*L2E>2.f*Dd+160.f); }
    const unsigned long long bal_=__ballot(skip_);
    if(tid==0)cbx[49]=(float)(__popcll(bal_)&~1);
    asm volatile("s_waitcnt vmcnt(0) lgkmcnt(0)\n\ts_barrier":::"memory");
    stat=(cbx[48]==0.f); t0=(int)cbx[49];
    stat=__builtin_amdgcn_readfirstlane((int)stat)!=0; t0=__builtin_amdgcn_readfirstlane(t0);
#ifdef FORCE_EXACT
    stat=false;
#endif
  }
  NT-=t0; ksrc+=(long)t0*KVBLK*DM; vsrc+=(long)t0*KVBLK*DM;
  typedef __attribute__((address_space(3))) const float* lds_cfp;
  const lds_cfp alp=(lds_cfp)(shm3+LDS_AL)+t0;
  const int tdw=NT-4+(wid>>1);
  #define ALF(t) (((t)>tdw)?1.f:alp[t])
  const lds_f4p cbp=(lds_f4p)(shm3+LDS_CB)+hi+16*t0;
  #define CBIAS(P0,P1,t) do{ const lds_f4p bp_=cbp+16*(t); _Pragma("unroll") for(int a_=0;a_<4;++a_){ const f32x4v b0_=bp_[2*a_], b1_=bp_[8+2*a_]; \
      P0[4*a_]+=b0_[0];P0[4*a_+1]+=b0_[1];P0[4*a_+2]+=b0_[2];P0[4*a_+3]+=b0_[3]; P1[4*a_]+=b1_[0];P1[4*a_+1]+=b1_[1];P1[4*a_+2]+=b1_[2];P1[4*a_+3]+=b1_[3]; } }while(0)
  DMA_K(0,0);DMA_V(0,0);DMA_K(1,SLOTB);
  bf16x8 qr[4];
  #pragma unroll
  for(int d0=0;d0<4;++d0)qr[d0]=*reinterpret_cast<const bf16x8*>(&Qw[(long)r32*DM+d0*16+hi*8]);
  float mhat=0.f,l_reg=0.f;f32x16 o[2];o[0]=f32x16{};o[1]=f32x16{};
  const int qrel=wid*QBLK+r32;
  #define CMASK(P0,P1,t) do{int jb_=(t)-(NT-4); if(jb_>=0)cmask(P0,P1,jb_,qrel,hi);}while(0)
  bool resc=false;
  #define START(P0,P1) do{ resc=false; \
    if(!stat){ const float rm=rowmax(P0,P1); const float dl=rm; mhat=fadd_s(mhat,dl); \
      _Pragma("unroll") for(int r=0;r<16;++r){P0[r]=fsub_s(P0[r],dl);P1[r]=fsub_s(P1[r],dl);} \
      } \
    _Pragma("unroll") for(int r=0;r<16;++r)P0[r]=__builtin_amdgcn_exp2f(P0[r]); }while(0)
  #define RESC(t) do{ if(stat){ const float al_=ALF(t); _Pragma("unroll") for(int d_=0;d_<2;++d_) _Pragma("unroll") for(int r=0;r<16;++r)o[d_][r]*=al_; } \
    else if(resc){ asm volatile("s_waitcnt lgkmcnt(0)":::"memory"); \
      _Pragma("unroll") for(int d_=0;d_<2;++d_) _Pragma("unroll") for(int r=0;r<16;++r)o[d_][r]*=wsf[crow(r,hi)]; } }while(0)
  f32x16 pA0,pA1,pB0,pB1;
  int sl_prev=0,sl_cur=0,sl_next=SLOTB;
  #define ROT() do{sl_prev=sl_cur;sl_cur=sl_next;sl_next=(sl_next==(NSLOT-1)*SLOTB)?0:sl_next+SLOTB;}while(0)
  DMA_K(2,2*SLOTB);
  WAIT_BAR(3);
  qkt(pA0,pA1,Kbase,qr,r32,hi);asm volatile("s_nop 15\n\ts_nop 7":"+v"(pA0),"+v"(pA1));CMASK(pA0,pA1,0);CBIAS(pA0,pA1,0);
  START(pA0,pA1);
  _Pragma("unroll") for(int r=0;r<16;++r)pA1[r]=__builtin_amdgcn_exp2f(pA1[r]);
  WAIT_BAR(0);
  DMA_K(3,0);DMA_V(1,SLOTB);
  ROT();
  kload8(kf,kp0+sl_cur);
  WAIT_BAR(2);
  s16x4 vlo[8],vhi[8]; u32x4 pw0,pw1,pw2,pw3;
  #define PKW(P,B) cvtpk_s(P[B],P[B+1])
  #define PAF(k) __builtin_bit_cast(bf16x8,pw##k)
  #define VFR(i) (bf16x8){vlo[i][0],vlo[i][1],vlo[i][2],vlo[i][3],vhi[i][0],vhi[i][1],vhi[i][2],vhi[i][3]}
  #define PIN(x) asm volatile("":"+v"(x))
  #define MX3(a,b,c) __builtin_fmaxf(__builtin_fmaxf((a),(b)),(c))
  #define GAPA(MF,A0,A1,A2,A3,W0,W1,PW) do{ MF; sacc+=A0; sacc+=A1; sacc+=A2; sacc+=A3; PIN(sacc); W0; W1; PIN(PW); SBAR(); }while(0)
  #define EX(v) __builtin_amdgcn_exp2f(v)
  #define GAPB(MF,X,B) do{ MF; X[B]=EX(X[B]); X[B+1]=EX(X[B+1]); X[B+2]=EX(X[B+2]); X[B+3]=EX(X[B+3]); PIN(X); SBAR(); }while(0)
  #define VRD(i) do{ vlo[i]=vtr(vp_+(((i)>>2)*4096+((i)&3)*1024)); vhi[i]=vtr(vp_+(((i)>>2)*4096+((i)&3)*1024+512)); }while(0)
  #define KRD(G,j) do{ if(G){ kload2(kf,kp0+sl_next,j); SBAR(); } }while(0)
  #define STEP(C0,C1,P0,P1,t,GK,GV,GL) do{ SBAR(); \
    const lds_cptr vp_=vp0+sl_prev; \
    VRD(0); SBAR(); float sacc=(P0[0]+P0[1]); \
    GAPA(C0=__builtin_amdgcn_mfma_f32_32x32x16_bf16(kf[0],qr[0],f32x16{},0,0,0), P0[2],P0[3],P0[4],P0[5],     pw0[0]=PKW(P0,0), pw0[1]=PKW(P0,2), pw0); \
    VRD(4); SBAR(); GAPA(C1=__builtin_amdgcn_mfma_f32_32x32x16_bf16(kf[1],qr[0],f32x16{},0,0,0), P0[6],P0[7],P0[8],P0[9],     pw0[2]=PKW(P0,4), pw0[3]=PKW(P0,6), pw0); \
    VRD(1); SBAR(); GAPA(C0=__builtin_amdgcn_mfma_f32_32x32x16_bf16(kf[2],qr[1],C0,0,0,0),   P0[10],P0[11],P0[12],P0[13], pw1[0]=PKW(P0,8), pw1[1]=PKW(P0,10), pw1); \
    VRD(5); SBAR(); GAPA(C1=__builtin_amdgcn_mfma_f32_32x32x16_bf16(kf[3],qr[1],C1,0,0,0),   P0[14],P0[15],P1[0],P1[1],   pw1[2]=PKW(P0,12),pw1[3]=PKW(P0,14), pw1); \
    VRD(2); SBAR(); GAPA(C0=__builtin_amdgcn_mfma_f32_32x32x16_bf16(kf[4],qr[2],C0,0,0,0),   P1[2],P1[3],P1[4],P1[5],     pw2[0]=PKW(P1,0), pw2[1]=PKW(P1,2), pw2); \
    VRD(6); SBAR(); GAPA(C1=__builtin_amdgcn_mfma_f32_32x32x16_bf16(kf[5],qr[2],C1,0,0,0),   P1[6],P1[7],P1[8],P1[9],     pw2[2]=PKW(P1,4), pw2[3]=PKW(P1,6), pw2); \
    VRD(3); SBAR(); GAPA(C0=__builtin_amdgcn_mfma_f32_32x32x16_bf16(kf[6],qr[3],C0,0,0,0),   P1[10],P1[11],P1[12],P1[13], pw3[0]=PKW(P1,8), pw3[1]=PKW(P1,10), pw3); \
    VRD(7); SBAR(); GAPA(C1=__builtin_amdgcn_mfma_f32_32x32x16_bf16(kf[7],qr[3],C1,0,0,0),   P1[14],P1[15],0.f,0.f,       pw3[2]=PKW(P1,12),pw3[3]=PKW(P1,14), pw3); \
    l_reg+=sacc; \
    if(GK){DMA_K((t)+3,sl_cur);} if(GV){DMA_V((t)+1,sl_next);} \
    CMASK(C0,C1,t); CBIAS(C0,C1,t); \
    if(stat){ l_reg*=ALF(t); resc=false; } else { mhat-=alp[32+(t)]; _Pragma("unroll") for(int r=0;r<16;++r){C0[r]-=mhat;C1[r]-=mhat;} float a=MX3(C0[0],C0[1],C1[0]),b=MX3(C0[2],C0[3],C1[1]); a=MX3(a,C1[2],C1[3]); \
      _Pragma("unroll") for(int r=4;r<16;r+=4){a=MX3(a,C0[r],C0[r+1]);b=MX3(b,C0[r+2],C0[r+3]);a=MX3(a,C1[r],C1[r+1]);b=MX3(b,C1[r+2],C1[r+3]);} \
      float rm=__builtin_fmaxf(a,b); { auto rr=__builtin_amdgcn_permlane32_swap(__float_as_uint(rm),__float_as_uint(rm),false,false); rm=__builtin_fmaxf(__uint_as_float(rr[0]),__uint_as_float(rr[1])); } \
      resc=false; \
      if(__builtin_expect(__any(rm>(float)THRL),0)){ const float dl=__builtin_fmaxf(rm,0.f); mhat+=dl; \
        _Pragma("unroll") for(int r=0;r<16;++r){C0[r]-=dl;C1[r]-=dl;} \
        const float f=__builtin_amdgcn_exp2f(-dl); l_reg*=f; if(hi==0)wsf[r32]=f; resc=true; } } \
    SBAR(); \
    GAPB(o[0]=__builtin_amdgcn_mfma_f32_32x32x16_bf16(PAF(0),VFR(0),o[0],0,0,0), C0,0); \
    GAPB(o[1]=__builtin_amdgcn_mfma_f32_32x32x16_bf16(PAF(0),VFR(4),o[1],0,0,0), C0,4); \
    KRD(GL,0); GAPB(o[0]=__builtin_amdgcn_mfma_f32_32x32x16_bf16(PAF(1),VFR(1),o[0],0,0,0), C0,8); \
    KRD(GL,1); GAPB(o[1]=__builtin_amdgcn_mfma_f32_32x32x16_bf16(PAF(1),VFR(5),o[1],0,0,0), C0,12); \
    KRD(GL,2); GAPB(o[0]=__builtin_amdgcn_mfma_f32_32x32x16_bf16(PAF(2),VFR(2),o[0],0,0,0), C1,0); \
    KRD(GL,3); GAPB(o[1]=__builtin_amdgcn_mfma_f32_32x32x16_bf16(PAF(2),VFR(6),o[1],0,0,0), C1,4); \
    GAPB(o[0]=__builtin_amdgcn_mfma_f32_32x32x16_bf16(PAF(3),VFR(3),o[0],0,0,0), C1,8); \
    GAPB(o[1]=__builtin_amdgcn_mfma_f32_32x32x16_bf16(PAF(3),VFR(7),o[1],0,0,0), C1,12); \
    }while(0)
  int t=1;
  #undef CMASK
  #define CMASK(P0,P1,t) do{}while(0)
  for(;t+5<NT;t+=2){
    STEP(pB0,pB1,pA0,pA1,t,true,true,true);     WAIT_BAR(2); RESC(t); ROT();
    STEP(pA0,pA1,pB0,pB1,t+1,true,true,true);   WAIT_BAR(2); RESC(t+1); ROT();
  }
  #undef CMASK
  #define CMASK(P0,P1,t) do{int jb_=(t)-(NT-4); if(jb_>=0)cmask(P0,P1,jb_,qrel,hi);}while(0)
  #define ENDW(tt) do{ if((tt)+3<NT){WAIT_BAR(2);} else if((tt)+2<NT){WAIT_BAR(1);} else {WAIT_BAR(0);} }while(0)
  for(;t+1<NT;t+=2){
    STEP(pB0,pB1,pA0,pA1,t,(t+3<NT),(t+1<NT),(t+1<NT));       ENDW(t);   RESC(t); ROT();
    STEP(pA0,pA1,pB0,pB1,t+1,(t+4<NT),(t+2<NT),(t+2<NT));     ENDW(t+1); RESC(t+1); ROT();
  }
  STEP(pB0,pB1,pA0,pA1,NT-1,false,false,false); RESC(NT-1);
  { float sacc=pB0[0]+pB0[1]; _Pragma("unroll") for(int r=2;r<16;++r)sacc+=pB0[r]; _Pragma("unroll") for(int r=0;r<16;++r)sacc+=pB1[r]; l_reg+=sacc;
    pw0=(u32x4){PKW(pB0,0),PKW(pB0,2),PKW(pB0,4),PKW(pB0,6)};pw1=(u32x4){PKW(pB0,8),PKW(pB0,10),PKW(pB0,12),PKW(pB0,14)};pw2=(u32x4){PKW(pB1,0),PKW(pB1,2),PKW(pB1,4),PKW(pB1,6)};pw3=(u32x4){PKW(pB1,8),PKW(pB1,10),PKW(pB1,12),PKW(pB1,14)};
    SBAR(); pv(o,vb0+sl_cur,PAF(0),PAF(1),PAF(2),PAF(3)); }
  #undef PKW
  #undef PAF
  #undef VFR
  #undef PIN
  #undef MX3
  #undef GAPA
  #undef GAPB
  #undef EX
  #undef VRD
  #undef KRD
  #undef STEP
  #undef ENDW
  {auto rr=__builtin_amdgcn_permlane32_swap(__float_as_uint(l_reg),__float_as_uint(l_reg),false,false);l_reg=__uint_as_float(rr[0])+__uint_as_float(rr[1]);}
  if(hi==0)wsf[32+r32]=l_reg;asm volatile("s_waitcnt lgkmcnt(0)":::"memory");
  float rli[16];
  #pragma unroll
  for(int r=0;r<16;++r)rli[r]=__builtin_amdgcn_rcpf(wsf[32+crow(r,hi)]);
  bf16*Ow=O+(rowbase+q0+wid*QBLK)*DM+h*D;
  { bf16*stg=(bf16*)(shm+LDS_OST)+wid*2048;
    #pragma unroll
    for(int r=0;r<16;++r){const int orow=crow(r,hi);
      #pragma unroll
      for(int d0=0;d0<2;++d0)stg[orow*64+d0*32+r32]=__float2bfloat16(o[d0][r]*rli[r]);}
    asm volatile("s_waitcnt lgkmcnt(0)":::"memory");
    #pragma unroll
    for(int i=0;i<4;++i){const int row=i*8+(lane>>3),ch=lane&7; const u32x4 v=*(const u32x4*)(stg+row*64+ch*8); ATTN_STORE16(Ow+(long)row*DM+ch*8,v);} }
  asm volatile("s_waitcnt lgkmcnt(0)\n\ts_barrier":::"memory");
  #undef DMA_K
  #undef DMA_V
  #undef CMASK
  #undef CBIAS
  #undef ALF
  #undef START
  #undef RESC
  #undef ROT
}
constexpr int ATTN_LDS_BYTES=LDS_BYTES;
#undef SBAR
#undef WAIT_BAR
}
namespace xb {
#define XLAS __attribute__((address_space(3)))
#define XB_TMO      128
#define XB_XCNT(j)  (256  + 64 * (j))
#define XB_XSUB(j)  (1280 + 64 * (j))
#define XB_XGEN(j)  (2304 + 64 * (j))
#define XB_TOP      3328
#define XB_TOPGEN   3392
#define XCD_BAR_WORDS 3456
#define XB_SPIN_CAP (1u << 18)

__device__ __forceinline__ unsigned xb_ld(unsigned* p)              { return __hip_atomic_load(p, __ATOMIC_RELAXED, __HIP_MEMORY_SCOPE_AGENT); }
__device__ __forceinline__ unsigned xb_add(unsigned* p, unsigned v) { return __hip_atomic_fetch_add(p, v, __ATOMIC_RELAXED, __HIP_MEMORY_SCOPE_AGENT); }
__device__ __forceinline__ unsigned xb_xcc_id() { return (unsigned)__builtin_amdgcn_s_getreg((3 << 11) | 20) & 0xFu; }
#define XB_SPIN(cond, bar) do { unsigned _sp = 0; while (cond) { __builtin_amdgcn_s_sleep(1); \
    if ((++_sp & 255u) == 0u) { if (xb_ld(&(bar)[XB_TMO])) break; if (_sp > XB_SPIN_CAP) { atomicAdd(&(bar)[XB_TMO], 1u); break; } } } } while (0)

struct XcdBarrier {
    unsigned* bar; unsigned x;
    volatile XLAS unsigned* st;
};

__device__ __forceinline__ XcdBarrier xcd_barrier_post(unsigned* bar, volatile XLAS unsigned* st) {
    XcdBarrier b; b.bar = bar; b.x = xb_xcc_id(); b.st = st;
    if (threadIdx.x == 0) (void)xb_add(&bar[XB_XCNT(b.x)], 1u);
    return b;
}
__device__ __forceinline__ void xcd_barrier_complete(unsigned* bar, unsigned x, unsigned& nloc, unsigned& nx) {
    const unsigned G = gridDim.x * gridDim.y * gridDim.z;
    unsigned sum, cnt, mine, sp = 0u;
    for (;;) {
        sum = 0u; cnt = 0u; mine = 0u;
#pragma unroll
        for (unsigned j = 0; j < 16; ++j) { const unsigned c = xb_ld(&bar[XB_XCNT(j)]); sum += c; cnt += (c > 0u) ? 1u : 0u; mine = (j == x) ? c : mine; }
        if (sum == G) break;
        __builtin_amdgcn_s_sleep(1);
        if ((++sp & 255u) == 0u) { if (xb_ld(&bar[XB_TMO])) break; if (sp > XB_SPIN_CAP) { atomicAdd(&bar[XB_TMO], 1u); break; } }
    }
    nloc = mine > 0u ? mine : 1u; nx = cnt > 0u ? cnt : 1u;
}

__device__ __forceinline__ void xcd_barrier(const XcdBarrier& b) {
    asm volatile("s_waitcnt vmcnt(0)" ::: "memory");
    __syncthreads();
    if (threadIdx.x == 0) {
        unsigned* bar = b.bar;
        __builtin_amdgcn_s_waitcnt(0);
        unsigned nloc = b.st[0], nx = b.st[1];
        if (nloc == 0u) { xcd_barrier_complete(bar, b.x, nloc, nx); b.st[0] = nloc; b.st[1] = nx; }
        const unsigned old = xb_add(&bar[XB_XSUB(b.x)], 1u);
        const unsigned gen = old / nloc;
        if (old + 1u == (gen + 1u) * nloc) {
            __builtin_amdgcn_fence(__ATOMIC_RELEASE, "agent");
            asm volatile("s_waitcnt vmcnt(0)" ::: "memory");
            const unsigned og = xb_add(&bar[XB_TOP], 1u);
            const unsigned tg = og / nx;
            if (og + 1u == (tg + 1u) * nx) xb_add(&bar[XB_TOPGEN], 1u);
            else XB_SPIN(xb_ld(&bar[XB_TOPGEN]) == tg, bar);
            __builtin_amdgcn_fence(__ATOMIC_ACQUIRE, "agent");
            xb_add(&bar[XB_XGEN(b.x)], 1u);
            asm volatile("s_waitcnt vmcnt(0)" ::: "memory");
        } else {
            XB_SPIN(xb_ld(&bar[XB_XGEN(b.x)]) == gen, bar);
            __builtin_amdgcn_fence(__ATOMIC_ACQUIRE, "agent");
            asm volatile("s_waitcnt vmcnt(0)" ::: "memory");
        }
    }
    __syncthreads();
}
}
namespace mk {
#define LAS __attribute__((address_space(3)))
typedef unsigned short u16;
typedef pg8::f32x4 f32x4;
typedef pg8::u32x4 u32x4;
typedef pg8::bf16x8 bf16x8;
typedef unsigned u32x2 __attribute__((ext_vector_type(2)));
using pg8::cvt_pk_bf16;

constexpr int DMODEL = 1024, SEQ = 2048, MP = 65536, MS = 256, MT = MP + MS, DFF = 2816, NMIX = 6912, PAST = 4096, NPOS = 2048 + 16;
constexpr float L2E = 1.4426950408889634f;
constexpr float QC2 = 0.125f * L2E;

constexpr size_t SZ1024 = (size_t)MT * 1024 * 2, SZ512 = (size_t)MT * 512 * 2;
constexpr size_t O_CTL = 0;
constexpr size_t O_SS = 65536;
constexpr size_t O_TABC = O_SS + (size_t)MT * 64;
constexpr size_t O_TABS = O_TABC + (size_t)NPOS * 256;
constexpr size_t O_W1IN = O_TABS + (size_t)NPOS * 256;
constexpr size_t O_W1OUT = O_W1IN + (size_t)5632 * 1024 * 2;
constexpr size_t O_WMIX = O_W1OUT + (size_t)1024 * 2816 * 2;
constexpr size_t O_WBR = O_WMIX + (size_t)NMIX * 1024 * 2;
constexpr size_t O_WBF = O_WBR + (size_t)1024 * 1024 * 2;
constexpr size_t O_WOUT = O_WBF + (size_t)1024 * 512 * 2;
constexpr size_t O_W2IN = O_WOUT + (size_t)1024 * 1024 * 2;
constexpr size_t O_W2OUT = O_W2IN + (size_t)5632 * 1024 * 2;
constexpr size_t O_WPLE = O_W2OUT + (size_t)1024 * 2816 * 2;
constexpr size_t O_WPG = O_WPLE + (size_t)1024 * 256 * 2;
constexpr size_t O_XB = O_WPG + (size_t)1024 * 1024 * 2;
constexpr size_t O_RQK = O_XB + SZ1024;
constexpr size_t O_RV = O_RQK + SZ1024;
constexpr size_t O_RG = O_RV + SZ1024;
constexpr size_t O_FQ = O_RG + SZ1024;
constexpr size_t O_FK = O_FQ + SZ512;
constexpr size_t O_FV = O_FK + SZ512;
constexpr size_t O_ZG = O_FV + SZ512;
constexpr size_t WS_NEED = O_ZG + (size_t)MT * 2048 * 2;
constexpr size_t O_ACT1 = O_RQK;
constexpr size_t O_ACT2 = O_RV;
static_assert(O_ACT1 + (size_t)MT * DFF * 2 <= O_FQ, "act1 overlay");
static_assert(O_ACT2 + (size_t)MT * DFF * 2 <= O_FV, "act2 overlay");
static_assert(WS_NEED <= 1073741824ull, "ws");
constexpr size_t OUT_YP = 0, OUT_YS = OUT_YP + (size_t)MP * 1024, OUT_RSP = OUT_YS + (size_t)MS * 1024, OUT_KP = OUT_RSP + (size_t)32 * 4 * 128 * 256,
                 OUT_VP = OUT_KP + (size_t)MP * 512, OUT_LP = OUT_VP + (size_t)MP * 512, OUT_RSS = OUT_LP + (size_t)MP * 8, OUT_KS = OUT_RSS + (size_t)16 * 4 * 128 * 256,
                 OUT_VS = OUT_KS + (size_t)MS * 512, OUT_LS = OUT_VS + (size_t)MS * 512, OUT_END = OUT_LS + (size_t)MS * 8;

constexpr int LDS_BYTES = 147456;

__device__ __forceinline__ float bf2f(unsigned h) { return __uint_as_float(h << 16); }
__device__ __forceinline__ float bflo(unsigned w) { return __uint_as_float(w << 16); }
__device__ __forceinline__ float bfhi(unsigned w) { return __uint_as_float(w & 0xffff0000u); }
__device__ __forceinline__ float fast_sigmoid(float x) { return __builtin_amdgcn_rcpf(1.f + __builtin_amdgcn_exp2f(-x * L2E)); }
__device__ __forceinline__ float wave_sum(float v) {
#pragma unroll
    for (int o = 1; o < 64; o <<= 1) v += __shfl_xor(v, o);
    return v;
}
__device__ __forceinline__ float wave_max(float v) {
#pragma unroll
    for (int o = 1; o < 64; o <<= 1) v = fmaxf(v, __shfl_xor(v, o));
    return v;
}
__device__ __forceinline__ float rstd_of(const float* ss, int row) {
    const f32x4* p = (const f32x4*)(ss + (size_t)row * 16); const f32x4 a = p[0], b = p[1], c = p[2], d = p[3];
    const float s = (((a[0] + a[1]) + (a[2] + a[3])) + ((b[0] + b[1]) + (b[2] + b[3]))) + (((c[0] + c[1]) + (c[2] + c[3])) + ((d[0] + d[1]) + (d[2] + d[3])));
    return rsqrtf(s * (1.f / 1024.f) + 1e-6f);
}
__device__ __forceinline__ int gcol(int q) { return (q & 128) + (q & 96) + ((q >> 2) & 3) * 8 + ((q >> 4) & 1) * 4 + (q & 3); }


constexpr int RS_TAB_OFF = 147456 - 128 - 1024;
__device__ __forceinline__ const LAS float* rs_table_fill(const float* ss, int pm) {
    LAS float* tab = (LAS float*)(uintptr_t)RS_TAB_OFF;
    const int t = threadIdx.x;
    if (t < 256) tab[t] = rstd_of(ss, pm * 256 + t);
    asm volatile("s_waitcnt lgkmcnt(0)" ::: "memory"); __builtin_amdgcn_s_barrier(); asm volatile("" ::: "memory");
    return tab;
}
struct EpiSwiglu {
    static constexpr bool PERM = false, AFTER_DRAIN = false;
    u16* O; const float* ss;
    __device__ __forceinline__ void operator()(const f32x4 (&acc)[2][2][4][2], const pg8::Unit& u, int wr, int wc, int fr, int fq) const {
        const int col = u.pn * 128 + wc * 32 + fq * 8; const LAS float* rst = rs_table_fill(ss, u.pm);
#pragma unroll
        for (int ai = 0; ai < 2; ++ai)
#pragma unroll
            for (int m = 0; m < 4; ++m) {
                const int row = u.pm * 256 + ai * 128 + wr * 64 + m * 16 + fr; const float rs = rst[ai * 128 + wr * 64 + m * 16 + fr];
                typedef float f32x2 __attribute__((ext_vector_type(2)));
                const float nrs = -rs * L2E, rs2 = rs * rs; unsigned wv[4];
#pragma unroll
                for (int n = 0; n < 2; ++n)
#pragma unroll
                    for (int e = 0; e < 4; e += 2) {
                        const f32x2 g2 = {acc[ai][0][m][n][e], acc[ai][0][m][n][e + 1]}, u2 = {acc[ai][1][m][n][e], acc[ai][1][m][n][e + 1]};
                        const f32x2 t2 = g2 * nrs; f32x2 d2 = {__builtin_amdgcn_exp2f(t2.x), __builtin_amdgcn_exp2f(t2.y)}; d2 = d2 + 1.0f;
                        const f32x2 r2 = {__builtin_amdgcn_rcpf(d2.x), __builtin_amdgcn_rcpf(d2.y)};
                        const f32x2 a2 = ((g2 * u2) * rs2) * r2;
                        wv[n * 2 + (e >> 1)] = cvt_pk_bf16(a2.x, a2.y);
                    }
                u32x4 w; w.x = wv[0]; w.y = wv[1]; w.z = wv[2]; w.w = wv[3];
                *(u32x4*)(O + (size_t)row * DFF + col) = w;
            }
    }
};
struct EpiMix {
    static constexpr bool PERM = false, AFTER_DRAIN = false;
    const float* ss; const float* tabc; const float* tabs; const float* qg; const float* kg; const float* bfg;
    u16 *RQK, *RV, *RG, *FQ, *FK, *FV, *ZG; float* out; float* lft;
    template <int MODE> static __device__ __forceinline__ void store8(const f32x4 (&acc)[2][2][4][2], u16* base, int ld, int t, int row, float rs, int ai, int m, int wc, int fq) {
        typedef float f32x2 __attribute__((ext_vector_type(2)));
        const float nrs = -rs * L2E;
#pragma unroll
        for (int bj = 0; bj < 2; ++bj) {
            unsigned wv[4];
#pragma unroll
            for (int n = 0; n < 2; ++n)
#pragma unroll
                for (int e = 0; e < 4; e += 2) {
                    const f32x2 x2 = {acc[ai][bj][m][n][e], acc[ai][bj][m][n][e + 1]}; f32x2 o2 = x2 * rs;
                    if (MODE != 0) { const f32x2 t2 = x2 * nrs; f32x2 d2 = {__builtin_amdgcn_exp2f(t2.x), __builtin_amdgcn_exp2f(t2.y)}; d2 = d2 + 1.0f;
                        const f32x2 r2 = {__builtin_amdgcn_rcpf(d2.x), __builtin_amdgcn_rcpf(d2.y)}; o2 = MODE == 1 ? o2 * r2 : r2; }
                    wv[n * 2 + (e >> 1)] = cvt_pk_bf16(o2.x, o2.y);
                }
            u32x4 w; w.x = wv[0]; w.y = wv[1]; w.z = wv[2]; w.w = wv[3];
            *(u32x4*)(base + (size_t)row * ld + t * 256 + bj * 128 + wc * 32 + fq * 8) = w;
        }
    }
    template <bool ISK> static __device__ __forceinline__ void headnorm(const f32x4 (&acc)[2][2][4][2], u16* dst, const float* gn, float* o, int row, float rs, int ai, int m, int head, int fq) {
        float q = 0.f;
#pragma unroll
        for (int bj = 0; bj < 2; ++bj)
#pragma unroll
            for (int n = 0; n < 2; ++n) { const f32x4 v = acc[ai][bj][m][n] * rs; q += (v[0] * v[0] + v[1] * v[1]) + (v[2] * v[2] + v[3] * v[3]); }
        q += __shfl_xor(q, 16); q += __shfl_xor(q, 32);
        const float hr = rsqrtf(q * (1.f / 64.f) + 1e-6f) * rs * (ISK ? 1.f : QC2);
#pragma unroll
        for (int bj = 0; bj < 2; ++bj)
#pragma unroll
            for (int n = 0; n < 2; ++n) {
                const int d = 32 * bj + 16 * n + 4 * fq; const f32x4 g4 = *(const f32x4*)(gn + d); const f32x4 v = acc[ai][bj][m][n] * hr * g4;
                u32x2 w; w.x = cvt_pk_bf16(v[0], v[1]); w.y = cvt_pk_bf16(v[2], v[3]);
                *(u32x2*)(dst + (size_t)row * 512 + head * 64 + d) = w;
                if (ISK) *(f32x4*)(o + head * 64 + d) = v;
            }
    }
    __device__ __forceinline__ void operator()(const f32x4 (&acc)[2][2][4][2], const pg8::Unit& u, int wr, int wc, int fr, int fq) const {
        const int pn = u.pn; const LAS float* rst = rs_table_fill(ss, u.pm);
#pragma unroll
        for (int ai = 0; ai < 2; ++ai)
#pragma unroll
            for (int m = 0; m < 4; ++m) {
                const int row = u.pm * 256 + ai * 128 + wr * 64 + m * 16 + fr; const float rs = rst[ai * 128 + wr * 64 + m * 16 + fr];
                if (pn < 4) {
                    const int pidx = row < MP ? (row & (SEQ - 1)) : SEQ + ((row - MP) & 15);
                    const int d = 16 * wc + 4 * fq;
                    const f32x4 c = *(const f32x4*)(tabc + pidx * 64 + d), s = *(const f32x4*)(tabs + pidx * 64 + d);
                    const float sc = rs * (pn >= 2 ? 0.08838834764831845f : 1.f);
#pragma unroll
                    for (int bj = 0; bj < 2; ++bj) {
                        const f32x4 x1 = acc[ai][bj][m][0] * sc, x2 = acc[ai][bj][m][1] * sc;
                        const f32x4 o1 = x1 * c - x2 * s, o2 = x1 * s + x2 * c;
                        u16* p = RQK + (size_t)row * 1024 + (pn >> 1) * 512 + (2 * (pn & 1) + bj) * 128 + d;
                        u32x2 w1, w2; w1.x = cvt_pk_bf16(o1[0], o1[1]); w1.y = cvt_pk_bf16(o1[2], o1[3]); w2.x = cvt_pk_bf16(o2[0], o2[1]); w2.y = cvt_pk_bf16(o2[2], o2[3]);
                        *(u32x2*)p = w1; *(u32x2*)(p + 64) = w2;
                    }
                } else if (pn < 8) { store8<0>(acc, RV, 1024, pn - 4, row, rs, ai, m, wc, fq);
                } else if (pn < 12) { store8<1>(acc, RG, 1024, pn - 8, row, rs, ai, m, wc, fq);
                } else if (pn >= 19) { store8<2>(acc, ZG, 2048, pn - 19, row, rs, ai, m, wc, fq);
                } else if (pn < 14) { headnorm<false>(acc, FQ, qg, nullptr, row, rs, ai, m, 4 * (pn & 1) + wc, fq);
                } else if (pn < 16) { headnorm<true>(acc, FK, kg, row < MP ? out + OUT_KP + (size_t)row * 512 : out + OUT_KS + (size_t)(row - MP) * 512, row, rs, ai, m, 4 * (pn & 1) + wc, fq);
                } else if (pn < 18) {
                    float* o = row < MP ? out + OUT_VP + (size_t)row * 512 : out + OUT_VS + (size_t)(row - MP) * 512;
#pragma unroll
                    for (int bj = 0; bj < 2; ++bj) {
                        const int col = (pn - 16) * 256 + bj * 128 + wc * 32 + fq * 8;
                        const f32x4 v0 = acc[ai][bj][m][0] * rs, v1 = acc[ai][bj][m][1] * rs;
                        u32x4 w; w.x = cvt_pk_bf16(v0[0], v0[1]); w.y = cvt_pk_bf16(v0[2], v0[3]); w.z = cvt_pk_bf16(v1[0], v1[1]); w.w = cvt_pk_bf16(v1[2], v1[3]);
                        *(u32x4*)(FV + (size_t)row * 512 + col) = w; *(f32x4*)(o + col) = v0; *(f32x4*)(o + col + 4) = v1;
                    }
                } else {
                    if (wc == 0 && fq == 0) {
                        float* o = row < MP ? out + OUT_LP + (size_t)row * 8 : out + OUT_LS + (size_t)(row - MP) * 8;
#pragma unroll
                        for (int n = 0; n < 2; ++n) { f32x4 r;
#pragma unroll
                            for (int e = 0; e < 4; ++e) { const float x = acc[ai][0][m][n][e] * rs + bfg[n * 4 + e]; r[e] = fminf(x, 0.f) - __logf(1.f + __expf(-fabsf(x))); }
                            *(f32x4*)(o + n * 4) = r;
                            if (row < MP) { float* lt = lft + ((size_t)(row >> 11) * 8 + n * 4) * SEQ + (row & (SEQ - 1)); lt[0] = r[0]; lt[SEQ] = r[1]; lt[2 * SEQ] = r[2]; lt[3 * SEQ] = r[3]; } }
                    }
                }
            }
    }
};
struct FResid {
    static constexpr bool NEED_RS = false, WRITE_SS = true; static constexpr int BATCH = 4;
    u16* XB; float* ss; float alpha;
    struct In { u32x4 x; };
    __device__ __forceinline__ In load(int row, int col) const { In r; r.x = *(const u32x4*)(XB + (size_t)row * 1024 + col); return r; }
    __device__ __forceinline__ float finish(int row, int col, const float (&v)[8], const In& in, float) const {
        const u32x4 x = in.x;
        const float r0 = bflo(x.x) + alpha * v[0], r1 = bfhi(x.x) + alpha * v[1], r2 = bflo(x.y) + alpha * v[2], r3 = bfhi(x.y) + alpha * v[3],
                    r4 = bflo(x.z) + alpha * v[4], r5 = bfhi(x.z) + alpha * v[5], r6 = bflo(x.w) + alpha * v[6], r7 = bfhi(x.w) + alpha * v[7];
        u32x4 w; w.x = cvt_pk_bf16(r0, r1); w.y = cvt_pk_bf16(r2, r3); w.z = cvt_pk_bf16(r4, r5); w.w = cvt_pk_bf16(r6, r7); *(u32x4*)(XB + (size_t)row * 1024 + col) = w;
        return ((r0 * r0 + r1 * r1) + (r2 * r2 + r3 * r3)) + ((r4 * r4 + r5 * r5) + (r6 * r6 + r7 * r7));
    }
};
template <bool SECOND> struct FGate {
    static constexpr bool NEED_RS = false, WRITE_SS = false; static constexpr int BATCH = 4;
    u16* T; const u16* ZG; float* ss;
    struct In { u32x4 g, p; };
    __device__ __forceinline__ In load(int row, int col) const { In r; r.g = *(const u32x4*)(ZG + (size_t)row * 2048 + (SECOND ? 1024 : 0) + col); if (SECOND) r.p = *(const u32x4*)(T + (size_t)row * 1024 + col); else r.p = (u32x4){0u, 0u, 0u, 0u}; return r; }
    __device__ __forceinline__ float finish(int row, int col, const float (&a)[8], const In& in, float) const {
        const u32x4 g = in.g, p = in.p;
        float v[8] = {bflo(g.x) * a[0], bfhi(g.x) * a[1], bflo(g.y) * a[2], bfhi(g.y) * a[3], bflo(g.z) * a[4], bfhi(g.z) * a[5], bflo(g.w) * a[6], bfhi(g.w) * a[7]};
        if (SECOND) { v[0] += bflo(p.x); v[1] += bfhi(p.x); v[2] += bflo(p.y); v[3] += bfhi(p.y); v[4] += bflo(p.z); v[5] += bfhi(p.z); v[6] += bflo(p.w); v[7] += bfhi(p.w); }
        u32x4 w; w.x = cvt_pk_bf16(v[0], v[1]); w.y = cvt_pk_bf16(v[2], v[3]); w.z = cvt_pk_bf16(v[4], v[5]); w.w = cvt_pk_bf16(v[6], v[7]);
        *(u32x4*)(T + (size_t)row * 1024 + col) = w; return 0.f;
    }
};
struct FPlain {
    static constexpr bool NEED_RS = false, WRITE_SS = false; static constexpr int BATCH = 4;
    u16* O; float* ss;
    struct In { int dummy; };
    __device__ __forceinline__ In load(int, int) const { In r; r.dummy = 0; return r; }
    __device__ __forceinline__ float finish(int row, int col, const float (&a)[8], const In&, float) const {
        u32x4 w; w.x = cvt_pk_bf16(a[0], a[1]); w.y = cvt_pk_bf16(a[2], a[3]); w.z = cvt_pk_bf16(a[4], a[5]); w.w = cvt_pk_bf16(a[6], a[7]);
        *(u32x4*)(O + (size_t)row * 1024 + col) = w; return 0.f;
    }
};
struct FFinal {
    static constexpr bool NEED_RS = true, WRITE_SS = false; static constexpr int BATCH = 2;
    float* yP; float* yS; const u16* XB; const u16* PLE; float* ss;
    struct In { u32x4 x, p; };
    __device__ __forceinline__ In load(int row, int col) const { In r; r.x = *(const u32x4*)(XB + (size_t)row * 1024 + col); r.p = *(const u32x4*)(PLE + (size_t)row * 1024 + col); return r; }
    __device__ __forceinline__ float finish(int row, int col, const float (&a)[8], const In& in, float rs) const {
        float* y = (row < MP ? yP + (size_t)row * 1024 : yS + (size_t)(row - MP) * 1024) + col;
        const u32x4 x = in.x, p = in.p;
        typedef float f32x2 __attribute__((ext_vector_type(2)));
        const float nrs = -rs * L2E; const unsigned xw[4] = {x.x, x.y, x.z, x.w}, pw[4] = {p.x, p.y, p.z, p.w};
        f32x4 y0, y1;
#pragma unroll
        for (int k = 0; k < 4; ++k) {
            const f32x2 a2 = {a[2 * k], a[2 * k + 1]}, x2 = {bflo(xw[k]), bfhi(xw[k])}, p2 = {bflo(pw[k]), bfhi(pw[k])};
            const f32x2 t2 = a2 * nrs; f32x2 d2 = {__builtin_amdgcn_exp2f(t2.x), __builtin_amdgcn_exp2f(t2.y)}; d2 = d2 + 1.0f;
            const f32x2 r2 = {__builtin_amdgcn_rcpf(d2.x), __builtin_amdgcn_rcpf(d2.y)}; const f32x2 o2 = x2 + p2 * r2;
            if (k < 2) { y0[2 * k] = o2.x; y0[2 * k + 1] = o2.y; } else { y1[2 * k - 4] = o2.x; y1[2 * k - 3] = o2.y; }
        }
        *(f32x4*)y = y0; *(f32x4*)(y + 4) = y1; return 0.f;
    }
};
template <class F> struct EpiWrap {
    static constexpr bool PERM = false, AFTER_DRAIN = false;
    F f;
    __device__ __forceinline__ void operator()(const f32x4 (&acc)[2][2][4][2], const pg8::Unit& u, int wr, int wc, int fr, int fq) const {
        constexpr int NB = F::BATCH; const LAS float* rst = nullptr; if (F::NEED_RS) rst = rs_table_fill(f.ss, u.pm);
#pragma unroll
        for (int ab = 0; ab < 8 / NB; ++ab) {
            const int ai = (ab * NB) / 4, m0 = (ab * NB) % 4;
            typename F::In in[NB][2];
            const int row0 = u.pm * 256 + ai * 128 + wr * 64 + fr + m0 * 16, col0 = u.pn * 256 + wc * 32 + fq * 8;
#pragma unroll
            for (int m = 0; m < NB; ++m) {
#pragma unroll
                for (int bj = 0; bj < 2; ++bj) in[m][bj] = f.load(row0 + m * 16, col0 + bj * 128);
            }
            __builtin_amdgcn_sched_barrier(0);
#pragma unroll
            for (int m = 0; m < NB; ++m) {
                const int row = row0 + m * 16; float rs = 1.f;
                if (F::NEED_RS) rs = rst[ai * 128 + wr * 64 + (m0 + m) * 16 + fr];
                float q = 0.f;
#pragma unroll
                for (int bj = 0; bj < 2; ++bj) {
                    const float v[8] = {acc[ai][bj][m0 + m][0][0], acc[ai][bj][m0 + m][0][1], acc[ai][bj][m0 + m][0][2], acc[ai][bj][m0 + m][0][3], acc[ai][bj][m0 + m][1][0], acc[ai][bj][m0 + m][1][1], acc[ai][bj][m0 + m][1][2], acc[ai][bj][m0 + m][1][3]};
                    q += f.finish(row, col0 + bj * 128, v, in[m][bj], rs);
                }
                if (F::WRITE_SS) { q += __shfl_xor(q, 16); q += __shfl_xor(q, 32); if (fq == 0) f.ss[(size_t)row * 16 + u.pn * 4 + wc] = q; }
            }
        }
    }
};
template <class F> __device__ __forceinline__ void small_gemm(LAS unsigned char* lds, const u16* A, const u16* Bt, int K, const F& f, int bx, int G) {
    int tid = threadIdx.x; asm volatile("" : "+v"(tid));
    const int lane = tid & 63, w = __builtin_amdgcn_readfirstlane(tid >> 6), g = lane >> 4, c16 = lane & 15;
    LAS float* red = (LAS float*)lds;
    const int steps = K / 256;
    for (int item = bx; item < 256; item += G) {
        const int rb = item >> 4, cb = item & 15;
        const u16* ap = A + (size_t)(16 * rb + c16) * K + (size_t)w * (K / 8) + 8 * g;
        const u16* bp = Bt + (size_t)(64 * cb + c16) * K + (size_t)w * (K / 8) + 8 * g;
        f32x4 acc[4];
#pragma unroll
        for (int nt = 0; nt < 4; ++nt) acc[nt] = (f32x4){0.f, 0.f, 0.f, 0.f};
        for (int s0 = 0; s0 < steps; s0 += 4) {
            bf16x8 a[4], b[4][4];
#pragma unroll
            for (int j = 0; j < 4; ++j) if (s0 + j < steps) { a[j] = *(const bf16x8*)(ap + 32 * (s0 + j));
#pragma unroll
                for (int nt = 0; nt < 4; ++nt) b[j][nt] = *(const bf16x8*)(bp + (size_t)16 * nt * K + 32 * (s0 + j)); }
#pragma unroll
            for (int j = 0; j < 4; ++j) if (s0 + j < steps) {
#pragma unroll
                for (int nt = 0; nt < 4; ++nt) acc[nt] = __builtin_amdgcn_mfma_f32_16x16x32_bf16(a[j], b[j][nt], acc[nt], 0, 0, 0); }
        }
        __syncthreads();
#pragma unroll
        for (int nt = 0; nt < 4; ++nt)
#pragma unroll
            for (int i = 0; i < 4; ++i) red[(w * 16 + 4 * g + i) * 64 + 16 * nt + c16] = acc[nt][i];
        __syncthreads();
        if (tid < 128) {
            const int row = tid >> 3, c8 = tid & 7, p0 = 32 * (c8 >> 2) + 4 * (c8 & 3);
            f32x4 s0 = {0.f, 0.f, 0.f, 0.f}, s1 = {0.f, 0.f, 0.f, 0.f};
#pragma unroll
            for (int ww = 0; ww < 8; ++ww) { s0 += *(const LAS f32x4*)(red + (ww * 16 + row) * 64 + p0); s1 += *(const LAS f32x4*)(red + (ww * 16 + row) * 64 + p0 + 16); }
            const float v[8] = {s0[0], s0[1], s0[2], s0[3], s1[0], s1[1], s1[2], s1[3]};
            const int grow = MP + 16 * rb + row; float rs = 1.f; if (F::NEED_RS) rs = rstd_of(f.ss, grow);
            const typename F::In in = f.load(grow, 64 * cb + 8 * c8); float q = f.finish(grow, 64 * cb + 8 * c8, v, in, rs);
            if (F::WRITE_SS) { q += __shfl_xor(q, 1); q += __shfl_xor(q, 2); q += __shfl_xor(q, 4); if (c8 == 0) f.ss[(size_t)grow * 16 + cb] = q; }
        }
    }
    __syncthreads();
}
__device__ __forceinline__ int logical_col(int kind, int pr) {
    const int t = pr >> 8, q = pr & 255, g = gcol(q);
    if (kind == 0) return t * 256 + g;
    if (kind == 1) { const int bj = q >> 7; return bj * DFF + t * 128 + (g & 127); }
    const int bj = q >> 7, wc = (q >> 5) & 3, n = (q >> 4) & 1, fq = (q >> 2) & 3, e = q & 3;
    if (t < 4) return (t >> 1) * 512 + (2 * (t & 1) + bj) * 128 + 16 * wc + 4 * fq + e + 64 * n;
    if (t < 8) return 1024 + (t - 4) * 256 + g;
    if (t < 12) return 2048 + (t - 8) * 256 + g;
    if (t < 16) return (t < 14 ? 3072 : 3584) + (4 * (t & 1) + wc) * 64 + 32 * bj + 16 * n + 4 * fq + e;
    if (t < 18) return 4096 + (t - 16) * 256 + g;
    if (t == 18) return g < 8 ? 4608 + g : -1;
    return 4616 + (t - 19) * 256 + g;
}
__device__ __forceinline__ void transpose_item(const float* W, const float* gain, int K, int Nlog, int kind, u16* WT, int nblk, LAS float* scr, int item, int lane) {
    const int kb = item / nblk, nb = item % nblk, k0 = 64 * kb, n0 = 32 * nb;
    const int lc = logical_col(kind, n0 + (lane & 31));
    float tv[32];
#pragma unroll
    for (int i = 0; i < 32; ++i) { const int kk = 2 * i + (lane >> 5); tv[i] = (lc >= 0) ? W[(size_t)(k0 + kk) * Nlog + lc] : 0.f; }
#pragma unroll
    for (int i = 0; i < 32; ++i) { const int kk = 2 * i + (lane >> 5); float v = tv[i]; if (gain) v *= gain[k0 + kk]; scr[kk * 33 + (lane & 31)] = v; }
    asm volatile("s_waitcnt lgkmcnt(0)" ::: "memory");
    const int c = lane & 7;
#pragma unroll
    for (int j = 0; j < 4; ++j) { const int n = (lane >> 3) + 8 * j; const LAS float* s = scr + (8 * c) * 33 + n;
        u32x4 o; o.x = cvt_pk_bf16(s[0 * 33], s[1 * 33]); o.y = cvt_pk_bf16(s[2 * 33], s[3 * 33]); o.z = cvt_pk_bf16(s[4 * 33], s[5 * 33]); o.w = cvt_pk_bf16(s[6 * 33], s[7 * 33]);
        *(u32x4*)(WT + (size_t)(n0 + n) * K + k0 + 8 * c) = o; }
    asm volatile("s_waitcnt lgkmcnt(0)" ::: "memory");
}

constexpr int R_QS = 0, R_KS = 17408, R_KDT = 34816, R_VT = 53248, R_AS = 90112, R_RED = 99328, R_RSTD = 101376, R_END = 101632;
template <int CH>
__device__ __forceinline__ void ret_item(LAS unsigned char* lds, const u16* RQK, u16* RV, const u16* RG, const float* s0, float* sout, size_t rowbase, int nchunks, int h) {
    constexpr int TT = CH / 16, KSN = (CH + 31) / 32;
    int tid = threadIdx.x; asm volatile("" : "+v"(tid)); const int lane = tid & 63, w = __builtin_amdgcn_readfirstlane(tid >> 6), g = lane >> 4, c16 = lane & 15;
    LAS u16* Qs = (LAS u16*)(lds + R_QS); LAS u16* Ks = (LAS u16*)(lds + R_KS); LAS u16* KdT = (LAS u16*)(lds + R_KDT); LAS u16* VT = (LAS u16*)(lds + R_VT); LAS u16* As = (LAS u16*)(lds + R_AS);
    LAS float* red = (LAS float*)(lds + R_RED); LAS float* rstdv = (LAS float*)(lds + R_RSTD);
    const float lg2 = __log2f(1.f - __builtin_amdgcn_exp2f(-5.f - (float)h));
    f32x4 S[8][2];
#pragma unroll
    for (int kt = 0; kt < 8; ++kt)
#pragma unroll
        for (int nt = 0; nt < 2; ++nt)
#pragma unroll
            for (int i = 0; i < 4; ++i) S[kt][nt][i] = s0 ? s0[(size_t)(16 * kt + 4 * g + i) * 256 + 32 * w + 16 * nt + c16] : 0.f;
    __syncthreads();
    if (CH < 32) {
        for (int i = tid; i < (R_RED - R_KDT) / 4; i += 512) ((LAS unsigned*)(lds + R_KDT))[i] = 0u;
        __syncthreads();
    }
    for (int c = 0; c < nchunks; ++c) {
        const size_t row0 = rowbase + (size_t)c * CH;
        __syncthreads();
        for (int p = tid; p < CH * 16; p += 512) {
            const int r = p >> 4, cc = p & 15;
            const u32x4 q = *(const u32x4*)(RQK + (row0 + r) * 1024 + h * 128 + cc * 8);
            const u32x4 k = *(const u32x4*)(RQK + (row0 + r) * 1024 + 512 + h * 128 + cc * 8);
            *(LAS u32x4*)(Qs + r * 136 + cc * 8) = q; *(LAS u32x4*)(Ks + r * 136 + cc * 8) = k;
            const float dec = __builtin_amdgcn_exp2f(lg2 * (float)(CH - 1 - r));
            const unsigned kw[4] = {k.x, k.y, k.z, k.w};
#pragma unroll
            for (int j = 0; j < 4; ++j) { const unsigned pk = cvt_pk_bf16(bflo(kw[j]) * dec, bfhi(kw[j]) * dec); KdT[(cc * 8 + 2 * j) * 72 + r] = (u16)(pk & 0xffffu); KdT[(cc * 8 + 2 * j + 1) * 72 + r] = (u16)(pk >> 16); }
        }
        for (int p = tid; p < CH * 32; p += 512) {
            const int r = p >> 5, cc = p & 31;
            const u32x4 v = *(const u32x4*)(RV + (row0 + r) * 1024 + h * 256 + cc * 8);
            const unsigned vw[4] = {v.x, v.y, v.z, v.w};
#pragma unroll
            for (int j = 0; j < 4; ++j) { VT[(cc * 8 + 2 * j) * 72 + r] = (u16)(vw[j] & 0xffffu); VT[(cc * 8 + 2 * j + 1) * 72 + r] = (u16)(vw[j] >> 16); }
        }
        __syncthreads();
        for (int tile = w; tile < TT * TT; tile += 8) {
            const int ti = tile / TT, tj = tile % TT; f32x4 a4 = {0.f, 0.f, 0.f, 0.f};
#pragma unroll
            for (int kk = 0; kk < 4; ++kk) {
                const bf16x8 a = *(const LAS bf16x8*)(Qs + (16 * ti + c16) * 136 + 32 * kk + 8 * g), b = *(const LAS bf16x8*)(Ks + (16 * tj + c16) * 136 + 32 * kk + 8 * g);
                a4 = __builtin_amdgcn_mfma_f32_16x16x32_bf16(a, b, a4, 0, 0, 0);
            }
#pragma unroll
            for (int i = 0; i < 4; ++i) { const int ri = 16 * ti + 4 * g + i, cj = 16 * tj + c16; const int dd = ri > cj ? ri - cj : cj - ri;
                const unsigned pk = cvt_pk_bf16(a4[i] * __builtin_amdgcn_exp2f(lg2 * (float)dd), 0.f); As[ri * 72 + cj] = (u16)(pk & 0xffffu); }
        }
        bf16x8 sb[4][2];
#pragma unroll
        for (int kk = 0; kk < 4; ++kk)
#pragma unroll
            for (int nt = 0; nt < 2; ++nt) { u32x4 t; t.x = cvt_pk_bf16(S[2 * kk][nt][0], S[2 * kk][nt][1]); t.y = cvt_pk_bf16(S[2 * kk][nt][2], S[2 * kk][nt][3]);
                t.z = cvt_pk_bf16(S[2 * kk + 1][nt][0], S[2 * kk + 1][nt][1]); t.w = cvt_pk_bf16(S[2 * kk + 1][nt][2], S[2 * kk + 1][nt][3]); sb[kk][nt] = __builtin_bit_cast(bf16x8, t); }
        f32x4 O[TT][2];
#pragma unroll
        for (int tt = 0; tt < TT; ++tt) {
            f32x4 o0 = {0.f, 0.f, 0.f, 0.f}, o1 = {0.f, 0.f, 0.f, 0.f};
#pragma unroll
            for (int kk = 0; kk < 4; ++kk) {
                const u32x2 lo = *(const LAS u32x2*)(Qs + (16 * tt + c16) * 136 + 32 * kk + 4 * g), hi = *(const LAS u32x2*)(Qs + (16 * tt + c16) * 136 + 32 * kk + 16 + 4 * g);
                u32x4 t; t.x = lo.x; t.y = lo.y; t.z = hi.x; t.w = hi.y; const bf16x8 a = __builtin_bit_cast(bf16x8, t);
                o0 = __builtin_amdgcn_mfma_f32_16x16x32_bf16(a, sb[kk][0], o0, 0, 0, 0); o1 = __builtin_amdgcn_mfma_f32_16x16x32_bf16(a, sb[kk][1], o1, 0, 0, 0);
            }
#pragma unroll
            for (int i = 0; i < 4; ++i) { const float dsc = __builtin_amdgcn_exp2f(lg2 * (float)(16 * tt + 4 * g + i + 1)); o0[i] *= dsc; o1[i] *= dsc; }
            O[tt][0] = o0; O[tt][1] = o1;
        }
        __syncthreads();
#pragma unroll
        for (int tt = 0; tt < TT; ++tt)
#pragma unroll
            for (int ks = 0; ks < KSN; ++ks) {
                const bf16x8 a = *(const LAS bf16x8*)(As + (16 * tt + c16) * 72 + 32 * ks + 8 * g);
#pragma unroll
                for (int nt = 0; nt < 2; ++nt) { const bf16x8 b = *(const LAS bf16x8*)(VT + (32 * w + 16 * nt + c16) * 72 + 32 * ks + 8 * g); O[tt][nt] = __builtin_amdgcn_mfma_f32_16x16x32_bf16(a, b, O[tt][nt], 0, 0, 0); }
            }
#pragma unroll
        for (int tt = 0; tt < TT; ++tt)
#pragma unroll
            for (int i = 0; i < 4; ++i) { float q = O[tt][0][i] * O[tt][0][i] + O[tt][1][i] * O[tt][1][i]; q += __shfl_xor(q, 1); q += __shfl_xor(q, 2); q += __shfl_xor(q, 4); q += __shfl_xor(q, 8);
                if (c16 == 0) red[w * 64 + 16 * tt + 4 * g + i] = q; }
        __syncthreads();
        if (tid < CH) { float s = 0.f;
#pragma unroll
            for (int ww = 0; ww < 8; ++ww) s += red[ww * 64 + tid];
            rstdv[tid] = rsqrtf(s * (1.f / 256.f) + 1e-6f); }
        __syncthreads();
#pragma unroll
        for (int tt = 0; tt < TT; ++tt)
#pragma unroll
            for (int i = 0; i < 4; ++i) { const int tok = 16 * tt + 4 * g + i; const float rsd = rstdv[tok];
#pragma unroll
                for (int nt = 0; nt < 2; ++nt) { const size_t off = (row0 + tok) * 1024 + h * 256 + 32 * w + 16 * nt + c16; const float gt = bf2f(RG[off]);
                    const unsigned pk = cvt_pk_bf16(O[tt][nt][i] * rsd * gt, 0.f); RV[off] = (u16)(pk & 0xffffu); } }
        const float cd = __builtin_amdgcn_exp2f(lg2 * (float)CH);
#pragma unroll
        for (int kt = 0; kt < 8; ++kt)
#pragma unroll
            for (int nt = 0; nt < 2; ++nt) S[kt][nt] = S[kt][nt] * cd;
#pragma unroll
        for (int ks = 0; ks < KSN; ++ks) {
            const bf16x8 b0 = *(const LAS bf16x8*)(VT + (32 * w + c16) * 72 + 32 * ks + 8 * g), b1 = *(const LAS bf16x8*)(VT + (32 * w + 16 + c16) * 72 + 32 * ks + 8 * g);
#pragma unroll
            for (int kt = 0; kt < 8; ++kt) { const bf16x8 a = *(const LAS bf16x8*)(KdT + (16 * kt + c16) * 72 + 32 * ks + 8 * g);
                S[kt][0] = __builtin_amdgcn_mfma_f32_16x16x32_bf16(a, b0, S[kt][0], 0, 0, 0); S[kt][1] = __builtin_amdgcn_mfma_f32_16x16x32_bf16(a, b1, S[kt][1], 0, 0, 0); }
        }
    }
#pragma unroll
    for (int kt = 0; kt < 8; ++kt)
#pragma unroll
        for (int nt = 0; nt < 2; ++nt)
#pragma unroll
            for (int i = 0; i < 4; ++i) sout[(size_t)(16 * kt + 4 * g + i) * 256 + 32 * w + 16 * nt + c16] = S[kt][nt][i];
    __syncthreads();
}
constexpr int R2_QS = 0, R2_KS = 17408, R2_KDT = 34816, R2_VT = 53248, R2_AS = 90112, R2_OS = 99328, R2_RED = 133120, R2_RSTD = 135168, R2_END = 135424;
__device__ __forceinline__ void ret_prompt_item(LAS unsigned char* lds, const u16* RQK, u16* RV, const u16* RG, float* sout, size_t rowbase, int h) {
    int tid = threadIdx.x; asm volatile("" : "+v"(tid));
    const int lane = tid & 63, w = __builtin_amdgcn_readfirstlane(tid >> 6), g = lane >> 4, c16 = lane & 15;
    LAS u16* Qs = (LAS u16*)(lds + R2_QS); LAS u16* Ks = (LAS u16*)(lds + R2_KS); LAS u16* KdT = (LAS u16*)(lds + R2_KDT); LAS u16* VT = (LAS u16*)(lds + R2_VT); LAS u16* As = (LAS u16*)(lds + R2_AS);
    LAS u16* Os = (LAS u16*)(lds + R2_OS); LAS float* red = (LAS float*)(lds + R2_RED); LAS float* rstdv = (LAS float*)(lds + R2_RSTD);
#define RBAR() asm volatile("s_waitcnt lgkmcnt(0)\n\ts_barrier" ::: "memory")
    const float lg2 = __log2f(1.f - __builtin_amdgcn_exp2f(-5.f - (float)h));
    const int rq = tid >> 4, cq = tid & 15;
    const int rv = tid >> 5, cv = tid & 31;
    const u16* gq = RQK + (rowbase + rq) * 1024 + h * 128 + cq * 8;
    const size_t voff = (rowbase + rv) * 1024 + h * 256 + cv * 8;
    u32x4 pq[2], pk[2], pv[4], pgc[4];
#define RLOAD(c) do { const size_t co_ = (size_t)(c) * 64 * 1024; \
        _Pragma("unroll") for (int i_ = 0; i_ < 2; ++i_) { pq[i_] = *(const u32x4*)(gq + co_ + (size_t)i_ * 32 * 1024); pk[i_] = *(const u32x4*)(gq + co_ + (size_t)i_ * 32 * 1024 + 512); } \
        _Pragma("unroll") for (int i_ = 0; i_ < 4; ++i_) { pv[i_] = *(const u32x4*)(RV + voff + co_ + (size_t)i_ * 16 * 1024); } } while (0)
#define GLOAD(c) do { const size_t co_ = (size_t)(c) * 64 * 1024; _Pragma("unroll") for (int i_ = 0; i_ < 4; ++i_) pgc[i_] = *(const u32x4*)(RG + voff + co_ + (size_t)i_ * 16 * 1024); } while (0)
    const int hb = c16 >> 3;
    const LAS u16* kb0 = KdT + c16 * 72 + ((g ^ hb) << 3); const LAS u16* kb2 = KdT + c16 * 72 + ((g ^ hb ^ 2) << 3);
    f32x4 S[8][2];
#pragma unroll
    for (int kt = 0; kt < 8; ++kt)
#pragma unroll
        for (int nt = 0; nt < 2; ++nt) S[kt][nt] = (f32x4){0.f, 0.f, 0.f, 0.f};
    RLOAD(0);
    asm volatile("s_waitcnt lgkmcnt(0)\n\ts_barrier" ::: "memory");
    const float cd = __builtin_amdgcn_exp2f(lg2 * 64.f);
    for (int c = 0; c < 32; ++c) {
        float lg = lg2, gf = (float)(4 * g), cf = (float)c16, rqf = (float)(63 - rq); int tw = w; asm volatile("" : "+v"(lg), "+v"(gf), "+v"(cf), "+v"(rqf), "+s"(tw));
#pragma unroll
        for (int i = 0; i < 2; ++i) {
            const int r = rq + 32 * i;
            *(LAS u32x4*)(Qs + r * 136 + cq * 8) = pq[i]; *(LAS u32x4*)(Ks + r * 136 + cq * 8) = pk[i];
            const float dec = __builtin_amdgcn_exp2f(lg * (rqf - (float)(32 * i)));
            const int pc = (((r >> 3) ^ (cq & 7)) << 3) | (r & 7);
            const unsigned kw[4] = {pk[i].x, pk[i].y, pk[i].z, pk[i].w};
#pragma unroll
            for (int j = 0; j < 4; ++j) { const unsigned pkd = cvt_pk_bf16(bflo(kw[j]) * dec, bfhi(kw[j]) * dec); KdT[(cq * 8 + 2 * j) * 72 + pc] = (u16)(pkd & 0xffffu); KdT[(cq * 8 + 2 * j + 1) * 72 + pc] = (u16)(pkd >> 16); }
        }
#pragma unroll
        for (int i = 0; i < 4; ++i) {
            const int r = rv + 16 * i; const int pc = (((r >> 3) ^ (cv & 7)) << 3) | (r & 7);
            const unsigned vw[4] = {pv[i].x, pv[i].y, pv[i].z, pv[i].w};
#pragma unroll
            for (int j = 0; j < 4; ++j) { VT[(cv * 8 + 2 * j) * 72 + pc] = (u16)(vw[j] & 0xffffu); VT[(cv * 8 + 2 * j + 1) * 72 + pc] = (u16)(vw[j] >> 16); }
        }
        __builtin_amdgcn_sched_barrier(0);
        RBAR();
#pragma unroll
        for (int t2 = 0; t2 < 2; ++t2) {
            const int tile = tw + 8 * t2, ti = tile >> 2, tj = tile & 3; f32x4 a4 = {0.f, 0.f, 0.f, 0.f}; const float dbase = (gf - cf) + (float)(16 * (ti - tj));
#pragma unroll
            for (int kk = 0; kk < 4; ++kk) {
                const bf16x8 a = *(const LAS bf16x8*)(Qs + (16 * ti + c16) * 136 + 32 * kk + 8 * g), b = *(const LAS bf16x8*)(Ks + (16 * tj + c16) * 136 + 32 * kk + 8 * g);
                a4 = __builtin_amdgcn_mfma_f32_16x16x32_bf16(a, b, a4, 0, 0, 0);
            }
#pragma unroll
            for (int i = 0; i < 4; ++i) { const int ri = 16 * ti + 4 * g + i, cj = 16 * tj + c16;
                const unsigned pkd = cvt_pk_bf16(a4[i] * __builtin_amdgcn_exp2f(lg * __builtin_fabsf(dbase + (float)i)), 0.f); As[ri * 72 + cj] = (u16)(pkd & 0xffffu); }
        }
        f32x4 O[4][2];
#pragma unroll
        for (int tt = 0; tt < 4; ++tt) { O[tt][0] = (f32x4){0.f, 0.f, 0.f, 0.f}; O[tt][1] = (f32x4){0.f, 0.f, 0.f, 0.f}; }
#pragma unroll
        for (int kk = 0; kk < 4; ++kk) {
            bf16x8 sb[2];
#pragma unroll
            for (int nt = 0; nt < 2; ++nt) { u32x4 t; t.x = cvt_pk_bf16(S[2 * kk][nt][0], S[2 * kk][nt][1]); t.y = cvt_pk_bf16(S[2 * kk][nt][2], S[2 * kk][nt][3]);
                t.z = cvt_pk_bf16(S[2 * kk + 1][nt][0], S[2 * kk + 1][nt][1]); t.w = cvt_pk_bf16(S[2 * kk + 1][nt][2], S[2 * kk + 1][nt][3]); sb[nt] = __builtin_bit_cast(bf16x8, t); }
#pragma unroll
            for (int tt = 0; tt < 4; ++tt) {
                const u32x2 lo = *(const LAS u32x2*)(Qs + (16 * tt + c16) * 136 + 32 * kk + 4 * g), hi = *(const LAS u32x2*)(Qs + (16 * tt + c16) * 136 + 32 * kk + 16 + 4 * g);
                u32x4 t; t.x = lo.x; t.y = lo.y; t.z = hi.x; t.w = hi.y; const bf16x8 a = __builtin_bit_cast(bf16x8, t);
                O[tt][0] = __builtin_amdgcn_mfma_f32_16x16x32_bf16(a, sb[0], O[tt][0], 0, 0, 0); O[tt][1] = __builtin_amdgcn_mfma_f32_16x16x32_bf16(a, sb[1], O[tt][1], 0, 0, 0);
            }
            __builtin_amdgcn_sched_barrier(0);
        }
#pragma unroll
        for (int tt = 0; tt < 4; ++tt)
#pragma unroll
            for (int i = 0; i < 4; ++i) { const float dsc = __builtin_amdgcn_exp2f(lg * (gf + (float)(16 * tt + i + 1))); O[tt][0][i] *= dsc; O[tt][1][i] *= dsc; }
        RBAR();
        if (c + 1 < 32) RLOAD(c + 1);
        const int vsw0 = (4 * w + (c16 >> 3)) & 7, vsw1 = (4 * w + 2 + (c16 >> 3)) & 7;
        bf16x8 vb[2][2];
#pragma unroll
        for (int ks = 0; ks < 2; ++ks) { vb[ks][0] = *(const LAS bf16x8*)(VT + (32 * w + c16) * 72 + (((4 * ks + g) ^ vsw0) << 3)); vb[ks][1] = *(const LAS bf16x8*)(VT + (32 * w + 16 + c16) * 72 + (((4 * ks + g) ^ vsw1) << 3)); }
#pragma unroll
        for (int tt = 0; tt < 4; ++tt)
#pragma unroll
            for (int ks = 0; ks < 2; ++ks) {
                const bf16x8 a = *(const LAS bf16x8*)(As + (16 * tt + c16) * 72 + 32 * ks + 8 * g);
                O[tt][0] = __builtin_amdgcn_mfma_f32_16x16x32_bf16(a, vb[ks][0], O[tt][0], 0, 0, 0); O[tt][1] = __builtin_amdgcn_mfma_f32_16x16x32_bf16(a, vb[ks][1], O[tt][1], 0, 0, 0); __builtin_amdgcn_sched_barrier(0);
            }
#pragma unroll
        for (int tt = 0; tt < 4; ++tt)
#pragma unroll
            for (int i = 0; i < 4; ++i) { const int tok = 16 * tt + 4 * g + i;
                float q = O[tt][0][i] * O[tt][0][i] + O[tt][1][i] * O[tt][1][i]; q += __shfl_xor(q, 1); q += __shfl_xor(q, 2); q += __shfl_xor(q, 4); q += __shfl_xor(q, 8);
                if (c16 == 0) red[tok * 8 + w] = q;
#pragma unroll
                for (int nt = 0; nt < 2; ++nt) { const unsigned pkd = cvt_pk_bf16(O[tt][nt][i], 0.f); Os[tok * 264 + 32 * w + 16 * nt + c16] = (u16)(pkd & 0xffffu); } }
        __builtin_amdgcn_sched_barrier(0);
        GLOAD(c);
#pragma unroll
        for (int kt = 0; kt < 8; ++kt) { S[kt][0] = S[kt][0] * cd; S[kt][1] = S[kt][1] * cd; }
#pragma unroll
        for (int ks = 0; ks < 2; ++ks)
#pragma unroll
            for (int kt = 0; kt < 8; ++kt) { const bf16x8 a = *(const LAS bf16x8*)(((kt & 1) ? kb2 : kb0) + 16 * kt * 72 + (((4 * ks) ^ ((kt & 2) ? 4 : 0)) << 3));
                S[kt][0] = __builtin_amdgcn_mfma_f32_16x16x32_bf16(a, vb[ks][0], S[kt][0], 0, 0, 0); S[kt][1] = __builtin_amdgcn_mfma_f32_16x16x32_bf16(a, vb[ks][1], S[kt][1], 0, 0, 0); if (kt & 1) __builtin_amdgcn_sched_barrier(0); }
        RBAR();
#pragma unroll
        for (int i = 0; i < 4; ++i) {
            const int tok = rv + 16 * i; const f32x4 p0 = *(const LAS f32x4*)(red + tok * 8), p1 = *(const LAS f32x4*)(red + tok * 8 + 4);
            const float rsd = rsqrtf((((p0[0] + p0[1]) + (p0[2] + p0[3])) + ((p1[0] + p1[1]) + (p1[2] + p1[3]))) * (1.f / 256.f) + 1e-6f);
            const u32x4 o = *(const LAS u32x4*)(Os + tok * 264 + cv * 8); const u32x4 gt = pgc[i]; u32x4 r;
            r.x = cvt_pk_bf16(bflo(o.x) * rsd * bflo(gt.x), bfhi(o.x) * rsd * bfhi(gt.x)); r.y = cvt_pk_bf16(bflo(o.y) * rsd * bflo(gt.y), bfhi(o.y) * rsd * bfhi(gt.y));
            r.z = cvt_pk_bf16(bflo(o.z) * rsd * bflo(gt.z), bfhi(o.z) * rsd * bfhi(gt.z)); r.w = cvt_pk_bf16(bflo(o.w) * rsd * bflo(gt.w), bfhi(o.w) * rsd * bfhi(gt.w));
            *(u32x4*)(RV + voff + (size_t)c * 64 * 1024 + (size_t)i * 16 * 1024) = r;
        }
    }
#pragma unroll
    for (int kt = 0; kt < 8; ++kt)
#pragma unroll
        for (int nt = 0; nt < 2; ++nt)
#pragma unroll
            for (int i = 0; i < 4; ++i) sout[(size_t)(16 * kt + 4 * g + i) * 256 + 32 * w + 16 * nt + c16] = S[kt][nt][i];
    __syncthreads();
#undef RBAR
#undef RLOAD
#undef GLOAD
}
constexpr int F2_BIAS = 0, F2_WS = 16512, F2_AW = 16640, F2_P = 17408, F2_M = 50176, F2_L = 50688, F2_ACC = 51200, F2_END = 83968;
__device__ __forceinline__ void fox_sample_item2(LAS unsigned char* lds, int b, int h, u16* FQ, const u16* FK, const u16* FV, const float* ck, const float* cv, const float* clf, const float* lfnew) {
    int tid = threadIdx.x; asm volatile("" : "+v"(tid));
    const int lane = tid & 63, w = __builtin_amdgcn_readfirstlane(tid >> 6), g = lane >> 4, c16 = lane & 15;
    LAS float* BIAS = (LAS float*)(lds + F2_BIAS); LAS float* WS = (LAS float*)(lds + F2_WS); LAS float* Aw = (LAS float*)(lds + F2_AW) + w * 16;
    LAS float* Pw = (LAS float*)(lds + F2_P) + w * 1024; LAS float* Mx = (LAS float*)(lds + F2_M); LAS float* Lx = (LAS float*)(lds + F2_L); LAS float* ACC = (LAS float*)(lds + F2_ACC);
    const size_t srow = (size_t)MP + (size_t)b * 16;
    __syncthreads();
    bf16x8 qa[2];
#pragma unroll
    for (int ks = 0; ks < 2; ++ks) qa[ks] = *(const bf16x8*)(FQ + (srow + c16) * 512 + h * 64 + 32 * ks + 8 * g);
    {
        float v[8]; float run = 0.f;
#pragma unroll
        for (int j = 0; j < 8; ++j) { run += clf[((size_t)b * PAST + 8 * tid + j) * 8 + h]; v[j] = run; }
        float tot = run;
#pragma unroll
        for (int o = 1; o < 64; o <<= 1) { const float u = __shfl_up(tot, o); if (lane >= o) tot += u; }
        if (lane == 63) WS[w] = tot;
        __syncthreads();
        float base = tot - run, all = 0.f;
#pragma unroll
        for (int ww = 0; ww < 8; ++ww) { const float x = WS[ww]; all += x; if (ww < w) base += x; }
#pragma unroll
        for (int j = 0; j < 8; ++j) BIAS[8 * tid + j] = (all - (base + v[j])) * L2E;
        if (tid == 0) { float cn = 0.f; for (int t = 0; t < 16; ++t) { cn += lfnew[((size_t)b * 16 + t) * 8 + h]; BIAS[PAST + t] = -cn * L2E; } }
    }
    __syncthreads();
    float mrun[4], lrun[4]; f32x4 acc[16];
    const int rr = lane >> 4, cc = lane & 15;
#pragma unroll
    for (int i = 0; i < 4; ++i) { mrun[i] = -INFINITY; lrun[i] = 0.f; }
#pragma unroll
    for (int t = 0; t < 16; ++t) acc[t] = (f32x4){0.f, 0.f, 0.f, 0.f};
    const int niter = (w == 0) ? 9 : 8;
    for (int it = 0; it < niter; ++it) {
        const bool isnew = it == 8;
        const int key0 = isnew ? 0 : 512 * w + 64 * it;
        f32x4 s[4]; f32x4 vv[16];
        if (!isnew) {
            f32x4 kf[4][2][2];
#pragma unroll
            for (int t = 0; t < 4; ++t) { const f32x4* kp = (const f32x4*)(ck + (((size_t)b * PAST + key0 + 16 * t + c16) * 8 + h) * 64 + 8 * g);
#pragma unroll
                for (int ks = 0; ks < 2; ++ks) { kf[t][ks][0] = kp[8 * ks]; kf[t][ks][1] = kp[8 * ks + 1]; } }
#pragma unroll
            for (int t = 0; t < 4; ++t) { f32x4 a4 = {0.f, 0.f, 0.f, 0.f};
#pragma unroll
                for (int ks = 0; ks < 2; ++ks) { u32x4 kb; kb.x = cvt_pk_bf16(kf[t][ks][0][0], kf[t][ks][0][1]); kb.y = cvt_pk_bf16(kf[t][ks][0][2], kf[t][ks][0][3]); kb.z = cvt_pk_bf16(kf[t][ks][1][0], kf[t][ks][1][1]); kb.w = cvt_pk_bf16(kf[t][ks][1][2], kf[t][ks][1][3]);
                    a4 = __builtin_amdgcn_mfma_f32_16x16x32_bf16(qa[ks], __builtin_bit_cast(bf16x8, kb), a4, 0, 0, 0); }
                const float bl = BIAS[key0 + 16 * t + c16];
                s[t] = a4 + bl; }
            { const f32x4* vp = (const f32x4*)(cv + (((size_t)b * PAST + key0 + rr) * 8 + h) * 64 + 4 * cc);
#pragma unroll
              for (int j = 0; j < 16; ++j) vv[j] = vp[(size_t)j * 4 * 128]; }
        } else {
            f32x4 a4 = {0.f, 0.f, 0.f, 0.f};
#pragma unroll
            for (int ks = 0; ks < 2; ++ks) { const bf16x8 kb = *(const bf16x8*)(FK + (srow + c16) * 512 + h * 64 + 32 * ks + 8 * g); a4 = __builtin_amdgcn_mfma_f32_16x16x32_bf16(qa[ks], kb, a4, 0, 0, 0); }
            const float bl = BIAS[PAST + c16];
#pragma unroll
            for (int i = 0; i < 4; ++i) s[0][i] = (c16 > 4 * g + i) ? -INFINITY : a4[i] + bl;
#pragma unroll
            for (int t = 1; t < 4; ++t) s[t] = (f32x4){-INFINITY, -INFINITY, -INFINITY, -INFINITY};
#pragma unroll
            for (int j = 0; j < 16; ++j) { if (j < 4) { const u32x2 x = *(const u32x2*)(FV + (srow + 4 * j + rr) * 512 + h * 64 + 4 * cc); vv[j] = (f32x4){bflo(x.x), bfhi(x.x), bflo(x.y), bfhi(x.y)}; } else vv[j] = (f32x4){0.f, 0.f, 0.f, 0.f}; }
        }
#pragma unroll
        for (int i = 0; i < 4; ++i) {
            float tm = fmaxf(fmaxf(s[0][i], s[1][i]), fmaxf(s[2][i], s[3][i]));
            tm = fmaxf(tm, __shfl_xor(tm, 1)); tm = fmaxf(tm, __shfl_xor(tm, 2)); tm = fmaxf(tm, __shfl_xor(tm, 4)); tm = fmaxf(tm, __shfl_xor(tm, 8));
            const float mn = fmaxf(mrun[i], tm), al = __builtin_amdgcn_exp2f(mrun[i] - mn);
            float ps = 0.f;
#pragma unroll
            for (int t = 0; t < 4; ++t) { const float p = __builtin_amdgcn_exp2f(s[t][i] - mn); s[t][i] = p; ps += p; }
            lrun[i] = lrun[i] * al + ps; mrun[i] = mn;
            if (c16 == 0) Aw[4 * g + i] = al;
        }
#pragma unroll
        for (int t = 0; t < 4; ++t) *(LAS f32x4*)(Pw + (16 * t + c16) * 16 + 4 * g) = s[t];
        asm volatile("s_waitcnt lgkmcnt(0)" ::: "memory"); __builtin_amdgcn_wave_barrier();
#pragma unroll
        for (int j = 0; j < 4; ++j) { const f32x4 al = *(const LAS f32x4*)(Aw + 4 * j); acc[4 * j] *= al[0]; acc[4 * j + 1] *= al[1]; acc[4 * j + 2] *= al[2]; acc[4 * j + 3] *= al[3]; }
        __builtin_amdgcn_sched_barrier(0);
#pragma unroll
        for (int j = 0; j < 16; ++j) {
            if (!isnew || j < 4) {
#pragma unroll
                for (int i = 0; i < 4; ++i) { const f32x4 p = *(const LAS f32x4*)(Pw + (4 * j + rr) * 16 + 4 * i);
                    acc[4 * i] += vv[j] * p[0]; acc[4 * i + 1] += vv[j] * p[1]; acc[4 * i + 2] += vv[j] * p[2]; acc[4 * i + 3] += vv[j] * p[3]; }
            }
            __builtin_amdgcn_sched_barrier(0);
        }
        asm volatile("s_waitcnt lgkmcnt(0)" ::: "memory"); __builtin_amdgcn_wave_barrier();
    }
#pragma unroll
    for (int i = 0; i < 4; ++i) { float l = lrun[i]; l += __shfl_xor(l, 1); l += __shfl_xor(l, 2); l += __shfl_xor(l, 4); l += __shfl_xor(l, 8); if (c16 == 0) { Mx[w * 16 + 4 * g + i] = mrun[i]; Lx[w * 16 + 4 * g + i] = l; } }
#pragma unroll
    for (int t = 0; t < 16; ++t) { f32x4 a = acc[t];
#pragma unroll
        for (int e = 0; e < 4; ++e) { a[e] += __shfl_xor(a[e], 16); a[e] += __shfl_xor(a[e], 32); }
        if (rr == 0) *(LAS f32x4*)(ACC + (w * 16 + t) * 64 + 4 * cc) = a; }
    __syncthreads();
    for (int e = tid; e < 1024; e += 512) {
        const int t = e >> 6, d = e & 63; float mm = -INFINITY;
#pragma unroll
        for (int ww = 0; ww < 8; ++ww) mm = fmaxf(mm, Mx[ww * 16 + t]);
        float num = 0.f, den = 0.f;
#pragma unroll
        for (int ww = 0; ww < 8; ++ww) { const float f = __builtin_amdgcn_exp2f(Mx[ww * 16 + t] - mm); num += ACC[(ww * 16 + t) * 64 + d] * f; den += Lx[ww * 16 + t] * f; }
        const unsigned pk = cvt_pk_bf16(num / den, 0.f); FQ[(srow + t) * 512 + h * 64 + d] = (u16)(pk & 0xffffu);
    }
    __syncthreads();
}
constexpr int F_Q = 0, F_BIAS = 4096, F_WS = 20736, F_P = 24576, F_M = 57344, F_L = 57856, F_ACC = 58368, F_END = 91136;
__device__ __forceinline__ void fox_sample_item(LAS unsigned char* lds, int b, int h, u16* FQ, const u16* FK, const u16* FV, const float* ck, const float* cv, const float* clf, const float* lfnew) {
    int tid = threadIdx.x; asm volatile("" : "+v"(tid)); const int lane = tid & 63, w = __builtin_amdgcn_readfirstlane(tid >> 6);
    LAS float* QF = (LAS float*)(lds + F_Q); LAS float* BIAS = (LAS float*)(lds + F_BIAS); LAS float* WS = (LAS float*)(lds + F_WS);
    LAS float* Pw = (LAS float*)(lds + F_P) + w * 1024; LAS float* Mx = (LAS float*)(lds + F_M); LAS float* Lx = (LAS float*)(lds + F_L); LAS float* ACC = (LAS float*)(lds + F_ACC);
    const size_t srow = (size_t)MP + (size_t)b * 16;
    __syncthreads();
    for (int e = tid; e < 1024; e += 512) QF[e] = bf2f(FQ[(srow + (e >> 6)) * 512 + h * 64 + (e & 63)]);
    {
        float v[8]; float run = 0.f;
#pragma unroll
        for (int j = 0; j < 8; ++j) { run += clf[((size_t)b * PAST + 8 * tid + j) * 8 + h]; v[j] = run; }
        float tot = run;
#pragma unroll
        for (int o = 1; o < 64; o <<= 1) { const float u = __shfl_up(tot, o); if (lane >= o) tot += u; }
        if (lane == 63) WS[w] = tot;
        __syncthreads();
        float base = tot - run, all = 0.f;
#pragma unroll
        for (int ww = 0; ww < 8; ++ww) { const float x = WS[ww]; all += x; if (ww < w) base += x; }
#pragma unroll
        for (int j = 0; j < 8; ++j) BIAS[8 * tid + j] = (all - (base + v[j])) * L2E;
        if (tid == 0) { float cn = 0.f; for (int t = 0; t < 16; ++t) { cn += lfnew[((size_t)b * 16 + t) * 8 + h]; BIAS[PAST + t] = -cn * L2E; } }
    }
    __syncthreads();
    float mrun[16], lrun[16], acc[16];
#pragma unroll
    for (int t = 0; t < 16; ++t) { mrun[t] = -INFINITY; lrun[t] = 0.f; acc[t] = 0.f; }
    const int ntile = (w == 0) ? 9 : 8;
    for (int tile = 0; tile < ntile; ++tile) {
        const bool isnew = tile == 8;
        const int key0 = isnew ? 0 : 512 * w + 64 * tile;
        float s[16];
        {
            f32x4 k[16];
            if (!isnew) { const f32x4* kp = (const f32x4*)(ck + (((size_t)b * PAST + key0 + lane) * 8 + h) * 64);
#pragma unroll
                for (int i = 0; i < 16; ++i) k[i] = kp[i];
            } else { const u32x4* kp = (const u32x4*)(FK + (srow + (lane & 15)) * 512 + h * 64);
#pragma unroll
                for (int i = 0; i < 8; ++i) { const u32x4 x = kp[i]; k[2 * i] = (f32x4){bflo(x.x), bfhi(x.x), bflo(x.y), bfhi(x.y)}; k[2 * i + 1] = (f32x4){bflo(x.z), bfhi(x.z), bflo(x.w), bfhi(x.w)}; } }
            const float bias = isnew ? BIAS[PAST + (lane & 15)] : BIAS[key0 + lane];
#pragma unroll
            for (int t = 0; t < 16; ++t) { float a = 0.f;
#pragma unroll
                for (int i = 0; i < 16; ++i) { const f32x4 q = *(const LAS f32x4*)(QF + t * 64 + 4 * i); a += (q[0] * k[i][0] + q[1] * k[i][1]) + (q[2] * k[i][2] + q[3] * k[i][3]); }
                a += bias; if (isnew && (lane > t || lane >= 16)) a = -INFINITY; s[t] = a; }
        }
#pragma unroll
        for (int t = 0; t < 16; ++t) {
            const float tm = wave_max(s[t]), mn = fmaxf(mrun[t], tm), al = __builtin_amdgcn_exp2f(mrun[t] - mn), p = __builtin_amdgcn_exp2f(s[t] - mn);
            Pw[lane * 16 + t] = p; acc[t] *= al; lrun[t] = lrun[t] * al + wave_sum(p); mrun[t] = mn;
        }
        asm volatile("s_waitcnt lgkmcnt(0)" ::: "memory"); __builtin_amdgcn_wave_barrier();
        const int nk = isnew ? 16 : 64;
        for (int kk = 0; kk < nk; ++kk) {
            const float v = isnew ? bf2f(FV[(srow + kk) * 512 + h * 64 + lane]) : cv[(((size_t)b * PAST + key0 + kk) * 8 + h) * 64 + lane];
#pragma unroll
            for (int i = 0; i < 4; ++i) { const f32x4 p = *(const LAS f32x4*)(Pw + kk * 16 + 4 * i); acc[4 * i] += p[0] * v; acc[4 * i + 1] += p[1] * v; acc[4 * i + 2] += p[2] * v; acc[4 * i + 3] += p[3] * v; }
        }
        asm volatile("s_waitcnt lgkmcnt(0)" ::: "memory"); __builtin_amdgcn_wave_barrier();
    }
#pragma unroll
    for (int t = 0; t < 16; ++t) { ACC[(w * 16 + t) * 64 + lane] = acc[t]; if (lane == 0) { Mx[w * 16 + t] = mrun[t]; Lx[w * 16 + t] = lrun[t]; } }
    __syncthreads();
    for (int e = tid; e < 1024; e += 512) {
        const int t = e >> 6, d = e & 63; float mm = -INFINITY;
#pragma unroll
        for (int ww = 0; ww < 8; ++ww) mm = fmaxf(mm, Mx[ww * 16 + t]);
        float num = 0.f, den = 0.f;
#pragma unroll
        for (int ww = 0; ww < 8; ++ww) { const float f = __builtin_amdgcn_exp2f(Mx[ww * 16 + t] - mm); num += ACC[(ww * 16 + t) * 64 + d] * f; den += Lx[ww * 16 + t] * f; }
        const unsigned pk = cvt_pk_bf16(num / den, 0.f); FQ[(srow + t) * 512 + h * 64 + d] = (u16)(pk & 0xffffu);
    }
    __syncthreads();
}

struct Args { const float* in[25]; float* out; unsigned char* ws; };
constexpr int P4_RET = 128, P4_FS = 128, P4_FP = 2048, P4_RS = 64, P4_ITEMS = P4_RET + P4_FS + P4_FP + P4_RS;

__device__ __forceinline__ unsigned char* kern_ptr(int k) {
    const __attribute__((address_space(4))) char* p = (const __attribute__((address_space(4))) char*)__builtin_amdgcn_kernarg_segment_ptr();
    asm volatile("" : "+s"(p));
    return *(unsigned char* const __attribute__((address_space(4)))*)(p + 8 * k);
}
__global__ void __launch_bounds__(512, 2) fwd(Args a) {
    extern __shared__ __attribute__((aligned(16))) unsigned char lds_raw[];
    LAS unsigned char* lds = (LAS unsigned char*)lds_raw;
    cg::grid_group grid = cg::this_grid();
    const int tid = threadIdx.x, lane = tid & 63, wave = __builtin_amdgcn_readfirstlane(tid >> 6);
    const int G = gridDim.x, bx = blockIdx.x;
#define WSB() kern_ptr(26)
#define OUTB() ((float*)kern_ptr(25))
#define INP(k) ((const float*)kern_ptr(k))
#define P16(off) ((u16*)(WSB() + (off)))
#define PF32(off) ((float*)(WSB() + (off)))
    unsigned* ctl = (unsigned*)(WSB() + O_CTL);
    LAS unsigned* misc = (LAS unsigned*)(lds + LDS_BYTES - 128);
    if (tid < 32) misc[tid] = 0u;
    __syncthreads();
    const xb::XcdBarrier bar = xb::xcd_barrier_post(ctl + 4096, (volatile XLAS unsigned*)(misc + 8));
#ifdef PROBE_PH
    unsigned long long pr_t0 = __builtin_amdgcn_s_memrealtime(), pr_acc = 0; int pr_n = 0;
#define GSYNC() do { xb::xcd_barrier(bar); if (pr_n == PROBE_PH) pr_acc = __builtin_amdgcn_s_memrealtime() - pr_t0; ++pr_n; pr_t0 = __builtin_amdgcn_s_memrealtime(); } while (0)
#else
#define GSYNC() xb::xcd_barrier(bar)
#endif

#ifndef PHM
#define PHM 0xffff
#endif
#define PH(k) if constexpr (((PHM)>>(k))&1)
    PH(0) {
        LAS float* scr = (LAS float*)(lds + wave * 16384);
        const int gw = bx * 8 + wave, NGW = G * 8;
        constexpr int I0 = 16 * 176, I1 = 44 * 32, I2 = 16 * 216, I3 = 16 * 32, I4 = 8 * 32, I5 = 16 * 32, I8 = 4 * 32;
        constexpr int NIT = I0 + I1 + I2 + I3 + I4 + I5 + I0 + I1 + I8 + I3;
        for (int it = gw; it < NIT; it += NGW) {
            int r = it;
            if (r < I0) { transpose_item(INP(9), INP(8), 1024, 5632, 1, P16(O_W1IN), 176, scr, r, lane); continue; } r -= I0;
            if (r < I1) { transpose_item(INP(10), nullptr, 2816, 1024, 0, P16(O_W1OUT), 32, scr, r, lane); continue; } r -= I1;
            if (r < I2) { transpose_item(INP(12), INP(11), 1024, 6664, 2, P16(O_WMIX), 216, scr, r, lane); continue; } r -= I2;
            if (r < I3) { transpose_item(INP(16), nullptr, 1024, 1024, 0, P16(O_WBR), 32, scr, r, lane); continue; } r -= I3;
            if (r < I4) { transpose_item(INP(17), nullptr, 512, 1024, 0, P16(O_WBF), 32, scr, r, lane); continue; } r -= I4;
            if (r < I5) { transpose_item(INP(18), nullptr, 1024, 1024, 0, P16(O_WOUT), 32, scr, r, lane); continue; } r -= I5;
            if (r < I0) { transpose_item(INP(20), INP(19), 1024, 5632, 1, P16(O_W2IN), 176, scr, r, lane); continue; } r -= I0;
            if (r < I1) { transpose_item(INP(21), nullptr, 2816, 1024, 0, P16(O_W2OUT), 32, scr, r, lane); continue; } r -= I1;
            if (r < I8) { transpose_item(INP(23), nullptr, 256, 1024, 0, P16(O_WPLE), 32, scr, r, lane); continue; } r -= I8;
            transpose_item(INP(24), INP(22), 1024, 1024, 0, P16(O_WPG), 32, scr, r, lane);
        }
        for (int rb = gw * 4; rb < MT; rb += NGW * 4) {
            f32x4 v[4][4]; float s[4];
#pragma unroll
            for (int r = 0; r < 4; ++r) { const int row = rb + r; const f32x4* xr = (const f32x4*)(row < MP ? INP(0) + (size_t)row * 1024 : INP(1) + (size_t)(row - MP) * 1024) + lane;
#pragma unroll
                for (int j = 0; j < 4; ++j) v[r][j] = xr[64 * j]; }
#pragma unroll
            for (int r = 0; r < 4; ++r) { float q = 0.f;
#pragma unroll
                for (int j = 0; j < 4; ++j) q += (v[r][j][0] * v[r][j][0] + v[r][j][1] * v[r][j][1]) + (v[r][j][2] * v[r][j][2] + v[r][j][3] * v[r][j][3]);
                s[r] = wave_sum(q);
                u32x2* o = (u32x2*)(P16(O_XB) + (size_t)(rb + r) * 1024) + lane;
#pragma unroll
                for (int j = 0; j < 4; ++j) { u32x2 w; w.x = cvt_pk_bf16(v[r][j][0], v[r][j][1]); w.y = cvt_pk_bf16(v[r][j][2], v[r][j][3]); o[64 * j] = w; } }
            { const int r = lane >> 4, c = lane & 15; const float sv = r == 0 ? s[0] : (r == 1 ? s[1] : (r == 2 ? s[2] : s[3])); PF32(O_SS)[(size_t)(rb + r) * 16 + c] = c == 0 ? sv : 0.f; }
        }
        for (int i = bx * 512 + tid; i < NPOS * 64; i += G * 512) {
            const int pi = i >> 6, f = i & 63; const float pos = pi < SEQ ? (float)pi : (float)(PAST + pi - SEQ);
            const float freq = __builtin_amdgcn_exp2f(-(float)f * (13.287712379549449f / 64.f)); const float ang = pos * freq;
            double rev = (double)ang * 0.15915494309189535; rev -= floor(rev); const float rf = (float)rev;
            PF32(O_TABC)[i] = __builtin_amdgcn_cosf(rf); PF32(O_TABS)[i] = __builtin_amdgcn_sinf(rf);
        }
    }
    if (gridDim.x == 0x7fffffffu) grid.sync();
    GSYNC();
    PH(1) { pg8::Gemm g{P16(O_XB), P16(O_W1IN), MT, 5632, 1024}; pg8::StaticOrder S; S.init(MT, 5632, G, bx); EpiSwiglu E{P16(O_ACT1), PF32(O_SS)};
      pg8::gemm_phase<EpiSwiglu, pg8::StaticOrder, true, true>(lds, g, S, E); }
    GSYNC();
    PH(2) { const FResid f{P16(O_XB), PF32(O_SS), 0.5f};
      small_gemm<FResid>(lds, P16(O_ACT1) + (size_t)MP * DFF, P16(O_W1OUT), DFF, f, bx, G);
      pg8::Gemm g{P16(O_ACT1), P16(O_W1OUT), MP, 1024, DFF}; pg8::StaticOrder S; S.init(MP, 1024, G, bx); const EpiWrap<FResid> E{f};
      pg8::gemm_phase<EpiWrap<FResid>, pg8::StaticOrder, true, true>(lds, g, S, E); }
    GSYNC();
    PH(3) { pg8::Gemm g{P16(O_XB), P16(O_WMIX), MT, NMIX, 1024}; pg8::StaticOrder S; S.init(MT, NMIX, G, bx);
      EpiMix E{PF32(O_SS), PF32(O_TABC), PF32(O_TABS), INP(14), INP(15), INP(13), P16(O_RQK), P16(O_RV), P16(O_RG), P16(O_FQ), P16(O_FK), P16(O_FV), P16(O_ZG), OUTB(), OUTB() + OUT_YP};
      pg8::gemm_phase<EpiMix, pg8::StaticOrder, true, true>(lds, g, S, E); }
    GSYNC();
    {
        LAS unsigned* slot = misc;
        float dbound;
        { float gq_ = __builtin_fabsf(INP(14)[lane]), gk_ = __builtin_fabsf(INP(15)[lane]);
#pragma unroll
          for (int o_ = 1; o_ < 64; o_ <<= 1) { gq_ = fmaxf(gq_, __shfl_xor(gq_, o_)); gk_ = fmaxf(gk_, __shfl_xor(gk_, o_)); }
          dbound = gq_ * gk_ * (64.f * 0.125f * L2E * 1.02f) + 1.f; if (tid == 0) misc[2] = __float_as_uint(dbound); }
        for (;;) {
            __syncthreads();
            if (tid == 0) slot[0] = atomicAdd(ctl, 1u);
            __syncthreads();
            const int it = (int)slot[0];
            if (it >= P4_ITEMS) break;
#ifdef PROBE_ITEM
            const unsigned long long pi_t0 = __builtin_amdgcn_s_memrealtime();
#endif
            if (it < P4_RET) { const int b = it >> 2, h = it & 3;
                PH(10) ret_prompt_item(lds, P16(O_RQK), P16(O_RV), P16(O_RG), OUTB() + OUT_RSP + (size_t)(b * 4 + h) * 32768, (size_t)b * SEQ, h);
            } else if (it < P4_RET + P4_FS) { const int j = it - P4_RET, b = j >> 3, h = j & 7;
                PH(11) fox_sample_item2(lds, b, h, P16(O_FQ), P16(O_FK), P16(O_FV), INP(5), INP(6), INP(7), OUTB() + OUT_LS);
            } else if (it < P4_RET + P4_FS + P4_FP) { const int j = it - P4_RET - P4_FS, qb = 7 - (j >> 8), bh = j & 255;
                PH(12) attn_body::attn_unit<8>(bh >> 3, bh & 7, qb, (const attn_body::bf16*)P16(O_FQ), (const attn_body::bf16*)P16(O_FK), (const attn_body::bf16*)P16(O_FV), (attn_body::bf16*)P16(O_FQ), OUTB() + OUT_YP, __uint_as_float(misc[2]), (char*)lds_raw);
            } else { const int j = it - P4_RET - P4_FS - P4_FP, b = j >> 2, h = j & 3;
                PH(13) ret_item<16>(lds, P16(O_RQK), P16(O_RV), P16(O_RG), INP(4) + (size_t)(b * 4 + h) * 32768, OUTB() + OUT_RSS + (size_t)(b * 4 + h) * 32768, (size_t)MP + (size_t)b * 16, 1, h);
            }
#ifdef PROBE_ITEM
            { const int kind = it < P4_RET ? 0 : (it < P4_RET + P4_FS ? 1 : (it < P4_RET + P4_FS + P4_FP ? 2 : 3));
              if (kind == PROBE_ITEM && tid == 0) atomicMax(ctl + 16, (unsigned)(__builtin_amdgcn_s_memrealtime() - pi_t0)); }
#endif
        }
    }
    GSYNC();
    {
        for (size_t i = (size_t)bx * 512 + tid; i < (size_t)MT * 32; i += (size_t)G * 512) {
            const size_t e8 = i * 8; const float* src = e8 < (size_t)MP * 256 ? INP(2) + e8 : INP(3) + (e8 - (size_t)MP * 256);
            const f32x4 v0 = *(const f32x4*)src, v1 = *(const f32x4*)(src + 4);
            u32x4 w; w.x = cvt_pk_bf16(v0[0], v0[1]); w.y = cvt_pk_bf16(v0[2], v0[3]); w.z = cvt_pk_bf16(v1[0], v1[1]); w.w = cvt_pk_bf16(v1[2], v1[3]);
            *(u32x4*)(P16(O_FV) + e8) = w;
        }
        PH(5) { const FGate<false> f0{P16(O_RG), P16(O_ZG), nullptr}; const FGate<true> f1{P16(O_RG), P16(O_ZG), nullptr};
          small_gemm<FGate<false>>(lds, P16(O_RV) + (size_t)MP * 1024, P16(O_WBR), 1024, f0, bx, G);
          small_gemm<FGate<true>>(lds, P16(O_FQ) + (size_t)MP * 512, P16(O_WBF), 512, f1, bx, G);
          { pg8::Gemm g{P16(O_RV), P16(O_WBR), MP, 1024, 1024}; pg8::StaticOrder S; S.init(MP, 1024, G, bx); const EpiWrap<FGate<false>> E{f0};
            pg8::gemm_phase<EpiWrap<FGate<false>>, pg8::StaticOrder, true, true>(lds, g, S, E); }
          { pg8::Gemm g{P16(O_FQ), P16(O_WBF), MP, 1024, 512}; pg8::StaticOrder S; S.init(MP, 1024, G, bx); const EpiWrap<FGate<true>> E{f1};
            pg8::gemm_phase<EpiWrap<FGate<true>>, pg8::StaticOrder, true, true>(lds, g, S, E); } }
    }
    GSYNC();
    PH(6) { const FResid f{P16(O_XB), PF32(O_SS), 1.0f};
      small_gemm<FResid>(lds, P16(O_RG) + (size_t)MP * 1024, P16(O_WOUT), 1024, f, bx, G);
      pg8::Gemm g{P16(O_RG), P16(O_WOUT), MP, 1024, 1024}; pg8::StaticOrder S; S.init(MP, 1024, G, bx); const EpiWrap<FResid> E{f};
      pg8::gemm_phase<EpiWrap<FResid>, pg8::StaticOrder, true, true>(lds, g, S, E); }
    GSYNC();
    PH(7) { pg8::Gemm g{P16(O_XB), P16(O_W2IN), MT, 5632, 1024}; pg8::StaticOrder S; S.init(MT, 5632, G, bx); EpiSwiglu E{P16(O_ACT2), PF32(O_SS)};
      pg8::gemm_phase<EpiSwiglu, pg8::StaticOrder, true, true>(lds, g, S, E); }
    GSYNC();
    PH(8) { const FResid f{P16(O_XB), PF32(O_SS), 0.5f}; const FPlain fp{P16(O_RQK), nullptr};
      small_gemm<FResid>(lds, P16(O_ACT2) + (size_t)MP * DFF, P16(O_W2OUT), DFF, f, bx, G);
      small_gemm<FPlain>(lds, P16(O_FV) + (size_t)MP * 256, P16(O_WPLE), 256, fp, bx, G);
      { pg8::Gemm g{P16(O_ACT2), P16(O_W2OUT), MP, 1024, DFF}; pg8::StaticOrder S; S.init(MP, 1024, G, bx); const EpiWrap<FResid> E{f};
        pg8::gemm_phase<EpiWrap<FResid>, pg8::StaticOrder, true, true>(lds, g, S, E); }
      { pg8::Gemm g{P16(O_FV), P16(O_WPLE), MP, 1024, 256}; pg8::StaticOrder S; S.init(MP, 1024, G, bx); const EpiWrap<FPlain> E{fp};
        pg8::gemm_phase<EpiWrap<FPlain>, pg8::StaticOrder, true, true>(lds, g, S, E); } }
    GSYNC();
    PH(9) { const FFinal f{OUTB() + OUT_YP, OUTB() + OUT_YS, P16(O_XB), P16(O_RQK), PF32(O_SS)};
      small_gemm<FFinal>(lds, P16(O_XB) + (size_t)MP * 1024, P16(O_WPG), 1024, f, bx, G);
      pg8::Gemm g{P16(O_XB), P16(O_WPG), MP, 1024, 1024}; pg8::StaticOrder S; S.init(MP, 1024, G, bx); const EpiWrap<FFinal> E{f};
      pg8::gemm_phase<EpiWrap<FFinal>, pg8::StaticOrder, true, true>(lds, g, S, E); }
#ifdef PROBE_ITEM
    GSYNC();
    if (bx == 0) { const unsigned long long t1 = __builtin_amdgcn_s_memrealtime(); const unsigned long long dur = __hip_atomic_load(ctl + 16, __ATOMIC_RELAXED, __HIP_MEMORY_SCOPE_AGENT); while (__builtin_amdgcn_s_memrealtime() - t1 < dur) __builtin_amdgcn_s_sleep(8); }
#endif
#ifdef PROBE_PH
    if (pr_n == PROBE_PH) pr_acc = __builtin_amdgcn_s_memrealtime() - pr_t0;
    if (bx == 0) { const unsigned long long t1 = __builtin_amdgcn_s_memrealtime(); while (__builtin_amdgcn_s_memrealtime() - t1 < pr_acc) __builtin_amdgcn_s_sleep(8); }
#endif
}
}

extern "C" void kernel_launch(void* const* d_in, const int* in_sizes, int n_in, void* d_out, int out_size, void* d_ws, size_t ws_size, hipStream_t stream) {
    static int grid = 0;
    if (grid == 0) {
        if (n_in != 25 || (size_t)out_size != mk::OUT_END || ws_size < mk::WS_NEED) { fprintf(stderr, "kernel_launch: unexpected shapes (n_in %d out %d ws %zu need %zu)\n", n_in, out_size, ws_size, (size_t)mk::WS_NEED); grid = -1; return; }
        int dev = 0, cus = 0, per_cu = 0;
        hipGetDevice(&dev); hipDeviceGetAttribute(&cus, hipDeviceAttributeMultiprocessorCount, dev);
        if (hipFuncSetAttribute((const void*)mk::fwd, hipFuncAttributeMaxDynamicSharedMemorySize, mk::LDS_BYTES) != hipSuccess) { fprintf(stderr, "kernel_launch: hipFuncSetAttribute failed\n"); grid = -1; return; }
        hipOccupancyMaxActiveBlocksPerMultiprocessor(&per_cu, (const void*)mk::fwd, 512, mk::LDS_BYTES);
        if (per_cu < 1) { fprintf(stderr, "kernel_launch: occupancy query says %d blocks per CU\n", per_cu); per_cu = 1; }
        grid = cus;
    }
    if (grid < 0) return;
    if (hipMemsetAsync((char*)d_ws + mk::O_CTL, 0, 65536, stream) != hipSuccess) { fprintf(stderr, "kernel_launch: memset failed\n"); return; }
    mk::Args a{};
    for (int i = 0; i < 25; ++i) a.in[i] = (const float*)d_in[i];
    a.out = (float*)d_out; a.ws = (unsigned char*)d_ws;
    void* args[] = {&a};
    hipError_t e = hipLaunchCooperativeKernel((const void*)mk::fwd, dim3(grid), dim3(512), args, mk::LDS_BYTES, stream);
    if (e != hipSuccess) fprintf(stderr, "cooperative launch failed: %s (grid %d)\n", hipGetErrorString(e), grid);
}
```
